# Optimizing an MI355X kernel written in HIP

```python
import math
import jax, jax.numpy as jnp
from jax import lax
import numpy as np

D_MODEL = 2048
BATCH = 8
SEQ = 4096
DEPTH = 2

CHUNK = 64
HEAD_DIM = 64
D_MIX = D_MODEL
A_WIDTH = D_MIX // 4
B_WIDTH = D_MIX // 4
C_WIDTH = D_MIX // 4
D_WIDTH = D_MIX - A_WIDTH - B_WIDTH - C_WIDTH
A_HEADS = A_WIDTH // HEAD_DIM
B_HEADS = B_WIDTH // HEAD_DIM
C_HEADS = C_WIDTH // (2 * HEAD_DIM)
A_DECAY_LORA = 64
A_ICLR_LORA = 64
A_GATE_LORA = 128
B_LEFT_CHUNKS = 8
B_BAND = (B_LEFT_CHUNKS + 1) * CHUNK
REL_CLIP = 128
T5_BUCKETS = 32
T5_MAX_DIST = 128
Q_BLOCK = 128
CONV_WIDTH = 3
N_GROUPS = 4
EXPERTS_PER_GROUP = 8
N_EXPERTS = N_GROUPS * EXPERTS_PER_GROUP
TOP_K_IN_GROUP = 2
EXPERT_HIDDEN = 256
RMS_EPS = 1e-6
RWKV_GN_EPS = 64e-5
SUBLN_EPS = 1e-5
NEG_INF = -1e30

A_COLS = 3 * A_WIDTH + A_DECAY_LORA + A_ICLR_LORA + A_GATE_LORA
B_COLS = 3 * B_WIDTH
C_COLS = 3 * C_WIDTH
D_COLS = 3 * D_WIDTH
IN_COLS = A_COLS + B_COLS + C_COLS + D_COLS

kernel_name = "hybrid_parallel_heads_streaming_encoder"


def rmsnorm(x, g, eps=RMS_EPS):
    xf = x.astype(jnp.float32)
    y = xf * lax.rsqrt(jnp.mean(xf * xf, axis=-1, keepdims=True) + eps)
    return (y * g.astype(jnp.float32)).astype(x.dtype)


def shift_right(x):
    return jnp.pad(x, ((0, 0), (1, 0), (0, 0)))[:, :-1]


def rwkv7_step(state, inp):
    r, w, k, v, a, b = inp
    sa = jnp.einsum('bhvk,bhk->bhv', state, a)
    state = (state * w[:, :, None, :] + sa[..., None] * b[:, :, None, :]
             + v[..., None] * k[:, :, None, :])
    y = jnp.einsum('bhvk,bhk->bhv', state, r)
    return state, y


def rwkv7_mixer(p, mu, w0, w2, a0, a2, g2, k_k, k_a, r_k, gn_w, gn_b):
    dtype = p.dtype
    p = p.astype(jnp.float32)
    bsz, slen, _ = p.shape
    p = p + (shift_right(p) - p) * mu
    o1 = A_WIDTH; o2 = 2 * A_WIDTH; o3 = 3 * A_WIDTH
    o4 = o3 + A_DECAY_LORA; o5 = o4 + A_ICLR_LORA
    r, k, v, w_lo, a_lo, g_lo = jnp.split(p, [o1, o2, o3, o4, o5], axis=-1)
    w = -jax.nn.softplus(-(w0 + jnp.tanh(w_lo) @ w2)) - 0.5
    decay = jnp.exp(-jnp.exp(w))
    a = jax.nn.sigmoid(a0 + a_lo @ a2)
    g = jax.nn.sigmoid(g_lo) @ g2
    heads = lambda t: t.reshape(bsz, slen, A_HEADS, HEAD_DIM)
    kk = heads(k * k_k)
    kk = kk / jnp.maximum(jnp.sqrt(jnp.sum(kk * kk, -1, keepdims=True)), 1e-12)
    k = k * (1.0 + (a - 1.0) * k_a)
    rh, kh, vh, ah, dh = heads(r), heads(k), heads(v), heads(a), heads(decay)
    xs = tuple(jnp.moveaxis(t, 1, 0) for t in (rh, dh, kh, vh, -kk, kk * ah))
    state0 = jnp.zeros((bsz, A_HEADS, HEAD_DIM, HEAD_DIM), jnp.float32)
    _, y = lax.scan(rwkv7_step, state0, xs)
    y = jnp.moveaxis(y, 0, 1)
    mean = jnp.mean(y, -1, keepdims=True)
    var = jnp.mean((y - mean) ** 2, -1, keepdims=True)
    y = ((y - mean) * lax.rsqrt(var + RWKV_GN_EPS)).reshape(bsz, slen, A_WIDTH) * gn_w + gn_b
    bonus = jnp.sum(rh * kh * r_k, -1, keepdims=True) * vh
    y = y + bonus.reshape(bsz, slen, A_WIDTH)
    return (y * g).astype(dtype)


def chunk_band_attention(q, k, v, rel_bias):
    bsz, slen, nh, dh = q.shape
    n_chunks = slen // CHUNK
    pad = B_LEFT_CHUNKS * CHUNK
    k_pad = jnp.pad(k, ((0, 0), (pad, 0), (0, 0), (0, 0)))
    v_pad = jnp.pad(v, ((0, 0), (pad, 0), (0, 0), (0, 0)))
    qi = jnp.arange(CHUNK)
    kl = jnp.arange(B_BAND)
    dist = (pad + qi[:, None]) - kl[None, :]
    bias = rel_bias[:, jnp.clip(dist, -REL_CLIP, REL_CLIP) + REL_CLIP].astype(jnp.float32)
    q_chunks = jnp.moveaxis(q.reshape(bsz, n_chunks, CHUNK, nh, dh), 1, 0)
    scale = dh ** -0.5

    def one_chunk(args):
        c, qc = args
        kc = lax.dynamic_slice_in_dim(k_pad, c * CHUNK, B_BAND, axis=1)
        vc = lax.dynamic_slice_in_dim(v_pad, c * CHUNK, B_BAND, axis=1)
        s = jnp.einsum('bqhd,bkhd->bhqk', qc, kc).astype(jnp.float32) * scale + bias
        valid = (c * CHUNK - pad + kl) >= 0
        s = jnp.where(valid[None, None, None, :], s, NEG_INF)
        pr = jax.nn.softmax(s, axis=-1)
        return jnp.einsum('bhqk,bkhd->bqhd', pr.astype(vc.dtype), vc)

    out = lax.map(one_chunk, (jnp.arange(n_chunks), q_chunks))
    return jnp.moveaxis(out, 0, 1).reshape(bsz, slen, nh * dh)


def t5_buckets(rel):
    nb = T5_BUCKETS // 2
    max_exact = nb // 2
    ret = (rel > 0).astype(jnp.int32) * nb
    n = jnp.abs(rel)
    nf = jnp.maximum(n, 1).astype(jnp.float32)
    large = max_exact + (jnp.log(nf / max_exact) / math.log(T5_MAX_DIST / max_exact)
                         * (nb - max_exact)).astype(jnp.int32)
    large = jnp.minimum(large, nb - 1)
    return ret + jnp.where(n < max_exact, n, large)


def diff_attention(q, k, v, t5_table, lam, lam_init, subln_w):
    bsz, slen, nh, _, dh = q.shape
    nq = slen // Q_BLOCK
    q_blocks = jnp.moveaxis(q.reshape(bsz, nq, Q_BLOCK, nh, 2, dh), 1, 0)
    key_pos = jnp.arange(slen)
    scale = dh ** -0.5

    def one_block(args):
        bi, qb = args
        q_pos = bi * Q_BLOCK + jnp.arange(Q_BLOCK)
        bias = t5_table[t5_buckets(key_pos[None, :] - q_pos[:, None])]
        bias = jnp.moveaxis(bias, -1, 0).astype(jnp.float32)
        allowed = (key_pos[None, :] // CHUNK) <= (q_pos[:, None] // CHUNK)
        s = jnp.einsum('bqhcd,bkhcd->bhcqk', qb, k).astype(jnp.float32) * scale + bias[None, :, None]
        s = jnp.where(allowed, s, NEG_INF)
        pr = jax.nn.softmax(s, axis=-1)
        attn = pr[:, :, 0] - lam * pr[:, :, 1]
        return jnp.einsum('bhqk,bkhd->bqhd', attn.astype(v.dtype), v)

    out = lax.map(one_block, (jnp.arange(nq), q_blocks))
    out = jnp.moveaxis(out, 0, 1).reshape(bsz, slen, nh, 2 * dh).astype(jnp.float32)
    out = out * lax.rsqrt(jnp.mean(out * out, -1, keepdims=True) + SUBLN_EPS)
    out = out * subln_w * (1.0 - lam_init)
    return out.reshape(bsz, slen, nh * 2 * dh).astype(v.dtype)


def short_conv_mixer(p, conv_w):
    b_gate, c_gate, h = jnp.split(p, 3, axis=-1)
    u = c_gate * h
    slen = u.shape[1]
    u_pad = jnp.pad(u, ((0, 0), (CONV_WIDTH - 1, 0), (0, 0)))
    y = conv_w[0] * u_pad[:, :slen] + conv_w[1] * u_pad[:, 1:slen + 1] + conv_w[2] * u_pad[:, 2:slen + 2]
    return b_gate * y


def hier_moe(x, wg_r, bg_r, we_r, be_r, w_gate, w_up, w_down):
    bsz, slen, d = x.shape
    xt = x.reshape(-1, d)
    g_logits = (xt @ wg_r).astype(jnp.float32) + bg_r
    g_prob = jax.nn.softmax(g_logits, axis=-1)
    g_idx = jnp.argmax(g_logits, axis=-1)
    g_w = jnp.take_along_axis(g_prob, g_idx[:, None], axis=-1)
    e_logits = ((xt @ we_r).astype(jnp.float32) + be_r).reshape(-1, N_GROUPS, EXPERTS_PER_GROUP)
    e_sel = jnp.take_along_axis(e_logits, g_idx[:, None, None], axis=1)[:, 0]
    e_prob = jax.nn.softmax(e_sel, axis=-1)
    top_p, top_i = lax.top_k(e_prob, TOP_K_IN_GROUP)
    top_p = top_p / jnp.sum(top_p, -1, keepdims=True)
    weights = g_w * top_p
    expert_ids = g_idx[:, None] * EXPERTS_PER_GROUP + top_i
    combine = jnp.sum(jax.nn.one_hot(expert_ids, N_EXPERTS, dtype=jnp.float32) * weights[..., None], axis=1)
    out = jnp.zeros(xt.shape, jnp.float32)
    for e in range(N_EXPERTS):
        h = jax.nn.silu(xt @ w_gate[e]) * (xt @ w_up[e])
        out = out + combine[:, e:e + 1] * (h @ w_down[e]).astype(jnp.float32)
    return out.astype(x.dtype).reshape(bsz, slen, d)


def setup_inputs(seed: int = 0) -> dict:
    key = jax.random.key(seed)
    ks = jax.random.split(key, 32)
    f32 = jnp.float32
    nrm = lambda k, shape, s: jax.random.normal(k, shape, f32) * s
    L = DEPTH
    return {
        "x": nrm(ks[0], (BATCH, SEQ, D_MODEL), 1.0),
        "w_in": nrm(ks[1], (L, D_MODEL, IN_COLS), D_MODEL ** -0.5),
        "w_out": nrm(ks[2], (L, D_MIX, D_MODEL), D_MIX ** -0.5),
        "norm_mix": 1.0 + nrm(ks[3], (L, D_MODEL), 0.02),
        "norm_ffn": 1.0 + nrm(ks[4], (L, D_MODEL), 0.02),
        "norm_final": 1.0 + nrm(ks[5], (D_MODEL,), 0.02),
        "rwkv_mu": jax.random.uniform(ks[6], (L, A_COLS), f32, 0.1, 0.9),
        "rwkv_w0": nrm(ks[7], (L, A_WIDTH), 0.5) - 0.5,
        "rwkv_w2": nrm(ks[8], (L, A_DECAY_LORA, A_WIDTH), 0.5 * A_DECAY_LORA ** -0.5),
        "rwkv_a0": nrm(ks[9], (L, A_WIDTH), 0.1),
        "rwkv_a2": nrm(ks[10], (L, A_ICLR_LORA, A_WIDTH), 0.5 * A_ICLR_LORA ** -0.5),
        "rwkv_g2": nrm(ks[11], (L, A_GATE_LORA, A_WIDTH), A_GATE_LORA ** -0.5),
        "rwkv_k_k": 0.85 + nrm(ks[12], (L, A_WIDTH), 0.02),
        "rwkv_k_a": 1.0 + nrm(ks[13], (L, A_WIDTH), 0.02),
        "rwkv_r_k": nrm(ks[14], (L, A_HEADS, HEAD_DIM), 0.1),
        "rwkv_gn_w": 1.0 + nrm(ks[15], (L, A_WIDTH), 0.02),
        "rwkv_gn_b": nrm(ks[16], (L, A_WIDTH), 0.02),
        "band_rel_bias": nrm(ks[17], (L, B_HEADS, 2 * REL_CLIP + 1), 0.5),
        "t5_rel_bias": nrm(ks[18], (T5_BUCKETS, C_HEADS), 0.5),
        "diff_lambda_q1": nrm(ks[19], (L, HEAD_DIM), 0.1),
        "diff_lambda_k1": nrm(ks[20], (L, HEAD_DIM), 0.1),
        "diff_lambda_q2": nrm(ks[21], (L, HEAD_DIM), 0.1),
        "diff_lambda_k2": nrm(ks[22], (L, HEAD_DIM), 0.1),
        "diff_subln_w": 1.0 + nrm(ks[23], (L, 2 * HEAD_DIM), 0.02),
        "conv_w": nrm(ks[24], (L, CONV_WIDTH, D_WIDTH), CONV_WIDTH ** -0.5),
        "router_group_w": nrm(ks[25], (L, D_MODEL, N_GROUPS), D_MODEL ** -0.5),
        "router_group_b": nrm(ks[26], (L, N_GROUPS), 0.01),
        "router_expert_w": nrm(ks[27], (L, D_MODEL, N_EXPERTS), D_MODEL ** -0.5),
        "router_expert_b": nrm(ks[28], (L, N_EXPERTS), 0.01),
        "expert_w_gate": nrm(ks[29], (L, N_EXPERTS, D_MODEL, EXPERT_HIDDEN), D_MODEL ** -0.5),
        "expert_w_up": nrm(ks[30], (L, N_EXPERTS, D_MODEL, EXPERT_HIDDEN), D_MODEL ** -0.5),
        "expert_w_down": nrm(ks[31], (L, N_EXPERTS, EXPERT_HIDDEN, D_MODEL), EXPERT_HIDDEN ** -0.5),
    }


def reference(x, w_in, w_out, norm_mix, norm_ffn, norm_final,
              rwkv_mu, rwkv_w0, rwkv_w2, rwkv_a0, rwkv_a2, rwkv_g2, rwkv_k_k, rwkv_k_a,
              rwkv_r_k, rwkv_gn_w, rwkv_gn_b, band_rel_bias, t5_rel_bias,
              diff_lambda_q1, diff_lambda_k1, diff_lambda_q2, diff_lambda_k2, diff_subln_w,
              conv_w, router_group_w, router_group_b, router_expert_w, router_expert_b,
              expert_w_gate, expert_w_up, expert_w_down):
    bsz, slen, _ = x.shape
    for l in range(DEPTH):
        xn = rmsnorm(x, norm_mix[l])
        p = xn @ w_in[l]
        pA, pB, pC, pD = jnp.split(p, [A_COLS, A_COLS + B_COLS, A_COLS + B_COLS + C_COLS], axis=-1)

        yA = rwkv7_mixer(pA, rwkv_mu[l], rwkv_w0[l], rwkv_w2[l], rwkv_a0[l], rwkv_a2[l],
                         rwkv_g2[l], rwkv_k_k[l], rwkv_k_a[l], rwkv_r_k[l],
                         rwkv_gn_w[l], rwkv_gn_b[l])

        qB, kB, vB = [t.reshape(bsz, slen, B_HEADS, HEAD_DIM) for t in jnp.split(pB, 3, axis=-1)]
        yB = chunk_band_attention(qB, kB, vB, band_rel_bias[l])

        qC, kC, vC = jnp.split(pC, 3, axis=-1)
        qC = qC.reshape(bsz, slen, C_HEADS, 2, HEAD_DIM)
        kC = kC.reshape(bsz, slen, C_HEADS, 2, HEAD_DIM)
        vC = vC.reshape(bsz, slen, C_HEADS, 2 * HEAD_DIM)
        lam_init = 0.8 - 0.6 * math.exp(-0.3 * l)
        lam = (jnp.exp(jnp.sum(diff_lambda_q1[l] * diff_lambda_k1[l]).astype(jnp.float32))
               - jnp.exp(jnp.sum(diff_lambda_q2[l] * diff_lambda_k2[l]).astype(jnp.float32))
               + lam_init)
        yC = diff_attention(qC, kC, vC, t5_rel_bias, lam, lam_init, diff_subln_w[l])

        yD = short_conv_mixer(pD, conv_w[l])

        y = jnp.concatenate([yA, yB.astype(yA.dtype), yC.astype(yA.dtype), yD.astype(yA.dtype)], axis=-1)
        x = x + (y @ w_out[l]).astype(x.dtype)

        x = x + hier_moe(rmsnorm(x, norm_ffn[l]), router_group_w[l], router_group_b[l],
                         router_expert_w[l], router_expert_b[l],
                         expert_w_gate[l], expert_w_up[l], expert_w_down[l])
    return rmsnorm(x, norm_final)
```

```cpp
#include <hip/hip_runtime.h>
#include <cstdint>
#include <cstdio>
#include <cmath>

typedef unsigned short bf16;
__host__ __device__ __forceinline__ unsigned f2bf(float f) { unsigned u = __builtin_bit_cast(unsigned, f); return (u + 0x7fffu + ((u >> 16) & 1u)) >> 16; }
__host__ __device__ __forceinline__ float bf2f(bf16 b) { return __builtin_bit_cast(float, ((unsigned)b) << 16); }

namespace cfg {
constexpr int D = 2048, BATCH = 8, SEQ = 4096, M = BATCH * SEQ, NL = 2;
constexpr int INC = 6400;
constexpr int OFF_BQ = 1792, OFF_BK = 2304, OFF_BV = 2816, OFF_CQ = 3328, OFF_CK = 3840, OFF_CV = 4352, OFF_D = 4864;
constexpr int NEXP = 32, EH = 256;
}
namespace nv {
using namespace cfg;

__device__ __forceinline__ float wsum(float v) {
#pragma unroll
    for (int o = 1; o < 64; o <<= 1) v += __shfl_xor(v, o);
    return v;
}
__device__ __forceinline__ float sigmoidf_(float x) { return 1.f / (1.f + expf(-x)); }
__device__ __forceinline__ float softplusf_(float x) { return x > 20.f ? x : log1pf(expf(x)); }

__global__ __launch_bounds__(256) void k_rmsnorm(const float* x, const float* g, bf16* xn, float* outf) {
    const int row = blockIdx.x * 4 + (threadIdx.x >> 6), lane = threadIdx.x & 63;
    const float* xr = x + (size_t)row * D;
    float v[32]; float s = 0.f;
#pragma unroll
    for (int i = 0; i < 32; ++i) { v[i] = xr[i * 64 + lane]; s += v[i] * v[i]; }
    s = wsum(s);
    const float rstd = rsqrtf(s * (1.f / D) + 1e-6f);
#pragma unroll
    for (int i = 0; i < 32; ++i) {
        const float o = v[i] * rstd * g[i * 64 + lane];
        if (xn) xn[(size_t)row * D + i * 64 + lane] = (bf16)f2bf(o);
        if (outf) outf[(size_t)row * D + i * 64 + lane] = o;
    }
}

template <int MODE>
__global__ __launch_bounds__(256) void k_gemm(const bf16* A, const float* W, int Mr, int N, int K, bf16* outb, const float* base, float* outf) {
    __shared__ float As[16][68];
    __shared__ float Ws[16][68];
    const int tid = threadIdx.x, tx = tid & 15, ty = tid >> 4;
    const int m0 = blockIdx.y * 64, n0 = blockIdx.x * 64;
    float acc[4][4];
#pragma unroll
    for (int i = 0; i < 4; ++i)
#pragma unroll
        for (int j = 0; j < 4; ++j) acc[i][j] = 0.f;
    for (int k0 = 0; k0 < K; k0 += 16) {
        {
            const int r = tid >> 2, kq = (tid & 3) * 4;
            const bf16* ap = A + (size_t)(m0 + r) * K + k0 + kq;
            const uint2 u = *(const uint2*)ap;
            As[kq + 0][r] = bf2f((bf16)(u.x & 0xffff)); As[kq + 1][r] = bf2f((bf16)(u.x >> 16));
            As[kq + 2][r] = bf2f((bf16)(u.y & 0xffff)); As[kq + 3][r] = bf2f((bf16)(u.y >> 16));
            const int k = tid >> 4, n4 = (tid & 15) * 4;
            const float4 w = *(const float4*)(W + (size_t)(k0 + k) * N + n0 + n4);
            Ws[k][n4 + 0] = w.x; Ws[k][n4 + 1] = w.y; Ws[k][n4 + 2] = w.z; Ws[k][n4 + 3] = w.w;
        }
        __syncthreads();
#pragma unroll
        for (int kk = 0; kk < 16; ++kk) {
            float a[4], b[4];
#pragma unroll
            for (int i = 0; i < 4; ++i) { a[i] = As[kk][ty * 4 + i]; b[i] = Ws[kk][tx * 4 + i]; }
#pragma unroll
            for (int i = 0; i < 4; ++i)
#pragma unroll
                for (int j = 0; j < 4; ++j) acc[i][j] += a[i] * b[j];
        }
        __syncthreads();
    }
#pragma unroll
    for (int i = 0; i < 4; ++i)
#pragma unroll
        for (int j = 0; j < 4; ++j) {
            const size_t o = (size_t)(m0 + ty * 4 + i) * N + n0 + tx * 4 + j;
            if (MODE == 0) outb[o] = (bf16)f2bf(acc[i][j]);
            else outf[o] = base[o] + acc[i][j];
        }
}

struct RwkvP { const float *mu, *w0, *w2, *a0, *a2, *g2, *k_k, *k_a, *r_k, *gn_w, *gn_b; };
__global__ __launch_bounds__(128) void k_rwkv(const bf16* p, RwkvP P, bf16* y) {
    const int b = blockIdx.x >> 3, h = blockIdx.x & 7, tid = threadIdx.x, i = tid & 63, hf = tid >> 6, c = h * 64 + i;
    __shared__ float wl[64], al[64], gl[128], sr[64], sw[64], sk[64], sa[64], sb[64], sv[64], sg[64], sbo[64], dp[2][64], yp[2][64];
    float st[32];
#pragma unroll
    for (int k = 0; k < 32; ++k) st[k] = 0.f;
    const float w0c = P.w0[c], a0c = P.a0[c], kkc = P.k_k[c], kac = P.k_a[c], rkc = P.r_k[c], gnw = P.gn_w[c], gnb = P.gn_b[c];
    const float mu_r = P.mu[c], mu_k = P.mu[512 + c], mu_v = P.mu[1024 + c], mu_w = P.mu[1536 + i], mu_a = P.mu[1600 + i], mu_g0 = P.mu[1664 + i], mu_g1 = P.mu[1728 + i];
    for (int t = 0; t < SEQ; ++t) {
        const bf16* cur = p + (size_t)(b * SEQ + t) * INC;
        const bf16* prv = cur - INC;
#define MIX(col, m) ({ const float cv = bf2f(cur[col]); const float pv = t > 0 ? bf2f(prv[col]) : 0.f; cv + (pv - cv) * (m); })
        float r = 0.f, k = 0.f, v = 0.f;
        if (hf == 0) {
            r = MIX(c, mu_r); k = MIX(512 + c, mu_k); v = MIX(1024 + c, mu_v);
            wl[i] = tanhf(MIX(1536 + i, mu_w)); al[i] = MIX(1600 + i, mu_a);
            gl[i] = sigmoidf_(MIX(1664 + i, mu_g0)); gl[64 + i] = sigmoidf_(MIX(1728 + i, mu_g1));
        }
#undef MIX
        __syncthreads();
        if (hf == 0) {
            float wacc = w0c, aacc = a0c, gacc = 0.f;
#pragma unroll 4
            for (int j = 0; j < 64; ++j) { wacc += wl[j] * P.w2[j * 512 + c]; aacc += al[j] * P.a2[j * 512 + c]; }
#pragma unroll 4
            for (int j = 0; j < 128; ++j) gacc += gl[j] * P.g2[j * 512 + c];
            const float wlog = -softplusf_(-wacc) - 0.5f;
            const float decay = expf(-expf(wlog));
            const float a = sigmoidf_(aacc);
            float kk = k * kkc;
            const float nrm = fmaxf(sqrtf(wsum(kk * kk)), 1e-12f);
            kk = kk / nrm;
            const float k2 = k * (1.f + (a - 1.f) * kac);
            sr[i] = r; sw[i] = decay; sk[i] = k2; sa[i] = -kk; sb[i] = kk * a; sv[i] = v; sg[i] = gacc;
            sbo[i] = wsum(r * k2 * rkc) * v;
        }
        __syncthreads();
        {
            float dot = 0.f;
#pragma unroll
            for (int kx = 0; kx < 32; ++kx) dot += st[kx] * sa[32 * hf + kx];
            dp[hf][i] = dot;
        }
        __syncthreads();
        {
            const float dot = dp[0][i] + dp[1][i], vv = sv[i];
            float yv = 0.f;
#pragma unroll
            for (int kx = 0; kx < 32; ++kx) { const int kq = 32 * hf + kx; st[kx] = st[kx] * sw[kq] + dot * sb[kq] + vv * sk[kq]; yv += st[kx] * sr[kq]; }
            yp[hf][i] = yv;
        }
        __syncthreads();
        if (hf == 0) {
            const float yv = yp[0][i] + yp[1][i];
            const float mean = wsum(yv) * (1.f / 64.f);
            const float dv = yv - mean;
            const float var = wsum(dv * dv) * (1.f / 64.f);
            const float yn = dv * rsqrtf(var + 64e-5f) * gnw + gnb;
            const float out = (yn + sbo[i]) * sg[i];
            y[(size_t)(b * SEQ + t) * D + c] = (bf16)f2bf(out);
        }
        __syncthreads();
    }
}

__global__ __launch_bounds__(64) void k_band(const bf16* p, const float* relb, bf16* y, float qmul) {
    const int gid = blockIdx.x * 64 + threadIdx.x;
    const int t = gid & (SEQ - 1), h = (gid >> 12) & 7, b = gid >> 15;
    const bf16* qp = p + (size_t)(b * SEQ + t) * INC + OFF_BQ + h * 64;
    float q[64], acc[64];
#pragma unroll
    for (int d = 0; d < 64; ++d) { q[d] = bf2f(qp[d]) * qmul; acc[d] = 0.f; }
    float m = -1e30f, l = 0.f;
    const int ch = t >> 6; int j0 = (ch - 8) * 64; if (j0 < 0) j0 = 0; const int j1 = (ch + 1) * 64;
    const float* rb = relb + h * 257;
    for (int j = j0; j < j1; ++j) {
        const bf16* kp = p + (size_t)(b * SEQ + j) * INC + OFF_BK + h * 64;
        float s = 0.f;
#pragma unroll
        for (int d = 0; d < 64; ++d) s += q[d] * bf2f(kp[d]);
        int dist = t - j; dist = dist < -128 ? -128 : (dist > 128 ? 128 : dist);
        s += rb[dist + 128];
        const float mn = fmaxf(m, s), f = expf(m - mn), pe = expf(s - mn);
        l = l * f + pe; m = mn;
        const bf16* vp = kp + (OFF_BV - OFF_BK);
#pragma unroll
        for (int d = 0; d < 64; ++d) acc[d] = acc[d] * f + pe * bf2f(vp[d]);
    }
    const float il = 1.f / l;
    bf16* yo = y + (size_t)(b * SEQ + t) * D + 512 + h * 64;
#pragma unroll
    for (int d = 0; d < 64; ++d) yo[d] = (bf16)f2bf(acc[d] * il);
}

__device__ __forceinline__ int t5_bucket(int rel) {
    const int ret = rel > 0 ? 16 : 0; const int n = rel < 0 ? -rel : rel; int bk;
    if (n < 8) bk = n; else if (n < 12) bk = 8; else if (n < 16) bk = 9; else if (n < 23) bk = 10; else if (n < 32) bk = 11;
    else if (n < 46) bk = 12; else if (n < 64) bk = 13; else if (n < 91) bk = 14; else bk = 15;
    return ret + bk;
}
__global__ __launch_bounds__(64) void k_diff(const bf16* p, const float* t5, float* O, float qmul) {
    const int gid = blockIdx.x * 64 + threadIdx.x;
    const int t = gid & (SEQ - 1), vq = (gid >> 12) & 3, sub = (gid >> 14) & 7, b = gid >> 17;
    const int head = sub >> 1;
    const bf16* qp = p + (size_t)(b * SEQ + t) * INC + OFF_CQ + sub * 64;
    float q[64], acc[32];
#pragma unroll
    for (int d = 0; d < 64; ++d) q[d] = bf2f(qp[d]) * qmul;
#pragma unroll
    for (int d = 0; d < 32; ++d) acc[d] = 0.f;
    float m = -1e30f, l = 0.f;
    const int j1 = ((t >> 6) + 1) * 64;
    for (int j = 0; j < j1; ++j) {
        const bf16* kp = p + (size_t)(b * SEQ + j) * INC + OFF_CK + sub * 64;
        float s = 0.f;
#pragma unroll
        for (int d = 0; d < 64; ++d) s += q[d] * bf2f(kp[d]);
        s += t5[t5_bucket(j - t) * 4 + head];
        const float mn = fmaxf(m, s), f = expf(m - mn), pe = expf(s - mn);
        l = l * f + pe; m = mn;
        const bf16* vp = p + (size_t)(b * SEQ + j) * INC + OFF_CV + head * 128 + vq * 32;
#pragma unroll
        for (int d = 0; d < 32; ++d) acc[d] = acc[d] * f + pe * bf2f(vp[d]);
    }
    const float il = 1.f / l;
    float* o = O + ((size_t)(b * SEQ + t) * 8 + sub) * 128 + vq * 32;
#pragma unroll
    for (int d = 0; d < 32; ++d) o[d] = acc[d] * il;
}
struct DiffP { const float *q1, *k1, *q2, *k2, *subw; float lam_init; int pad; };
__global__ __launch_bounds__(256) void k_diff_combine(const float* O, DiffP P, bf16* y) {
    const int wv = blockIdx.x * 4 + (threadIdx.x >> 6), lane = threadIdx.x & 63;
    const int tok = wv >> 2, head = wv & 3;
    const float lam = expf(wsum(P.q1[lane] * P.k1[lane])) - expf(wsum(P.q2[lane] * P.k2[lane])) + P.lam_init;
    const float* o1 = O + ((size_t)tok * 8 + head * 2) * 128; const float* o2 = o1 + 128;
    const float v0 = o1[lane] - lam * o2[lane], v1 = o1[64 + lane] - lam * o2[64 + lane];
    const float ms = wsum(v0 * v0 + v1 * v1) * (1.f / 128.f);
    const float rs = rsqrtf(ms + 1e-5f) * (1.f - P.lam_init);
    bf16* yo = y + (size_t)tok * D + 1024 + head * 128;
    yo[lane] = (bf16)f2bf(v0 * rs * P.subw[lane]); yo[64 + lane] = (bf16)f2bf(v1 * rs * P.subw[64 + lane]);
}
__global__ __launch_bounds__(256) void k_conv(const bf16* p, const float* cw, bf16* y) {
    const size_t gid = (size_t)blockIdx.x * 256 + threadIdx.x;
    const int ch = (int)(gid & 511); const int tok = (int)(gid >> 9); const int t = tok & (SEQ - 1);
    const bf16* r0 = p + (size_t)tok * INC + OFF_D;
    float u0 = bf2f(r0[512 + ch]) * bf2f(r0[1024 + ch]);
    float u1 = 0.f, u2 = 0.f;
    if (t >= 1) { const bf16* r1 = r0 - INC; u1 = bf2f(r1[512 + ch]) * bf2f(r1[1024 + ch]); }
    if (t >= 2) { const bf16* r2 = r0 - 2 * INC; u2 = bf2f(r2[512 + ch]) * bf2f(r2[1024 + ch]); }
    const float yv = cw[ch] * u2 + cw[512 + ch] * u1 + cw[1024 + ch] * u0;
    y[(size_t)tok * D + 1536 + ch] = (bf16)f2bf(bf2f(r0[ch]) * yv);
}
__global__ __launch_bounds__(256) void k_norm_router(const float* x, const float* g, const float* wg, const float* bg, const float* we, const float* be, bf16* xn, int4* route) {
    const int row = blockIdx.x * 4 + (threadIdx.x >> 6), lane = threadIdx.x & 63;
    const float* xr = x + (size_t)row * D;
    float v[32]; float s = 0.f;
#pragma unroll
    for (int i = 0; i < 32; ++i) { v[i] = xr[i * 64 + lane]; s += v[i] * v[i]; }
    s = wsum(s);
    const float rstd = rsqrtf(s * (1.f / D) + 1e-6f);
#pragma unroll
    for (int i = 0; i < 32; ++i) { v[i] = v[i] * rstd * g[i * 64 + lane]; xn[(size_t)row * D + i * 64 + lane] = (bf16)f2bf(v[i]); }
    float lg[4];
#pragma unroll
    for (int o = 0; o < 4; ++o) { float a = 0.f;
#pragma unroll
        for (int i = 0; i < 32; ++i) a += v[i] * wg[(size_t)(i * 64 + lane) * 4 + o];
        lg[o] = wsum(a) + bg[o]; }
    int gi = 0; float gm = lg[0];
#pragma unroll
    for (int o = 1; o < 4; ++o) if (lg[o] > gm) { gm = lg[o]; gi = o; }
    float gs = 0.f;
#pragma unroll
    for (int o = 0; o < 4; ++o) gs += expf(lg[o] - gm);
    const float gw = 1.f / gs;
    float el[8];
#pragma unroll
    for (int o = 0; o < 8; ++o) { float a = 0.f;
#pragma unroll
        for (int i = 0; i < 32; ++i) a += v[i] * we[(size_t)(i * 64 + lane) * 32 + gi * 8 + o];
        el[o] = wsum(a) + be[gi * 8 + o]; }
    int i1 = 0; float m1 = el[0];
#pragma unroll
    for (int o = 1; o < 8; ++o) if (el[o] > m1) { m1 = el[o]; i1 = o; }
    int i2 = -1; float m2 = -3e38f;
#pragma unroll
    for (int o = 0; o < 8; ++o) if (o != i1 && el[o] > m2) { m2 = el[o]; i2 = o; }
    const float e2 = expf(m2 - m1); const float p1 = 1.f / (1.f + e2), p2 = e2 / (1.f + e2);
    if (lane == 0) route[row] = make_int4(gi * 8 + i1, gi * 8 + i2, __float_as_int(gw * p1), __float_as_int(gw * p2));
}
__global__ __launch_bounds__(256) void k_moe(const bf16* xn, const int4* route, const float* Wg, const float* Wu, const float* Wd, float* x) {
    const int tok = blockIdx.x, tid = threadIdx.x;
    __shared__ float xs[2048]; __shared__ float hs[256];
    for (int i = tid; i < 2048; i += 256) xs[i] = bf2f(xn[(size_t)tok * D + i]);
    const int4 rt = route[tok];
    float o[8];
#pragma unroll
    for (int i = 0; i < 8; ++i) o[i] = 0.f;
    __syncthreads();
    for (int s = 0; s < 2; ++s) {
        const int e = s ? rt.y : rt.x; const float w = __int_as_float(s ? rt.w : rt.z);
        const float* wg = Wg + (size_t)e * 2048 * 256 + tid; const float* wu = Wu + (size_t)e * 2048 * 256 + tid;
        float ga = 0.f, ua = 0.f;
        for (int k = 0; k < 2048; ++k) { const float xv = xs[k]; ga += xv * wg[(size_t)k * 256]; ua += xv * wu[(size_t)k * 256]; }
        hs[tid] = ga / (1.f + expf(-ga)) * ua * w;
        __syncthreads();
        const float* wd = Wd + (size_t)e * 256 * 2048 + tid;
        for (int j = 0; j < 256; ++j) { const float hv = hs[j];
#pragma unroll
            for (int i = 0; i < 8; ++i) o[i] += hv * wd[(size_t)j * 2048 + i * 256]; }
        __syncthreads();
    }
#pragma unroll
    for (int i = 0; i < 8; ++i) x[(size_t)tok * D + i * 256 + tid] += o[i];
}
}
namespace ws {
constexpr size_t MiB = 1u << 20;
constexpr size_t CTL = 0;
constexpr size_t XN = 16 * MiB;
constexpr size_t P = XN + 128 * MiB;
constexpr size_t Y = P + 400 * MiB;
constexpr size_t ROUTE = Y + 128 * MiB;
constexpr size_t END = ROUTE + 1 * MiB;
}

extern "C" void kernel_launch(void* const* d_in, const int* in_sizes, int n_in, void* d_out, int out_size, void* d_ws, size_t ws_size, hipStream_t stream) {
    using namespace cfg;
    if (n_in != 32 || ws_size < ws::END) { fprintf(stderr, "kernel_launch: bad args n_in=%d ws=%zu\n", n_in, ws_size); return; }
    const float* const* in = (const float* const*)d_in;
    unsigned char* w = (unsigned char*)d_ws;
    bf16* xn = (bf16*)(w + ws::XN); bf16* p = (bf16*)(w + ws::P); bf16* y = (bf16*)(w + ws::Y); int4* route = (int4*)(w + ws::ROUTE);
    float* Otmp = (float*)(w + ws::XN);
    float* x = (float*)d_out;
    const float* xin = in[0];
    for (int l = 0; l < NL; ++l) {
        const float* xcur = (l == 0) ? xin : x;
        nv::k_rmsnorm<<<M / 4, 256, 0, stream>>>(xcur, in[3] + l * D, xn, nullptr);
        nv::k_gemm<0><<<dim3(INC / 64, M / 64), 256, 0, stream>>>(xn, in[1] + (size_t)l * D * INC, M, INC, D, p, nullptr, nullptr);
        nv::RwkvP rp{in[6] + l * 1792, in[7] + l * 512, in[8] + l * 64 * 512, in[9] + l * 512, in[10] + l * 64 * 512, in[11] + l * 128 * 512,
                     in[12] + l * 512, in[13] + l * 512, in[14] + l * 512, in[15] + l * 512, in[16] + l * 512};
        nv::k_rwkv<<<64, 128, 0, stream>>>(p, rp, y);
        nv::k_band<<<M * 8 / 64, 64, 0, stream>>>(p, in[17] + l * 8 * 257, y, 0.125f);
        nv::k_diff<<<M * 8 * 4 / 64, 64, 0, stream>>>(p, in[18], Otmp, 0.125f);
        const float lam_init = (float)(0.8 - 0.6 * exp(-0.3 * l));
        nv::DiffP dp{in[19] + l * 64, in[20] + l * 64, in[21] + l * 64, in[22] + l * 64, in[23] + l * 128, lam_init, 0};
        nv::k_diff_combine<<<M * 4 / 4, 256, 0, stream>>>(Otmp, dp, y);
        nv::k_conv<<<M * 512 / 256, 256, 0, stream>>>(p, in[24] + l * 3 * 512, y);
        nv::k_gemm<1><<<dim3(D / 64, M / 64), 256, 0, stream>>>(y, in[2] + (size_t)l * D * D, M, D, D, nullptr, xcur, x);
        nv::k_norm_router<<<M / 4, 256, 0, stream>>>(x, in[4] + l * D, in[25] + l * D * 4, in[26] + l * 4, in[27] + l * D * 32, in[28] + l * 32, xn, route);
        const size_t es = (size_t)NEXP * D * EH;
        nv::k_moe<<<M, 256, 0, stream>>>(xn, route, in[29] + l * es, in[30] + l * es, in[31] + l * es, x);
    }
    nv::k_rmsnorm<<<M / 4, 256, 0, stream>>>(x, in[5], nullptr, x);
}
```

```cpp
#include <hip/hip_runtime.h>
#include <cstdint>
#include <cstdio>
#include <cmath>

typedef unsigned short bf16;
__host__ __device__ __forceinline__ unsigned f2bf(float f) { unsigned u = __builtin_bit_cast(unsigned, f); return (u + 0x7fffu + ((u >> 16) & 1u)) >> 16; }
__host__ __device__ __forceinline__ float bf2f(bf16 b) { return __builtin_bit_cast(float, ((unsigned)b) << 16); }

namespace cfg {
constexpr int D = 2048, BATCH = 8, SEQ = 4096, M = BATCH * SEQ, NL = 2;
constexpr int INC = 6400;
constexpr int OFF_BQ = 1792, OFF_BK = 2304, OFF_BV = 2816, OFF_CQ = 3328, OFF_CK = 3840, OFF_CV = 4352, OFF_D = 4864;
constexpr int NEXP = 32, EH = 256;
}
#define MK_FLAGS 1
namespace nv {
using namespace cfg;

__device__ __forceinline__ float wsum(float v) {
#pragma unroll
    for (int o = 1; o < 64; o <<= 1) v += __shfl_xor(v, o);
    return v;
}
__device__ __forceinline__ float sigmoidf_(float x) { return 1.f / (1.f + expf(-x)); }
__device__ __forceinline__ float softplusf_(float x) { return x > 20.f ? x : log1pf(expf(x)); }

__global__ __launch_bounds__(256) void k_rmsnorm(const float* x, const float* g, bf16* xn, float* outf) {
    const int row = blockIdx.x * 4 + (threadIdx.x >> 6), lane = threadIdx.x & 63;
    const float* xr = x + (size_t)row * D;
    float v[32]; float s = 0.f;
#pragma unroll
    for (int i = 0; i < 32; ++i) { v[i] = xr[i * 64 + lane]; s += v[i] * v[i]; }
    s = wsum(s);
    const float rstd = rsqrtf(s * (1.f / D) + 1e-6f);
#pragma unroll
    for (int i = 0; i < 32; ++i) {
        const float o = v[i] * rstd * g[i * 64 + lane];
        if (xn) xn[(size_t)row * D + i * 64 + lane] = (bf16)f2bf(o);
        if (outf) outf[(size_t)row * D + i * 64 + lane] = o;
    }
}

template <int MODE>
__global__ __launch_bounds__(256) void k_gemm(const bf16* A, const float* W, int Mr, int N, int K, bf16* outb, const float* base, float* outf) {
    __shared__ float As[16][68];
    __shared__ float Ws[16][68];
    const int tid = threadIdx.x, tx = tid & 15, ty = tid >> 4;
    const int m0 = blockIdx.y * 64, n0 = blockIdx.x * 64;
    float acc[4][4];
#pragma unroll
    for (int i = 0; i < 4; ++i)
#pragma unroll
        for (int j = 0; j < 4; ++j) acc[i][j] = 0.f;
    for (int k0 = 0; k0 < K; k0 += 16) {
        {
            const int r = tid >> 2, kq = (tid & 3) * 4;
            const bf16* ap = A + (size_t)(m0 + r) * K + k0 + kq;
            const uint2 u = *(const uint2*)ap;
            As[kq + 0][r] = bf2f((bf16)(u.x & 0xffff)); As[kq + 1][r] = bf2f((bf16)(u.x >> 16));
            As[kq + 2][r] = bf2f((bf16)(u.y & 0xffff)); As[kq + 3][r] = bf2f((bf16)(u.y >> 16));
            const int k = tid >> 4, n4 = (tid & 15) * 4;
            const float4 w = *(const float4*)(W + (size_t)(k0 + k) * N + n0 + n4);
            Ws[k][n4 + 0] = w.x; Ws[k][n4 + 1] = w.y; Ws[k][n4 + 2] = w.z; Ws[k][n4 + 3] = w.w;
        }
        __syncthreads();
#pragma unroll
        for (int kk = 0; kk < 16; ++kk) {
            float a[4], b[4];
#pragma unroll
            for (int i = 0; i < 4; ++i) { a[i] = As[kk][ty * 4 + i]; b[i] = Ws[kk][tx * 4 + i]; }
#pragma unroll
            for (int i = 0; i < 4; ++i)
#pragma unroll
                for (int j = 0; j < 4; ++j) acc[i][j] += a[i] * b[j];
        }
        __syncthreads();
    }
#pragma unroll
    for (int i = 0; i < 4; ++i)
#pragma unroll
        for (int j = 0; j < 4; ++j) {
            const size_t o = (size_t)(m0 + ty * 4 + i) * N + n0 + tx * 4 + j;
            if (MODE == 0) outb[o] = (bf16)f2bf(acc[i][j]);
            else outf[o] = base[o] + acc[i][j];
        }
}

struct RwkvP { const float *mu, *w0, *w2, *a0, *a2, *g2, *k_k, *k_a, *r_k, *gn_w, *gn_b; };
__global__ __launch_bounds__(128) void k_rwkv(const bf16* p, RwkvP P, bf16* y) {
    const int b = blockIdx.x >> 3, h = blockIdx.x & 7, tid = threadIdx.x, i = tid & 63, hf = tid >> 6, c = h * 64 + i;
    __shared__ float wl[64], al[64], gl[128], sr[64], sw[64], sk[64], sa[64], sb[64], sv[64], sg[64], sbo[64], dp[2][64], yp[2][64];
    float st[32];
#pragma unroll
    for (int k = 0; k < 32; ++k) st[k] = 0.f;
    const float w0c = P.w0[c], a0c = P.a0[c], kkc = P.k_k[c], kac = P.k_a[c], rkc = P.r_k[c], gnw = P.gn_w[c], gnb = P.gn_b[c];
    const float mu_r = P.mu[c], mu_k = P.mu[512 + c], mu_v = P.mu[1024 + c], mu_w = P.mu[1536 + i], mu_a = P.mu[1600 + i], mu_g0 = P.mu[1664 + i], mu_g1 = P.mu[1728 + i];
    for (int t = 0; t < SEQ; ++t) {
        const bf16* cur = p + (size_t)(b * SEQ + t) * INC;
        const bf16* prv = cur - INC;
#define MIX(col, m) ({ const float cv = bf2f(cur[col]); const float pv = t > 0 ? bf2f(prv[col]) : 0.f; cv + (pv - cv) * (m); })
        float r = 0.f, k = 0.f, v = 0.f;
        if (hf == 0) {
            r = MIX(c, mu_r); k = MIX(512 + c, mu_k); v = MIX(1024 + c, mu_v);
            wl[i] = tanhf(MIX(1536 + i, mu_w)); al[i] = MIX(1600 + i, mu_a);
            gl[i] = sigmoidf_(MIX(1664 + i, mu_g0)); gl[64 + i] = sigmoidf_(MIX(1728 + i, mu_g1));
        }
#undef MIX
        __syncthreads();
        if (hf == 0) {
            float wacc = w0c, aacc = a0c, gacc = 0.f;
#pragma unroll 4
            for (int j = 0; j < 64; ++j) { wacc += wl[j] * P.w2[j * 512 + c]; aacc += al[j] * P.a2[j * 512 + c]; }
#pragma unroll 4
            for (int j = 0; j < 128; ++j) gacc += gl[j] * P.g2[j * 512 + c];
            const float wlog = -softplusf_(-wacc) - 0.5f;
            const float decay = expf(-expf(wlog));
            const float a = sigmoidf_(aacc);
            float kk = k * kkc;
            const float nrm = fmaxf(sqrtf(wsum(kk * kk)), 1e-12f);
            kk = kk / nrm;
            const float k2 = k * (1.f + (a - 1.f) * kac);
            sr[i] = r; sw[i] = decay; sk[i] = k2; sa[i] = -kk; sb[i] = kk * a; sv[i] = v; sg[i] = gacc;
            sbo[i] = wsum(r * k2 * rkc) * v;
        }
        __syncthreads();
        {
            float dot = 0.f;
#pragma unroll
            for (int kx = 0; kx < 32; ++kx) dot += st[kx] * sa[32 * hf + kx];
            dp[hf][i] = dot;
        }
        __syncthreads();
        {
            const float dot = dp[0][i] + dp[1][i], vv = sv[i];
            float yv = 0.f;
#pragma unroll
            for (int kx = 0; kx < 32; ++kx) { const int kq = 32 * hf + kx; st[kx] = st[kx] * sw[kq] + dot * sb[kq] + vv * sk[kq]; yv += st[kx] * sr[kq]; }
            yp[hf][i] = yv;
        }
        __syncthreads();
        if (hf == 0) {
            const float yv = yp[0][i] + yp[1][i];
            const float mean = wsum(yv) * (1.f / 64.f);
            const float dv = yv - mean;
            const float var = wsum(dv * dv) * (1.f / 64.f);
            const float yn = dv * rsqrtf(var + 64e-5f) * gnw + gnb;
            const float out = (yn + sbo[i]) * sg[i];
            y[(size_t)(b * SEQ + t) * D + c] = (bf16)f2bf(out);
        }
        __syncthreads();
    }
}

__global__ __launch_bounds__(64) void k_band(const bf16* p, const float* relb, bf16* y, float qmul) {
    const int gid = blockIdx.x * 64 + threadIdx.x;
    const int t = gid & (SEQ - 1), h = (gid >> 12) & 7, b = gid >> 15;
    const bf16* qp = p + (size_t)(b * SEQ + t) * INC + OFF_BQ + h * 64;
    float q[64], acc[64];
#pragma unroll
    for (int d = 0; d < 64; ++d) { q[d] = bf2f(qp[d]) * qmul; acc[d] = 0.f; }
    float m = -1e30f, l = 0.f;
    const int ch = t >> 6; int j0 = (ch - 8) * 64; if (j0 < 0) j0 = 0; const int j1 = (ch + 1) * 64;
    const float* rb = relb + h * 257;
    for (int j = j0; j < j1; ++j) {
        const bf16* kp = p + (size_t)(b * SEQ + j) * INC + OFF_BK + h * 64;
        float s = 0.f;
#pragma unroll
        for (int d = 0; d < 64; ++d) s += q[d] * bf2f(kp[d]);
        int dist = t - j; dist = dist < -128 ? -128 : (dist > 128 ? 128 : dist);
        s += rb[dist + 128];
        const float mn = fmaxf(m, s), f = expf(m - mn), pe = expf(s - mn);
        l = l * f + pe; m = mn;
        const bf16* vp = kp + (OFF_BV - OFF_BK);
#pragma unroll
        for (int d = 0; d < 64; ++d) acc[d] = acc[d] * f + pe * bf2f(vp[d]);
    }
    const float il = 1.f / l;
    bf16* yo = y + (size_t)(b * SEQ + t) * D + 512 + h * 64;
#pragma unroll
    for (int d = 0; d < 64; ++d) yo[d] = (bf16)f2bf(acc[d] * il);
}

__device__ __forceinline__ int t5_bucket(int rel) {
    const int ret = rel > 0 ? 16 : 0; const int n = rel < 0 ? -rel : rel; int bk;
    if (n < 8) bk = n; else if (n < 12) bk = 8; else if (n < 16) bk = 9; else if (n < 23) bk = 10; else if (n < 32) bk = 11;
    else if (n < 46) bk = 12; else if (n < 64) bk = 13; else if (n < 91) bk = 14; else bk = 15;
    return ret + bk;
}
__global__ __launch_bounds__(64) void k_diff(const bf16* p, const float* t5, float* O, float qmul) {
    const int gid = blockIdx.x * 64 + threadIdx.x;
    const int t = gid & (SEQ - 1), vq = (gid >> 12) & 3, sub = (gid >> 14) & 7, b = gid >> 17;
    const int head = sub >> 1;
    const bf16* qp = p + (size_t)(b * SEQ + t) * INC + OFF_CQ + sub * 64;
    float q[64], acc[32];
#pragma unroll
    for (int d = 0; d < 64; ++d) q[d] = bf2f(qp[d]) * qmul;
#pragma unroll
    for (int d = 0; d < 32; ++d) acc[d] = 0.f;
    float m = -1e30f, l = 0.f;
    const int j1 = ((t >> 6) + 1) * 64;
    for (int j = 0; j < j1; ++j) {
        const bf16* kp = p + (size_t)(b * SEQ + j) * INC + OFF_CK + sub * 64;
        float s = 0.f;
#pragma unroll
        for (int d = 0; d < 64; ++d) s += q[d] * bf2f(kp[d]);
        s += t5[t5_bucket(j - t) * 4 + head];
        const float mn = fmaxf(m, s), f = expf(m - mn), pe = expf(s - mn);
        l = l * f + pe; m = mn;
        const bf16* vp = p + (size_t)(b * SEQ + j) * INC + OFF_CV + head * 128 + vq * 32;
#pragma unroll
        for (int d = 0; d < 32; ++d) acc[d] = acc[d] * f + pe * bf2f(vp[d]);
    }
    const float il = 1.f / l;
    float* o = O + ((size_t)(b * SEQ + t) * 8 + sub) * 128 + vq * 32;
#pragma unroll
    for (int d = 0; d < 32; ++d) o[d] = acc[d] * il;
}
struct DiffP { const float *q1, *k1, *q2, *k2, *subw; float lam_init; int pad; };
__global__ __launch_bounds__(256) void k_diff_combine(const float* O, DiffP P, bf16* y) {
    const int wv = blockIdx.x * 4 + (threadIdx.x >> 6), lane = threadIdx.x & 63;
    const int tok = wv >> 2, head = wv & 3;
    const float lam = expf(wsum(P.q1[lane] * P.k1[lane])) - expf(wsum(P.q2[lane] * P.k2[lane])) + P.lam_init;
    const float* o1 = O + ((size_t)tok * 8 + head * 2) * 128; const float* o2 = o1 + 128;
    const float v0 = o1[lane] - lam * o2[lane], v1 = o1[64 + lane] - lam * o2[64 + lane];
    const float ms = wsum(v0 * v0 + v1 * v1) * (1.f / 128.f);
    const float rs = rsqrtf(ms + 1e-5f) * (1.f - P.lam_init);
    bf16* yo = y + (size_t)tok * D + 1024 + head * 128;
    yo[lane] = (bf16)f2bf(v0 * rs * P.subw[lane]); yo[64 + lane] = (bf16)f2bf(v1 * rs * P.subw[64 + lane]);
}
__global__ __launch_bounds__(256) void k_conv(const bf16* p, const float* cw, bf16* y) {
    const size_t gid = (size_t)blockIdx.x * 256 + threadIdx.x;
    const int ch = (int)(gid & 511); const int tok = (int)(gid >> 9); const int t = tok & (SEQ - 1);
    const bf16* r0 = p + (size_t)tok * INC + OFF_D;
    float u0 = bf2f(r0[512 + ch]) * bf2f(r0[1024 + ch]);
    float u1 = 0.f, u2 = 0.f;
    if (t >= 1) { const bf16* r1 = r0 - INC; u1 = bf2f(r1[512 + ch]) * bf2f(r1[1024 + ch]); }
    if (t >= 2) { const bf16* r2 = r0 - 2 * INC; u2 = bf2f(r2[512 + ch]) * bf2f(r2[1024 + ch]); }
    const float yv = cw[ch] * u2 + cw[512 + ch] * u1 + cw[1024 + ch] * u0;
    y[(size_t)tok * D + 1536 + ch] = (bf16)f2bf(bf2f(r0[ch]) * yv);
}
__global__ __launch_bounds__(256) void k_norm_router(const float* x, const float* g, const float* wg, const float* bg, const float* we, const float* be, bf16* xn, int4* route) {
    const int row = blockIdx.x * 4 + (threadIdx.x >> 6), lane = threadIdx.x & 63;
    const float* xr = x + (size_t)row * D;
    float v[32]; float s = 0.f;
#pragma unroll
    for (int i = 0; i < 32; ++i) { v[i] = xr[i * 64 + lane]; s += v[i] * v[i]; }
    s = wsum(s);
    const float rstd = rsqrtf(s * (1.f / D) + 1e-6f);
#pragma unroll
    for (int i = 0; i < 32; ++i) { v[i] = v[i] * rstd * g[i * 64 + lane]; xn[(size_t)row * D + i * 64 + lane] = (bf16)f2bf(v[i]); }
    float lg[4];
#pragma unroll
    for (int o = 0; o < 4; ++o) { float a = 0.f;
#pragma unroll
        for (int i = 0; i < 32; ++i) a += v[i] * wg[(size_t)(i * 64 + lane) * 4 + o];
        lg[o] = wsum(a) + bg[o]; }
    int gi = 0; float gm = lg[0];
#pragma unroll
    for (int o = 1; o < 4; ++o) if (lg[o] > gm) { gm = lg[o]; gi = o; }
    float gs = 0.f;
#pragma unroll
    for (int o = 0; o < 4; ++o) gs += expf(lg[o] - gm);
    const float gw = 1.f / gs;
    float el[8];
#pragma unroll
    for (int o = 0; o < 8; ++o) { float a = 0.f;
#pragma unroll
        for (int i = 0; i < 32; ++i) a += v[i] * we[(size_t)(i * 64 + lane) * 32 + gi * 8 + o];
        el[o] = wsum(a) + be[gi * 8 + o]; }
    int i1 = 0; float m1 = el[0];
#pragma unroll
    for (int o = 1; o < 8; ++o) if (el[o] > m1) { m1 = el[o]; i1 = o; }
    int i2 = -1; float m2 = -3e38f;
#pragma unroll
    for (int o = 0; o < 8; ++o) if (o != i1 && el[o] > m2) { m2 = el[o]; i2 = o; }
    const float e2 = expf(m2 - m1); const float p1 = 1.f / (1.f + e2), p2 = e2 / (1.f + e2);
    if (lane == 0) route[row] = make_int4(gi * 8 + i1, gi * 8 + i2, __float_as_int(gw * p1), __float_as_int(gw * p2));
}
__global__ __launch_bounds__(256) void k_moe(const bf16* xn, const int4* route, const float* Wg, const float* Wu, const float* Wd, float* x) {
    const int tok = blockIdx.x, tid = threadIdx.x;
    __shared__ float xs[2048]; __shared__ float hs[256];
    for (int i = tid; i < 2048; i += 256) xs[i] = bf2f(xn[(size_t)tok * D + i]);
    const int4 rt = route[tok];
    float o[8];
#pragma unroll
    for (int i = 0; i < 8; ++i) o[i] = 0.f;
    __syncthreads();
    for (int s = 0; s < 2; ++s) {
        const int e = s ? rt.y : rt.x; const float w = __int_as_float(s ? rt.w : rt.z);
        const float* wg = Wg + (size_t)e * 2048 * 256 + tid; const float* wu = Wu + (size_t)e * 2048 * 256 + tid;
        float ga = 0.f, ua = 0.f;
        for (int k = 0; k < 2048; ++k) { const float xv = xs[k]; ga += xv * wg[(size_t)k * 256]; ua += xv * wu[(size_t)k * 256]; }
        hs[tid] = ga / (1.f + expf(-ga)) * ua * w;
        __syncthreads();
        const float* wd = Wd + (size_t)e * 256 * 2048 + tid;
        for (int j = 0; j < 256; ++j) { const float hv = hs[j];
#pragma unroll
            for (int i = 0; i < 8; ++i) o[i] += hv * wd[(size_t)j * 2048 + i * 256]; }
        __syncthreads();
    }
#pragma unroll
    for (int i = 0; i < 8; ++i) x[(size_t)tok * D + i * 256 + tid] += o[i];
}
}
#define GAS __attribute__((address_space(1)))
#define LAS __attribute__((address_space(3)))
typedef float f32x4 __attribute__((ext_vector_type(4)));
typedef float f32x2 __attribute__((ext_vector_type(2)));
typedef short bf16x8 __attribute__((ext_vector_type(8)));
typedef unsigned u32x4 __attribute__((ext_vector_type(4)));
typedef unsigned u32x2 __attribute__((ext_vector_type(2)));
#define RLX_AGENT __ATOMIC_RELAXED, __HIP_MEMORY_SCOPE_AGENT
#define LDS_WAIT() asm volatile("s_waitcnt lgkmcnt(0)" ::: "memory")
#define VM_WAIT() asm volatile("s_waitcnt vmcnt(0)" ::: "memory")

namespace wsm {
constexpr size_t MiB = 1u << 20;
constexpr size_t CTL = 0, CTL_ZERO_BYTES = 1 * MiB;
constexpr size_t LISTS = 2 * MiB;
constexpr size_t WLIST = 6 * MiB;
constexpr size_t TOKINFO = 10 * MiB;
constexpr size_t ROUTE = 11 * MiB;
constexpr size_t WRT = 12 * MiB;
constexpr size_t W_IN = 16 * MiB;
constexpr size_t W_OUT = 41 * MiB;
constexpr size_t W_GU = 49 * MiB;
constexpr size_t W_D = 113 * MiB;
constexpr size_t XN = 146 * MiB;
constexpr size_t P = 274 * MiB;
constexpr size_t HB = P;
constexpr size_t OB = P + 40 * MiB;
constexpr size_t Y = 674 * MiB;
constexpr size_t RW = 802 * MiB;
constexpr size_t END = 1010 * MiB;
constexpr int CW_BAR = 4096;
constexpr int CW_CNT = 16384;
constexpr int CW_Q = 32768;
}
constexpr int LCAP = 32768;
constexpr int RING_BYTES = 131072;
constexpr int MISC_OFF = RING_BYTES + 320;
constexpr int TAB_OFF = RING_BYTES + 1024;
constexpr int LDS_BYTES = 147456;
constexpr float C2F = 0.125f * 1.4426950408889634f;
constexpr float LOG2E = 1.4426950408889634f;

__device__ __forceinline__ unsigned pk2(float lo, float hi) { return f2bf(lo) | (f2bf(hi) << 16); }
__device__ __forceinline__ float wave_sum(float v) {
#pragma unroll
    for (int o = 1; o < 64; o <<= 1) v += __shfl_xor(v, o);
    return v;
}

struct Args {
    const float* in[32]; float* out; unsigned char* ws;
    int ph_lo, ph_hi, flags, pad;
};
#define XB_TMO      128
#define XB_XCNT(j)  (256  + 64 * (j))
#define XB_XSUB(j)  (1280 + 64 * (j))
#define XB_XGEN(j)  (2304 + 64 * (j))
#define XB_TOP      3328
#define XB_TOPGEN   3392
#define XCD_BAR_WORDS 3456
#define XB_SPIN_CAP (1u << 22)

__device__ __forceinline__ unsigned xb_ld(unsigned* p)              { return __hip_atomic_load(p, __ATOMIC_RELAXED, __HIP_MEMORY_SCOPE_AGENT); }
__device__ __forceinline__ unsigned xb_add(unsigned* p, unsigned v) { return __hip_atomic_fetch_add(p, v, __ATOMIC_RELAXED, __HIP_MEMORY_SCOPE_AGENT); }
__device__ __forceinline__ unsigned xb_xcc_id() { return (unsigned)__builtin_amdgcn_s_getreg((3 << 11) | 20) & 0xFu; }
#define XB_SPIN(cond, bar) do { unsigned _sp = 0; while (cond) { __builtin_amdgcn_s_sleep(1); \
    if ((++_sp & 255u) == 0u) { if (xb_ld(&(bar)[XB_TMO])) break; if (_sp > XB_SPIN_CAP) { atomicAdd(&(bar)[XB_TMO], 1u); break; } } } } while (0)

struct XcdBarrier {
    unsigned* bar; unsigned x;
    volatile LAS unsigned* st;
};

__device__ __forceinline__ XcdBarrier xcd_barrier_post(unsigned* bar, volatile LAS unsigned* st) {
    XcdBarrier b; b.bar = bar; b.x = xb_xcc_id(); b.st = st;
    if (threadIdx.x == 0) (void)xb_add(&bar[XB_XCNT(b.x)], 1u);
    return b;
}
__device__ __forceinline__ void xcd_barrier_complete(unsigned* bar, unsigned x, unsigned& nloc, unsigned& nx) {
    const unsigned G = gridDim.x * gridDim.y * gridDim.z;
    unsigned sum, cnt, mine, sp = 0u;
    for (;;) {
        sum = 0u; cnt = 0u; mine = 0u;
#pragma unroll
        for (unsigned j = 0; j < 16; ++j) { const unsigned c = xb_ld(&bar[XB_XCNT(j)]); sum += c; cnt += (c > 0u) ? 1u : 0u; mine = (j == x) ? c : mine; }
        if (sum == G) break;
        __builtin_amdgcn_s_sleep(1);
        if ((++sp & 255u) == 0u) { if (xb_ld(&bar[XB_TMO])) break; if (sp > XB_SPIN_CAP) { atomicAdd(&bar[XB_TMO], 1u); break; } }
    }
    nloc = mine > 0u ? mine : 1u; nx = cnt > 0u ? cnt : 1u;
}

__device__ __forceinline__ void xcd_barrier(const XcdBarrier& b) {
    asm volatile("s_waitcnt vmcnt(0)" ::: "memory");
    __syncthreads();
    if (threadIdx.x == 0) {
        unsigned* bar = b.bar;
        __builtin_amdgcn_s_waitcnt(0);
        unsigned nloc = b.st[0], nx = b.st[1];
        if (nloc == 0u) { xcd_barrier_complete(bar, b.x, nloc, nx); b.st[0] = nloc; b.st[1] = nx; }
        const unsigned old = xb_add(&bar[XB_XSUB(b.x)], 1u);
        const unsigned gen = old / nloc;
        if (old + 1u == (gen + 1u) * nloc) {
            __builtin_amdgcn_fence(__ATOMIC_RELEASE, "agent");
            asm volatile("s_waitcnt vmcnt(0)" ::: "memory");
            const unsigned og = xb_add(&bar[XB_TOP], 1u);
            const unsigned tg = og / nx;
            if (og + 1u == (tg + 1u) * nx) xb_add(&bar[XB_TOPGEN], 1u);
            else XB_SPIN(xb_ld(&bar[XB_TOPGEN]) == tg, bar);
            __builtin_amdgcn_fence(__ATOMIC_ACQUIRE, "agent");
            xb_add(&bar[XB_XGEN(b.x)], 1u);
            asm volatile("s_waitcnt vmcnt(0)" ::: "memory");
        } else {
            XB_SPIN(xb_ld(&bar[XB_XGEN(b.x)]) == gen, bar);
            __builtin_amdgcn_fence(__ATOMIC_ACQUIRE, "agent");
            asm volatile("s_waitcnt vmcnt(0)" ::: "memory");
        }
    }
    __syncthreads();
}
namespace pg8 {
#define PG8_LAS __attribute__((address_space(3)))
typedef unsigned short bf16_t;
typedef short bf16x8 __attribute__((ext_vector_type(8)));
typedef float f32x4 __attribute__((ext_vector_type(4)));
typedef unsigned u32x4 __attribute__((ext_vector_type(4)));
typedef unsigned u32x2 __attribute__((ext_vector_type(2)));
constexpr int BM = 256, BK = 64, HALF = 128, HTB = HALF * BK * 2, STAGE_BYTES = 8 * HTB, NXCD = 8, WGM = 8;

__host__ __device__ __forceinline__ int lds_byte(int r, int c) { const int st = (r >> 4) * 2 + (c >> 5), rr = r & 15, cc = c & 31, ob = rr * 64 + cc * 2; return st * 1024 + (ob ^ (((ob >> 9) & 1) << 5)); }
__host__ __device__ __forceinline__ void stage_rc(int b, int& R, int& C) { const int st = b / 1024, sb = b % 1024, swz = sb ^ (((sb >> 9) & 1) << 5); R = (st >> 1) * 16 + swz / 64; C = (st & 1) * 32 + (swz % 64) / 2; }
__host__ __device__ __forceinline__ int perm32(int rho) { const int n = rho >> 4, i = rho & 15; return 8 * (i >> 2) + 4 * n + (i & 3); }

struct Unit { int pm, pn; const char* a; const char* b; const int* rows; const float* wrow; int nvalid; int pad_; };

struct StaticOrder {
    int nM, nN, nwg, G, c; const char* A; const char* Bt; size_t tstep;
    __device__ void init(const bf16_t* A_, const bf16_t* Bt_, int M, int N, int K, int G_, int c_) { nM = M / BM; nN = N / BM; nwg = nM * nN; G = G_; c = c_; A = (const char*)A_; Bt = (const char*)Bt_; tstep = (size_t)BM * K * 2; }
    __device__ bool next(int i, Unit& u) const {
        const long L = (long)i * G + c; if (L >= nwg) return false;
        int wgid = (int)L; { const int q = nwg / NXCD, r = nwg % NXCD, xcd = wgid % NXCD, off = wgid / NXCD; wgid = (xcd < r ? xcd * (q + 1) : r * (q + 1) + (xcd - r) * q) + off; }
        const int nig = WGM * nN, gid = wgid / nig, fm = gid * WGM, gsz = (nM - fm) < WGM ? (nM - fm) : WGM;
        u.pm = fm + ((wgid % nig) % gsz); u.pn = (wgid % nig) / gsz; u.a = A + (size_t)u.pm * tstep; u.b = Bt + (size_t)u.pn * tstep; u.rows = nullptr; u.wrow = nullptr; u.nvalid = 256; return true;
    }
};

__device__ __forceinline__ unsigned cvt_pk_bf16(float lo, float hi) { unsigned r; asm volatile("v_cvt_pk_bf16_f32 %0, %1, %2" : "=v"(r) : "v"(lo), "v"(hi)); return r; }

struct EpiBf16 {
    static constexpr bool PERM = true;
    bf16_t* O; int ldc;
    __device__ __forceinline__ void operator()(const f32x4 (&acc)[2][2][4][2], const Unit& u, int wr, int wc, int fr, int fq) const {
        const int row0 = u.pm * BM + wr * 64 + fr; const int col0 = u.pn * BM + wc * 32 + 8 * fq;
#pragma unroll
        for (int ai = 0; ai < 2; ++ai)
#pragma unroll
            for (int m = 0; m < 4; ++m) { bf16_t* rowp = O + (size_t)(row0 + ai * HALF + m * 16) * ldc + col0;
#pragma unroll
                for (int bj = 0; bj < 2; ++bj) { const f32x4 v0 = acc[ai][bj][m][0], v1 = acc[ai][bj][m][1];
                    u32x4 w; w.x = cvt_pk_bf16(v0[0], v0[1]); w.y = cvt_pk_bf16(v0[2], v0[3]); w.z = cvt_pk_bf16(v1[0], v1[1]); w.w = cvt_pk_bf16(v1[2], v1[3]);
                    *(u32x4*)(rowp + bj * HALF) = w; } }
    }
};
struct EpiResF32 {
    static constexpr bool PERM = false;
    const float* base; float* C; int ldc;
    __device__ __forceinline__ void operator()(const f32x4 (&acc)[2][2][4][2], const Unit& u, int wr, int wc, int fr, int fq) const {
        const int row0 = u.pm * BM + wr * 64 + fr, col0 = u.pn * BM + wc * 32 + 4 * fq;
#pragma unroll
        for (int ai = 0; ai < 2; ++ai)
#pragma unroll
            for (int m = 0; m < 4; ++m) { const size_t off = (size_t)(row0 + ai * HALF + m * 16) * ldc + col0;
#pragma unroll
                for (int bj = 0; bj < 2; ++bj)
#pragma unroll
                    for (int n = 0; n < 2; ++n) { const f32x4 bs = *(const f32x4*)(base + off + bj * HALF + n * 16); *(f32x4*)(C + off + bj * HALF + n * 16) = bs + acc[ai][bj][m][n]; }
                asm volatile("" ::: "memory"); }
    }
};
struct EpiSilu {
    static constexpr bool PERM = true;
    bf16_t* H;
    __device__ __forceinline__ void operator()(const f32x4 (&acc)[2][2][4][2], const Unit& u, int wr, int wc, int fr, int fq) const {
        const int row0 = u.pm * BM + wr * 64 + fr; const int col0 = u.pn * HALF + wc * 32 + 8 * fq;
#pragma unroll
        for (int ai = 0; ai < 2; ++ai)
#pragma unroll
            for (int m = 0; m < 4; ++m) { const int row = row0 + ai * HALF + m * 16; const float w = u.wrow[wr * 64 + fr + ai * HALF + m * 16];
                float o[8];
#pragma unroll
                for (int n = 0; n < 2; ++n)
#pragma unroll
                    for (int j = 0; j < 4; ++j) { const float g = acc[ai][0][m][n][j], up = acc[ai][1][m][n][j]; o[n * 4 + j] = g * __builtin_amdgcn_rcpf(1.f + __expf(-g)) * up * w; }
                u32x4 wv; wv.x = cvt_pk_bf16(o[0], o[1]); wv.y = cvt_pk_bf16(o[2], o[3]); wv.z = cvt_pk_bf16(o[4], o[5]); wv.w = cvt_pk_bf16(o[6], o[7]);
                *(u32x4*)(H + (size_t)row * 256 + col0) = wv; }
    }
};

template <class Epi, class Sched, bool GATHER>
__device__ __forceinline__ void gemm_phase(PG8_LAS unsigned char* lds, const int K, const Sched& S, const Epi& E) {
    const int tid = threadIdx.x, wid = __builtin_amdgcn_readfirstlane(tid >> 6), lane = tid & 63, wr = wid >> 2, wc = wid & 3, fr = lane & 15, fq = lane >> 4;
    const int nt = K / BK;
    const size_t kstep = (size_t)(BK * 2);
    const unsigned hstep = (unsigned)HALF * K * 2;
    int sR[2], sC[2];
    unsigned voffB[2], vc[2][2], vn[2][2];
#pragma unroll
    for (int i = 0; i < 2; ++i) { int R, C; stage_rc(tid * 16 + i * 8192, R, C); sR[i] = R; sC[i] = C; const int Rb = Epi::PERM ? ((R & ~31) + perm32(R & 31)) : R;
        voffB[i] = (unsigned)(Rb * K + C) * 2u; vc[0][i] = (unsigned)(R * K + C) * 2u; vc[1][i] = vc[0][i] + hstep; vn[0][i] = vc[0][i]; vn[1][i] = vc[1][i]; }
    const unsigned ldsw = (unsigned)wid * 1024u;
    const int aoff = lds_byte(wr * 64 + fr, fq * 8), boff = lds_byte(wc * 32 + fr, fq * 8);
#define PG8_SA(b, h) (((b) * 2 + (h)) * HTB)
#define PG8_SB(b, h) ((4 + (b) * 2 + (h)) * HTB)
#define PG8_STAGE(bufoff, gbase, voff) do { _Pragma("unroll") for (int _i = 0; _i < 2; ++_i) \
        __builtin_amdgcn_global_load_lds((const unsigned*)((const char*)(gbase) + (voff)[_i]), (PG8_LAS unsigned*)(lds + (bufoff) + ldsw + _i * 8192), 16, 0, 0); } while (0)
#define PG8_LDA(dst, b, h) do { _Pragma("unroll") for (int m = 0; m < 4; ++m) _Pragma("unroll") for (int k = 0; k < 2; ++k) dst[m][k] = *(const PG8_LAS bf16x8*)(lds + PG8_SA(b, h) + aoff + m * 2048 + k * 1024); } while (0)
#define PG8_LDB(dst, b, h) do { _Pragma("unroll") for (int n = 0; n < 2; ++n) _Pragma("unroll") for (int k = 0; k < 2; ++k) dst[n][k] = *(const PG8_LAS bf16x8*)(lds + PG8_SB(b, h) + boff + n * 2048 + k * 1024); } while (0)
#define PG8_MMA(ai, bj, At, Bt) do { __builtin_amdgcn_s_setprio(1); _Pragma("unroll") for (int m = 0; m < 4; ++m) _Pragma("unroll") for (int n = 0; n < 2; ++n) _Pragma("unroll") for (int k = 0; k < 2; ++k) \
        acc[ai][bj][m][n] = __builtin_amdgcn_mfma_f32_16x16x32_bf16(Bt[n][k], At[m][k], acc[ai][bj][m][n], 0, 0, 0); __builtin_amdgcn_s_setprio(0); } while (0)
#define PG8_WAIT_V(n) asm volatile("s_waitcnt vmcnt(" #n ")" ::: "memory")
#define PG8_WAIT_L(n) asm volatile("s_waitcnt lgkmcnt(" #n ")" ::: "memory")
#define PG8_BAR __builtin_amdgcn_s_barrier()
#define PG8_SCHED __builtin_amdgcn_sched_barrier(0)
#define PG8_GV(dst, u) do { if constexpr (GATHER) { _Pragma("unroll") for (int _h = 0; _h < 2; ++_h) _Pragma("unroll") for (int _i = 0; _i < 2; ++_i) { const int _idx = _h * HALF + sR[_i]; \
        const int _tok = (u).rows[_idx < (u).nvalid ? _idx : 0]; dst[_h][_i] = ((unsigned)_tok * (unsigned)K + (unsigned)sC[_i]) * 2u; } } } while (0)
    Unit cur, nxt; int ui = 0;
    if (!S.next(0, cur)) return;
    f32x4 acc[2][2][4][2];
#pragma unroll
    for (int a = 0; a < 2; ++a)
#pragma unroll
        for (int b = 0; b < 2; ++b)
#pragma unroll
            for (int m = 0; m < 4; ++m)
#pragma unroll
                for (int n = 0; n < 2; ++n) acc[a][b][m][n] = (f32x4){0.f, 0.f, 0.f, 0.f};
    bf16x8 At[4][2], B0[2][2], B1[2][2];
    const char* cA = cur.a; const char* cB = cur.b;
    PG8_GV(vc, cur);
    PG8_STAGE(PG8_SB(0, 0), cB, voffB); PG8_STAGE(PG8_SB(0, 1), cB + hstep, voffB); PG8_STAGE(PG8_SA(0, 0), cA, vc[0]); PG8_STAGE(PG8_SA(0, 1), cA, vc[1]);
    if (wr == 1) PG8_BAR;
    PG8_WAIT_V(2); PG8_BAR;
    PG8_STAGE(PG8_SB(1, 0), cB + kstep, voffB); PG8_STAGE(PG8_SA(1, 0), cA + kstep, vc[0]); PG8_STAGE(PG8_SB(1, 1), cB + hstep + kstep, voffB);
    PG8_WAIT_V(6); PG8_BAR;
    for (;;) {
        const bool has_next = S.next(ui + 1, nxt);
        const char* nA = has_next ? nxt.a : cA; const char* nB = has_next ? nxt.b : cB;
        if constexpr (GATHER) { if (has_next) { PG8_GV(vn, nxt); } else {
#pragma unroll
            for (int h = 0; h < 2; ++h)
#pragma unroll
                for (int i = 0; i < 2; ++i) vn[h][i] = vc[h][i]; } }
#pragma unroll 1
        for (int t = 0; t < nt; t += 2) {
            const bool last = (t == nt - 2);
            const char* a1 = cA + (size_t)(t + 1) * kstep;
            const char* a2 = last ? nA : cA + (size_t)(t + 2) * kstep; const char* b2 = last ? nB : cB + (size_t)(t + 2) * kstep;
            const char* a3 = a2 + kstep; const char* b3 = b2 + kstep;
            unsigned v2[2][2];
#pragma unroll
            for (int h = 0; h < 2; ++h)
#pragma unroll
                for (int i = 0; i < 2; ++i) v2[h][i] = (GATHER && last) ? vn[h][i] : vc[h][i];
            PG8_LDB(B0, 0, 0); PG8_LDB(B1, 0, 1); PG8_SCHED; PG8_LDA(At, 0, 0); PG8_STAGE(PG8_SA(1, 1), a1, vc[1]);
            PG8_WAIT_V(8); PG8_WAIT_L(0); PG8_BAR; PG8_MMA(0, 0, At, B0); PG8_MMA(0, 1, At, B1); PG8_BAR; PG8_SCHED;
            PG8_LDA(At, 0, 1); PG8_STAGE(PG8_SB(0, 0), b2, voffB); PG8_STAGE(PG8_SB(0, 1), b2 + hstep, voffB); PG8_STAGE(PG8_SA(0, 0), a2, v2[0]);
            PG8_WAIT_V(8); PG8_WAIT_L(0); PG8_BAR; PG8_MMA(1, 0, At, B0); PG8_MMA(1, 1, At, B1); PG8_BAR; PG8_SCHED;
            PG8_LDB(B0, 1, 0); PG8_LDB(B1, 1, 1); PG8_SCHED; PG8_LDA(At, 1, 0); PG8_STAGE(PG8_SA(0, 1), a2, v2[1]);
            PG8_WAIT_V(8); PG8_WAIT_L(0); PG8_BAR; PG8_MMA(0, 0, At, B0); PG8_MMA(0, 1, At, B1); PG8_BAR; PG8_SCHED;
            PG8_LDA(At, 1, 1); PG8_STAGE(PG8_SB(1, 0), b3, voffB); PG8_STAGE(PG8_SB(1, 1), b3 + hstep, voffB); PG8_STAGE(PG8_SA(1, 0), a3, v2[0]);
            PG8_WAIT_V(8); PG8_WAIT_L(0); PG8_BAR; PG8_MMA(1, 0, At, B0); PG8_MMA(1, 1, At, B1); PG8_BAR; PG8_SCHED;
        }
        if (wr == 0) PG8_BAR;
        E(acc, cur, wr, wc, fr, fq);
        if (!has_next) break;
#pragma unroll
        for (int a = 0; a < 2; ++a)
#pragma unroll
            for (int b = 0; b < 2; ++b)
#pragma unroll
                for (int m = 0; m < 4; ++m)
#pragma unroll
                    for (int n = 0; n < 2; ++n) acc[a][b][m][n] = (f32x4){0.f, 0.f, 0.f, 0.f};
        cur = nxt; cA = nA; cB = nB; ++ui;
        if constexpr (GATHER) {
#pragma unroll
            for (int h = 0; h < 2; ++h)
#pragma unroll
                for (int i = 0; i < 2; ++i) vc[h][i] = vn[h][i]; }
        if (wr == 1) PG8_BAR;
    }
    PG8_WAIT_V(0);
    PG8_BAR;
#undef PG8_SA
#undef PG8_SB
#undef PG8_STAGE
#undef PG8_LDA
#undef PG8_LDB
#undef PG8_MMA
#undef PG8_WAIT_V
#undef PG8_WAIT_L
#undef PG8_BAR
#undef PG8_SCHED
#undef PG8_GV
}
}
struct Frame {
    LAS unsigned char* lds; unsigned char* ws; unsigned* ctl;
    int tid, lane, wave, G, vcu;
};

__device__ __forceinline__ void cvt_tile(const float* W, int N, int K, int k0, int n0, bf16* dst, int drow0, float scale, LAS float* scr, int lane) {
#pragma unroll 8
    for (int i = 0; i < 32; ++i) { const int kk = 2 * i + (lane >> 5); scr[kk * 33 + (lane & 31)] = W[(size_t)(k0 + kk) * N + n0 + (lane & 31)]; }
    LDS_WAIT(); asm volatile("" ::: "memory");
    const int c = lane & 7;
#pragma unroll
    for (int j = 0; j < 4; ++j) { const int n = (lane >> 3) + 8 * j; const LAS float* s = scr + (8 * c) * 33 + n;
        u32x4 o; o.x = pk2(s[0 * 33] * scale, s[1 * 33] * scale); o.y = pk2(s[2 * 33] * scale, s[3 * 33] * scale); o.z = pk2(s[4 * 33] * scale, s[5 * 33] * scale); o.w = pk2(s[6 * 33] * scale, s[7 * 33] * scale);
        *(u32x4*)(dst + (size_t)(drow0 + n) * K + k0 + 8 * c) = o; }
    LDS_WAIT(); asm volatile("" ::: "memory");
}
__device__ __forceinline__ void convert_phase(Frame& F, const Args& a, int l) {
    using namespace cfg;
    LAS float* scr = (LAS float*)(F.lds + F.wave * 16384);
    const int gw = F.vcu * 8 + F.wave, NGW = F.G * 8;
    const float* w_in = a.in[1] + (size_t)l * D * INC; const float* w_out = a.in[2] + (size_t)l * D * D;
    const size_t es = (size_t)NEXP * D * EH;
    const float* wg = a.in[29] + l * es; const float* wu = a.in[30] + l * es; const float* wd = a.in[31] + l * es;
    bf16* Wi = (bf16*)(F.ws + wsm::W_IN); bf16* Wo = (bf16*)(F.ws + wsm::W_OUT); bf16* Wgu = (bf16*)(F.ws + wsm::W_GU); bf16* Wd = (bf16*)(F.ws + wsm::W_D);
    constexpr int I_IN = 32 * 200, I_OUT = 32 * 64, I_G = 32 * 256, I_D = 32 * 256;
    constexpr int NITEMS = I_IN + I_OUT + 2 * I_G + I_D;
    for (int it = gw; it < NITEMS; it += NGW) {
        int r = it;
        if (r < I_IN) { const int kb = r / 200, nb = r % 200, n0 = nb * 32; const bool isq = (n0 >= OFF_BQ && n0 < OFF_BK) || (n0 >= OFF_CQ && n0 < OFF_CK);
            cvt_tile(w_in, INC, D, kb * 64, n0, Wi, n0, isq ? C2F : 1.f, scr, F.lane); continue; } r -= I_IN;
        if (r < I_OUT) { const int kb = r / 64, nb = r % 64; cvt_tile(w_out, D, D, kb * 64, nb * 32, Wo, nb * 32, 1.f, scr, F.lane); continue; } r -= I_OUT;
        if (r < 2 * I_G) { const int up = r >= I_G; if (up) r -= I_G; const int e = r >> 8, q = r & 255, kb = q >> 3, nb = q & 7, n0 = nb * 32;
            cvt_tile((up ? wu : wg) + (size_t)e * D * EH, EH, D, kb * 64, n0, Wgu, e * 512 + 256 * (n0 >> 7) + (n0 & 127) + (up ? 128 : 0), 1.f, scr, F.lane); continue; } r -= 2 * I_G;
        { const int e = r >> 8, q = r & 255, kb = q >> 6, nb = q & 63; cvt_tile(wd + (size_t)e * EH * D, D, EH, kb * 64, nb * 32, Wd + (size_t)e * D * EH, nb * 32, 1.f, scr, F.lane); }
    }
    bf16* Wr = (bf16*)(F.ws + wsm::WRT); const float* rg = a.in[25] + (size_t)l * D * 4; const float* re = a.in[27] + (size_t)l * D * 32;
    for (int idx = (F.vcu * 512 + F.tid); idx < 48 * 2048; idx += F.G * 512) { const int n = idx >> 11, k = idx & 2047;
        const float v = n < 4 ? rg[k * 4 + n] : (n < 36 ? re[k * 32 + n - 4] : 0.f); Wr[idx] = (bf16)f2bf(v); }
}

__device__ __forceinline__ void build_pref(Frame& F, int l) {
    LAS int* pref = (LAS int*)(F.lds + TAB_OFF);
    if (F.tid == 0) { int s = 0; for (int e = 0; e < 32; ++e) { pref[e] = s; const unsigned c = __hip_atomic_load(F.ctl + wsm::CW_CNT + (l * 32 + e) * 64, RLX_AGENT); pref[40 + e] = (int)c; s += (int)((c + 255u) >> 8); } pref[32] = s; }
    __syncthreads();
}

template <bool COMBINE, bool ROUTER, bool FINAL>
__device__ __forceinline__ void norm_phase(Frame& F, const Args& a, const float* xsrc, float* xout, const float* gain, int l) {
    using namespace cfg;
    constexpr int PITCHB = 4112;
    LAS unsigned char* tile = F.lds;
    LAS float* part = (LAS float*)(F.lds + 67584);
    LAS int* pref = (LAS int*)(F.lds + TAB_OFF);
    bf16* xn = (bf16*)(F.ws + wsm::XN);
    const bf16* OB = (const bf16*)(F.ws + wsm::OB);
    const int4* tokinfo = (const int4*)(F.ws + wsm::TOKINFO);
    const int lane = F.lane, w = F.wave;
    f32x4 g4[8];
#pragma unroll
    for (int j = 0; j < 8; ++j) g4[j] = *(const f32x4*)(gain + 4 * lane + 256 * j);
    for (int pass = F.vcu; pass < M / 16; pass += F.G) {
#pragma unroll
        for (int rr = 0; rr < 2; ++rr) {
            const int rt = 2 * w + rr, row = pass * 16 + rt;
            const float* xr = xsrc + (size_t)row * D + 4 * lane;
            f32x4 v[8];
#pragma unroll
            for (int j = 0; j < 8; ++j) v[j] = *(const f32x4*)(xr + 256 * j);
            if constexpr (COMBINE) {
                const int4 ti = tokinfo[row];
                const bf16* o0 = OB + ((size_t)pref[ti.x] * 256 + ti.y) * D + 4 * lane; const bf16* o1 = OB + ((size_t)pref[ti.z] * 256 + ti.w) * D + 4 * lane;
#pragma unroll
                for (int j = 0; j < 8; ++j) { const u32x2 p0 = *(const u32x2*)(o0 + 256 * j), p1 = *(const u32x2*)(o1 + 256 * j);
                    v[j].x += __uint_as_float(p0.x << 16) + __uint_as_float(p1.x << 16); v[j].y += __uint_as_float(p0.x & 0xffff0000u) + __uint_as_float(p1.x & 0xffff0000u);
                    v[j].z += __uint_as_float(p0.y << 16) + __uint_as_float(p1.y << 16); v[j].w += __uint_as_float(p0.y & 0xffff0000u) + __uint_as_float(p1.y & 0xffff0000u); }
                if constexpr (!FINAL) {
#pragma unroll
                    for (int j = 0; j < 8; ++j) *(f32x4*)(xout + (size_t)row * D + 4 * lane + 256 * j) = v[j];
                }
            }
            float s = 0.f;
#pragma unroll
            for (int j = 0; j < 8; ++j) s += (v[j].x * v[j].x + v[j].y * v[j].y) + (v[j].z * v[j].z + v[j].w * v[j].w);
            const float rstd = rsqrtf(wave_sum(s) * (1.f / D) + 1e-6f);
#pragma unroll
            for (int j = 0; j < 8; ++j) { const f32x4 o = v[j] * rstd * g4[j];
                if constexpr (FINAL) *(f32x4*)(xout + (size_t)row * D + 4 * lane + 256 * j) = o;
                else { u32x2 pk; pk.x = pk2(o.x, o.y); pk.y = pk2(o.z, o.w);
                    *(u32x2*)(xn + (size_t)row * D + 4 * lane + 256 * j) = pk;
                    if constexpr (ROUTER) *(LAS u32x2*)(tile + rt * PITCHB + (4 * lane + 256 * j) * 2) = pk; } }
        }
        if constexpr (ROUTER) {
            __syncthreads();
            const bf16* Wr = (const bf16*)(F.ws + wsm::WRT);
            f32x4 acc[3] = {(f32x4){0.f, 0.f, 0.f, 0.f}, (f32x4){0.f, 0.f, 0.f, 0.f}, (f32x4){0.f, 0.f, 0.f, 0.f}};
#pragma unroll
            for (int s8 = 0; s8 < 8; ++s8) { const int k = 256 * w + 32 * s8 + 8 * (lane >> 4);
                const bf16x8 af = *(const LAS bf16x8*)(tile + (lane & 15) * PITCHB + k * 2);
#pragma unroll
                for (int nt = 0; nt < 3; ++nt) { const bf16x8 bfr = *(const bf16x8*)(Wr + (size_t)(16 * nt + (lane & 15)) * D + k);
                    acc[nt] = __builtin_amdgcn_mfma_f32_16x16x32_bf16(af, bfr, acc[nt], 0, 0, 0); } }
#pragma unroll
            for (int nt = 0; nt < 3; ++nt)
#pragma unroll
                for (int i = 0; i < 4; ++i) part[(w * 16 + (lane >> 4) * 4 + i) * 48 + 16 * nt + (lane & 15)] = acc[nt][i];
            __syncthreads();
            if (F.tid < 16) {
                const int m = F.tid, tok = pass * 16 + m;
                const float* bg = a.in[26] + l * 4; const float* be = a.in[28] + l * 32;
                float lg[4];
#pragma unroll
                for (int o = 0; o < 4; ++o) { float sacc = bg[o];
#pragma unroll
                    for (int ww = 0; ww < 8; ++ww) sacc += part[(ww * 16 + m) * 48 + o]; lg[o] = sacc; }
                int gi = 0; float gm = lg[0];
#pragma unroll
                for (int o = 1; o < 4; ++o) if (lg[o] > gm) { gm = lg[o]; gi = o; }
                float gs = 0.f;
#pragma unroll
                for (int o = 0; o < 4; ++o) gs += __expf(lg[o] - gm);
                const float gw = 1.f / gs;
                float el[8];
#pragma unroll
                for (int o = 0; o < 8; ++o) { float sacc = be[gi * 8 + o];
#pragma unroll
                    for (int ww = 0; ww < 8; ++ww) sacc += part[(ww * 16 + m) * 48 + 4 + gi * 8 + o]; el[o] = sacc; }
                int i1 = 0; float m1 = el[0];
#pragma unroll
                for (int o = 1; o < 8; ++o) if (el[o] > m1) { m1 = el[o]; i1 = o; }
                int i2 = 0; float m2 = -3e38f;
#pragma unroll
                for (int o = 0; o < 8; ++o) if (o != i1 && el[o] > m2) { m2 = el[o]; i2 = o; }
                const float e2x = __expf(m2 - m1); const float w1 = gw / (1.f + e2x), w2 = gw * e2x / (1.f + e2x);
                const int e1 = gi * 8 + i1, e2 = gi * 8 + i2;
                const int p1 = (int)__hip_atomic_fetch_add(F.ctl + wsm::CW_CNT + (l * 32 + e1) * 64, 1u, RLX_AGENT);
                const int p2 = (int)__hip_atomic_fetch_add(F.ctl + wsm::CW_CNT + (l * 32 + e2) * 64, 1u, RLX_AGENT);
                int* lists = (int*)(F.ws + wsm::LISTS); float* wl = (float*)(F.ws + wsm::WLIST);
                lists[e1 * LCAP + p1] = tok; lists[e2 * LCAP + p2] = tok; wl[e1 * LCAP + p1] = w1; wl[e2 * LCAP + p2] = w2;
                ((int4*)(F.ws + wsm::TOKINFO))[tok] = make_int4(e1, p1, e2, p2);
                ((int4*)(F.ws + wsm::ROUTE))[tok] = make_int4(e1, e2, __float_as_int(w1), __float_as_int(w2));
            }
            __syncthreads();
        }
    }
}
struct MoeOrder {
    const LAS int* pref; int G, c, npn, mode;
    const char* A; const char* B; const int* lists; const float* wl;
    __device__ __forceinline__ bool next(int i, pg8::Unit& u) const {
        const int total = __builtin_amdgcn_readfirstlane(pref[32]) * npn;
        const long L = (long)i * G + c; if (L >= total) return false;
        int wgid = (int)L; { const int q = total / 8, r = total % 8, xcd = wgid % 8, off = wgid / 8; wgid = (xcd < r ? xcd * (q + 1) : r * (q + 1) + (xcd - r) * q) + off; }
        const int panel = wgid / npn, pn = wgid % npn;
        int e = 0;
        for (int k = 1; k < 32; ++k) { const int pk = __builtin_amdgcn_readfirstlane(pref[k]); if (pk <= panel) e = k; }
        const int tl = panel - __builtin_amdgcn_readfirstlane(pref[e]);
        u.pm = panel; u.pn = pn;
        if (mode == 0) { u.a = A; u.b = B + ((size_t)e * 512 + (size_t)pn * 256) * 2048 * 2; u.rows = lists + e * LCAP + tl * 256; const int rem = __builtin_amdgcn_readfirstlane(pref[40 + e]) - tl * 256; u.nvalid = rem < 256 ? rem : 256; u.wrow = wl + e * LCAP + tl * 256; }
        else { u.a = A + (size_t)panel * 256 * 256 * 2; u.b = B + ((size_t)e * 2048 + (size_t)pn * 256) * 256 * 2; u.rows = nullptr; u.nvalid = 256; u.wrow = nullptr; }
        return true;
    }
};

#define IN(k) (lo <= (k) && (k) < hi)
#define SEAM(k) do { if (IN(k) && IN((k) + 1)) xcd_barrier(bar); } while (0)
template <int l>
__device__ __forceinline__ void layer_phases(Frame& F, const Args& args, const XcdBarrier& bar, const int lo, const int hi) {
    using namespace cfg;
    float* xo = args.out;

        const int pb = 8 * l;
        const float* xin = (l == 0) ? args.in[0] : xo;
        if (IN(pb + 0)) {
            convert_phase(F, args, l);
            if (l == 0) norm_phase<false, false, false>(F, args, xin, nullptr, args.in[3] + l * D, l);
            else if (args.flags & 1) { build_pref(F, l - 1); norm_phase<true, false, false>(F, args, xin, xo, args.in[3] + l * D, l); }
            else norm_phase<false, false, false>(F, args, xin, nullptr, args.in[3] + l * D, l);
        }
        SEAM(pb + 0);
        if (IN(pb + 1)) {
            pg8::StaticOrder S; S.init((const bf16*)(F.ws + wsm::XN), (const bf16*)(F.ws + wsm::W_IN), M, INC, D, F.G, (int)blockIdx.x);
            pg8::EpiBf16 E{(bf16*)(F.ws + wsm::P), INC};
            pg8::gemm_phase<pg8::EpiBf16, pg8::StaticOrder, false>(F.lds, D, S, E);
        }
        SEAM(pb + 1);
        if (IN(pb + 2)) { }
        SEAM(pb + 2);
        if (IN(pb + 3)) { }
        SEAM(pb + 3);
        if (IN(pb + 4)) {
            pg8::StaticOrder S; S.init((const bf16*)(F.ws + wsm::Y), (const bf16*)(F.ws + wsm::W_OUT), M, D, D, F.G, (int)blockIdx.x);
            pg8::EpiResF32 E{xin, xo, D};
            pg8::gemm_phase<pg8::EpiResF32, pg8::StaticOrder, false>(F.lds, D, S, E);
        }
        SEAM(pb + 4);
        if (IN(pb + 5)) norm_phase<false, true, false>(F, args, xo, nullptr, args.in[4] + l * D, l);
        SEAM(pb + 5);
        if (IN(pb + 6)) {
            build_pref(F, l);
            MoeOrder S{(const LAS int*)(F.lds + TAB_OFF), F.G, (int)blockIdx.x, 2, 0, (const char*)(F.ws + wsm::XN), (const char*)(F.ws + wsm::W_GU), (const int*)(F.ws + wsm::LISTS), (const float*)(F.ws + wsm::WLIST)};
            pg8::EpiSilu E{(bf16*)(F.ws + wsm::HB)};
            pg8::gemm_phase<pg8::EpiSilu, MoeOrder, true>(F.lds, D, S, E);
        }
        SEAM(pb + 6);
        if (IN(pb + 7)) {
            build_pref(F, l);
            MoeOrder S{(const LAS int*)(F.lds + TAB_OFF), F.G, (int)blockIdx.x, 8, 1, (const char*)(F.ws + wsm::HB), (const char*)(F.ws + wsm::W_D), nullptr, nullptr};
            pg8::EpiBf16 E{(bf16*)(F.ws + wsm::OB), D};
            pg8::gemm_phase<pg8::EpiBf16, MoeOrder, false>(F.lds, EH, S, E);
        }
        SEAM(pb + 7);
    }
__global__ void __launch_bounds__(512, 2) mk_fwd(Args args) {
    extern __shared__ __attribute__((aligned(16))) unsigned char lds_raw[];
    using namespace cfg;
    Frame F;
    F.lds = (LAS unsigned char*)lds_raw; F.ws = args.ws; F.ctl = (unsigned*)(args.ws + wsm::CTL);
    F.tid = threadIdx.x; F.lane = F.tid & 63; F.wave = __builtin_amdgcn_readfirstlane(F.tid >> 6);
    F.G = gridDim.x; { const int bx = blockIdx.x; F.vcu = (F.G % 8 == 0) ? (bx % 8) * (F.G / 8) + bx / 8 : bx; }
    volatile LAS unsigned* MISC = (volatile LAS unsigned*)(F.lds + MISC_OFF);
    for (int u = F.tid; u < (LDS_BYTES - RING_BYTES) / 4; u += 512) ((LAS unsigned*)(F.lds + RING_BYTES))[u] = 0u;
    __syncthreads();
    const int lo = args.ph_lo, hi = args.ph_hi;
    XcdBarrier bar; bar.bar = F.ctl + wsm::CW_BAR; bar.x = 0; bar.st = nullptr;
    if (hi - lo > 1) bar = xcd_barrier_post(F.ctl + wsm::CW_BAR, MISC + 8);
    float* xo = args.out;
    layer_phases<0>(F, args, bar, lo, hi);
    layer_phases<1>(F, args, bar, lo, hi);
    if (IN(16)) {
        if (args.flags & 1) { build_pref(F, NL - 1); norm_phase<true, false, true>(F, args, xo, xo, args.in[5], 0); }
        else norm_phase<false, false, true>(F, args, xo, xo, args.in[5], 0);
    }
#undef IN
#undef SEAM
}
static void launch_mk(Args a, int lo, int hi, int grid, hipStream_t stream) {
    a.ph_lo = lo; a.ph_hi = hi;
    hipMemsetAsync(a.ws + wsm::CTL + wsm::CW_BAR * 4, 0, XCD_BAR_WORDS * 4, stream);
    hipLaunchKernelGGL(mk_fwd, dim3(grid), dim3(512), LDS_BYTES, stream, a);
}
extern "C" void kernel_launch(void* const* d_in, const int* in_sizes, int n_in, void* d_out, int out_size, void* d_ws, size_t ws_size, hipStream_t stream) {
    using namespace cfg;
    static int grid = 0;
    if (grid == 0) {
        if (n_in != 32 || ws_size < wsm::END) { fprintf(stderr, "kernel_launch: bad args n_in=%d ws=%zu\n", n_in, ws_size); grid = -1; return; }
        int dev = 0, cus = 0; hipGetDevice(&dev); hipDeviceGetAttribute(&cus, hipDeviceAttributeMultiprocessorCount, dev);
        if (hipFuncSetAttribute((const void*)mk_fwd, hipFuncAttributeMaxDynamicSharedMemorySize, LDS_BYTES) != hipSuccess) { fprintf(stderr, "hipFuncSetAttribute failed\n"); grid = -1; return; }
        int per_cu = 0; hipOccupancyMaxActiveBlocksPerMultiprocessor(&per_cu, (const void*)mk_fwd, 512, LDS_BYTES); (void)hipGetLastError();
        grid = cus;
    }
    if (grid < 0) return;
    const float* const* in = (const float* const*)d_in;
    unsigned char* w = (unsigned char*)d_ws;
    hipMemsetAsync(w + wsm::CTL, 0, wsm::CTL_ZERO_BYTES, stream);
    Args a{};
    for (int i = 0; i < 32; ++i) a.in[i] = in[i];
    a.out = (float*)d_out; a.ws = w; a.flags = MK_FLAGS;
    bf16* xn = (bf16*)(w + wsm::XN); bf16* p = (bf16*)(w + wsm::P); bf16* y = (bf16*)(w + wsm::Y); int4* route = (int4*)(w + wsm::ROUTE);
    float* Otmp = (float*)(w + wsm::XN);
    float* x = (float*)d_out;
    for (int l = 0; l < NL; ++l) {
        const int pb = 8 * l;
        launch_mk(a, pb + 0, pb + 2, grid, stream);
        nv::RwkvP rp{in[6] + l * 1792, in[7] + l * 512, in[8] + l * 64 * 512, in[9] + l * 512, in[10] + l * 64 * 512, in[11] + l * 128 * 512,
                     in[12] + l * 512, in[13] + l * 512, in[14] + l * 512, in[15] + l * 512, in[16] + l * 512};
        nv::k_rwkv<<<64, 128, 0, stream>>>(p, rp, y);
        nv::k_band<<<M * 8 / 64, 64, 0, stream>>>(p, in[17] + l * 8 * 257, y, 0.6931471805599453f);
        nv::k_diff<<<M * 8 * 4 / 64, 64, 0, stream>>>(p, in[18], Otmp, 0.6931471805599453f);
        const float lam_init = (float)(0.8 - 0.6 * exp(-0.3 * l));
        nv::DiffP dp{in[19] + l * 64, in[20] + l * 64, in[21] + l * 64, in[22] + l * 64, in[23] + l * 128, lam_init, 0};
        nv::k_diff_combine<<<M * 4 / 4, 256, 0, stream>>>(Otmp, dp, y);
        nv::k_conv<<<M * 512 / 256, 256, 0, stream>>>(p, in[24] + l * 3 * 512, y);
#if MK_FLAGS & 1
        launch_mk(a, pb + 4, pb + 8, grid, stream);
#else
        launch_mk(a, pb + 4, pb + 6, grid, stream);
        const size_t es = (size_t)NEXP * D * EH;
        nv::k_moe<<<M, 256, 0, stream>>>(xn, route, in[29] + l * es, in[30] + l * es, in[31] + l * es, x);
#endif
    }
    launch_mk(a, 16, 17, grid, stream);
}
```

```cpp
#include <hip/hip_runtime.h>
#include <cstdint>
#include <cstdio>
#include <cmath>

typedef unsigned short bf16;
__host__ __device__ __forceinline__ unsigned f2bf(float f) { unsigned u = __builtin_bit_cast(unsigned, f); return (u + 0x7fffu + ((u >> 16) & 1u)) >> 16; }
__host__ __device__ __forceinline__ float bf2f(bf16 b) { return __builtin_bit_cast(float, ((unsigned)b) << 16); }

namespace cfg {
constexpr int D = 2048, BATCH = 8, SEQ = 4096, M = BATCH * SEQ, NL = 2;
constexpr int INC = 6400;
constexpr int OFF_BQ = 1792, OFF_BK = 2304, OFF_BV = 2816, OFF_CQ = 3328, OFF_CK = 3840, OFF_CV = 4352, OFF_D = 4864;
constexpr int NEXP = 32, EH = 256;
}
#define GAS __attribute__((address_space(1)))
#define LAS __attribute__((address_space(3)))
typedef float f32x4 __attribute__((ext_vector_type(4)));
typedef float f32x2 __attribute__((ext_vector_type(2)));
typedef short bf16x8 __attribute__((ext_vector_type(8)));
typedef unsigned u32x4 __attribute__((ext_vector_type(4)));
typedef unsigned u32x2 __attribute__((ext_vector_type(2)));
#define RLX_AGENT __ATOMIC_RELAXED, __HIP_MEMORY_SCOPE_AGENT
#define LDS_WAIT() asm volatile("s_waitcnt lgkmcnt(0)" ::: "memory")
#define VM_WAIT() asm volatile("s_waitcnt vmcnt(0)" ::: "memory")

namespace wsm {
constexpr size_t MiB = 1u << 20;
constexpr size_t CTL = 0, CTL_ZERO_BYTES = 1 * MiB;
constexpr size_t LISTS = 2 * MiB;
constexpr size_t WLIST = 6 * MiB;
constexpr size_t TOKINFO = 10 * MiB;
constexpr size_t ROUTE = 11 * MiB;
constexpr size_t WRT = 12 * MiB;
constexpr size_t W_IN = 16 * MiB;
constexpr size_t W_OUT = 41 * MiB;
constexpr size_t W_GU = 49 * MiB;
constexpr size_t W_D = 113 * MiB;
constexpr size_t XN = 146 * MiB;
constexpr size_t P = 274 * MiB;
constexpr size_t HB = P;
constexpr size_t OB = P + 40 * MiB;
constexpr size_t Y = 674 * MiB;
constexpr size_t RW = 802 * MiB;
constexpr size_t END = 1010 * MiB;
constexpr int CW_BAR = 4096;
constexpr int CW_CNT = 16384;
constexpr int CW_Q = 32768;
}
constexpr int LCAP = 32768;
constexpr int RING_BYTES = 139264;
constexpr int MISC_OFF = RING_BYTES + 320;
constexpr int TAB_OFF = RING_BYTES + 1024;
constexpr int LDS_BYTES = 147456;
constexpr float C2F = 0.125f * 1.4426950408889634f;
constexpr float LOG2E = 1.4426950408889634f;

__device__ __forceinline__ unsigned pk2(float lo, float hi) { return f2bf(lo) | (f2bf(hi) << 16); }
__device__ __forceinline__ float wave_sum(float v) {
#pragma unroll
    for (int o = 1; o < 64; o <<= 1) v += __shfl_xor(v, o);
    return v;
}

struct Args {
    const float* in[32]; float* out; unsigned char* ws;
    int ph_lo, ph_hi, flags, pad;
};
#define XB_TMO      128
#define XB_XCNT(j)  (256  + 64 * (j))
#define XB_XSUB(j)  (1280 + 64 * (j))
#define XB_XGEN(j)  (2304 + 64 * (j))
#define XB_TOP      3328
#define XB_TOPGEN   3392
#define XCD_BAR_WORDS 3456
#define XB_SPIN_CAP (1u << 22)

__device__ __forceinline__ unsigned xb_ld(unsigned* p)              { return __hip_atomic_load(p, __ATOMIC_RELAXED, __HIP_MEMORY_SCOPE_AGENT); }
__device__ __forceinline__ unsigned xb_add(unsigned* p, unsigned v) { return __hip_atomic_fetch_add(p, v, __ATOMIC_RELAXED, __HIP_MEMORY_SCOPE_AGENT); }
__device__ __forceinline__ unsigned xb_xcc_id() { return (unsigned)__builtin_amdgcn_s_getreg((3 << 11) | 20) & 0xFu; }
#define XB_SPIN(cond, bar) do { unsigned _sp = 0; while (cond) { __builtin_amdgcn_s_sleep(1); \
    if ((++_sp & 255u) == 0u) { if (xb_ld(&(bar)[XB_TMO])) break; if (_sp > XB_SPIN_CAP) { atomicAdd(&(bar)[XB_TMO], 1u); break; } } } } while (0)

struct XcdBarrier {
    unsigned* bar; unsigned x;
    volatile LAS unsigned* st;
};

__device__ __forceinline__ XcdBarrier xcd_barrier_post(unsigned* bar, volatile LAS unsigned* st) {
    XcdBarrier b; b.bar = bar; b.x = xb_xcc_id(); b.st = st;
    if (threadIdx.x == 0) (void)xb_add(&bar[XB_XCNT(b.x)], 1u);
    return b;
}
__device__ __forceinline__ void xcd_barrier_complete(unsigned* bar, unsigned x, unsigned& nloc, unsigned& nx) {
    const unsigned G = gridDim.x * gridDim.y * gridDim.z;
    unsigned sum, cnt, mine, sp = 0u;
    for (;;) {
        sum = 0u; cnt = 0u; mine = 0u;
#pragma unroll
        for (unsigned j = 0; j < 16; ++j) { const unsigned c = xb_ld(&bar[XB_XCNT(j)]); sum += c; cnt += (c > 0u) ? 1u : 0u; mine = (j == x) ? c : mine; }
        if (sum == G) break;
        __builtin_amdgcn_s_sleep(1);
        if ((++sp & 255u) == 0u) { if (xb_ld(&bar[XB_TMO])) break; if (sp > XB_SPIN_CAP) { atomicAdd(&bar[XB_TMO], 1u); break; } }
    }
    nloc = mine > 0u ? mine : 1u; nx = cnt > 0u ? cnt : 1u;
}

__device__ __forceinline__ void xcd_barrier(const XcdBarrier& b) {
    asm volatile("s_waitcnt vmcnt(0)" ::: "memory");
    __syncthreads();
    if (threadIdx.x == 0) {
        unsigned* bar = b.bar;
        __builtin_amdgcn_s_waitcnt(0);
        unsigned nloc = b.st[0], nx = b.st[1];
        if (nloc == 0u) { xcd_barrier_complete(bar, b.x, nloc, nx); b.st[0] = nloc; b.st[1] = nx; }
        const unsigned old = xb_add(&bar[XB_XSUB(b.x)], 1u);
        const unsigned gen = old / nloc;
        if (old + 1u == (gen + 1u) * nloc) {
            __builtin_amdgcn_fence(__ATOMIC_RELEASE, "agent");
            asm volatile("s_waitcnt vmcnt(0)" ::: "memory");
            const unsigned og = xb_add(&bar[XB_TOP], 1u);
            const unsigned tg = og / nx;
            if (og + 1u == (tg + 1u) * nx) xb_add(&bar[XB_TOPGEN], 1u);
            else XB_SPIN(xb_ld(&bar[XB_TOPGEN]) == tg, bar);
            __builtin_amdgcn_fence(__ATOMIC_ACQUIRE, "agent");
            xb_add(&bar[XB_XGEN(b.x)], 1u);
            asm volatile("s_waitcnt vmcnt(0)" ::: "memory");
        } else {
            XB_SPIN(xb_ld(&bar[XB_XGEN(b.x)]) == gen, bar);
            __builtin_amdgcn_fence(__ATOMIC_ACQUIRE, "agent");
            asm volatile("s_waitcnt vmcnt(0)" ::: "memory");
        }
    }
    __syncthreads();
}
namespace pg8 {
#define PG8_LAS __attribute__((address_space(3)))
typedef unsigned short bf16_t;
typedef short bf16x8 __attribute__((ext_vector_type(8)));
typedef float f32x4 __attribute__((ext_vector_type(4)));
typedef unsigned u32x4 __attribute__((ext_vector_type(4)));
typedef unsigned u32x2 __attribute__((ext_vector_type(2)));
constexpr int BM = 256, BK = 64, HALF = 128, HTB = HALF * BK * 2, STAGE_BYTES = 8 * HTB, NXCD = 8, WGM = 8;

__host__ __device__ __forceinline__ int lds_byte(int r, int c) { const int st = (r >> 4) * 2 + (c >> 5), rr = r & 15, cc = c & 31, ob = rr * 64 + cc * 2; return st * 1024 + (ob ^ (((ob >> 9) & 1) << 5)); }
__host__ __device__ __forceinline__ void stage_rc(int b, int& R, int& C) { const int st = b / 1024, sb = b % 1024, swz = sb ^ (((sb >> 9) & 1) << 5); R = (st >> 1) * 16 + swz / 64; C = (st & 1) * 32 + (swz % 64) / 2; }
__host__ __device__ __forceinline__ int perm32(int rho) { const int n = rho >> 4, i = rho & 15; return 8 * (i >> 2) + 4 * n + (i & 3); }

struct Unit { int pm, pn; const char* a; const char* b; const int* rows; const float* wrow; int nvalid; int pad_; };

struct StaticOrder {
    int nM, nN, nwg, G, c; const char* A; const char* Bt; size_t tstep;
    __device__ void init(const bf16_t* A_, const bf16_t* Bt_, int M, int N, int K, int G_, int c_) { nM = M / BM; nN = N / BM; nwg = nM * nN; G = G_; c = c_; A = (const char*)A_; Bt = (const char*)Bt_; tstep = (size_t)BM * K * 2; }
    __device__ bool next(int i, Unit& u) const {
        const long L = (long)i * G + c; if (L >= nwg) return false;
        int wgid = (int)L; { const int q = nwg / NXCD, r = nwg % NXCD, xcd = wgid % NXCD, off = wgid / NXCD; wgid = (xcd < r ? xcd * (q + 1) : r * (q + 1) + (xcd - r) * q) + off; }
        const int nig = WGM * nN, gid = wgid / nig, fm = gid * WGM, gsz = (nM - fm) < WGM ? (nM - fm) : WGM;
        u.pm = fm + ((wgid % nig) % gsz); u.pn = (wgid % nig) / gsz; u.a = A + (size_t)u.pm * tstep; u.b = Bt + (size_t)u.pn * tstep; u.rows = nullptr; u.wrow = nullptr; u.nvalid = 256; return true;
    }
};

__device__ __forceinline__ unsigned cvt_pk_bf16(float lo, float hi) { unsigned r; asm volatile("v_cvt_pk_bf16_f32 %0, %1, %2" : "=v"(r) : "v"(lo), "v"(hi)); return r; }

struct EpiBf16 {
    static constexpr bool PERM = true;
    bf16_t* O; int ldc;
    __device__ __forceinline__ void operator()(const f32x4 (&acc)[2][2][4][2], const Unit& u, int wr, int wc, int fr, int fq) const {
        const int row0 = u.pm * BM + wr * 64 + fr; const int col0 = u.pn * BM + wc * 32 + 8 * fq;
#pragma unroll
        for (int ai = 0; ai < 2; ++ai)
#pragma unroll
            for (int m = 0; m < 4; ++m) { bf16_t* rowp = O + (size_t)(row0 + ai * HALF + m * 16) * ldc + col0;
#pragma unroll
                for (int bj = 0; bj < 2; ++bj) { const f32x4 v0 = acc[ai][bj][m][0], v1 = acc[ai][bj][m][1];
                    u32x4 w; w.x = cvt_pk_bf16(v0[0], v0[1]); w.y = cvt_pk_bf16(v0[2], v0[3]); w.z = cvt_pk_bf16(v1[0], v1[1]); w.w = cvt_pk_bf16(v1[2], v1[3]);
                    *(u32x4*)(rowp + bj * HALF) = w; } }
    }
};
struct EpiResF32 {
    static constexpr bool PERM = false;
    const float* base; float* C; int ldc;
    __device__ __forceinline__ void operator()(const f32x4 (&acc)[2][2][4][2], const Unit& u, int wr, int wc, int fr, int fq) const {
        const int row0 = u.pm * BM + wr * 64 + fr, col0 = u.pn * BM + wc * 32 + 4 * fq;
#pragma unroll
        for (int ai = 0; ai < 2; ++ai)
#pragma unroll
            for (int m = 0; m < 4; ++m) { const size_t off = (size_t)(row0 + ai * HALF + m * 16) * ldc + col0;
#pragma unroll
                for (int bj = 0; bj < 2; ++bj)
#pragma unroll
                    for (int n = 0; n < 2; ++n) { const f32x4 bs = *(const f32x4*)(base + off + bj * HALF + n * 16); *(f32x4*)(C + off + bj * HALF + n * 16) = bs + acc[ai][bj][m][n]; }
                asm volatile("" ::: "memory"); }
    }
};
struct EpiSilu {
    static constexpr bool PERM = true;
    bf16_t* H;
    __device__ __forceinline__ void operator()(const f32x4 (&acc)[2][2][4][2], const Unit& u, int wr, int wc, int fr, int fq) const {
        const int row0 = u.pm * BM + wr * 64 + fr; const int col0 = u.pn * HALF + wc * 32 + 8 * fq;
#pragma unroll
        for (int ai = 0; ai < 2; ++ai)
#pragma unroll
            for (int m = 0; m < 4; ++m) { const int row = row0 + ai * HALF + m * 16; const float w = u.wrow[wr * 64 + fr + ai * HALF + m * 16];
                float o[8];
#pragma unroll
                for (int n = 0; n < 2; ++n)
#pragma unroll
                    for (int j = 0; j < 4; ++j) { const float g = acc[ai][0][m][n][j], up = acc[ai][1][m][n][j]; o[n * 4 + j] = g * __builtin_amdgcn_rcpf(1.f + __expf(-g)) * up * w; }
                u32x4 wv; wv.x = cvt_pk_bf16(o[0], o[1]); wv.y = cvt_pk_bf16(o[2], o[3]); wv.z = cvt_pk_bf16(o[4], o[5]); wv.w = cvt_pk_bf16(o[6], o[7]);
                *(u32x4*)(H + (size_t)row * 256 + col0) = wv; }
    }
};

template <class Epi, class Sched, bool GATHER>
__device__ __forceinline__ void gemm_phase(PG8_LAS unsigned char* lds, const int K, const Sched& S, const Epi& E) {
    const int tid = threadIdx.x, wid = __builtin_amdgcn_readfirstlane(tid >> 6), lane = tid & 63, wr = wid >> 2, wc = wid & 3, fr = lane & 15, fq = lane >> 4;
    const int nt = K / BK;
    const size_t kstep = (size_t)(BK * 2);
    const unsigned hstep = (unsigned)HALF * K * 2;
    int sR[2], sC[2];
    unsigned voffB[2], vc[2][2], vn[2][2];
#pragma unroll
    for (int i = 0; i < 2; ++i) { int R, C; stage_rc(tid * 16 + i * 8192, R, C); sR[i] = R; sC[i] = C; const int Rb = Epi::PERM ? ((R & ~31) + perm32(R & 31)) : R;
        voffB[i] = (unsigned)(Rb * K + C) * 2u; vc[0][i] = (unsigned)(R * K + C) * 2u; vc[1][i] = vc[0][i] + hstep; vn[0][i] = vc[0][i]; vn[1][i] = vc[1][i]; }
    const unsigned ldsw = (unsigned)wid * 1024u;
    const int aoff = lds_byte(wr * 64 + fr, fq * 8), boff = lds_byte(wc * 32 + fr, fq * 8);
#define PG8_SA(b, h) (((b) * 2 + (h)) * HTB)
#define PG8_SB(b, h) ((4 + (b) * 2 + (h)) * HTB)
#define PG8_STAGE(bufoff, gbase, voff) do { _Pragma("unroll") for (int _i = 0; _i < 2; ++_i) \
        __builtin_amdgcn_global_load_lds((const unsigned*)((const char*)(gbase) + (voff)[_i]), (PG8_LAS unsigned*)(lds + (bufoff) + ldsw + _i * 8192), 16, 0, 0); } while (0)
#define PG8_LDA(dst, b, h) do { _Pragma("unroll") for (int m = 0; m < 4; ++m) _Pragma("unroll") for (int k = 0; k < 2; ++k) dst[m][k] = *(const PG8_LAS bf16x8*)(lds + PG8_SA(b, h) + aoff + m * 2048 + k * 1024); } while (0)
#define PG8_LDB(dst, b, h) do { _Pragma("unroll") for (int n = 0; n < 2; ++n) _Pragma("unroll") for (int k = 0; k < 2; ++k) dst[n][k] = *(const PG8_LAS bf16x8*)(lds + PG8_SB(b, h) + boff + n * 2048 + k * 1024); } while (0)
#define PG8_MMA(ai, bj, At, Bt) do { __builtin_amdgcn_s_setprio(1); _Pragma("unroll") for (int m = 0; m < 4; ++m) _Pragma("unroll") for (int n = 0; n < 2; ++n) _Pragma("unroll") for (int k = 0; k < 2; ++k) \
        acc[ai][bj][m][n] = __builtin_amdgcn_mfma_f32_16x16x32_bf16(Bt[n][k], At[m][k], acc[ai][bj][m][n], 0, 0, 0); __builtin_amdgcn_s_setprio(0); } while (0)
#define PG8_WAIT_V(n) asm volatile("s_waitcnt vmcnt(" #n ")" ::: "memory")
#define PG8_WAIT_L(n) asm volatile("s_waitcnt lgkmcnt(" #n ")" ::: "memory")
#define PG8_BAR __builtin_amdgcn_s_barrier()
#define PG8_SCHED __builtin_amdgcn_sched_barrier(0)
#define PG8_GV(dst, u) do { if constexpr (GATHER) { _Pragma("unroll") for (int _h = 0; _h < 2; ++_h) _Pragma("unroll") for (int _i = 0; _i < 2; ++_i) { const int _idx = _h * HALF + sR[_i]; \
        const int _tok = (u).rows[_idx < (u).nvalid ? _idx : 0]; dst[_h][_i] = ((unsigned)_tok * (unsigned)K + (unsigned)sC[_i]) * 2u; } } } while (0)
    Unit cur, nxt; int ui = 0;
    if (!S.next(0, cur)) return;
    f32x4 acc[2][2][4][2];
#pragma unroll
    for (int a = 0; a < 2; ++a)
#pragma unroll
        for (int b = 0; b < 2; ++b)
#pragma unroll
            for (int m = 0; m < 4; ++m)
#pragma unroll
                for (int n = 0; n < 2; ++n) acc[a][b][m][n] = (f32x4){0.f, 0.f, 0.f, 0.f};
    bf16x8 At[4][2], B0[2][2], B1[2][2];
    const char* cA = cur.a; const char* cB = cur.b;
    PG8_GV(vc, cur);
    PG8_STAGE(PG8_SB(0, 0), cB, voffB); PG8_STAGE(PG8_SB(0, 1), cB + hstep, voffB); PG8_STAGE(PG8_SA(0, 0), cA, vc[0]); PG8_STAGE(PG8_SA(0, 1), cA, vc[1]);
    if (wr == 1) PG8_BAR;
    PG8_WAIT_V(2); PG8_BAR;
    PG8_STAGE(PG8_SB(1, 0), cB + kstep, voffB); PG8_STAGE(PG8_SA(1, 0), cA + kstep, vc[0]); PG8_STAGE(PG8_SB(1, 1), cB + hstep + kstep, voffB);
    PG8_WAIT_V(6); PG8_BAR;
    for (;;) {
        const bool has_next = S.next(ui + 1, nxt);
        const char* nA = has_next ? nxt.a : cA; const char* nB = has_next ? nxt.b : cB;
        if constexpr (GATHER) { if (has_next) { PG8_GV(vn, nxt); } else {
#pragma unroll
            for (int h = 0; h < 2; ++h)
#pragma unroll
                for (int i = 0; i < 2; ++i) vn[h][i] = vc[h][i]; } }
#pragma unroll 1
        for (int t = 0; t < nt; t += 2) {
            const bool last = (t == nt - 2);
            const char* a1 = cA + (size_t)(t + 1) * kstep;
            const char* a2 = last ? nA : cA + (size_t)(t + 2) * kstep; const char* b2 = last ? nB : cB + (size_t)(t + 2) * kstep;
            const char* a3 = a2 + kstep; const char* b3 = b2 + kstep;
            unsigned v2[2][2];
#pragma unroll
            for (int h = 0; h < 2; ++h)
#pragma unroll
                for (int i = 0; i < 2; ++i) v2[h][i] = (GATHER && last) ? vn[h][i] : vc[h][i];
            PG8_LDB(B0, 0, 0); PG8_LDB(B1, 0, 1); PG8_SCHED; PG8_LDA(At, 0, 0); PG8_STAGE(PG8_SA(1, 1), a1, vc[1]);
            PG8_WAIT_V(8); PG8_WAIT_L(0); PG8_BAR; PG8_MMA(0, 0, At, B0); PG8_MMA(0, 1, At, B1); PG8_BAR; PG8_SCHED;
            PG8_LDA(At, 0, 1); PG8_STAGE(PG8_SB(0, 0), b2, voffB); PG8_STAGE(PG8_SB(0, 1), b2 + hstep, voffB); PG8_STAGE(PG8_SA(0, 0), a2, v2[0]);
            PG8_WAIT_V(8); PG8_WAIT_L(0); PG8_BAR; PG8_MMA(1, 0, At, B0); PG8_MMA(1, 1, At, B1); PG8_BAR; PG8_SCHED;
            PG8_LDB(B0, 1, 0); PG8_LDB(B1, 1, 1); PG8_SCHED; PG8_LDA(At, 1, 0); PG8_STAGE(PG8_SA(0, 1), a2, v2[1]);
            PG8_WAIT_V(8); PG8_WAIT_L(0); PG8_BAR; PG8_MMA(0, 0, At, B0); PG8_MMA(0, 1, At, B1); PG8_BAR; PG8_SCHED;
            PG8_LDA(At, 1, 1); PG8_STAGE(PG8_SB(1, 0), b3, voffB); PG8_STAGE(PG8_SB(1, 1), b3 + hstep, voffB); PG8_STAGE(PG8_SA(1, 0), a3, v2[0]);
            PG8_WAIT_V(8); PG8_WAIT_L(0); PG8_BAR; PG8_MMA(1, 0, At, B0); PG8_MMA(1, 1, At, B1); PG8_BAR; PG8_SCHED;
        }
        if (wr == 0) PG8_BAR;
        E(acc, cur, wr, wc, fr, fq);
        if (!has_next) break;
#pragma unroll
        for (int a = 0; a < 2; ++a)
#pragma unroll
            for (int b = 0; b < 2; ++b)
#pragma unroll
                for (int m = 0; m < 4; ++m)
#pragma unroll
                    for (int n = 0; n < 2; ++n) acc[a][b][m][n] = (f32x4){0.f, 0.f, 0.f, 0.f};
        cur = nxt; cA = nA; cB = nB; ++ui;
        if constexpr (GATHER) {
#pragma unroll
            for (int h = 0; h < 2; ++h)
#pragma unroll
                for (int i = 0; i < 2; ++i) vc[h][i] = vn[h][i]; }
        if (wr == 1) PG8_BAR;
    }
    PG8_WAIT_V(0);
    PG8_BAR;
#undef PG8_SA
#undef PG8_SB
#undef PG8_STAGE
#undef PG8_LDA
#undef PG8_LDB
#undef PG8_MMA
#undef PG8_WAIT_V
#undef PG8_WAIT_L
#undef PG8_BAR
#undef PG8_SCHED
#undef PG8_GV
}
}
struct Frame {
    LAS unsigned char* lds; unsigned char* ws; unsigned* ctl;
    int tid, lane, wave, G, vcu;
};

__device__ __forceinline__ void cvt_tile(const float* W, int N, int K, int k0, int n0, bf16* dst, int drow0, float scale, LAS float* scr, int lane) {
#pragma unroll 8
    for (int i = 0; i < 32; ++i) { const int kk = 2 * i + (lane >> 5); scr[kk * 33 + (lane & 31)] = W[(size_t)(k0 + kk) * N + n0 + (lane & 31)]; }
    LDS_WAIT(); asm volatile("" ::: "memory");
    const int c = lane & 7;
#pragma unroll
    for (int j = 0; j < 4; ++j) { const int n = (lane >> 3) + 8 * j; const LAS float* s = scr + (8 * c) * 33 + n;
        u32x4 o; o.x = pk2(s[0 * 33] * scale, s[1 * 33] * scale); o.y = pk2(s[2 * 33] * scale, s[3 * 33] * scale); o.z = pk2(s[4 * 33] * scale, s[5 * 33] * scale); o.w = pk2(s[6 * 33] * scale, s[7 * 33] * scale);
        *(u32x4*)(dst + (size_t)(drow0 + n) * K + k0 + 8 * c) = o; }
    LDS_WAIT(); asm volatile("" ::: "memory");
}
__device__ __forceinline__ void convert_phase(Frame& F, const Args& a, int l) {
    using namespace cfg;
    LAS float* scr = (LAS float*)(F.lds + F.wave * 16384);
    const int gw = F.vcu * 8 + F.wave, NGW = F.G * 8;
    const float* w_in = a.in[1] + (size_t)l * D * INC; const float* w_out = a.in[2] + (size_t)l * D * D;
    const size_t es = (size_t)NEXP * D * EH;
    const float* wg = a.in[29] + l * es; const float* wu = a.in[30] + l * es; const float* wd = a.in[31] + l * es;
    bf16* Wi = (bf16*)(F.ws + wsm::W_IN); bf16* Wo = (bf16*)(F.ws + wsm::W_OUT); bf16* Wgu = (bf16*)(F.ws + wsm::W_GU); bf16* Wd = (bf16*)(F.ws + wsm::W_D);
    constexpr int I_IN = 32 * 200, I_OUT = 32 * 64, I_G = 32 * 256, I_D = 32 * 256;
    constexpr int NITEMS = I_IN + I_OUT + 2 * I_G + I_D;
    for (int it = gw; it < NITEMS; it += NGW) {
        int r = it;
        if (r < I_IN) { const int kb = r / 200, nb = r % 200, n0 = nb * 32; const bool isq = (n0 >= OFF_BQ && n0 < OFF_BK) || (n0 >= OFF_CQ && n0 < OFF_CK);
            cvt_tile(w_in, INC, D, kb * 64, n0, Wi, n0, isq ? C2F : 1.f, scr, F.lane); continue; } r -= I_IN;
        if (r < I_OUT) { const int kb = r / 64, nb = r % 64; cvt_tile(w_out, D, D, kb * 64, nb * 32, Wo, nb * 32, 1.f, scr, F.lane); continue; } r -= I_OUT;
        if (r < 2 * I_G) { const int up = r >= I_G; if (up) r -= I_G; const int e = r >> 8, q = r & 255, kb = q >> 3, nb = q & 7, n0 = nb * 32;
            cvt_tile((up ? wu : wg) + (size_t)e * D * EH, EH, D, kb * 64, n0, Wgu, e * 512 + 256 * (n0 >> 7) + (n0 & 127) + (up ? 128 : 0), 1.f, scr, F.lane); continue; } r -= 2 * I_G;
        { const int e = r >> 8, q = r & 255, kb = q >> 6, nb = q & 63; cvt_tile(wd + (size_t)e * EH * D, D, EH, kb * 64, nb * 32, Wd + (size_t)e * D * EH, nb * 32, 1.f, scr, F.lane); }
    }
    bf16* Wr = (bf16*)(F.ws + wsm::WRT); const float* rg = a.in[25] + (size_t)l * D * 4; const float* re = a.in[27] + (size_t)l * D * 32;
    for (int idx = (F.vcu * 512 + F.tid); idx < 48 * 2048; idx += F.G * 512) { const int n = idx >> 11, k = idx & 2047;
        const float v = n < 4 ? rg[k * 4 + n] : (n < 36 ? re[k * 32 + n - 4] : 0.f); Wr[idx] = (bf16)f2bf(v); }
    bf16* w2t = (bf16*)(F.ws + wsm::WRT + 262144); bf16* a2t = w2t + 512 * 64; bf16* g2t = a2t + 512 * 64;
    const float* w2 = a.in[8] + (size_t)l * 64 * 512; const float* a2 = a.in[10] + (size_t)l * 64 * 512; const float* g2 = a.in[11] + (size_t)l * 128 * 512;
    for (int idx = (F.vcu * 512 + F.tid); idx < 512 * 256; idx += F.G * 512) { const int ch = idx & 511, j = idx >> 9;
        if (j < 64) w2t[ch * 64 + j] = (bf16)f2bf(w2[j * 512 + ch]); else if (j < 128) a2t[ch * 64 + (j - 64)] = (bf16)f2bf(a2[(j - 64) * 512 + ch]); else g2t[ch * 128 + (j - 128)] = (bf16)f2bf(g2[(j - 128) * 512 + ch]); }
}

__device__ __forceinline__ void build_pref(Frame& F, int l) {
    LAS int* pref = (LAS int*)(F.lds + TAB_OFF);
    if (F.tid == 0) { int s = 0; for (int e = 0; e < 32; ++e) { pref[e] = s; const unsigned c = __hip_atomic_load(F.ctl + wsm::CW_CNT + (l * 32 + e) * 64, RLX_AGENT); pref[40 + e] = (int)c; s += (int)((c + 255u) >> 8); } pref[32] = s; }
    __syncthreads();
}

template <bool COMBINE, bool ROUTER, bool FINAL>
__device__ __forceinline__ void norm_phase(Frame& F, const Args& a, const float* xsrc, float* xout, const float* gain, int l) {
    using namespace cfg;
    constexpr int PITCHB = 4112;
    LAS unsigned char* tile = F.lds;
    LAS float* part = (LAS float*)(F.lds + 67584);
    LAS int* pref = (LAS int*)(F.lds + TAB_OFF);
    bf16* xn = (bf16*)(F.ws + wsm::XN);
    const bf16* OB = (const bf16*)(F.ws + wsm::OB);
    const int4* tokinfo = (const int4*)(F.ws + wsm::TOKINFO);
    const int lane = F.lane, w = F.wave;
    f32x4 g4[8];
#pragma unroll
    for (int j = 0; j < 8; ++j) g4[j] = *(const f32x4*)(gain + 4 * lane + 256 * j);
    for (int pass = F.vcu; pass < M / 16; pass += F.G) {
#pragma unroll
        for (int rr = 0; rr < 2; ++rr) {
            const int rt = 2 * w + rr, row = pass * 16 + rt;
            const float* xr = xsrc + (size_t)row * D + 4 * lane;
            f32x4 v[8];
#pragma unroll
            for (int j = 0; j < 8; ++j) v[j] = *(const f32x4*)(xr + 256 * j);
            if constexpr (COMBINE) {
                const int4 ti = tokinfo[row];
                const bf16* o0 = OB + ((size_t)pref[ti.x] * 256 + ti.y) * D + 4 * lane; const bf16* o1 = OB + ((size_t)pref[ti.z] * 256 + ti.w) * D + 4 * lane;
#pragma unroll
                for (int j = 0; j < 8; ++j) { const u32x2 p0 = *(const u32x2*)(o0 + 256 * j), p1 = *(const u32x2*)(o1 + 256 * j);
                    v[j].x += __uint_as_float(p0.x << 16) + __uint_as_float(p1.x << 16); v[j].y += __uint_as_float(p0.x & 0xffff0000u) + __uint_as_float(p1.x & 0xffff0000u);
                    v[j].z += __uint_as_float(p0.y << 16) + __uint_as_float(p1.y << 16); v[j].w += __uint_as_float(p0.y & 0xffff0000u) + __uint_as_float(p1.y & 0xffff0000u); }
                if constexpr (!FINAL) {
#pragma unroll
                    for (int j = 0; j < 8; ++j) *(f32x4*)(xout + (size_t)row * D + 4 * lane + 256 * j) = v[j];
                }
            }
            float s = 0.f;
#pragma unroll
            for (int j = 0; j < 8; ++j) s += (v[j].x * v[j].x + v[j].y * v[j].y) + (v[j].z * v[j].z + v[j].w * v[j].w);
            const float rstd = rsqrtf(wave_sum(s) * (1.f / D) + 1e-6f);
#pragma unroll
            for (int j = 0; j < 8; ++j) { const f32x4 o = v[j] * rstd * g4[j];
                if constexpr (FINAL) *(f32x4*)(xout + (size_t)row * D + 4 * lane + 256 * j) = o;
                else { u32x2 pk; pk.x = pk2(o.x, o.y); pk.y = pk2(o.z, o.w);
                    *(u32x2*)(xn + (size_t)row * D + 4 * lane + 256 * j) = pk;
                    if constexpr (ROUTER) *(LAS u32x2*)(tile + rt * PITCHB + (4 * lane + 256 * j) * 2) = pk; } }
        }
        if constexpr (ROUTER) {
            __syncthreads();
            const bf16* Wr = (const bf16*)(F.ws + wsm::WRT);
            f32x4 acc[3] = {(f32x4){0.f, 0.f, 0.f, 0.f}, (f32x4){0.f, 0.f, 0.f, 0.f}, (f32x4){0.f, 0.f, 0.f, 0.f}};
#pragma unroll
            for (int s8 = 0; s8 < 8; ++s8) { const int k = 256 * w + 32 * s8 + 8 * (lane >> 4);
                const bf16x8 af = *(const LAS bf16x8*)(tile + (lane & 15) * PITCHB + k * 2);
#pragma unroll
                for (int nt = 0; nt < 3; ++nt) { const bf16x8 bfr = *(const bf16x8*)(Wr + (size_t)(16 * nt + (lane & 15)) * D + k);
                    acc[nt] = __builtin_amdgcn_mfma_f32_16x16x32_bf16(af, bfr, acc[nt], 0, 0, 0); } }
#pragma unroll
            for (int nt = 0; nt < 3; ++nt)
#pragma unroll
                for (int i = 0; i < 4; ++i) part[(w * 16 + (lane >> 4) * 4 + i) * 48 + 16 * nt + (lane & 15)] = acc[nt][i];
            __syncthreads();
            if (F.tid < 16) {
                const int m = F.tid, tok = pass * 16 + m;
                const float* bg = a.in[26] + l * 4; const float* be = a.in[28] + l * 32;
                float lg[4];
#pragma unroll
                for (int o = 0; o < 4; ++o) { float sacc = bg[o];
#pragma unroll
                    for (int ww = 0; ww < 8; ++ww) sacc += part[(ww * 16 + m) * 48 + o]; lg[o] = sacc; }
                int gi = 0; float gm = lg[0];
#pragma unroll
                for (int o = 1; o < 4; ++o) if (lg[o] > gm) { gm = lg[o]; gi = o; }
                float gs = 0.f;
#pragma unroll
                for (int o = 0; o < 4; ++o) gs += __expf(lg[o] - gm);
                const float gw = 1.f / gs;
                float el[8];
#pragma unroll
                for (int o = 0; o < 8; ++o) { float sacc = be[gi * 8 + o];
#pragma unroll
                    for (int ww = 0; ww < 8; ++ww) sacc += part[(ww * 16 + m) * 48 + 4 + gi * 8 + o]; el[o] = sacc; }
                int i1 = 0; float m1 = el[0];
#pragma unroll
                for (int o = 1; o < 8; ++o) if (el[o] > m1) { m1 = el[o]; i1 = o; }
                int i2 = 0; float m2 = -3e38f;
#pragma unroll
                for (int o = 0; o < 8; ++o) if (o != i1 && el[o] > m2) { m2 = el[o]; i2 = o; }
                const float e2x = __expf(m2 - m1); const float w1 = gw / (1.f + e2x), w2 = gw * e2x / (1.f + e2x);
                const int e1 = gi * 8 + i1, e2 = gi * 8 + i2;
                const int p1 = (int)__hip_atomic_fetch_add(F.ctl + wsm::CW_CNT + (l * 32 + e1) * 64, 1u, RLX_AGENT);
                const int p2 = (int)__hip_atomic_fetch_add(F.ctl + wsm::CW_CNT + (l * 32 + e2) * 64, 1u, RLX_AGENT);
                int* lists = (int*)(F.ws + wsm::LISTS); float* wl = (float*)(F.ws + wsm::WLIST);
                lists[e1 * LCAP + p1] = tok; lists[e2 * LCAP + p2] = tok; wl[e1 * LCAP + p1] = w1; wl[e2 * LCAP + p2] = w2;
                ((int4*)(F.ws + wsm::TOKINFO))[tok] = make_int4(e1, p1, e2, p2);
                ((int4*)(F.ws + wsm::ROUTE))[tok] = make_int4(e1, e2, __float_as_int(w1), __float_as_int(w2));
            }
            __syncthreads();
        }
    }
}
namespace att {
typedef float f32x16 __attribute__((ext_vector_type(16)));
typedef short s16x4 __attribute__((ext_vector_type(4)));
constexpr int L_K = 0, L_V = 16384, L_WSF = 135168, L_TAB = 137216;
__device__ __forceinline__ int crow(int r, int hi) { return (r & 3) + 8 * (r >> 2) + 4 * hi; }
__device__ __forceinline__ int t5_bucket(int rel) {
    const int ret = rel > 0 ? 16 : 0; const int n = rel < 0 ? -rel : rel; int bk;
    if (n < 8) bk = n; else if (n < 12) bk = 8; else if (n < 16) bk = 9; else if (n < 23) bk = 10; else if (n < 32) bk = 11;
    else if (n < 46) bk = 12; else if (n < 64) bk = 13; else if (n < 91) bk = 14; else bk = 15;
    return ret + bk;
}
__device__ __forceinline__ unsigned cvtpk(float lo, float hi) { unsigned r; asm volatile("v_cvt_pk_bf16_f32 %0, %1, %2" : "=v"(r) : "v"(lo), "v"(hi)); return r; }
__device__ __forceinline__ void qkt(f32x16& p0, f32x16& p1, const LAS unsigned char* Kslot, const bf16x8* qr, const f32x16& c0, const f32x16& c1, int r32, int hi) {
    const LAS unsigned char* kb = Kslot + hi * 1024 + r32 * 16;
#pragma unroll
    for (int d0 = 0; d0 < 4; ++d0) {
        const bf16x8 b0 = *(const LAS bf16x8*)(kb + d0 * 2048);
        const bf16x8 b1 = *(const LAS bf16x8*)(kb + d0 * 2048 + 512);
        if (d0 == 0) { p0 = __builtin_amdgcn_mfma_f32_32x32x16_bf16(b0, qr[0], c0, 0, 0, 0); p1 = __builtin_amdgcn_mfma_f32_32x32x16_bf16(b1, qr[0], c1, 0, 0, 0); }
        else { p0 = __builtin_amdgcn_mfma_f32_32x32x16_bf16(b0, qr[d0], p0, 0, 0, 0); p1 = __builtin_amdgcn_mfma_f32_32x32x16_bf16(b1, qr[d0], p1, 0, 0, 0); } }
}
__device__ __forceinline__ float rowmax(const f32x16& p0, const f32x16& p1) {
    float a = fmaxf(fmaxf(p0[0], p0[1]), p1[0]), b = fmaxf(fmaxf(p0[2], p0[3]), p1[1]); a = fmaxf(fmaxf(a, p1[2]), p1[3]);
#pragma unroll
    for (int r = 4; r < 16; r += 4) { a = fmaxf(fmaxf(a, p0[r]), p0[r + 1]); b = fmaxf(fmaxf(b, p0[r + 2]), p0[r + 3]); a = fmaxf(fmaxf(a, p1[r]), p1[r + 1]); b = fmaxf(fmaxf(b, p1[r + 2]), p1[r + 3]); }
    const float m = fmaxf(a, b);
    auto rr = __builtin_amdgcn_permlane32_swap(__float_as_uint(m), __float_as_uint(m), false, false);
    return fmaxf(__uint_as_float(rr[0]), __uint_as_float(rr[1]));
}
template <int ND>
__device__ __forceinline__ void pv(f32x16* o, int vb, bf16x8 pa0, bf16x8 pa1, bf16x8 pa2, bf16x8 pa3) {
#pragma unroll
    for (int d0 = 0; d0 < ND; ++d0) { s16x4 lo[4], hi[4];
#pragma unroll
        for (int ks = 0; ks < 4; ++ks) {
            asm volatile("ds_read_b64_tr_b16 %0,%1 offset:%c2" : "=&v"(lo[ks]) : "v"(vb), "i"(d0 * 4096 + ks * 1024) : "memory");
            asm volatile("ds_read_b64_tr_b16 %0,%1 offset:%c2" : "=&v"(hi[ks]) : "v"(vb), "i"(d0 * 4096 + ks * 1024 + 512) : "memory"); }
        asm volatile("s_waitcnt lgkmcnt(0)" ::: "memory"); __builtin_amdgcn_sched_barrier(0);
#define ATT_PK(k) (bf16x8){lo[k][0], lo[k][1], lo[k][2], lo[k][3], hi[k][0], hi[k][1], hi[k][2], hi[k][3]}
        o[d0] = __builtin_amdgcn_mfma_f32_32x32x16_bf16(pa0, ATT_PK(0), o[d0], 0, 0, 0);
        o[d0] = __builtin_amdgcn_mfma_f32_32x32x16_bf16(pa1, ATT_PK(1), o[d0], 0, 0, 0);
        o[d0] = __builtin_amdgcn_mfma_f32_32x32x16_bf16(pa2, ATT_PK(2), o[d0], 0, 0, 0);
        o[d0] = __builtin_amdgcn_mfma_f32_32x32x16_bf16(pa3, ATT_PK(3), o[d0], 0, 0, 0);
#undef ATT_PK
    }
}
#define ATT_WAIT_BAR(N) asm volatile("s_waitcnt vmcnt(" #N ") lgkmcnt(0)\n\ts_barrier" ::: "memory")

template <int MODE>
__device__ __forceinline__ void attn_unit(Frame& F, const Args& a, const int l, const int b, const int hh, const int qb) {
    using namespace cfg;
    constexpr int ND = MODE ? 4 : 2, VBYTES = ND * 4096, NDMA = MODE ? 3 : 2;
    const int lane = F.lane, r32 = lane & 31, hi = lane >> 5, wid = F.wave;
    const bf16* p = (const bf16*)(F.ws + wsm::P);
    bf16* y = (bf16*)(F.ws + wsm::Y);
    float* O1s = (float*)(F.ws + wsm::XN);
    LAS unsigned char* lds = F.lds;
    LAS float* wsf = (LAS float*)(lds + L_WSF) + wid * 64;
    LAS float* tab = (LAS float*)(lds + L_TAB);
    const size_t rowbase = (size_t)b * SEQ;
    if (F.tid < 320) { const int i = F.tid; float v;
        if (MODE == 0) { int d = i - 64; d = d < -128 ? -128 : (d > 128 ? 128 : d); v = a.in[17][(size_t)(l * 8 + hh) * 257 + d + 128]; }
        else v = a.in[18][t5_bucket(-(i - 64)) * 4 + hh];
        tab[i] = v * LOG2E; }
    float lam = 0.f, lam_init = 0.f;
    if (MODE == 1) { lam_init = l == 0 ? 0.2f : (float)(0.8 - 0.6 * 0.7408182206817179);
        lam = __expf(wave_sum(a.in[19][l * 64 + lane] * a.in[20][l * 64 + lane])) - __expf(wave_sum(a.in[21][l * 64 + lane] * a.in[22][l * 64 + lane])) + lam_init; }
    const int t0 = MODE == 0 ? (4 * qb - 8 > 0 ? 4 * qb - 8 : 0) : 0, t1 = 4 * qb + 3;
    const int cw = 4 * qb + (wid >> 1);
    const int q0w = qb * 256 + 32 * wid, myq = q0w + r32;
    const int vb0 = (int)(unsigned)(uintptr_t)(lds + L_V) + ((lane >> 4) & 1) * 32 + (lane & 3) * 8 + (4 * hi + ((lane & 15) >> 2)) * 64;
#pragma unroll 1
    for (int sub = 0; sub < (MODE ? 2 : 1); ++sub) {
        const int qcol = MODE ? OFF_CQ + (hh * 2 + sub) * 64 : OFF_BQ + hh * 64;
        const int kcol = MODE ? OFF_CK + (hh * 2 + sub) * 64 : OFF_BK + hh * 64;
        const int vcol = MODE ? OFF_CV + hh * 128 : OFF_BV + hh * 64;
        const bf16* Kh = p + rowbase * INC + kcol; const bf16* Vh = p + rowbase * INC + vcol;
        const bf16* ksrc = Kh + (size_t)lane * INC + wid * 8;
        const bf16* vsrc0 = Vh + (size_t)(16 * (wid & 3) + (lane >> 2)) * INC + (wid >> 2) * 32 + (lane & 3) * 8;
#define ATT_DMA(t, buf) do { \
        __builtin_amdgcn_global_load_lds((const unsigned*)(ksrc + (size_t)(t) * 64 * INC), (LAS unsigned*)(lds + L_K + (buf) * 8192 + wid * 1024), 16, 0, 0); \
        __builtin_amdgcn_global_load_lds((const unsigned*)(vsrc0 + (size_t)(t) * 64 * INC), (LAS unsigned*)(lds + L_V + (buf) * VBYTES + wid * 1024), 16, 0, 0); \
        if (MODE) __builtin_amdgcn_global_load_lds((const unsigned*)(vsrc0 + (size_t)(t) * 64 * INC + 64), (LAS unsigned*)(lds + L_V + (buf) * VBYTES + (wid + 8) * 1024), 16, 0, 0); } while (0)
        ATT_DMA(t0, 0);
        bf16x8 qr[4];
        { const bf16* Qw = p + (rowbase + q0w) * INC + qcol;
#pragma unroll
          for (int d0 = 0; d0 < 4; ++d0) qr[d0] = *(const bf16x8*)(Qw + (size_t)r32 * INC + d0 * 16 + hi * 8); }
        float m = -1e30f, lh = 0.f;
        f32x16 o[ND];
#pragma unroll
        for (int d0 = 0; d0 < ND; ++d0)
#pragma unroll
            for (int r = 0; r < 16; ++r) o[d0][r] = 0.f;
#pragma unroll 1
        for (int t = t0; t <= t1; ++t) {
            const int buf = (t - t0) & 1;
            if (t < t1) { ATT_DMA(t + 1, buf ^ 1); if (MODE) { ATT_WAIT_BAR(3); } else { ATT_WAIT_BAR(2); } }
            else { ATT_WAIT_BAR(0); }
            const bool vis = (t <= cw) && (MODE == 1 || t >= cw - 8);
            if (vis) {
                f32x16 c0, c1;
                const int dmin = q0w - (t * 64 + 63);
                if (dmin >= 128) { const float cf = tab[300];
#pragma unroll
                    for (int r = 0; r < 16; ++r) { c0[r] = cf; c1[r] = cf; } }
                else { const LAS float* tb = tab + (myq - t * 64 - 4 * hi + 64 - 27 - 32);
#pragma unroll
                    for (int r = 0; r < 16; ++r) { c1[r] = tb[27 - ((r & 3) + 8 * (r >> 2))]; c0[r] = tb[32 + 27 - ((r & 3) + 8 * (r >> 2))]; } }
                f32x16 p0, p1;
                qkt(p0, p1, lds + L_K + buf * 8192, qr, c0, c1, r32, hi);
                const float rm = rowmax(p0, p1);
                const float mn = fmaxf(m, rm);
                if (__any(mn > m)) {
                    const float f = __builtin_amdgcn_exp2f(m - mn); lh *= f; m = mn;
                    if (hi == 0) wsf[r32] = f;
                    LDS_WAIT();
#pragma unroll
                    for (int r = 0; r < 16; ++r) { const float fr = wsf[crow(r, hi)];
#pragma unroll
                        for (int d0 = 0; d0 < ND; ++d0) o[d0][r] *= fr; }
                }
                float sacc = 0.f;
#pragma unroll
                for (int r = 0; r < 16; ++r) { p0[r] = __builtin_amdgcn_exp2f(p0[r] - m); p1[r] = __builtin_amdgcn_exp2f(p1[r] - m); sacc += p0[r] + p1[r]; }
                lh += sacc;
                u32x4 pw0, pw1, pw2, pw3;
                pw0 = (u32x4){cvtpk(p0[0], p0[1]), cvtpk(p0[2], p0[3]), cvtpk(p0[4], p0[5]), cvtpk(p0[6], p0[7])};
                pw1 = (u32x4){cvtpk(p0[8], p0[9]), cvtpk(p0[10], p0[11]), cvtpk(p0[12], p0[13]), cvtpk(p0[14], p0[15])};
                pw2 = (u32x4){cvtpk(p1[0], p1[1]), cvtpk(p1[2], p1[3]), cvtpk(p1[4], p1[5]), cvtpk(p1[6], p1[7])};
                pw3 = (u32x4){cvtpk(p1[8], p1[9]), cvtpk(p1[10], p1[11]), cvtpk(p1[12], p1[13]), cvtpk(p1[14], p1[15])};
                pv<ND>(o, vb0 + buf * VBYTES, __builtin_bit_cast(bf16x8, pw0), __builtin_bit_cast(bf16x8, pw1), __builtin_bit_cast(bf16x8, pw2), __builtin_bit_cast(bf16x8, pw3));
            }
            asm volatile("s_waitcnt lgkmcnt(0)\n\ts_barrier" ::: "memory");
        }
#undef ATT_DMA
        { auto rr = __builtin_amdgcn_permlane32_swap(__float_as_uint(lh), __float_as_uint(lh), false, false); lh = __uint_as_float(rr[0]) + __uint_as_float(rr[1]); }
        if (hi == 0) wsf[32 + r32] = lh;
        LDS_WAIT();
        constexpr int SP = ND * 128 + 16;
        LAS unsigned char* stg = lds + wid * (32 * SP);
#pragma unroll
        for (int r = 0; r < 16; ++r) { const float rl = __builtin_amdgcn_rcpf(wsf[32 + crow(r, hi)]);
#pragma unroll
            for (int d0 = 0; d0 < ND; ++d0) *(LAS float*)(stg + crow(r, hi) * SP + (d0 * 32 + r32) * 4) = o[d0][r] * rl; }
        LDS_WAIT();
        const size_t tok0 = rowbase + q0w;
        if (MODE == 0) {
#pragma unroll 4
            for (int row = 0; row < 32; ++row) { const float v = *(const LAS float*)(stg + row * SP + lane * 4); y[(tok0 + row) * D + 512 + hh * 64 + lane] = (bf16)f2bf(v); }
        } else if (sub == 0) {
#pragma unroll 4
            for (int row = 0; row < 32; ++row) { const f32x2 v = *(const LAS f32x2*)(stg + row * SP + lane * 8); *(f32x2*)(O1s + ((tok0 + row) * 4 + hh) * 128 + 2 * lane) = v; }
        } else {
            const float* sw = a.in[23] + l * 128;
            const float sw0 = sw[2 * lane] * (1.f - lam_init), sw1 = sw[2 * lane + 1] * (1.f - lam_init);
#pragma unroll 2
            for (int row = 0; row < 32; ++row) { const f32x2 v2 = *(const LAS f32x2*)(stg + row * SP + lane * 8); const f32x2 o1 = *(const f32x2*)(O1s + ((tok0 + row) * 4 + hh) * 128 + 2 * lane);
                const float v0 = o1.x - lam * v2.x, v1 = o1.y - lam * v2.y;
                const float ms = wave_sum(v0 * v0 + v1 * v1);
                const float rs = rsqrtf(ms * (1.f / 128.f) + 1e-5f);
                *(unsigned*)(y + (tok0 + row) * D + 1024 + hh * 128 + 2 * lane) = pk2(v0 * rs * sw0, v1 * rs * sw1); }
        }
        asm volatile("s_waitcnt vmcnt(0) lgkmcnt(0)\n\ts_barrier" ::: "memory");
    }
}

__device__ __forceinline__ void conv_items(Frame& F, const Args& a, const int l, const int start, const int stride) {
    using namespace cfg;
    const bf16* p = (const bf16*)(F.ws + wsm::P); bf16* y = (bf16*)(F.ws + wsm::Y);
    const float* cw = a.in[24] + l * 3 * 512;
    for (int it = start; it < M * 64; it += stride) {
        const int tok = it >> 6, cg = (it & 63) * 8, t = tok & (SEQ - 1);
        const bf16* r0 = p + (size_t)tok * INC + OFF_D + cg;
        const u32x4 bg = *(const u32x4*)r0;
        u32x4 c0 = *(const u32x4*)(r0 + 512), h0 = *(const u32x4*)(r0 + 1024);
        u32x4 c1 = (u32x4){0, 0, 0, 0}, h1 = c1, c2 = c1, h2 = c1;
        if (t >= 1) { c1 = *(const u32x4*)(r0 - INC + 512); h1 = *(const u32x4*)(r0 - INC + 1024); }
        if (t >= 2) { c2 = *(const u32x4*)(r0 - 2 * INC + 512); h2 = *(const u32x4*)(r0 - 2 * INC + 1024); }
        unsigned ow[4];
#pragma unroll
        for (int j = 0; j < 4; ++j) {
            float res[2];
#pragma unroll
            for (int e = 0; e < 2; ++e) {
                const int ch = cg + 2 * j + e;
#define ATT_UP(w) (e ? __uint_as_float((w) & 0xffff0000u) : __uint_as_float((w) << 16))
                const float u0 = ATT_UP(c0[j]) * ATT_UP(h0[j]), u1 = ATT_UP(c1[j]) * ATT_UP(h1[j]), u2 = ATT_UP(c2[j]) * ATT_UP(h2[j]);
                res[e] = ATT_UP(bg[j]) * (cw[ch] * u2 + cw[512 + ch] * u1 + cw[1024 + ch] * u0);
#undef ATT_UP
            }
            ow[j] = pk2(res[0], res[1]);
        }
        *(u32x4*)(y + (size_t)tok * D + 1536 + cg) = (u32x4){ow[0], ow[1], ow[2], ow[3]};
    }
}
}
namespace rw {
constexpr int PB = 144, PB2 = 272;
constexpr int SLOT = 9216;
constexpr int R0 = 0, R1B = 49152;
constexpr int O_P0 = 0, O_P0T = 9216, O_AAK = 18432, O_ARB = 27648, O_ARK = 36864;
constexpr int O_SEG = R1B + 9 * SLOT, O_BON = O_SEG + 2048;
constexpr size_t UNIT_BYTES = 49152;
constexpr size_t WL_OFF = (size_t)4096 * UNIT_BYTES;
#define RW_S(i) (R1B + (i) * SLOT)

__device__ __forceinline__ bf16x8 ldfrag(const LAS unsigned char* base, int pitch, int row0, int lane, int s) {
    return *(const LAS bf16x8*)(base + (row0 + (lane & 15)) * pitch + (32 * s + 8 * (lane >> 4)) * 2);
}
template <int KS>
__device__ __forceinline__ f32x4 tile_mm(f32x4 acc, const LAS unsigned char* X, int px, int m0, const LAS unsigned char* Y, int py, int n0, int lane) {
#pragma unroll
    for (int s = 0; s < KS; ++s) acc = __builtin_amdgcn_mfma_f32_16x16x32_bf16(ldfrag(Y, py, n0, lane, s), ldfrag(X, px, m0, lane, s), acc, 0, 0, 0);
    return acc;
}
__device__ __forceinline__ void st_rm(LAS unsigned char* base, int pitch, int m, int n0, f32x4 v) {
    u32x2 w; w.x = pk2(v[0], v[1]); w.y = pk2(v[2], v[3]); *(LAS u32x2*)(base + m * pitch + n0 * 2) = w;
}
__device__ __forceinline__ void st_tr(LAS unsigned char* base, int pitch, int m, int n0, f32x4 v) {
#pragma unroll
    for (int i = 0; i < 4; ++i) *(LAS bf16*)(base + (n0 + i) * pitch + m * 2) = (bf16)f2bf(v[i]);
}
__device__ __forceinline__ f32x4 ld_rm(const LAS unsigned char* base, int pitch, int m, int n0) {
    const u32x2 w = *(const LAS u32x2*)(base + m * pitch + n0 * 2);
    return (f32x4){__uint_as_float(w.x << 16), __uint_as_float(w.x & 0xffff0000u), __uint_as_float(w.y << 16), __uint_as_float(w.y & 0xffff0000u)};
}
__device__ __forceinline__ void unpack8(const u32x4 w, float* f) {
#pragma unroll
    for (int j = 0; j < 4; ++j) { f[2 * j] = __uint_as_float(w[j] << 16); f[2 * j + 1] = __uint_as_float(w[j] & 0xffff0000u); }
}
__device__ __forceinline__ u32x4 pack8(const float* f) { return (u32x4){pk2(f[0], f[1]), pk2(f[2], f[3]), pk2(f[4], f[5]), pk2(f[6], f[7])}; }
__device__ __forceinline__ float sigm(float x) { return __builtin_amdgcn_rcpf(1.f + __expf(-x)); }
#define RW_BAR() do { asm volatile("s_waitcnt vmcnt(0) lgkmcnt(0)" ::: "memory"); __builtin_amdgcn_s_barrier(); asm volatile("" ::: "memory"); } while (0)

__device__ __forceinline__ void r1_unit(Frame& F, const Args& a, const int l, const int u) {
    using namespace cfg;
    const int tid = F.tid, lane = F.lane, w = F.wave;
    const int c = u & 63, h = (u >> 6) & 7, b = u >> 9;
    LAS unsigned char* lds = F.lds;
    const bf16* p = (const bf16*)(F.ws + wsm::P);
    const bf16* w2t = (const bf16*)(F.ws + wsm::WRT + 262144);
    const bf16* a2t = w2t + 512 * 64; const bf16* g2t = a2t + 512 * 64;
    unsigned char* gout = F.ws + wsm::RW + (size_t)u * UNIT_BYTES;
    float* wl_out = (float*)(F.ws + wsm::RW + WL_OFF) + (size_t)u * 64;
    const float* mu = a.in[6] + l * 1792;
    const size_t tok0 = (size_t)b * SEQ + c * 64;
    const int t = tid >> 3, j0 = (tid & 7) * 8;
    const bool hasprev = (c > 0) || (t > 0);
    const bf16* cur = p + (tok0 + t) * INC; const bf16* prv = cur - INC;
    LAS float* WPRE = (LAS float*)(lds + 0); LAS float* APRE = (LAS float*)(lds + 16384); LAS float* GG = (LAS float*)(lds + 32768);
    {
        auto mix8 = [&](int col, float* o) { float cv[8], pv[8], m8[8]; unpack8(*(const u32x4*)(cur + col), cv);
            if (hasprev) unpack8(*(const u32x4*)(prv + col), pv); else {
#pragma unroll
                for (int j = 0; j < 8; ++j) pv[j] = 0.f; }
            *(f32x4*)m8 = *(const f32x4*)(mu + col); *(f32x4*)(m8 + 4) = *(const f32x4*)(mu + col + 4);
#pragma unroll
            for (int j = 0; j < 8; ++j) o[j] = cv[j] + (pv[j] - cv[j]) * m8[j]; };
        float x[8];
        mix8(1536 + j0, x);
#pragma unroll
        for (int j = 0; j < 8; ++j) { const float e2 = __expf(2.f * x[j]); x[j] = 1.f - 2.f * __builtin_amdgcn_rcpf(e2 + 1.f); }
        *(LAS u32x4*)(lds + RW_S(0) + t * PB + j0 * 2) = pack8(x);
        mix8(1600 + j0, x);
        *(LAS u32x4*)(lds + RW_S(1) + t * PB + j0 * 2) = pack8(x);
        mix8(1664 + j0, x);
#pragma unroll
        for (int j = 0; j < 8; ++j) x[j] = sigm(x[j]);
        *(LAS u32x4*)(lds + RW_S(2) + t * PB2 + j0 * 2) = pack8(x);
        mix8(1728 + j0, x);
#pragma unroll
        for (int j = 0; j < 8; ++j) x[j] = sigm(x[j]);
        *(LAS u32x4*)(lds + RW_S(2) + t * PB2 + (64 + j0) * 2) = pack8(x);
    }
    RW_BAR();
    {
        const int mt = w >> 1;
#pragma unroll
        for (int q = 0; q < 2; ++q) { const int nt = 2 * (w & 1) + q; const int ch = h * 64 + 16 * nt + (lane & 15);
            f32x4 aw = {0.f, 0.f, 0.f, 0.f}, aa = aw, ag = aw;
#pragma unroll
            for (int s = 0; s < 2; ++s) { const int k = 32 * s + 8 * (lane >> 4);
                aw = __builtin_amdgcn_mfma_f32_16x16x32_bf16(*(const bf16x8*)(w2t + ch * 64 + k), ldfrag(lds + RW_S(0), PB, 16 * mt, lane, s), aw, 0, 0, 0);
                aa = __builtin_amdgcn_mfma_f32_16x16x32_bf16(*(const bf16x8*)(a2t + ch * 64 + k), ldfrag(lds + RW_S(1), PB, 16 * mt, lane, s), aa, 0, 0, 0); }
#pragma unroll
            for (int s = 0; s < 4; ++s) { const int k = 32 * s + 8 * (lane >> 4);
                ag = __builtin_amdgcn_mfma_f32_16x16x32_bf16(*(const bf16x8*)(g2t + ch * 128 + k), ldfrag(lds + RW_S(2), PB2, 16 * mt, lane, s), ag, 0, 0, 0); }
            const int m = 16 * mt + (lane & 15), n0 = 16 * nt + 4 * (lane >> 4);
            *(LAS f32x4*)(WPRE + m * 64 + n0) = aw; *(LAS f32x4*)(APRE + m * 64 + n0) = aa; *(LAS f32x4*)(GG + m * 64 + n0) = ag; }
    }
    RW_BAR();
    {
        const float* w0 = a.in[7] + l * 512 + h * 64 + j0; const float* a0 = a.in[9] + l * 512 + h * 64 + j0;
#pragma unroll
        for (int j = 0; j < 8; ++j) { const float wa = w0[j] + WPRE[t * 64 + j0 + j]; const float nx = -wa;
            const float sp = nx > 20.f ? nx : __logf(1.f + __expf(nx)); const float wlog = -sp - 0.5f;
            WPRE[t * 64 + j0 + j] = -__expf(wlog);
            APRE[t * 64 + j0 + j] = sigm(a0[j] + APRE[t * 64 + j0 + j]); }
    }
    RW_BAR();
    {
        LAS float* SEG = (LAS float*)(lds + O_SEG);
        const int ch = tid & 63, seg = tid >> 6;
        float pf[8]; float run = 0.f;
#pragma unroll
        for (int i = 0; i < 8; ++i) { run += WPRE[(8 * seg + i) * 64 + ch]; pf[i] = run; }
        SEG[seg * 64 + ch] = run;
        RW_BAR();
        float off = 0.f;
        for (int s = 0; s < seg; ++s) off += SEG[s * 64 + ch];
#pragma unroll
        for (int i = 0; i < 8; ++i) WPRE[(8 * seg + i) * 64 + ch] = off + pf[i];
    }
    RW_BAR();
    {
        float r[8], k[8], v[8];
        auto mix8 = [&](int col, float* o) { float cv[8], pv[8], m8[8]; unpack8(*(const u32x4*)(cur + col), cv);
            if (hasprev) unpack8(*(const u32x4*)(prv + col), pv); else {
#pragma unroll
                for (int j = 0; j < 8; ++j) pv[j] = 0.f; }
            *(f32x4*)m8 = *(const f32x4*)(mu + col); *(f32x4*)(m8 + 4) = *(const f32x4*)(mu + col + 4);
#pragma unroll
            for (int j = 0; j < 8; ++j) o[j] = cv[j] + (pv[j] - cv[j]) * m8[j]; };
        mix8(h * 64 + j0, r); mix8(512 + h * 64 + j0, k); mix8(1024 + h * 64 + j0, v);
        const int cb = l * 512 + h * 64 + j0;
        float kk[8], k2[8], aic[8]; float ss = 0.f, bon = 0.f;
#pragma unroll
        for (int j = 0; j < 8; ++j) { aic[j] = APRE[t * 64 + j0 + j]; kk[j] = k[j] * a.in[12][cb + j]; ss += kk[j] * kk[j];
            k2[j] = k[j] * (1.f + (aic[j] - 1.f) * a.in[13][cb + j]); bon += r[j] * k2[j] * a.in[14][cb + j]; }
        ss += __shfl_xor(ss, 1); ss += __shfl_xor(ss, 2); ss += __shfl_xor(ss, 4);
        bon += __shfl_xor(bon, 1); bon += __shfl_xor(bon, 2); bon += __shfl_xor(bon, 4);
        const float inv = 1.f / fmaxf(sqrtf(ss), 1e-12f);
        float xa[8], xr[8], xb[8], xk[8], xbh[8], xkh[8], g1[8], g0[8];
#pragma unroll
        for (int j = 0; j < 8; ++j) { const float cum = WPRE[t * 64 + j0 + j], cp = t > 0 ? WPRE[(t - 1) * 64 + j0 + j] : 0.f, tot = WPRE[63 * 64 + j0 + j];
            const float kn = kk[j] * inv, bv = kn * aic[j];
            const float e_ex = __expf(cp), e_in = __expf(cum), e_ng = __expf(-cum), e_tt = __expf(tot - cum);
            xa[j] = -kn * e_ex; xr[j] = r[j] * e_in; xb[j] = bv * e_ng; xk[j] = k2[j] * e_ng; xbh[j] = bv * e_tt; xkh[j] = k2[j] * e_tt;
            const float g = GG[t * 64 + j0 + j]; g1[j] = a.in[15][cb + j] * g; g0[j] = (a.in[16][cb + j] + bon * v[j]) * g;
            if (t == 63) wl_out[j0 + j] = __expf(tot); }
        RW_BAR();
        *(LAS u32x4*)(lds + RW_S(0) + t * PB + j0 * 2) = pack8(xa);
        *(LAS u32x4*)(lds + RW_S(1) + t * PB + j0 * 2) = pack8(xr);
        *(LAS u32x4*)(lds + RW_S(2) + t * PB + j0 * 2) = pack8(xb);
        *(LAS u32x4*)(lds + RW_S(3) + t * PB + j0 * 2) = pack8(xk);
#pragma unroll
        for (int j = 0; j < 8; ++j) { *(LAS bf16*)(lds + RW_S(4) + (j0 + j) * PB + t * 2) = (bf16)f2bf(xa[j]); *(LAS bf16*)(lds + RW_S(5) + (j0 + j) * PB + t * 2) = (bf16)f2bf(v[j]);
            *(LAS bf16*)(lds + RW_S(6) + (j0 + j) * PB + t * 2) = (bf16)f2bf(xbh[j]); *(LAS bf16*)(lds + RW_S(7) + (j0 + j) * PB + t * 2) = (bf16)f2bf(xkh[j]); }
        *(u32x4*)(gout + 32768 + (t * 64 + j0) * 2) = pack8(g1);
        *(u32x4*)(gout + 40960 + (t * 64 + j0) * 2) = pack8(g0);
    }
    RW_BAR();
    {
        const int mi = w >> 1;
        const LAS unsigned char* X = lds + RW_S(mi < 2 ? 0 : 1); const LAS unsigned char* Y = lds + RW_S((mi & 1) ? 3 : 2);
        LAS unsigned char* dst = lds + (mi == 0 ? O_P0 : mi == 1 ? O_AAK : mi == 2 ? O_ARB : O_ARK);
        const bool incl = mi >= 2;
#pragma unroll
        for (int q = 0; q < 2; ++q) { const int mt = 2 * (w & 1) + q; const int m = 16 * mt + (lane & 15);
#pragma unroll
            for (int nt = 0; nt < 4; ++nt) { f32x4 acc = {0.f, 0.f, 0.f, 0.f};
                if (nt <= mt) acc = tile_mm<2>(acc, X, PB, 16 * mt, Y, PB, 16 * nt, lane);
                const int n0 = 16 * nt + 4 * (lane >> 4);
#pragma unroll
                for (int i = 0; i < 4; ++i) { const int n = n0 + i; if (!(incl ? n <= m : n < m)) acc[i] = 0.f; }
                st_rm(dst, PB, m, n0, acc);
                if (mi == 0) st_tr(lds + O_P0T, PB, m, n0, acc); } }
    }
    RW_BAR();
    {
        f32x4 T[4];
        const int wr = w & 3, m = 16 * wr + (lane & 15);
        LAS unsigned char* Trm = lds + RW_S(8);
        if (w < 4) {
#pragma unroll
            for (int nt = 0; nt < 4; ++nt) { const int n0 = 16 * nt + 4 * (lane >> 4); T[nt] = ld_rm(lds + O_P0, PB, m, n0);
#pragma unroll
                for (int i = 0; i < 4; ++i) if (n0 + i == m) T[nt][i] += 1.f;
                st_rm(Trm, PB, m, n0, T[nt]); }
#pragma unroll
            for (int nt = 0; nt < 4; ++nt) { f32x4 acc = {0.f, 0.f, 0.f, 0.f}; acc = tile_mm<2>(acc, lds + RW_S(5), PB, 16 * wr, lds + O_AAK, PB, 16 * nt, lane); st_rm(lds + RW_S(0), PB, m, 16 * nt + 4 * (lane >> 4), acc); }
        } else {
#pragma unroll
            for (int nt = 0; nt < 4; ++nt) { f32x4 acc = {0.f, 0.f, 0.f, 0.f}; acc = tile_mm<2>(acc, lds + O_P0, PB, 16 * wr, lds + O_P0T, PB, 16 * nt, lane);
                const int n0 = 16 * nt + 4 * (lane >> 4); st_rm(lds + RW_S(2), PB, m, n0, acc); st_tr(lds + RW_S(3), PB, m, n0, acc); }
        }
        RW_BAR();
#pragma unroll 1
        for (int s = 1; s <= 5; ++s) {
            const int cb = s & 1;
            const LAS unsigned char* Pc = lds + (cb ? RW_S(2) : O_P0); const LAS unsigned char* PcT = lds + (cb ? RW_S(3) : O_P0T);
            LAS unsigned char* Pn = lds + (cb ? O_P0 : RW_S(2)); LAS unsigned char* PnT = lds + (cb ? O_P0T : RW_S(3));
            if (w < 4) {
                f32x4 d[4];
#pragma unroll
                for (int nt = 0; nt < 4; ++nt) { d[nt] = (f32x4){0.f, 0.f, 0.f, 0.f}; d[nt] = tile_mm<2>(d[nt], Trm, PB, 16 * wr, PcT, PB, 16 * nt, lane); }
                LDS_WAIT();
#pragma unroll
                for (int nt = 0; nt < 4; ++nt) { T[nt] += d[nt]; st_rm(Trm, PB, m, 16 * nt + 4 * (lane >> 4), T[nt]); }
            } else if (s < 5) {
#pragma unroll
                for (int nt = 0; nt < 4; ++nt) { f32x4 acc = {0.f, 0.f, 0.f, 0.f}; acc = tile_mm<2>(acc, Pc, PB, 16 * wr, PcT, PB, 16 * nt, lane);
                    const int n0 = 16 * nt + 4 * (lane >> 4); st_rm(Pn, PB, m, n0, acc); st_tr(PnT, PB, m, n0, acc); }
            }
            RW_BAR();
        }
    }
    {
        const LAS unsigned char* Z = lds + (w < 4 ? RW_S(4) : RW_S(0)); const int zr0 = 16 * (w & 3);
        f32x4 acc[4];
#pragma unroll
        for (int nt = 0; nt < 4; ++nt) { acc[nt] = (f32x4){0.f, 0.f, 0.f, 0.f}; acc[nt] = tile_mm<2>(acc[nt], Z, PB, zr0, lds + RW_S(8), PB, 16 * nt, lane); }
        RW_BAR();
#pragma unroll
        for (int nt = 0; nt < 4; ++nt) st_rm(lds + RW_S(2), PB, 16 * w + (lane & 15), 16 * nt + 4 * (lane >> 4), acc[nt]);
    }
    RW_BAR();
    {
        const int job = w >> 1;
        const LAS unsigned char* XTt = lds + RW_S(2); const LAS unsigned char* XTb = lds + RW_S(2) + 64 * PB;
#pragma unroll
        for (int q = 0; q < 2; ++q) { const int mt = 2 * (w & 1) + q; const int m = 16 * mt + (lane & 15);
#pragma unroll
            for (int nt = 0; nt < 4; ++nt) { f32x4 acc = {0.f, 0.f, 0.f, 0.f}; const int n0 = 16 * nt + 4 * (lane >> 4);
                if (job == 0) { acc = ld_rm(lds + RW_S(1), PB, m, n0); acc = tile_mm<2>(acc, lds + O_ARB, PB, 16 * mt, XTt, PB, 16 * nt, lane); }
                else if (job == 1) { acc = tile_mm<2>(acc, lds + O_ARB, PB, 16 * mt, XTb, PB, 16 * nt, lane); acc = tile_mm<2>(acc, lds + O_ARK, PB, 16 * mt, lds + RW_S(5), PB, 16 * nt, lane); }
                else if (job == 2) { acc = tile_mm<2>(acc, lds + RW_S(6), PB, 16 * mt, XTt, PB, 16 * nt, lane); }
                else { acc = tile_mm<2>(acc, XTb, PB, 16 * mt, lds + RW_S(6), PB, 16 * nt, lane); acc = tile_mm<2>(acc, lds + RW_S(5), PB, 16 * mt, lds + RW_S(7), PB, 16 * nt, lane); }
                u32x2 o; o.x = pk2(acc[0], acc[1]); o.y = pk2(acc[2], acc[3]);
                *(u32x2*)(gout + job * 8192 + (m * 64 + n0) * 2) = o; } }
    }
    RW_BAR();
}

__device__ __forceinline__ void r2_unit(Frame& F, const Args& a, const int l, const int bh) {
    using namespace cfg;
    const int lane = F.lane, w = F.wave, wr = w & 3;
    LAS unsigned char* lds = F.lds;
    bf16* y = (bf16*)(F.ws + wsm::Y);
    const unsigned char* gin = F.ws + wsm::RW + (size_t)bh * 64 * UNIT_BYTES;
    const float* wlp = (const float*)(F.ws + wsm::RW + WL_OFF) + (size_t)bh * 64 * 64;
    const int b = bh >> 3, h = bh & 7;
    const int m = 16 * wr + (lane & 15), q4 = 4 * (lane >> 4);
    f32x4 S[4];
#pragma unroll
    for (int nt = 0; nt < 4; ++nt) S[nt] = (f32x4){0.f, 0.f, 0.f, 0.f};
    if (w < 4) {
#pragma unroll
        for (int nt = 0; nt < 4; ++nt) st_rm(lds, PB, m, 16 * nt + q4, S[nt]);
    }
#pragma unroll 1
    for (int c = 0; c < 64; ++c) {
        const unsigned char* g = gin + (size_t)c * UNIT_BYTES;
        LAS unsigned char* Scur = lds + (c & 1) * SLOT; LAS unsigned char* Snxt = lds + ((c + 1) & 1) * SLOT;
        if (w < 4) {
            bf16x8 mtf[4][2]; u32x2 cf[4]; f32x4 wl[4];
#pragma unroll
            for (int nt = 0; nt < 4; ++nt) {
#pragma unroll
                for (int s = 0; s < 2; ++s) mtf[nt][s] = *(const bf16x8*)(g + 16384 + ((16 * nt + (lane & 15)) * 64 + 32 * s + 8 * (lane >> 4)) * 2);
                cf[nt] = *(const u32x2*)(g + 24576 + (m * 64 + 16 * nt + q4) * 2);
                wl[nt] = *(const f32x4*)(wlp + c * 64 + 16 * nt + q4); }
            RW_BAR();
            bf16x8 sf[2];
#pragma unroll
            for (int s = 0; s < 2; ++s) sf[s] = ldfrag(Scur, PB, 16 * wr, lane, s);
#pragma unroll
            for (int nt = 0; nt < 4; ++nt) {
                f32x4 acc = S[nt] * wl[nt];
                acc[0] += __uint_as_float(cf[nt].x << 16); acc[1] += __uint_as_float(cf[nt].x & 0xffff0000u); acc[2] += __uint_as_float(cf[nt].y << 16); acc[3] += __uint_as_float(cf[nt].y & 0xffff0000u);
#pragma unroll
                for (int s = 0; s < 2; ++s) acc = __builtin_amdgcn_mfma_f32_16x16x32_bf16(mtf[nt][s], sf[s], acc, 0, 0, 0);
                S[nt] = acc; st_rm(Snxt, PB, m, 16 * nt + q4, acc); }
        } else {
            bf16x8 rf[2]; u32x2 y0[4], g1[4], g0[4];
#pragma unroll
            for (int s = 0; s < 2; ++s) rf[s] = *(const bf16x8*)(g + (m * 64 + 32 * s + 8 * (lane >> 4)) * 2);
#pragma unroll
            for (int nt = 0; nt < 4; ++nt) { const int o = (m * 64 + 16 * nt + q4) * 2; y0[nt] = *(const u32x2*)(g + 8192 + o); g1[nt] = *(const u32x2*)(g + 32768 + o); g0[nt] = *(const u32x2*)(g + 40960 + o); }
            RW_BAR();
            f32x4 Y[4]; float sum = 0.f;
#pragma unroll
            for (int nt = 0; nt < 4; ++nt) {
                f32x4 acc = {__uint_as_float(y0[nt].x << 16), __uint_as_float(y0[nt].x & 0xffff0000u), __uint_as_float(y0[nt].y << 16), __uint_as_float(y0[nt].y & 0xffff0000u)};
#pragma unroll
                for (int s = 0; s < 2; ++s) acc = __builtin_amdgcn_mfma_f32_16x16x32_bf16(ldfrag(Scur, PB, 16 * nt, lane, s), rf[s], acc, 0, 0, 0);
                Y[nt] = acc; sum += (acc[0] + acc[1]) + (acc[2] + acc[3]); }
            sum += __shfl_xor(sum, 16); sum += __shfl_xor(sum, 32);
            const float mean = sum * (1.f / 64.f); float var = 0.f;
#pragma unroll
            for (int nt = 0; nt < 4; ++nt)
#pragma unroll
                for (int i = 0; i < 4; ++i) { const float d = Y[nt][i] - mean; var += d * d; }
            var += __shfl_xor(var, 16); var += __shfl_xor(var, 32);
            const float rs = rsqrtf(var * (1.f / 64.f) + 64e-5f);
            bf16* yo = y + ((size_t)b * SEQ + c * 64 + m) * D + h * 64;
#pragma unroll
            for (int nt = 0; nt < 4; ++nt) {
                const f32x4 a1 = {__uint_as_float(g1[nt].x << 16), __uint_as_float(g1[nt].x & 0xffff0000u), __uint_as_float(g1[nt].y << 16), __uint_as_float(g1[nt].y & 0xffff0000u)};
                const f32x4 a0 = {__uint_as_float(g0[nt].x << 16), __uint_as_float(g0[nt].x & 0xffff0000u), __uint_as_float(g0[nt].y << 16), __uint_as_float(g0[nt].y & 0xffff0000u)};
                const f32x4 o = (Y[nt] - mean) * rs * a1 + a0;
                u32x2 ow; ow.x = pk2(o[0], o[1]); ow.y = pk2(o[2], o[3]);
                *(u32x2*)(yo + 16 * nt + q4) = ow; }
        }
    }
    RW_BAR();
}
}
struct MoeOrder {
    const LAS int* pref; int G, c, npn, mode;
    const char* A; const char* B; const int* lists; const float* wl;
    __device__ __forceinline__ bool next(int i, pg8::Unit& u) const {
        const int total = __builtin_amdgcn_readfirstlane(pref[32]) * npn;
        const long L = (long)i * G + c; if (L >= total) return false;
        int wgid = (int)L; { const int q = total / 8, r = total % 8, xcd = wgid % 8, off = wgid / 8; wgid = (xcd < r ? xcd * (q + 1) : r * (q + 1) + (xcd - r) * q) + off; }
        const int panel = wgid / npn, pn = wgid % npn;
        int e = 0;
        for (int k = 1; k < 32; ++k) { const int pk = __builtin_amdgcn_readfirstlane(pref[k]); if (pk <= panel) e = k; }
        const int tl = panel - __builtin_amdgcn_readfirstlane(pref[e]);
        u.pm = panel; u.pn = pn;
        if (mode == 0) { u.a = A; u.b = B + ((size_t)e * 512 + (size_t)pn * 256) * 2048 * 2; u.rows = lists + e * LCAP + tl * 256; const int rem = __builtin_amdgcn_readfirstlane(pref[40 + e]) - tl * 256; u.nvalid = rem < 256 ? rem : 256; u.wrow = wl + e * LCAP + tl * 256; }
        else { u.a = A + (size_t)panel * 256 * 256 * 2; u.b = B + ((size_t)e * 2048 + (size_t)pn * 256) * 256 * 2; u.rows = nullptr; u.nvalid = 256; u.wrow = nullptr; }
        return true;
    }
};

#define IN(k) (lo <= (k) && (k) < hi)
#define SEAM(k) do { if (IN(k) && IN((k) + 1)) xcd_barrier(bar); } while (0)
template <int l>
__device__ __forceinline__ void layer_phases(Frame& F, const Args& args, const XcdBarrier& bar, const int lo, const int hi) {
    using namespace cfg;
    float* xo = args.out;

        const int pb = 8 * l;
        const float* xin = (l == 0) ? args.in[0] : xo;
        if (IN(pb + 0)) {
            convert_phase(F, args, l);
            if (l == 0) norm_phase<false, false, false>(F, args, xin, nullptr, args.in[3] + l * D, l);
            else if (args.flags & 1) { build_pref(F, l - 1); norm_phase<true, false, false>(F, args, xin, xo, args.in[3] + l * D, l); }
            else norm_phase<false, false, false>(F, args, xin, nullptr, args.in[3] + l * D, l);
        }
        SEAM(pb + 0);
        if (IN(pb + 1)) {
            pg8::StaticOrder S; S.init((const bf16*)(F.ws + wsm::XN), (const bf16*)(F.ws + wsm::W_IN), M, INC, D, F.G, (int)blockIdx.x);
            pg8::EpiBf16 E{(bf16*)(F.ws + wsm::P), INC};
            pg8::gemm_phase<pg8::EpiBf16, pg8::StaticOrder, false>(F.lds, D, S, E);
        }
        SEAM(pb + 1);
        if (IN(pb + 2)) {
            if (args.flags & 4) { for (int u = F.vcu; u < 4096; u += F.G) rw::r1_unit(F, args, l, u); }
            for (int u = F.vcu; u < 1024; u += F.G) { const int b = u >> 7, hh = (u >> 4) & 7, qb = ((u & 15) + (u >> 8) * 4) & 15; att::attn_unit<0>(F, args, l, b, hh, qb); }
            att::conv_items(F, args, l, F.vcu * 512 + F.tid, F.G * 512);
        }
        SEAM(pb + 2);
        if (IN(pb + 3)) {
            if ((args.flags & 4) && F.vcu < 64) rw::r2_unit(F, args, l, F.vcu);
            for (int u = F.vcu; u < 512; u += F.G) { const int b = u >> 6, hh = (u >> 4) & 3, qb = (u < 256) ? (u & 15) : 15 - (u & 15); att::attn_unit<1>(F, args, l, b, hh, qb); }
        }
        SEAM(pb + 3);
        if (IN(pb + 4)) {
            pg8::StaticOrder S; S.init((const bf16*)(F.ws + wsm::Y), (const bf16*)(F.ws + wsm::W_OUT), M, D, D, F.G, (int)blockIdx.x);
            pg8::EpiResF32 E{xin, xo, D};
            pg8::gemm_phase<pg8::EpiResF32, pg8::StaticOrder, false>(F.lds, D, S, E);
        }
        SEAM(pb + 4);
        if (IN(pb + 5)) norm_phase<false, true, false>(F, args, xo, nullptr, args.in[4] + l * D, l);
        SEAM(pb + 5);
        if (IN(pb + 6)) {
            build_pref(F, l);
            MoeOrder S{(const LAS int*)(F.lds + TAB_OFF), F.G, (int)blockIdx.x, 2, 0, (const char*)(F.ws + wsm::XN), (const char*)(F.ws + wsm::W_GU), (const int*)(F.ws + wsm::LISTS), (const float*)(F.ws + wsm::WLIST)};
            pg8::EpiSilu E{(bf16*)(F.ws + wsm::HB)};
            pg8::gemm_phase<pg8::EpiSilu, MoeOrder, true>(F.lds, D, S, E);
        }
        SEAM(pb + 6);
        if (IN(pb + 7)) {
            build_pref(F, l);
            MoeOrder S{(const LAS int*)(F.lds + TAB_OFF), F.G, (int)blockIdx.x, 8, 1, (const char*)(F.ws + wsm::HB), (const char*)(F.ws + wsm::W_D), nullptr, nullptr};
            pg8::EpiBf16 E{(bf16*)(F.ws + wsm::OB), D};
            pg8::gemm_phase<pg8::EpiBf16, MoeOrder, false>(F.lds, EH, S, E);
        }
        SEAM(pb + 7);
    }
__global__ void __launch_bounds__(512, 2) mk_fwd(Args args) {
    extern __shared__ __attribute__((aligned(16))) unsigned char lds_raw[];
    using namespace cfg;
    Frame F;
    F.lds = (LAS unsigned char*)lds_raw; F.ws = args.ws; F.ctl = (unsigned*)(args.ws + wsm::CTL);
    F.tid = threadIdx.x; F.lane = F.tid & 63; F.wave = __builtin_amdgcn_readfirstlane(F.tid >> 6);
    F.G = gridDim.x; { const int bx = blockIdx.x; F.vcu = (F.G % 8 == 0) ? (bx % 8) * (F.G / 8) + bx / 8 : bx; }
    volatile LAS unsigned* MISC = (volatile LAS unsigned*)(F.lds + MISC_OFF);
    for (int u = F.tid; u < (LDS_BYTES - RING_BYTES) / 4; u += 512) ((LAS unsigned*)(F.lds + RING_BYTES))[u] = 0u;
    __syncthreads();
    const int lo = args.ph_lo, hi = args.ph_hi;
    XcdBarrier bar; bar.bar = F.ctl + wsm::CW_BAR; bar.x = 0; bar.st = nullptr;
    if (hi - lo > 1) bar = xcd_barrier_post(F.ctl + wsm::CW_BAR, MISC + 8);
    float* xo = args.out;
    layer_phases<0>(F, args, bar, lo, hi);
    layer_phases<1>(F, args, bar, lo, hi);
    if (IN(16)) {
        if (args.flags & 1) { build_pref(F, NL - 1); norm_phase<true, false, true>(F, args, xo, xo, args.in[5], 0); }
        else norm_phase<false, false, true>(F, args, xo, xo, args.in[5], 0);
    }
#undef IN
#undef SEAM
}
extern "C" void kernel_launch(void* const* d_in, const int* in_sizes, int n_in, void* d_out, int out_size, void* d_ws, size_t ws_size, hipStream_t stream) {
    using namespace cfg;
    static int grid = 0;
    if (grid == 0) {
        if (n_in != 32 || ws_size < wsm::END || out_size != M * D) { fprintf(stderr, "kernel_launch: bad args n_in=%d ws=%zu out=%d\n", n_in, ws_size, out_size); grid = -1; return; }
        int dev = 0, cus = 0;
        if (hipGetDevice(&dev) != hipSuccess || hipDeviceGetAttribute(&cus, hipDeviceAttributeMultiprocessorCount, dev) != hipSuccess) { grid = -1; return; }
        if (hipFuncSetAttribute((const void*)mk_fwd, hipFuncAttributeMaxDynamicSharedMemorySize, LDS_BYTES) != hipSuccess) { fprintf(stderr, "hipFuncSetAttribute failed\n"); grid = -1; return; }
        int per_cu = 0;
        if (hipOccupancyMaxActiveBlocksPerMultiprocessor(&per_cu, (const void*)mk_fwd, 512, LDS_BYTES) != hipSuccess || per_cu < 1) fprintf(stderr, "kernel_launch: occupancy query says %d\n", per_cu);
        (void)hipGetLastError();
        grid = cus;
    }
    if (grid < 0) return;
    unsigned char* w = (unsigned char*)d_ws;
    if (hipMemsetAsync(w + wsm::CTL, 0, wsm::CTL_ZERO_BYTES, stream) != hipSuccess) return;
    Args a{};
    for (int i = 0; i < 32; ++i) a.in[i] = (const float*)d_in[i];
    a.out = (float*)d_out; a.ws = w; a.flags = 7; a.ph_lo = 0; a.ph_hi = 17;
    hipLaunchKernelGGL(mk_fwd, dim3(grid), dim3(512), LDS_BYTES, stream, a);
}
```

```cpp
#define DUP_PHASE -1
#include <hip/hip_runtime.h>
#include <cstdint>
#include <cstdio>
#include <cmath>

typedef unsigned short bf16;
__host__ __device__ __forceinline__ unsigned f2bf(float f) { unsigned u = __builtin_bit_cast(unsigned, f); return (u + 0x7fffu + ((u >> 16) & 1u)) >> 16; }
__host__ __device__ __forceinline__ float bf2f(bf16 b) { return __builtin_bit_cast(float, ((unsigned)b) << 16); }

namespace cfg {
constexpr int D = 2048, BATCH = 8, SEQ = 4096, M = BATCH * SEQ, NL = 2;
constexpr int INC = 6400;
constexpr int OFF_BQ = 1792, OFF_BK = 2304, OFF_BV = 2816, OFF_CQ = 3328, OFF_CK = 3840, OFF_CV = 4352, OFF_D = 4864;
constexpr int NEXP = 32, EH = 256;
}
#define GAS __attribute__((address_space(1)))
#define LAS __attribute__((address_space(3)))
typedef float f32x4 __attribute__((ext_vector_type(4)));
typedef float f32x2 __attribute__((ext_vector_type(2)));
typedef short bf16x8 __attribute__((ext_vector_type(8)));
typedef unsigned u32x4 __attribute__((ext_vector_type(4)));
typedef unsigned u32x2 __attribute__((ext_vector_type(2)));
#define RLX_AGENT __ATOMIC_RELAXED, __HIP_MEMORY_SCOPE_AGENT
#define LDS_WAIT() asm volatile("s_waitcnt lgkmcnt(0)" ::: "memory")
#define VM_WAIT() asm volatile("s_waitcnt vmcnt(0)" ::: "memory")

namespace wsm {
constexpr size_t MiB = 1u << 20;
constexpr size_t CTL = 0, CTL_ZERO_BYTES = 1 * MiB;
constexpr size_t LISTS = 2 * MiB;
constexpr size_t WLIST = 6 * MiB;
constexpr size_t TOKINFO = 10 * MiB;
constexpr size_t ROUTE = 11 * MiB;
constexpr size_t WRT = 12 * MiB;
constexpr size_t W_IN = 16 * MiB;
constexpr size_t W_OUT = 41 * MiB;
constexpr size_t W_GU = 49 * MiB;
constexpr size_t W_D = 113 * MiB;
constexpr size_t XN = 146 * MiB;
constexpr size_t P = 274 * MiB;
constexpr size_t HB = P;
constexpr size_t OB = P + 40 * MiB;
constexpr size_t Y = 674 * MiB;
constexpr size_t RW = 802 * MiB;
constexpr size_t END = 1010 * MiB;
constexpr int CW_BAR = 4096;
constexpr int CW_CNT = 16384;
constexpr int CW_Q = 32768;
}
constexpr int LCAP = 32768;
constexpr int RING_BYTES = 139264;
constexpr int MISC_OFF = RING_BYTES + 320;
constexpr int TAB_OFF = RING_BYTES + 1024;
constexpr int LDS_BYTES = 147456;
constexpr float C2F = 0.125f * 1.4426950408889634f;
constexpr float LOG2E = 1.4426950408889634f;

typedef __bf16 bf16x2_hw __attribute__((ext_vector_type(2)));
__device__ __forceinline__ unsigned pk2(float lo, float hi) { const f32x2 v = {lo, hi}; const bf16x2_hw b = __builtin_convertvector(v, bf16x2_hw); return __builtin_bit_cast(unsigned, b); }
__device__ __forceinline__ bf16 cvt1(float x) { return (bf16)(pk2(x, x) & 0xffffu); }
__device__ __forceinline__ float wave_sum(float v) {
#pragma unroll
    for (int o = 1; o < 64; o <<= 1) v += __shfl_xor(v, o);
    return v;
}

struct Args {
    const float* in[32]; float* out; unsigned char* ws;
    int ph_lo, ph_hi, flags, pad;
};
#define XB_TMO      128
#define XB_XCNT(j)  (256  + 64 * (j))
#define XB_XSUB(j)  (1280 + 64 * (j))
#define XB_XGEN(j)  (2304 + 64 * (j))
#define XB_TOP      3328
#define XB_TOPGEN   3392
#define XCD_BAR_WORDS 3456
#define XB_SPIN_CAP (1u << 22)

__device__ __forceinline__ unsigned xb_ld(unsigned* p)              { return __hip_atomic_load(p, __ATOMIC_RELAXED, __HIP_MEMORY_SCOPE_AGENT); }
__device__ __forceinline__ unsigned xb_add(unsigned* p, unsigned v) { return __hip_atomic_fetch_add(p, v, __ATOMIC_RELAXED, __HIP_MEMORY_SCOPE_AGENT); }
__device__ __forceinline__ unsigned xb_xcc_id() { return (unsigned)__builtin_amdgcn_s_getreg((3 << 11) | 20) & 0xFu; }
#define XB_SPIN(cond, bar) do { unsigned _sp = 0; while (cond) { __builtin_amdgcn_s_sleep(1); \
    if ((++_sp & 255u) == 0u) { if (xb_ld(&(bar)[XB_TMO])) break; if (_sp > XB_SPIN_CAP) { atomicAdd(&(bar)[XB_TMO], 1u); break; } } } } while (0)

struct XcdBarrier {
    unsigned* bar; unsigned x;
    volatile LAS unsigned* st;
};

__device__ __forceinline__ XcdBarrier xcd_barrier_post(unsigned* bar, volatile LAS unsigned* st) {
    XcdBarrier b; b.bar = bar; b.x = xb_xcc_id(); b.st = st;
    if (threadIdx.x == 0) (void)xb_add(&bar[XB_XCNT(b.x)], 1u);
    return b;
}
__device__ __forceinline__ void xcd_barrier_complete(unsigned* bar, unsigned x, unsigned& nloc, unsigned& nx) {
    const unsigned G = gridDim.x * gridDim.y * gridDim.z;
    unsigned sum, cnt, mine, sp = 0u;
    for (;;) {
        sum = 0u; cnt = 0u; mine = 0u;
#pragma unroll
        for (unsigned j = 0; j < 16; ++j) { const unsigned c = xb_ld(&bar[XB_XCNT(j)]); sum += c; cnt += (c > 0u) ? 1u : 0u; mine = (j == x) ? c : mine; }
        if (sum == G) break;
        __builtin_amdgcn_s_sleep(1);
        if ((++sp & 255u) == 0u) { if (xb_ld(&bar[XB_TMO])) break; if (sp > XB_SPIN_CAP) { atomicAdd(&bar[XB_TMO], 1u); break; } }
    }
    nloc = mine > 0u ? mine : 1u; nx = cnt > 0u ? cnt : 1u;
}

__device__ __forceinline__ void xcd_barrier(const XcdBarrier& b) {
    asm volatile("s_waitcnt vmcnt(0)" ::: "memory");
    __syncthreads();
    if (threadIdx.x == 0) {
        unsigned* bar = b.bar;
        __builtin_amdgcn_s_waitcnt(0);
        unsigned nloc = b.st[0], nx = b.st[1];
        if (nloc == 0u) { xcd_barrier_complete(bar, b.x, nloc, nx); b.st[0] = nloc; b.st[1] = nx; }
        const unsigned old = xb_add(&bar[XB_XSUB(b.x)], 1u);
        const unsigned gen = old / nloc;
        if (old + 1u == (gen + 1u) * nloc) {
            __builtin_amdgcn_fence(__ATOMIC_RELEASE, "agent");
            asm volatile("s_waitcnt vmcnt(0)" ::: "memory");
            const unsigned og = xb_add(&bar[XB_TOP], 1u);
            const unsigned tg = og / nx;
            if (og + 1u == (tg + 1u) * nx) xb_add(&bar[XB_TOPGEN], 1u);
            else XB_SPIN(xb_ld(&bar[XB_TOPGEN]) == tg, bar);
            __builtin_amdgcn_fence(__ATOMIC_ACQUIRE, "agent");
            xb_add(&bar[XB_XGEN(b.x)], 1u);
            asm volatile("s_waitcnt vmcnt(0)" ::: "memory");
        } else {
            XB_SPIN(xb_ld(&bar[XB_XGEN(b.x)]) == gen, bar);
            __builtin_amdgcn_fence(__ATOMIC_ACQUIRE, "agent");
            asm volatile("s_waitcnt vmcnt(0)" ::: "memory");
        }
    }
    __syncthreads();
}
namespace pg8 {
#define PG8_LAS __attribute__((address_space(3)))
typedef unsigned short bf16_t;
typedef short bf16x8 __attribute__((ext_vector_type(8)));
typedef float f32x4 __attribute__((ext_vector_type(4)));
typedef unsigned u32x4 __attribute__((ext_vector_type(4)));
typedef unsigned u32x2 __attribute__((ext_vector_type(2)));
constexpr int BM = 256, BK = 64, HALF = 128, HTB = HALF * BK * 2, STAGE_BYTES = 8 * HTB, NXCD = 8, WGM = 8;

__host__ __device__ __forceinline__ int lds_byte(int r, int c) { const int st = (r >> 4) * 2 + (c >> 5), rr = r & 15, cc = c & 31, ob = rr * 64 + cc * 2; return st * 1024 + (ob ^ (((ob >> 9) & 1) << 5)); }
__host__ __device__ __forceinline__ void stage_rc(int b, int& R, int& C) { const int st = b / 1024, sb = b % 1024, swz = sb ^ (((sb >> 9) & 1) << 5); R = (st >> 1) * 16 + swz / 64; C = (st & 1) * 32 + (swz % 64) / 2; }
__host__ __device__ __forceinline__ int perm32(int rho) { const int n = rho >> 4, i = rho & 15; return 8 * (i >> 2) + 4 * n + (i & 3); }

struct Unit { int pm, pn; const char* a; const char* b; const int* rows; const float* wrow; int nvalid; int pad_; };

struct StaticOrder {
    int nM, nN, nwg, G, c; const char* A; const char* Bt; size_t tstep;
    __device__ void init(const bf16_t* A_, const bf16_t* Bt_, int M, int N, int K, int G_, int c_) { nM = M / BM; nN = N / BM; nwg = nM * nN; G = G_; c = c_; A = (const char*)A_; Bt = (const char*)Bt_; tstep = (size_t)BM * K * 2; }
    __device__ bool next(int i, Unit& u) const {
        const long L = (long)i * G + c; if (L >= nwg) return false;
        int wgid = (int)L; { const int q = nwg / NXCD, r = nwg % NXCD, xcd = wgid % NXCD, off = wgid / NXCD; wgid = (xcd < r ? xcd * (q + 1) : r * (q + 1) + (xcd - r) * q) + off; }
        const int nig = WGM * nN, gid = wgid / nig, fm = gid * WGM, gsz = (nM - fm) < WGM ? (nM - fm) : WGM;
        u.pm = fm + ((wgid % nig) % gsz); u.pn = (wgid % nig) / gsz; u.a = A + (size_t)u.pm * tstep; u.b = Bt + (size_t)u.pn * tstep; u.rows = nullptr; u.wrow = nullptr; u.nvalid = 256; return true;
    }
};

__device__ __forceinline__ unsigned cvt_pk_bf16(float lo, float hi) { unsigned r; asm volatile("v_cvt_pk_bf16_f32 %0, %1, %2" : "=v"(r) : "v"(lo), "v"(hi)); return r; }

struct EpiBf16 {
    static constexpr bool PERM = true;
    bf16_t* O; int ldc;
    __device__ __forceinline__ void operator()(const f32x4 (&acc)[2][2][4][2], const Unit& u, int wr, int wc, int fr, int fq) const {
        const int row0 = u.pm * BM + wr * 64 + fr; const int col0 = u.pn * BM + wc * 32 + 8 * fq;
#pragma unroll
        for (int ai = 0; ai < 2; ++ai)
#pragma unroll
            for (int m = 0; m < 4; ++m) { bf16_t* rowp = O + (size_t)(row0 + ai * HALF + m * 16) * ldc + col0;
#pragma unroll
                for (int bj = 0; bj < 2; ++bj) { const f32x4 v0 = acc[ai][bj][m][0], v1 = acc[ai][bj][m][1];
                    u32x4 w; w.x = cvt_pk_bf16(v0[0], v0[1]); w.y = cvt_pk_bf16(v0[2], v0[3]); w.z = cvt_pk_bf16(v1[0], v1[1]); w.w = cvt_pk_bf16(v1[2], v1[3]);
                    *(u32x4*)(rowp + bj * HALF) = w; } }
    }
};
struct EpiResF32 {
    static constexpr bool PERM = false;
    const float* base; float* C; int ldc;
    __device__ __forceinline__ void operator()(const f32x4 (&acc)[2][2][4][2], const Unit& u, int wr, int wc, int fr, int fq) const {
        const int row0 = u.pm * BM + wr * 64 + fr, col0 = u.pn * BM + wc * 32 + 4 * fq;
#pragma unroll
        for (int ai = 0; ai < 2; ++ai)
#pragma unroll
            for (int m = 0; m < 4; ++m) { const size_t off = (size_t)(row0 + ai * HALF + m * 16) * ldc + col0;
#pragma unroll
                for (int bj = 0; bj < 2; ++bj)
#pragma unroll
                    for (int n = 0; n < 2; ++n) { const f32x4 bs = *(const f32x4*)(base + off + bj * HALF + n * 16); *(f32x4*)(C + off + bj * HALF + n * 16) = bs + acc[ai][bj][m][n]; }
                asm volatile("" ::: "memory"); }
    }
};
struct EpiSilu {
    static constexpr bool PERM = true;
    bf16_t* H;
    __device__ __forceinline__ void operator()(const f32x4 (&acc)[2][2][4][2], const Unit& u, int wr, int wc, int fr, int fq) const {
        const int row0 = u.pm * BM + wr * 64 + fr; const int col0 = u.pn * HALF + wc * 32 + 8 * fq;
#pragma unroll
        for (int ai = 0; ai < 2; ++ai)
#pragma unroll
            for (int m = 0; m < 4; ++m) { const int row = row0 + ai * HALF + m * 16; const float w = u.wrow[wr * 64 + fr + ai * HALF + m * 16];
                float o[8];
#pragma unroll
                for (int n = 0; n < 2; ++n)
#pragma unroll
                    for (int j = 0; j < 4; ++j) { const float g = acc[ai][0][m][n][j], up = acc[ai][1][m][n][j]; o[n * 4 + j] = g * __builtin_amdgcn_rcpf(1.f + __expf(-g)) * up * w; }
                u32x4 wv; wv.x = cvt_pk_bf16(o[0], o[1]); wv.y = cvt_pk_bf16(o[2], o[3]); wv.z = cvt_pk_bf16(o[4], o[5]); wv.w = cvt_pk_bf16(o[6], o[7]);
                *(u32x4*)(H + (size_t)row * 256 + col0) = wv; }
    }
};

template <class Epi, class Sched, bool GATHER>
__device__ __forceinline__ void gemm_phase(PG8_LAS unsigned char* lds, const int K, const Sched& S, const Epi& E) {
    const int tid = threadIdx.x, wid = __builtin_amdgcn_readfirstlane(tid >> 6), lane = tid & 63, wr = wid >> 2, wc = wid & 3, fr = lane & 15, fq = lane >> 4;
    const int nt = K / BK;
    const size_t kstep = (size_t)(BK * 2);
    const unsigned hstep = (unsigned)HALF * K * 2;
    int sR[2], sC[2];
    unsigned voffB[2], vc[2][2], vn[2][2];
#pragma unroll
    for (int i = 0; i < 2; ++i) { int R, C; stage_rc(tid * 16 + i * 8192, R, C); sR[i] = R; sC[i] = C; const int Rb = Epi::PERM ? ((R & ~31) + perm32(R & 31)) : R;
        voffB[i] = (unsigned)(Rb * K + C) * 2u; vc[0][i] = (unsigned)(R * K + C) * 2u; vc[1][i] = vc[0][i] + hstep; vn[0][i] = vc[0][i]; vn[1][i] = vc[1][i]; }
    const unsigned ldsw = (unsigned)wid * 1024u;
    const int aoff = lds_byte(wr * 64 + fr, fq * 8), boff = lds_byte(wc * 32 + fr, fq * 8);
#define PG8_SA(b, h) (((b) * 2 + (h)) * HTB)
#define PG8_SB(b, h) ((4 + (b) * 2 + (h)) * HTB)
#define PG8_STAGE(bufoff, gbase, voff) do { _Pragma("unroll") for (int _i = 0; _i < 2; ++_i) \
        __builtin_amdgcn_global_load_lds((const unsigned*)((const char*)(gbase) + (voff)[_i]), (PG8_LAS unsigned*)(lds + (bufoff) + ldsw + _i * 8192), 16, 0, 0); } while (0)
#define PG8_LDA(dst, b, h) do { _Pragma("unroll") for (int m = 0; m < 4; ++m) _Pragma("unroll") for (int k = 0; k < 2; ++k) dst[m][k] = *(const PG8_LAS bf16x8*)(lds + PG8_SA(b, h) + aoff + m * 2048 + k * 1024); } while (0)
#define PG8_LDB(dst, b, h) do { _Pragma("unroll") for (int n = 0; n < 2; ++n) _Pragma("unroll") for (int k = 0; k < 2; ++k) dst[n][k] = *(const PG8_LAS bf16x8*)(lds + PG8_SB(b, h) + boff + n * 2048 + k * 1024); } while (0)
#define PG8_MMA(ai, bj, At, Bt) do { __builtin_amdgcn_s_setprio(1); _Pragma("unroll") for (int m = 0; m < 4; ++m) _Pragma("unroll") for (int n = 0; n < 2; ++n) _Pragma("unroll") for (int k = 0; k < 2; ++k) \
        acc[ai][bj][m][n] = __builtin_amdgcn_mfma_f32_16x16x32_bf16(Bt[n][k], At[m][k], acc[ai][bj][m][n], 0, 0, 0); __builtin_amdgcn_s_setprio(0); } while (0)
#define PG8_WAIT_V(n) asm volatile("s_waitcnt vmcnt(" #n ")" ::: "memory")
#define PG8_WAIT_L(n) asm volatile("s_waitcnt lgkmcnt(" #n ")" ::: "memory")
#define PG8_BAR __builtin_amdgcn_s_barrier()
#define PG8_SCHED __builtin_amdgcn_sched_barrier(0)
#define PG8_GV(dst, u) do { if constexpr (GATHER) { _Pragma("unroll") for (int _h = 0; _h < 2; ++_h) _Pragma("unroll") for (int _i = 0; _i < 2; ++_i) { const int _idx = _h * HALF + sR[_i]; \
        const int _tok = (u).rows[_idx < (u).nvalid ? _idx : 0]; dst[_h][_i] = ((unsigned)_tok * (unsigned)K + (unsigned)sC[_i]) * 2u; } } } while (0)
    Unit cur, nxt; int ui = 0;
    if (!S.next(0, cur)) return;
    f32x4 acc[2][2][4][2];
#pragma unroll
    for (int a = 0; a < 2; ++a)
#pragma unroll
        for (int b = 0; b < 2; ++b)
#pragma unroll
            for (int m = 0; m < 4; ++m)
#pragma unroll
                for (int n = 0; n < 2; ++n) acc[a][b][m][n] = (f32x4){0.f, 0.f, 0.f, 0.f};
    bf16x8 At[4][2], B0[2][2], B1[2][2];
    const char* cA = cur.a; const char* cB = cur.b;
    PG8_GV(vc, cur);
    PG8_STAGE(PG8_SB(0, 0), cB, voffB); PG8_STAGE(PG8_SB(0, 1), cB + hstep, voffB); PG8_STAGE(PG8_SA(0, 0), cA, vc[0]); PG8_STAGE(PG8_SA(0, 1), cA, vc[1]);
    if (wr == 1) PG8_BAR;
    PG8_WAIT_V(2); PG8_BAR;
    PG8_STAGE(PG8_SB(1, 0), cB + kstep, voffB); PG8_STAGE(PG8_SA(1, 0), cA + kstep, vc[0]); PG8_STAGE(PG8_SB(1, 1), cB + hstep + kstep, voffB);
    PG8_WAIT_V(6); PG8_BAR;
    for (;;) {
        const bool has_next = S.next(ui + 1, nxt);
        const char* nA = has_next ? nxt.a : cA; const char* nB = has_next ? nxt.b : cB;
        if constexpr (GATHER) { if (has_next) { PG8_GV(vn, nxt); } else {
#pragma unroll
            for (int h = 0; h < 2; ++h)
#pragma unroll
                for (int i = 0; i < 2; ++i) vn[h][i] = vc[h][i]; } }
#pragma unroll 1
        for (int t = 0; t < nt; t += 2) {
            const bool last = (t == nt - 2);
            const char* a1 = cA + (size_t)(t + 1) * kstep;
            const char* a2 = last ? nA : cA + (size_t)(t + 2) * kstep; const char* b2 = last ? nB : cB + (size_t)(t + 2) * kstep;
            const char* a3 = a2 + kstep; const char* b3 = b2 + kstep;
            unsigned v2[2][2];
#pragma unroll
            for (int h = 0; h < 2; ++h)
#pragma unroll
                for (int i = 0; i < 2; ++i) v2[h][i] = (GATHER && last) ? vn[h][i] : vc[h][i];
            PG8_LDB(B0, 0, 0); PG8_LDB(B1, 0, 1); PG8_SCHED; PG8_LDA(At, 0, 0); PG8_STAGE(PG8_SA(1, 1), a1, vc[1]);
            PG8_WAIT_V(8); PG8_WAIT_L(0); PG8_BAR; PG8_MMA(0, 0, At, B0); PG8_MMA(0, 1, At, B1); PG8_BAR; PG8_SCHED;
            PG8_LDA(At, 0, 1); PG8_STAGE(PG8_SB(0, 0), b2, voffB); PG8_STAGE(PG8_SB(0, 1), b2 + hstep, voffB); PG8_STAGE(PG8_SA(0, 0), a2, v2[0]);
            PG8_WAIT_V(8); PG8_WAIT_L(0); PG8_BAR; PG8_MMA(1, 0, At, B0); PG8_MMA(1, 1, At, B1); PG8_BAR; PG8_SCHED;
            PG8_LDB(B0, 1, 0); PG8_LDB(B1, 1, 1); PG8_SCHED; PG8_LDA(At, 1, 0); PG8_STAGE(PG8_SA(0, 1), a2, v2[1]);
            PG8_WAIT_V(8); PG8_WAIT_L(0); PG8_BAR; PG8_MMA(0, 0, At, B0); PG8_MMA(0, 1, At, B1); PG8_BAR; PG8_SCHED;
            PG8_LDA(At, 1, 1); PG8_STAGE(PG8_SB(1, 0), b3, voffB); PG8_STAGE(PG8_SB(1, 1), b3 + hstep, voffB); PG8_STAGE(PG8_SA(1, 0), a3, v2[0]);
            PG8_WAIT_V(8); PG8_WAIT_L(0); PG8_BAR; PG8_MMA(1, 0, At, B0); PG8_MMA(1, 1, At, B1); PG8_BAR; PG8_SCHED;
        }
        if (wr == 0) PG8_BAR;
        E(acc, cur, wr, wc, fr, fq);
        if (!has_next) break;
#pragma unroll
        for (int a = 0; a < 2; ++a)
#pragma unroll
            for (int b = 0; b < 2; ++b)
#pragma unroll
                for (int m = 0; m < 4; ++m)
#pragma unroll
                    for (int n = 0; n < 2; ++n) acc[a][b][m][n] = (f32x4){0.f, 0.f, 0.f, 0.f};
        cur = nxt; cA = nA; cB = nB; ++ui;
        if constexpr (GATHER) {
#pragma unroll
            for (int h = 0; h < 2; ++h)
#pragma unroll
                for (int i = 0; i < 2; ++i) vc[h][i] = vn[h][i]; }
        if (wr == 1) PG8_BAR;
    }
    PG8_WAIT_V(0);
    PG8_BAR;
#undef PG8_SA
#undef PG8_SB
#undef PG8_STAGE
#undef PG8_LDA
#undef PG8_LDB
#undef PG8_MMA
#undef PG8_WAIT_V
#undef PG8_WAIT_L
#undef PG8_BAR
#undef PG8_SCHED
#undef PG8_GV
}
}
struct Frame {
    LAS unsigned char* lds; unsigned char* ws; unsigned* ctl;
    int tid, lane, wave, G, vcu;
};

__device__ __forceinline__ void cvt_tile(const float* W, int N, int K, int k0, int n0, bf16* dst, int drow0, float scale, LAS float* scr, int lane) {
#pragma unroll 8
    for (int i = 0; i < 32; ++i) { const int kk = 2 * i + (lane >> 5); scr[kk * 33 + (lane & 31)] = W[(size_t)(k0 + kk) * N + n0 + (lane & 31)]; }
    LDS_WAIT(); asm volatile("" ::: "memory");
    const int c = lane & 7;
#pragma unroll
    for (int j = 0; j < 4; ++j) { const int n = (lane >> 3) + 8 * j; const LAS float* s = scr + (8 * c) * 33 + n;
        u32x4 o; o.x = pk2(s[0 * 33] * scale, s[1 * 33] * scale); o.y = pk2(s[2 * 33] * scale, s[3 * 33] * scale); o.z = pk2(s[4 * 33] * scale, s[5 * 33] * scale); o.w = pk2(s[6 * 33] * scale, s[7 * 33] * scale);
        *(u32x4*)(dst + (size_t)(drow0 + n) * K + k0 + 8 * c) = o; }
    LDS_WAIT(); asm volatile("" ::: "memory");
}
__device__ __forceinline__ void convert_phase(Frame& F, const Args& a, int l) {
    using namespace cfg;
    LAS float* scr = (LAS float*)(F.lds + F.wave * 16384);
    const int gw = F.vcu * 8 + F.wave, NGW = F.G * 8;
    const float* w_in = a.in[1] + (size_t)l * D * INC; const float* w_out = a.in[2] + (size_t)l * D * D;
    const size_t es = (size_t)NEXP * D * EH;
    const float* wg = a.in[29] + l * es; const float* wu = a.in[30] + l * es; const float* wd = a.in[31] + l * es;
    bf16* Wi = (bf16*)(F.ws + wsm::W_IN); bf16* Wo = (bf16*)(F.ws + wsm::W_OUT); bf16* Wgu = (bf16*)(F.ws + wsm::W_GU); bf16* Wd = (bf16*)(F.ws + wsm::W_D);
    constexpr int I_IN = 32 * 200, I_OUT = 32 * 64, I_G = 32 * 256, I_D = 32 * 256;
    constexpr int NITEMS = I_IN + I_OUT + 2 * I_G + I_D;
    for (int it = gw; it < NITEMS; it += NGW) {
        int r = it;
        if (r < I_IN) { const int kb = r / 200, nb = r % 200, n0 = nb * 32; const bool isq = (n0 >= OFF_BQ && n0 < OFF_BK) || (n0 >= OFF_CQ && n0 < OFF_CK);
            cvt_tile(w_in, INC, D, kb * 64, n0, Wi, n0, isq ? C2F : 1.f, scr, F.lane); continue; } r -= I_IN;
        if (r < I_OUT) { const int kb = r / 64, nb = r % 64; cvt_tile(w_out, D, D, kb * 64, nb * 32, Wo, nb * 32, 1.f, scr, F.lane); continue; } r -= I_OUT;
        if (r < 2 * I_G) { const int up = r >= I_G; if (up) r -= I_G; const int e = r >> 8, q = r & 255, kb = q >> 3, nb = q & 7, n0 = nb * 32;
            cvt_tile((up ? wu : wg) + (size_t)e * D * EH, EH, D, kb * 64, n0, Wgu, e * 512 + 256 * (n0 >> 7) + (n0 & 127) + (up ? 128 : 0), 1.f, scr, F.lane); continue; } r -= 2 * I_G;
        { const int e = r >> 8, q = r & 255, kb = q >> 6, nb = q & 63; cvt_tile(wd + (size_t)e * EH * D, D, EH, kb * 64, nb * 32, Wd + (size_t)e * D * EH, nb * 32, 1.f, scr, F.lane); }
    }
    bf16* Wr = (bf16*)(F.ws + wsm::WRT); const float* rg = a.in[25] + (size_t)l * D * 4; const float* re = a.in[27] + (size_t)l * D * 32;
    for (int idx = (F.vcu * 512 + F.tid); idx < 48 * 2048; idx += F.G * 512) { const int n = idx >> 11, k = idx & 2047;
        const float v = n < 4 ? rg[k * 4 + n] : (n < 36 ? re[k * 32 + n - 4] : 0.f); Wr[idx] = cvt1(v); }
    bf16* w2t = (bf16*)(F.ws + wsm::WRT + 262144); bf16* a2t = w2t + 512 * 64; bf16* g2t = a2t + 512 * 64;
    const float* w2 = a.in[8] + (size_t)l * 64 * 512; const float* a2 = a.in[10] + (size_t)l * 64 * 512; const float* g2 = a.in[11] + (size_t)l * 128 * 512;
    for (int idx = (F.vcu * 512 + F.tid); idx < 512 * 256; idx += F.G * 512) { const int ch = idx & 511, j = idx >> 9;
        if (j < 64) w2t[ch * 64 + j] = cvt1(w2[j * 512 + ch]); else if (j < 128) a2t[ch * 64 + (j - 64)] = cvt1(a2[(j - 64) * 512 + ch]); else g2t[ch * 128 + (j - 128)] = cvt1(g2[(j - 128) * 512 + ch]); }
}

__device__ __forceinline__ int grab(Frame& F, int q) {
    volatile LAS int* slot = (volatile LAS int*)(F.lds + MISC_OFF + 64);
    if (F.tid == 0) *slot = (int)__hip_atomic_fetch_add(F.ctl + wsm::CW_Q + q * 64, 1u, RLX_AGENT);
    __syncthreads();
    const int v = *slot;
    __syncthreads();
    return __builtin_amdgcn_readfirstlane(v);
}
__device__ __forceinline__ void build_pref(Frame& F, int l) {
    LAS int* pref = (LAS int*)(F.lds + TAB_OFF);
    if (F.tid == 0) { int s = 0; for (int e = 0; e < 32; ++e) { pref[e] = s; const unsigned c = __hip_atomic_load(F.ctl + wsm::CW_CNT + (l * 32 + e) * 64, RLX_AGENT); pref[40 + e] = (int)c; s += (int)((c + 255u) >> 8); } pref[32] = s; }
    __syncthreads();
}

template <bool COMBINE, bool ROUTER, bool FINAL>
__device__ __forceinline__ void norm_phase(Frame& F, const Args& a, const float* xsrc, float* xout, const float* gain, int l, int lc) {
    using namespace cfg;
    constexpr int PITCHB = 4112;
    LAS unsigned char* tile = F.lds;
    LAS float* part = (LAS float*)(F.lds + 67584);
    LAS int* pref = (LAS int*)(F.lds + TAB_OFF);
    bf16* xn = (bf16*)(F.ws + wsm::XN);
    const bf16* OB = (const bf16*)(F.ws + wsm::OB);
    const int4* tokinfo = (const int4*)(F.ws + wsm::TOKINFO);
    const int lane = F.lane, w = F.wave;
    f32x4 g4[8];
#pragma unroll
    for (int j = 0; j < 8; ++j) g4[j] = *(const f32x4*)(gain + 4 * lane + 256 * j);
    for (int pass = F.vcu; pass < M / 16; pass += F.G) {
#pragma unroll
        for (int rr = 0; rr < 2; ++rr) {
            const int rt = 2 * w + rr, row = pass * 16 + rt;
            const float* xr = xsrc + (size_t)row * D + 4 * lane;
            f32x4 v[8];
#pragma unroll
            for (int j = 0; j < 8; ++j) v[j] = *(const f32x4*)(xr + 256 * j);
            if constexpr (COMBINE) {
                const int4 ti = tokinfo[row];
                const bf16* o0 = OB + ((size_t)pref[ti.x] * 256 + ti.y) * D + 4 * lane; const bf16* o1 = OB + ((size_t)pref[ti.z] * 256 + ti.w) * D + 4 * lane;
#pragma unroll
                for (int j = 0; j < 8; ++j) { const u32x2 p0 = *(const u32x2*)(o0 + 256 * j), p1 = *(const u32x2*)(o1 + 256 * j);
                    v[j].x += __uint_as_float(p0.x << 16) + __uint_as_float(p1.x << 16); v[j].y += __uint_as_float(p0.x & 0xffff0000u) + __uint_as_float(p1.x & 0xffff0000u);
                    v[j].z += __uint_as_float(p0.y << 16) + __uint_as_float(p1.y << 16); v[j].w += __uint_as_float(p0.y & 0xffff0000u) + __uint_as_float(p1.y & 0xffff0000u); }
                if constexpr (!FINAL) {
#pragma unroll
                    for (int j = 0; j < 8; ++j) *(f32x4*)(xout + (size_t)row * D + 4 * lane + 256 * j) = v[j];
                }
            }
            float s = 0.f;
#pragma unroll
            for (int j = 0; j < 8; ++j) s += (v[j].x * v[j].x + v[j].y * v[j].y) + (v[j].z * v[j].z + v[j].w * v[j].w);
            const float rstd = rsqrtf(wave_sum(s) * (1.f / D) + 1e-6f);
#pragma unroll
            for (int j = 0; j < 8; ++j) { const f32x4 o = v[j] * rstd * g4[j];
                if constexpr (FINAL) *(f32x4*)(xout + (size_t)row * D + 4 * lane + 256 * j) = o;
                else { u32x2 pk; pk.x = pk2(o.x, o.y); pk.y = pk2(o.z, o.w);
                    *(u32x2*)(xn + (size_t)row * D + 4 * lane + 256 * j) = pk;
                    if constexpr (ROUTER) *(LAS u32x2*)(tile + rt * PITCHB + (4 * lane + 256 * j) * 2) = pk; } }
        }
        if constexpr (ROUTER) {
            __syncthreads();
            const bf16* Wr = (const bf16*)(F.ws + wsm::WRT);
            f32x4 acc[3] = {(f32x4){0.f, 0.f, 0.f, 0.f}, (f32x4){0.f, 0.f, 0.f, 0.f}, (f32x4){0.f, 0.f, 0.f, 0.f}};
#pragma unroll
            for (int s8 = 0; s8 < 8; ++s8) { const int k = 256 * w + 32 * s8 + 8 * (lane >> 4);
                const bf16x8 af = *(const LAS bf16x8*)(tile + (lane & 15) * PITCHB + k * 2);
#pragma unroll
                for (int nt = 0; nt < 3; ++nt) { const bf16x8 bfr = *(const bf16x8*)(Wr + (size_t)(16 * nt + (lane & 15)) * D + k);
                    acc[nt] = __builtin_amdgcn_mfma_f32_16x16x32_bf16(af, bfr, acc[nt], 0, 0, 0); } }
#pragma unroll
            for (int nt = 0; nt < 3; ++nt)
#pragma unroll
                for (int i = 0; i < 4; ++i) part[(w * 16 + (lane >> 4) * 4 + i) * 48 + 16 * nt + (lane & 15)] = acc[nt][i];
            __syncthreads();
            if (F.tid < 16) {
                const int m = F.tid, tok = pass * 16 + m;
                const float* bg = a.in[26] + l * 4; const float* be = a.in[28] + l * 32;
                float lg[4];
#pragma unroll
                for (int o = 0; o < 4; ++o) { float sacc = bg[o];
#pragma unroll
                    for (int ww = 0; ww < 8; ++ww) sacc += part[(ww * 16 + m) * 48 + o]; lg[o] = sacc; }
                int gi = 0; float gm = lg[0];
#pragma unroll
                for (int o = 1; o < 4; ++o) if (lg[o] > gm) { gm = lg[o]; gi = o; }
                float gs = 0.f;
#pragma unroll
                for (int o = 0; o < 4; ++o) gs += __expf(lg[o] - gm);
                const float gw = 1.f / gs;
                float el[8];
#pragma unroll
                for (int o = 0; o < 8; ++o) { float sacc = be[gi * 8 + o];
#pragma unroll
                    for (int ww = 0; ww < 8; ++ww) sacc += part[(ww * 16 + m) * 48 + 4 + gi * 8 + o]; el[o] = sacc; }
                int i1 = 0; float m1 = el[0];
#pragma unroll
                for (int o = 1; o < 8; ++o) if (el[o] > m1) { m1 = el[o]; i1 = o; }
                int i2 = 0; float m2 = -3e38f;
#pragma unroll
                for (int o = 0; o < 8; ++o) if (o != i1 && el[o] > m2) { m2 = el[o]; i2 = o; }
                const float e2x = __expf(m2 - m1); const float w1 = gw / (1.f + e2x), w2 = gw * e2x / (1.f + e2x);
                const int e1 = gi * 8 + i1, e2 = gi * 8 + i2;
                const int p1 = (int)__hip_atomic_fetch_add(F.ctl + wsm::CW_CNT + (lc * 32 + e1) * 64, 1u, RLX_AGENT);
                const int p2 = (int)__hip_atomic_fetch_add(F.ctl + wsm::CW_CNT + (lc * 32 + e2) * 64, 1u, RLX_AGENT);
                int* lists = (int*)(F.ws + wsm::LISTS); float* wl = (float*)(F.ws + wsm::WLIST);
                lists[e1 * LCAP + p1] = tok; lists[e2 * LCAP + p2] = tok; wl[e1 * LCAP + p1] = w1; wl[e2 * LCAP + p2] = w2;
                ((int4*)(F.ws + wsm::TOKINFO))[tok] = make_int4(e1, p1, e2, p2);
                ((int4*)(F.ws + wsm::ROUTE))[tok] = make_int4(e1, e2, __float_as_int(w1), __float_as_int(w2));
            }
            __syncthreads();
        }
    }
}
namespace att {
typedef float f32x16 __attribute__((ext_vector_type(16)));
typedef short s16x4 __attribute__((ext_vector_type(4)));
constexpr int L_K = 0, L_V = 16384, L_WSF = 135168, L_TAB = 137216;
__device__ __forceinline__ int crow(int r, int hi) { return (r & 3) + 8 * (r >> 2) + 4 * hi; }
__device__ __forceinline__ int t5_bucket(int rel) {
    const int ret = rel > 0 ? 16 : 0; const int n = rel < 0 ? -rel : rel; int bk;
    if (n < 8) bk = n; else if (n < 12) bk = 8; else if (n < 16) bk = 9; else if (n < 23) bk = 10; else if (n < 32) bk = 11;
    else if (n < 46) bk = 12; else if (n < 64) bk = 13; else if (n < 91) bk = 14; else bk = 15;
    return ret + bk;
}
__device__ __forceinline__ unsigned cvtpk(float lo, float hi) { return pk2(lo, hi); }
__device__ __forceinline__ void qkt(f32x16& p0, f32x16& p1, const LAS unsigned char* Kslot, const bf16x8* qr, const f32x16& c0, const f32x16& c1, int r32, int hi) {
    const LAS unsigned char* kb = Kslot + hi * 1024 + r32 * 16;
#pragma unroll
    for (int d0 = 0; d0 < 4; ++d0) {
        const bf16x8 b0 = *(const LAS bf16x8*)(kb + d0 * 2048);
        const bf16x8 b1 = *(const LAS bf16x8*)(kb + d0 * 2048 + 512);
        if (d0 == 0) { p0 = __builtin_amdgcn_mfma_f32_32x32x16_bf16(b0, qr[0], c0, 0, 0, 0); p1 = __builtin_amdgcn_mfma_f32_32x32x16_bf16(b1, qr[0], c1, 0, 0, 0); }
        else { p0 = __builtin_amdgcn_mfma_f32_32x32x16_bf16(b0, qr[d0], p0, 0, 0, 0); p1 = __builtin_amdgcn_mfma_f32_32x32x16_bf16(b1, qr[d0], p1, 0, 0, 0); } }
}
__device__ __forceinline__ float rowmax(const f32x16& p0, const f32x16& p1) {
    float a = fmaxf(fmaxf(p0[0], p0[1]), p1[0]), b = fmaxf(fmaxf(p0[2], p0[3]), p1[1]); a = fmaxf(fmaxf(a, p1[2]), p1[3]);
#pragma unroll
    for (int r = 4; r < 16; r += 4) { a = fmaxf(fmaxf(a, p0[r]), p0[r + 1]); b = fmaxf(fmaxf(b, p0[r + 2]), p0[r + 3]); a = fmaxf(fmaxf(a, p1[r]), p1[r + 1]); b = fmaxf(fmaxf(b, p1[r + 2]), p1[r + 3]); }
    const float m = fmaxf(a, b);
    auto rr = __builtin_amdgcn_permlane32_swap(__float_as_uint(m), __float_as_uint(m), false, false);
    return fmaxf(__uint_as_float(rr[0]), __uint_as_float(rr[1]));
}
template <int ND>
__device__ __forceinline__ void pv(f32x16* o, int vb, bf16x8 pa0, bf16x8 pa1, bf16x8 pa2, bf16x8 pa3) {
#pragma unroll
    for (int d0 = 0; d0 < ND; ++d0) { s16x4 lo[4], hi[4];
#pragma unroll
        for (int ks = 0; ks < 4; ++ks) {
            asm volatile("ds_read_b64_tr_b16 %0,%1 offset:%c2" : "=&v"(lo[ks]) : "v"(vb), "i"(d0 * 4096 + ks * 1024) : "memory");
            asm volatile("ds_read_b64_tr_b16 %0,%1 offset:%c2" : "=&v"(hi[ks]) : "v"(vb), "i"(d0 * 4096 + ks * 1024 + 512) : "memory"); }
        asm volatile("s_waitcnt lgkmcnt(0)" ::: "memory"); __builtin_amdgcn_sched_barrier(0);
#define ATT_PK(k) (bf16x8){lo[k][0], lo[k][1], lo[k][2], lo[k][3], hi[k][0], hi[k][1], hi[k][2], hi[k][3]}
        o[d0] = __builtin_amdgcn_mfma_f32_32x32x16_bf16(pa0, ATT_PK(0), o[d0], 0, 0, 0);
        o[d0] = __builtin_amdgcn_mfma_f32_32x32x16_bf16(pa1, ATT_PK(1), o[d0], 0, 0, 0);
        o[d0] = __builtin_amdgcn_mfma_f32_32x32x16_bf16(pa2, ATT_PK(2), o[d0], 0, 0, 0);
        o[d0] = __builtin_amdgcn_mfma_f32_32x32x16_bf16(pa3, ATT_PK(3), o[d0], 0, 0, 0);
#undef ATT_PK
    }
}
#define ATT_WAIT_BAR(N) asm volatile("s_waitcnt vmcnt(" #N ") lgkmcnt(0)\n\ts_barrier" ::: "memory")

template <int MODE>
__device__ __forceinline__ void attn_unit(Frame& F, const Args& a, const int l, const int b, const int hh, const int qb) {
    using namespace cfg;
    constexpr int ND = MODE ? 4 : 2, VBYTES = ND * 4096, NDMA = MODE ? 3 : 2;
    const int lane = F.lane, r32 = lane & 31, hi = lane >> 5, wid = F.wave;
    const bf16* p = (const bf16*)(F.ws + wsm::P);
    bf16* y = (bf16*)(F.ws + wsm::Y);
    float* O1s = (float*)(F.ws + wsm::XN);
    LAS unsigned char* lds = F.lds;
    LAS float* wsf = (LAS float*)(lds + L_WSF) + wid * 64;
    LAS float* tab = (LAS float*)(lds + L_TAB);
    const size_t rowbase = (size_t)b * SEQ;
    if (F.tid < 320) { const int i = F.tid; float v;
        if (MODE == 0) { int d = i - 64; d = d < -128 ? -128 : (d > 128 ? 128 : d); v = a.in[17][(size_t)(l * 8 + hh) * 257 + d + 128]; }
        else v = a.in[18][t5_bucket(-(i - 64)) * 4 + hh];
        tab[i] = v * LOG2E; }
    float lam = 0.f, lam_init = 0.f;
    if (MODE == 1) { lam_init = l == 0 ? 0.2f : (float)(0.8 - 0.6 * 0.7408182206817179);
        lam = __expf(wave_sum(a.in[19][l * 64 + lane] * a.in[20][l * 64 + lane])) - __expf(wave_sum(a.in[21][l * 64 + lane] * a.in[22][l * 64 + lane])) + lam_init; }
    const int t0 = MODE == 0 ? (4 * qb - 8 > 0 ? 4 * qb - 8 : 0) : 0, t1 = 4 * qb + 3;
    const int cw = 4 * qb + (wid >> 1);
    const int q0w = qb * 256 + 32 * wid, myq = q0w + r32;
    const int vb0 = (int)(unsigned)(uintptr_t)(lds + L_V) + ((lane >> 4) & 1) * 32 + (lane & 3) * 8 + (4 * hi + ((lane & 15) >> 2)) * 64;
#pragma unroll 1
    for (int sub = 0; sub < (MODE ? 2 : 1); ++sub) {
        const int qcol = MODE ? OFF_CQ + (hh * 2 + sub) * 64 : OFF_BQ + hh * 64;
        const int kcol = MODE ? OFF_CK + (hh * 2 + sub) * 64 : OFF_BK + hh * 64;
        const int vcol = MODE ? OFF_CV + hh * 128 : OFF_BV + hh * 64;
        const bf16* Kh = p + rowbase * INC + kcol; const bf16* Vh = p + rowbase * INC + vcol;
        const bf16* ksrc = Kh + (size_t)lane * INC + wid * 8;
        const bf16* vsrc0 = Vh + (size_t)(16 * (wid & 3) + (lane >> 2)) * INC + (wid >> 2) * 32 + (lane & 3) * 8;
#define ATT_DMA(t, buf) do { \
        __builtin_amdgcn_global_load_lds((const unsigned*)(ksrc + (size_t)(t) * 64 * INC), (LAS unsigned*)(lds + L_K + (buf) * 8192 + wid * 1024), 16, 0, 0); \
        __builtin_amdgcn_global_load_lds((const unsigned*)(vsrc0 + (size_t)(t) * 64 * INC), (LAS unsigned*)(lds + L_V + (buf) * VBYTES + wid * 1024), 16, 0, 0); \
        if (MODE) __builtin_amdgcn_global_load_lds((const unsigned*)(vsrc0 + (size_t)(t) * 64 * INC + 64), (LAS unsigned*)(lds + L_V + (buf) * VBYTES + (wid + 8) * 1024), 16, 0, 0); } while (0)
        ATT_DMA(t0, 0);
        bf16x8 qr[4];
        { const bf16* Qw = p + (rowbase + q0w) * INC + qcol;
#pragma unroll
          for (int d0 = 0; d0 < 4; ++d0) qr[d0] = *(const bf16x8*)(Qw + (size_t)r32 * INC + d0 * 16 + hi * 8); }
        float m = -1e30f, lh = 0.f;
        f32x16 o[ND];
#pragma unroll
        for (int d0 = 0; d0 < ND; ++d0)
#pragma unroll
            for (int r = 0; r < 16; ++r) o[d0][r] = 0.f;
#pragma unroll 1
        for (int t = t0; t <= t1; ++t) {
            const int buf = (t - t0) & 1;
            if (t < t1) { ATT_DMA(t + 1, buf ^ 1); if (MODE) { ATT_WAIT_BAR(3); } else { ATT_WAIT_BAR(2); } }
            else { ATT_WAIT_BAR(0); }
            const bool vis = (t <= cw) && (MODE == 1 || t >= cw - 8);
            if (vis) {
                f32x16 c0, c1;
                const int dmin = q0w - (t * 64 + 63);
                if (dmin >= 128) { const float cf = tab[300];
#pragma unroll
                    for (int r = 0; r < 16; ++r) { c0[r] = cf; c1[r] = cf; } }
                else { const LAS float* tb = tab + (myq - t * 64 - 4 * hi + 64 - 27 - 32);
#pragma unroll
                    for (int r = 0; r < 16; ++r) { c1[r] = tb[27 - ((r & 3) + 8 * (r >> 2))]; c0[r] = tb[32 + 27 - ((r & 3) + 8 * (r >> 2))]; } }
                f32x16 p0, p1;
                qkt(p0, p1, lds + L_K + buf * 8192, qr, c0, c1, r32, hi);
                const float rm = rowmax(p0, p1);
                const float mn = fmaxf(m, rm);
                if (__any(mn > m)) {
                    const float f = __builtin_amdgcn_exp2f(m - mn); lh *= f; m = mn;
                    if (hi == 0) wsf[r32] = f;
                    LDS_WAIT();
#pragma unroll
                    for (int r = 0; r < 16; ++r) { const float fr = wsf[crow(r, hi)];
#pragma unroll
                        for (int d0 = 0; d0 < ND; ++d0) o[d0][r] *= fr; }
                }
                float sacc = 0.f;
#pragma unroll
                for (int r = 0; r < 16; ++r) { p0[r] = __builtin_amdgcn_exp2f(p0[r] - m); p1[r] = __builtin_amdgcn_exp2f(p1[r] - m); sacc += p0[r] + p1[r]; }
                lh += sacc;
                u32x4 pw0, pw1, pw2, pw3;
                pw0 = (u32x4){cvtpk(p0[0], p0[1]), cvtpk(p0[2], p0[3]), cvtpk(p0[4], p0[5]), cvtpk(p0[6], p0[7])};
                pw1 = (u32x4){cvtpk(p0[8], p0[9]), cvtpk(p0[10], p0[11]), cvtpk(p0[12], p0[13]), cvtpk(p0[14], p0[15])};
                pw2 = (u32x4){cvtpk(p1[0], p1[1]), cvtpk(p1[2], p1[3]), cvtpk(p1[4], p1[5]), cvtpk(p1[6], p1[7])};
                pw3 = (u32x4){cvtpk(p1[8], p1[9]), cvtpk(p1[10], p1[11]), cvtpk(p1[12], p1[13]), cvtpk(p1[14], p1[15])};
                pv<ND>(o, vb0 + buf * VBYTES, __builtin_bit_cast(bf16x8, pw0), __builtin_bit_cast(bf16x8, pw1), __builtin_bit_cast(bf16x8, pw2), __builtin_bit_cast(bf16x8, pw3));
            }
            asm volatile("s_waitcnt lgkmcnt(0)\n\ts_barrier" ::: "memory");
        }
#undef ATT_DMA
        { auto rr = __builtin_amdgcn_permlane32_swap(__float_as_uint(lh), __float_as_uint(lh), false, false); lh = __uint_as_float(rr[0]) + __uint_as_float(rr[1]); }
        if (hi == 0) wsf[32 + r32] = lh;
        LDS_WAIT();
        constexpr int SP = ND * 128 + 16;
        LAS unsigned char* stg = lds + wid * (32 * SP);
#pragma unroll
        for (int r = 0; r < 16; ++r) { const float rl = __builtin_amdgcn_rcpf(wsf[32 + crow(r, hi)]);
#pragma unroll
            for (int d0 = 0; d0 < ND; ++d0) *(LAS float*)(stg + crow(r, hi) * SP + (d0 * 32 + r32) * 4) = o[d0][r] * rl; }
        LDS_WAIT();
        const size_t tok0 = rowbase + q0w;
        if (MODE == 0) {
#pragma unroll 4
            for (int row = 0; row < 32; ++row) { const float v = *(const LAS float*)(stg + row * SP + lane * 4); y[(tok0 + row) * D + 512 + hh * 64 + lane] = cvt1(v); }
        } else if (sub == 0) {
#pragma unroll 4
            for (int row = 0; row < 32; ++row) { const f32x2 v = *(const LAS f32x2*)(stg + row * SP + lane * 8); *(f32x2*)(O1s + ((tok0 + row) * 4 + hh) * 128 + 2 * lane) = v; }
        } else {
            const float* sw = a.in[23] + l * 128;
            const float sw0 = sw[2 * lane] * (1.f - lam_init), sw1 = sw[2 * lane + 1] * (1.f - lam_init);
#pragma unroll 2
            for (int row = 0; row < 32; ++row) { const f32x2 v2 = *(const LAS f32x2*)(stg + row * SP + lane * 8); const f32x2 o1 = *(const f32x2*)(O1s + ((tok0 + row) * 4 + hh) * 128 + 2 * lane);
                const float v0 = o1.x - lam * v2.x, v1 = o1.y - lam * v2.y;
                const float ms = wave_sum(v0 * v0 + v1 * v1);
                const float rs = rsqrtf(ms * (1.f / 128.f) + 1e-5f);
                *(unsigned*)(y + (tok0 + row) * D + 1024 + hh * 128 + 2 * lane) = pk2(v0 * rs * sw0, v1 * rs * sw1); }
        }
        asm volatile("s_waitcnt vmcnt(0) lgkmcnt(0)\n\ts_barrier" ::: "memory");
    }
}

__device__ __forceinline__ void conv_items(Frame& F, const Args& a, const int l, const int start, const int stride) {
    using namespace cfg;
    const bf16* p = (const bf16*)(F.ws + wsm::P); bf16* y = (bf16*)(F.ws + wsm::Y);
    const float* cw = a.in[24] + l * 3 * 512;
    for (int it = start; it < M * 64; it += stride) {
        const int tok = it >> 6, cg = (it & 63) * 8, t = tok & (SEQ - 1);
        const bf16* r0 = p + (size_t)tok * INC + OFF_D + cg;
        const u32x4 bg = *(const u32x4*)r0;
        u32x4 c0 = *(const u32x4*)(r0 + 512), h0 = *(const u32x4*)(r0 + 1024);
        u32x4 c1 = (u32x4){0, 0, 0, 0}, h1 = c1, c2 = c1, h2 = c1;
        if (t >= 1) { c1 = *(const u32x4*)(r0 - INC + 512); h1 = *(const u32x4*)(r0 - INC + 1024); }
        if (t >= 2) { c2 = *(const u32x4*)(r0 - 2 * INC + 512); h2 = *(const u32x4*)(r0 - 2 * INC + 1024); }
        unsigned ow[4];
#pragma unroll
        for (int j = 0; j < 4; ++j) {
            float res[2];
#pragma unroll
            for (int e = 0; e < 2; ++e) {
                const int ch = cg + 2 * j + e;
#define ATT_UP(w) (e ? __uint_as_float((w) & 0xffff0000u) : __uint_as_float((w) << 16))
                const float u0 = ATT_UP(c0[j]) * ATT_UP(h0[j]), u1 = ATT_UP(c1[j]) * ATT_UP(h1[j]), u2 = ATT_UP(c2[j]) * ATT_UP(h2[j]);
                res[e] = ATT_UP(bg[j]) * (cw[ch] * u2 + cw[512 + ch] * u1 + cw[1024 + ch] * u0);
#undef ATT_UP
            }
            ow[j] = pk2(res[0], res[1]);
        }
        *(u32x4*)(y + (size_t)tok * D + 1536 + cg) = (u32x4){ow[0], ow[1], ow[2], ow[3]};
    }
}
}
namespace rw {
constexpr int PB = 144, PB2 = 272;
constexpr int SLOT = 9216;
constexpr int R0 = 0, R1B = 49152;
constexpr int O_P0 = 0, O_P0T = 9216, O_AAK = 18432, O_ARB = 27648, O_ARK = 36864;
constexpr int O_SEG = R1B + 9 * SLOT, O_BON = O_SEG + 2048;
constexpr size_t UNIT_BYTES = 49152;
constexpr size_t WL_OFF = (size_t)4096 * UNIT_BYTES;
#define RW_S(i) (R1B + (i) * SLOT)

__device__ __forceinline__ bf16x8 ldfrag(const LAS unsigned char* base, int pitch, int row0, int lane, int s) {
    return *(const LAS bf16x8*)(base + (row0 + (lane & 15)) * pitch + (32 * s + 8 * (lane >> 4)) * 2);
}
template <int KS>
__device__ __forceinline__ f32x4 tile_mm(f32x4 acc, const LAS unsigned char* X, int px, int m0, const LAS unsigned char* Y, int py, int n0, int lane) {
#pragma unroll
    for (int s = 0; s < KS; ++s) acc = __builtin_amdgcn_mfma_f32_16x16x32_bf16(ldfrag(Y, py, n0, lane, s), ldfrag(X, px, m0, lane, s), acc, 0, 0, 0);
    return acc;
}
__device__ __forceinline__ void st_rm(LAS unsigned char* base, int pitch, int m, int n0, f32x4 v) {
    u32x2 w; w.x = pk2(v[0], v[1]); w.y = pk2(v[2], v[3]); *(LAS u32x2*)(base + m * pitch + n0 * 2) = w;
}
__device__ __forceinline__ void st_tr(LAS unsigned char* base, int pitch, int m, int n0, f32x4 v) {
    const unsigned p01 = pk2(v[0], v[1]), p23 = pk2(v[2], v[3]);
    *(LAS bf16*)(base + (n0 + 0) * pitch + m * 2) = (bf16)(p01 & 0xffffu); *(LAS bf16*)(base + (n0 + 1) * pitch + m * 2) = (bf16)(p01 >> 16);
    *(LAS bf16*)(base + (n0 + 2) * pitch + m * 2) = (bf16)(p23 & 0xffffu); *(LAS bf16*)(base + (n0 + 3) * pitch + m * 2) = (bf16)(p23 >> 16);
}
__device__ __forceinline__ f32x4 ld_rm(const LAS unsigned char* base, int pitch, int m, int n0) {
    const u32x2 w = *(const LAS u32x2*)(base + m * pitch + n0 * 2);
    return (f32x4){__uint_as_float(w.x << 16), __uint_as_float(w.x & 0xffff0000u), __uint_as_float(w.y << 16), __uint_as_float(w.y & 0xffff0000u)};
}
__device__ __forceinline__ void unpack8(const u32x4 w, float* f) {
#pragma unroll
    for (int j = 0; j < 4; ++j) { f[2 * j] = __uint_as_float(w[j] << 16); f[2 * j + 1] = __uint_as_float(w[j] & 0xffff0000u); }
}
__device__ __forceinline__ u32x4 pack8(const float* f) { return (u32x4){pk2(f[0], f[1]), pk2(f[2], f[3]), pk2(f[4], f[5]), pk2(f[6], f[7])}; }
__device__ __forceinline__ float sigm(float x) { return __builtin_amdgcn_rcpf(1.f + __expf(-x)); }
#define RW_BAR() do { asm volatile("s_waitcnt lgkmcnt(0)" ::: "memory"); __builtin_amdgcn_s_barrier(); asm volatile("" ::: "memory"); } while (0)

#ifndef PROBE_R1
#define PROBE_R1 -1
#endif
#define R1_STAMP(k) do { if (PROBE_R1 >= 0) { const unsigned long long now_ = __builtin_amdgcn_s_memrealtime(); if (PROBE_R1 == (k)) racc += now_ - rlast; rlast = now_; } } while (0)
__device__ __forceinline__ void r1_unit(Frame& F, const Args& a, const int l, const int u, unsigned long long& racc, int& hcur) {
    using namespace cfg;
    unsigned long long rlast = PROBE_R1 >= 0 ? __builtin_amdgcn_s_memrealtime() : 0ull;
    int tid_ = F.tid; asm volatile("" : "+v"(tid_));
    const int tid = tid_, lane = tid & 63, w = F.wave;
    const int c = u & 63, h = (u >> 6) & 7, b = u >> 9;
    unsigned lbase_ = (unsigned)(uintptr_t)F.lds; asm volatile("" : "+s"(lbase_));
    LAS unsigned char* lds = (LAS unsigned char*)(uintptr_t)lbase_;
    const bf16* p = (const bf16*)(F.ws + wsm::P);
    const bf16* w2t = (const bf16*)(F.ws + wsm::WRT + 262144);
    const bf16* a2t = w2t + 512 * 64; const bf16* g2t = a2t + 512 * 64;
    unsigned char* gout = F.ws + wsm::RW + (size_t)u * UNIT_BYTES;
    float* wl_out = (float*)(F.ws + wsm::RW + WL_OFF) + (size_t)u * 64;
    const float* mu = a.in[6] + l * 1792;
    const size_t tok0 = (size_t)b * SEQ + c * 64;
    const int t = tid >> 3, j0 = (tid & 7) * 8;
    const bool hasprev = (c > 0) || (t > 0);
    const bf16* cur = p + (tok0 + t) * INC; const bf16* prv = cur - INC;
    LAS float* WPRE = (LAS float*)(lds + 0); LAS float* APRE = (LAS float*)(lds + 16384); LAS float* GG = (LAS float*)(lds + 32768);
    LAS float* PAR = (LAS float*)(lds + 134400);
    const int mtA = w >> 1;
    bf16x8 fw[2][2], fa[2][2], fg[2][4];
    if (h != hcur) {
        RW_BAR();
        if (w < 7) { const int pidx = w == 0 ? 7 : (w == 1 ? 9 : 10 + w); PAR[w * 64 + lane] = a.in[pidx][l * 512 + h * 64 + lane]; }
        if (tid < 448) { const int col = tid < 192 ? (tid >> 6) * 512 + h * 64 + (tid & 63) : 1536 + (tid - 192); PAR[448 + tid] = mu[col]; }
        hcur = h;
        RW_BAR();
    }
    float r[8], k[8], v[8];
    {
        auto mix8 = [&](int col, int mo, float* o) { float cv[8], pv[8], m8[8]; unpack8(*(const u32x4*)(cur + col), cv);
            if (hasprev) unpack8(*(const u32x4*)(prv + col), pv); else {
#pragma unroll
                for (int j = 0; j < 8; ++j) pv[j] = 0.f; }
            *(f32x4*)m8 = *(const LAS f32x4*)(PAR + 448 + mo); *(f32x4*)(m8 + 4) = *(const LAS f32x4*)(PAR + 448 + mo + 4);
#pragma unroll
            for (int j = 0; j < 8; ++j) o[j] = cv[j] + (pv[j] - cv[j]) * m8[j]; };
        float x[8];
        mix8(1536 + j0, 192 + j0, x);
#pragma unroll
        for (int j = 0; j < 8; ++j) { const float e2 = __expf(2.f * x[j]); x[j] = 1.f - 2.f * __builtin_amdgcn_rcpf(e2 + 1.f); }
        *(LAS u32x4*)(lds + RW_S(0) + t * PB + j0 * 2) = pack8(x);
        mix8(1600 + j0, 256 + j0, x);
        *(LAS u32x4*)(lds + RW_S(1) + t * PB + j0 * 2) = pack8(x);
        asm volatile("" ::: "memory");
        mix8(1664 + j0, 320 + j0, x);
#pragma unroll
        for (int j = 0; j < 8; ++j) x[j] = sigm(x[j]);
        *(LAS u32x4*)(lds + RW_S(2) + t * PB2 + j0 * 2) = pack8(x);
        mix8(1728 + j0, 384 + j0, x);
#pragma unroll
        for (int j = 0; j < 8; ++j) x[j] = sigm(x[j]);
        *(LAS u32x4*)(lds + RW_S(2) + t * PB2 + (64 + j0) * 2) = pack8(x);
        asm volatile("" ::: "memory");
#pragma unroll
        for (int q = 0; q < 2; ++q) { const int ch = h * 64 + 16 * (2 * (w & 1) + q) + (lane & 15);
#pragma unroll
            for (int s2 = 0; s2 < 2; ++s2) { const int kq = 32 * s2 + 8 * (lane >> 4); fw[q][s2] = *(const bf16x8*)(w2t + ch * 64 + kq); fa[q][s2] = *(const bf16x8*)(a2t + ch * 64 + kq); }
#pragma unroll
            for (int s2 = 0; s2 < 4; ++s2) fg[q][s2] = *(const bf16x8*)(g2t + ch * 128 + 32 * s2 + 8 * (lane >> 4)); }
        mix8(h * 64 + j0, j0, r); mix8(512 + h * 64 + j0, 64 + j0, k); mix8(1024 + h * 64 + j0, 128 + j0, v);
    }
    RW_BAR(); R1_STAMP(0);
    {
#pragma unroll
        for (int q = 0; q < 2; ++q) { const int nt = 2 * (w & 1) + q;
            f32x4 aw = {0.f, 0.f, 0.f, 0.f}, aa = aw, ag = aw;
#pragma unroll
            for (int s2 = 0; s2 < 2; ++s2) {
                aw = __builtin_amdgcn_mfma_f32_16x16x32_bf16(fw[q][s2], ldfrag(lds + RW_S(0), PB, 16 * mtA, lane, s2), aw, 0, 0, 0);
                aa = __builtin_amdgcn_mfma_f32_16x16x32_bf16(fa[q][s2], ldfrag(lds + RW_S(1), PB, 16 * mtA, lane, s2), aa, 0, 0, 0); }
#pragma unroll
            for (int s2 = 0; s2 < 4; ++s2) ag = __builtin_amdgcn_mfma_f32_16x16x32_bf16(fg[q][s2], ldfrag(lds + RW_S(2), PB2, 16 * mtA, lane, s2), ag, 0, 0, 0);
            const int m = 16 * mtA + (lane & 15), n0 = 16 * nt + 4 * (lane >> 4);
            const f32x4 w04 = *(const LAS f32x4*)(PAR + n0), a04 = *(const LAS f32x4*)(PAR + 64 + n0);
#pragma unroll
            for (int i = 0; i < 4; ++i) { const float nx = -(w04[i] + aw[i]); const float sp = nx > 20.f ? nx : __logf(1.f + __expf(nx)); aw[i] = -__expf(-sp - 0.5f); aa[i] = sigm(a04[i] + aa[i]); }
            *(LAS f32x4*)(WPRE + m * 64 + n0) = aw; *(LAS f32x4*)(APRE + m * 64 + n0) = aa; *(LAS f32x4*)(GG + m * 64 + n0) = ag; }
    }
    RW_BAR(); R1_STAMP(1); R1_STAMP(2);
    {
        LAS float* SEG = (LAS float*)(lds + O_SEG);
        const int ch = tid & 63, seg = tid >> 6;
        float pf[8]; float run = 0.f;
#pragma unroll
        for (int i = 0; i < 8; ++i) { run += WPRE[(8 * seg + i) * 64 + ch]; pf[i] = run; }
        SEG[seg * 64 + ch] = run;
        RW_BAR();
        float off = 0.f;
        for (int s2 = 0; s2 < seg; ++s2) off += SEG[s2 * 64 + ch];
#pragma unroll
        for (int i = 0; i < 8; ++i) WPRE[(8 * seg + i) * 64 + ch] = off + pf[i];
    }
    RW_BAR(); R1_STAMP(3);
    {
        float kk[8], k2[8], aic[8]; float ss = 0.f, bon = 0.f;
        { float pkk[8], pka[8], prk[8];
#define R1_LD8(dst, src) do { *(f32x4*)(dst) = *(const LAS f32x4*)(src); *(f32x4*)((dst) + 4) = *(const LAS f32x4*)((src) + 4); } while (0)
          R1_LD8(aic, APRE + t * 64 + j0); R1_LD8(pkk, PAR + 128 + j0); R1_LD8(pka, PAR + 192 + j0); R1_LD8(prk, PAR + 256 + j0);
#undef R1_LD8
#pragma unroll
          for (int j = 0; j < 8; ++j) { kk[j] = k[j] * pkk[j]; ss += kk[j] * kk[j]; k2[j] = k[j] * (1.f + (aic[j] - 1.f) * pka[j]); bon += r[j] * k2[j] * prk[j]; } }
        ss += __shfl_xor(ss, 1); ss += __shfl_xor(ss, 2); ss += __shfl_xor(ss, 4);
        bon += __shfl_xor(bon, 1); bon += __shfl_xor(bon, 2); bon += __shfl_xor(bon, 4);
        const float inv = 1.f / fmaxf(sqrtf(ss), 1e-12f);
        unsigned g1w[4], g0w[4];
#pragma unroll
        for (int jp = 0; jp < 8; jp += 2) {
            const f32x2 cum = *(const LAS f32x2*)(WPRE + t * 64 + j0 + jp), tot = *(const LAS f32x2*)(WPRE + 63 * 64 + j0 + jp), gg = *(const LAS f32x2*)(GG + t * 64 + j0 + jp);
            f32x2 cpv = {0.f, 0.f}; if (t > 0) cpv = *(const LAS f32x2*)(WPRE + (t - 1) * 64 + j0 + jp);
            const f32x2 pgw = *(const LAS f32x2*)(PAR + 320 + j0 + jp), pgb = *(const LAS f32x2*)(PAR + 384 + j0 + jp);
            float xa[2], xr[2], xb[2], xk[2], xbh[2], xkh[2], g1[2], g0[2];
#pragma unroll
            for (int e = 0; e < 2; ++e) { const int j = jp + e; const float kn = kk[j] * inv, bv = kn * aic[j];
                const float e_ex = __expf(cpv[e]), e_in = __expf(cum[e]), e_ng = __expf(-cum[e]), e_tt = __expf(tot[e] - cum[e]);
                xa[e] = -kn * e_ex; xr[e] = r[j] * e_in; xb[e] = bv * e_ng; xk[e] = k2[j] * e_ng; xbh[e] = bv * e_tt; xkh[e] = k2[j] * e_tt;
                g1[e] = pgw[e] * gg[e]; g0[e] = (pgb[e] + bon * v[j]) * gg[e];
                if (t == 63) wl_out[j0 + j] = __expf(tot[e]); }
            const unsigned pa = pk2(xa[0], xa[1]), pr = pk2(xr[0], xr[1]), pb = pk2(xb[0], xb[1]), pkn = pk2(xk[0], xk[1]), pv2 = pk2(v[jp], v[jp + 1]), pbh = pk2(xbh[0], xbh[1]), pkh = pk2(xkh[0], xkh[1]);
            *(LAS unsigned*)(lds + RW_S(0) + t * PB + (j0 + jp) * 2) = pa; *(LAS unsigned*)(lds + RW_S(1) + t * PB + (j0 + jp) * 2) = pr;
            *(LAS unsigned*)(lds + RW_S(2) + t * PB + (j0 + jp) * 2) = pb; *(LAS unsigned*)(lds + RW_S(3) + t * PB + (j0 + jp) * 2) = pkn;
            *(LAS bf16*)(lds + RW_S(4) + (j0 + jp) * PB + t * 2) = (bf16)(pa & 0xffffu); *(LAS bf16*)(lds + RW_S(4) + (j0 + jp + 1) * PB + t * 2) = (bf16)(pa >> 16);
            *(LAS bf16*)(lds + RW_S(5) + (j0 + jp) * PB + t * 2) = (bf16)(pv2 & 0xffffu); *(LAS bf16*)(lds + RW_S(5) + (j0 + jp + 1) * PB + t * 2) = (bf16)(pv2 >> 16);
            *(LAS bf16*)(lds + RW_S(6) + (j0 + jp) * PB + t * 2) = (bf16)(pbh & 0xffffu); *(LAS bf16*)(lds + RW_S(6) + (j0 + jp + 1) * PB + t * 2) = (bf16)(pbh >> 16);
            *(LAS bf16*)(lds + RW_S(7) + (j0 + jp) * PB + t * 2) = (bf16)(pkh & 0xffffu); *(LAS bf16*)(lds + RW_S(7) + (j0 + jp + 1) * PB + t * 2) = (bf16)(pkh >> 16);
            g1w[jp >> 1] = pk2(g1[0], g1[1]); g0w[jp >> 1] = pk2(g0[0], g0[1]);
        }
        *(u32x4*)(gout + 32768 + (t * 64 + j0) * 2) = (u32x4){g1w[0], g1w[1], g1w[2], g1w[3]};
        *(u32x4*)(gout + 40960 + (t * 64 + j0) * 2) = (u32x4){g0w[0], g0w[1], g0w[2], g0w[3]};
    }
    RW_BAR(); R1_STAMP(4);
    {
        const int mi = w >> 1;
        const LAS unsigned char* X = lds + RW_S(mi < 2 ? 0 : 1); const LAS unsigned char* Y = lds + RW_S((mi & 1) ? 3 : 2);
        LAS unsigned char* dst = lds + (mi == 0 ? O_P0 : mi == 1 ? O_AAK : mi == 2 ? O_ARB : O_ARK);
        const bool incl = mi >= 2;
#pragma unroll
        for (int q = 0; q < 2; ++q) { const int mt = 2 * (w & 1) + q; const int m = 16 * mt + (lane & 15);
#pragma unroll
            for (int nt = 0; nt < 4; ++nt) { f32x4 acc = {0.f, 0.f, 0.f, 0.f};
                if (nt <= mt) acc = tile_mm<2>(acc, X, PB, 16 * mt, Y, PB, 16 * nt, lane);
                const int n0 = 16 * nt + 4 * (lane >> 4);
#pragma unroll
                for (int i = 0; i < 4; ++i) { const int n = n0 + i; if (!(incl ? n <= m : n < m)) acc[i] = 0.f; }
                st_rm(dst, PB, m, n0, acc);
                if (mi == 0) st_tr(lds + O_P0T, PB, m, n0, acc); } }
    }
    RW_BAR(); R1_STAMP(5);
    {
        f32x4 T[4];
        const int wr = w & 3, m = 16 * wr + (lane & 15);
        LAS unsigned char* Trm = lds + RW_S(8);
        if (w < 4) {
#pragma unroll
            for (int nt = 0; nt < 4; ++nt) { const int n0 = 16 * nt + 4 * (lane >> 4); T[nt] = ld_rm(lds + O_P0, PB, m, n0);
#pragma unroll
                for (int i = 0; i < 4; ++i) if (n0 + i == m) T[nt][i] += 1.f;
                st_rm(Trm, PB, m, n0, T[nt]); }
#pragma unroll
            for (int nt = 0; nt < 4; ++nt) { f32x4 acc = {0.f, 0.f, 0.f, 0.f}; acc = tile_mm<2>(acc, lds + RW_S(5), PB, 16 * wr, lds + O_AAK, PB, 16 * nt, lane); st_rm(lds + RW_S(0), PB, m, 16 * nt + 4 * (lane >> 4), acc); }
        } else {
#pragma unroll
            for (int nt = 0; nt < 4; ++nt) { f32x4 acc = {0.f, 0.f, 0.f, 0.f}; acc = tile_mm<2>(acc, lds + O_P0, PB, 16 * wr, lds + O_P0T, PB, 16 * nt, lane);
                const int n0 = 16 * nt + 4 * (lane >> 4); st_rm(lds + RW_S(2), PB, m, n0, acc); st_tr(lds + RW_S(3), PB, m, n0, acc); }
        }
        RW_BAR();
#pragma unroll 1
        for (int s = 1; s <= 5; ++s) {
            const int cb = s & 1;
            const LAS unsigned char* Pc = lds + (cb ? RW_S(2) : O_P0); const LAS unsigned char* PcT = lds + (cb ? RW_S(3) : O_P0T);
            LAS unsigned char* Pn = lds + (cb ? O_P0 : RW_S(2)); LAS unsigned char* PnT = lds + (cb ? O_P0T : RW_S(3));
            if (w < 4) {
                f32x4 d[4];
#pragma unroll
                for (int nt = 0; nt < 4; ++nt) { d[nt] = (f32x4){0.f, 0.f, 0.f, 0.f}; d[nt] = tile_mm<2>(d[nt], Trm, PB, 16 * wr, PcT, PB, 16 * nt, lane); }
                LDS_WAIT();
#pragma unroll
                for (int nt = 0; nt < 4; ++nt) { T[nt] += d[nt]; st_rm(Trm, PB, m, 16 * nt + 4 * (lane >> 4), T[nt]); }
            } else if (s < 5) {
#pragma unroll
                for (int nt = 0; nt < 4; ++nt) { f32x4 acc = {0.f, 0.f, 0.f, 0.f}; acc = tile_mm<2>(acc, Pc, PB, 16 * wr, PcT, PB, 16 * nt, lane);
                    const int n0 = 16 * nt + 4 * (lane >> 4); st_rm(Pn, PB, m, n0, acc); st_tr(PnT, PB, m, n0, acc); }
            }
            RW_BAR();
        }
    }
    R1_STAMP(6);
    {
        const LAS unsigned char* Z = lds + (w < 4 ? RW_S(4) : RW_S(0)); const int zr0 = 16 * (w & 3);
        f32x4 acc[4];
#pragma unroll
        for (int nt = 0; nt < 4; ++nt) { acc[nt] = (f32x4){0.f, 0.f, 0.f, 0.f}; acc[nt] = tile_mm<2>(acc[nt], Z, PB, zr0, lds + RW_S(8), PB, 16 * nt, lane); }
#pragma unroll
        for (int nt = 0; nt < 4; ++nt) st_rm(lds + RW_S(2), PB, 16 * w + (lane & 15), 16 * nt + 4 * (lane >> 4), acc[nt]);
    }
    RW_BAR(); R1_STAMP(7);
    {
        const int job = w >> 1;
        const LAS unsigned char* XTt = lds + RW_S(2); const LAS unsigned char* XTb = lds + RW_S(2) + 64 * PB;
#pragma unroll
        for (int q = 0; q < 2; ++q) { const int mt = 2 * (w & 1) + q; const int m = 16 * mt + (lane & 15);
#pragma unroll
            for (int nt = 0; nt < 4; ++nt) { f32x4 acc = {0.f, 0.f, 0.f, 0.f}; const int n0 = 16 * nt + 4 * (lane >> 4);
                if (job == 0) { acc = ld_rm(lds + RW_S(1), PB, m, n0); acc = tile_mm<2>(acc, lds + O_ARB, PB, 16 * mt, XTt, PB, 16 * nt, lane); }
                else if (job == 1) { acc = tile_mm<2>(acc, lds + O_ARB, PB, 16 * mt, XTb, PB, 16 * nt, lane); acc = tile_mm<2>(acc, lds + O_ARK, PB, 16 * mt, lds + RW_S(5), PB, 16 * nt, lane); }
                else if (job == 2) { acc = tile_mm<2>(acc, lds + RW_S(6), PB, 16 * mt, XTt, PB, 16 * nt, lane); }
                else { acc = tile_mm<2>(acc, XTb, PB, 16 * mt, lds + RW_S(6), PB, 16 * nt, lane); acc = tile_mm<2>(acc, lds + RW_S(5), PB, 16 * mt, lds + RW_S(7), PB, 16 * nt, lane); }
                u32x2 o; o.x = pk2(acc[0], acc[1]); o.y = pk2(acc[2], acc[3]);
                *(u32x2*)(gout + job * 8192 + (m * 64 + n0) * 2) = o; } }
    }
    RW_BAR(); R1_STAMP(8);
}

__device__ __forceinline__ void r2_unit(Frame& F, const Args& a, const int l, const int bh) {
    using namespace cfg;
    const int lane = F.lane, w = F.wave, wr = w & 3;
    LAS unsigned char* lds = F.lds;
    bf16* y = (bf16*)(F.ws + wsm::Y);
    const unsigned char* gin = F.ws + wsm::RW + (size_t)bh * 64 * UNIT_BYTES;
    const float* wlp = (const float*)(F.ws + wsm::RW + WL_OFF) + (size_t)bh * 64 * 64;
    const int b = bh >> 3, h = bh & 7;
    const int m = 16 * wr + (lane & 15), q4 = 4 * (lane >> 4);
    if (w < 4) {
        f32x4 S[4];
#pragma unroll
        for (int nt = 0; nt < 4; ++nt) { S[nt] = (f32x4){0.f, 0.f, 0.f, 0.f}; st_rm(lds, PB, m, 16 * nt + q4, S[nt]); }
        bf16x8 mtf[4][2], mtn[4][2]; u32x2 cf[4], cfn[4]; f32x4 wl[4], wln[4];
#define R2_LDS(c_, M_, C_, W_) do { const unsigned char* g_ = gin + (size_t)(c_) * UNIT_BYTES; _Pragma("unroll") for (int nt = 0; nt < 4; ++nt) { \
            _Pragma("unroll") for (int s_ = 0; s_ < 2; ++s_) M_[nt][s_] = *(const bf16x8*)(g_ + 16384 + ((16 * nt + (lane & 15)) * 64 + 32 * s_ + 8 * (lane >> 4)) * 2); \
            C_[nt] = *(const u32x2*)(g_ + 24576 + (m * 64 + 16 * nt + q4) * 2); W_[nt] = *(const f32x4*)(wlp + (c_) * 64 + 16 * nt + q4); } } while (0)
        R2_LDS(0, mtf, cf, wl);
#pragma unroll 1
        for (int c = 0; c < 64; ++c) {
            LAS unsigned char* Scur = lds + (c & 1) * SLOT; LAS unsigned char* Snxt = lds + ((c + 1) & 1) * SLOT;
            const int cn = c < 63 ? c + 1 : 63;
            R2_LDS(cn, mtn, cfn, wln);
            RW_BAR();
            bf16x8 sf[2];
#pragma unroll
            for (int s = 0; s < 2; ++s) sf[s] = ldfrag(Scur, PB, 16 * wr, lane, s);
#pragma unroll
            for (int nt = 0; nt < 4; ++nt) {
                f32x4 acc = S[nt] * wl[nt];
                acc[0] += __uint_as_float(cf[nt].x << 16); acc[1] += __uint_as_float(cf[nt].x & 0xffff0000u); acc[2] += __uint_as_float(cf[nt].y << 16); acc[3] += __uint_as_float(cf[nt].y & 0xffff0000u);
#pragma unroll
                for (int s = 0; s < 2; ++s) acc = __builtin_amdgcn_mfma_f32_16x16x32_bf16(mtf[nt][s], sf[s], acc, 0, 0, 0);
                S[nt] = acc; st_rm(Snxt, PB, m, 16 * nt + q4, acc); }
#pragma unroll
            for (int nt = 0; nt < 4; ++nt) { mtf[nt][0] = mtn[nt][0]; mtf[nt][1] = mtn[nt][1]; cf[nt] = cfn[nt]; wl[nt] = wln[nt]; }
        }
#undef R2_LDS
    } else {
        bf16x8 rf[2], rfn[2]; u32x2 y0[4], g1[4], g0[4], y0n[4], g1n[4], g0n[4];
#define R2_LDY(c_, R_, Y_, G1_, G0_) do { const unsigned char* g_ = gin + (size_t)(c_) * UNIT_BYTES; \
            _Pragma("unroll") for (int s_ = 0; s_ < 2; ++s_) R_[s_] = *(const bf16x8*)(g_ + (m * 64 + 32 * s_ + 8 * (lane >> 4)) * 2); \
            _Pragma("unroll") for (int nt = 0; nt < 4; ++nt) { const int o_ = (m * 64 + 16 * nt + q4) * 2; Y_[nt] = *(const u32x2*)(g_ + 8192 + o_); G1_[nt] = *(const u32x2*)(g_ + 32768 + o_); G0_[nt] = *(const u32x2*)(g_ + 40960 + o_); } } while (0)
        R2_LDY(0, rf, y0, g1, g0);
#pragma unroll 1
        for (int c = 0; c < 64; ++c) {
            LAS unsigned char* Scur = lds + (c & 1) * SLOT;
            const int cn = c < 63 ? c + 1 : 63;
            R2_LDY(cn, rfn, y0n, g1n, g0n);
            RW_BAR();
            f32x4 Y[4]; float sum = 0.f;
#pragma unroll
            for (int nt = 0; nt < 4; ++nt) {
                f32x4 acc = {__uint_as_float(y0[nt].x << 16), __uint_as_float(y0[nt].x & 0xffff0000u), __uint_as_float(y0[nt].y << 16), __uint_as_float(y0[nt].y & 0xffff0000u)};
#pragma unroll
                for (int s = 0; s < 2; ++s) acc = __builtin_amdgcn_mfma_f32_16x16x32_bf16(ldfrag(Scur, PB, 16 * nt, lane, s), rf[s], acc, 0, 0, 0);
                Y[nt] = acc; sum += (acc[0] + acc[1]) + (acc[2] + acc[3]); }
            sum += __shfl_xor(sum, 16); sum += __shfl_xor(sum, 32);
            const float mean = sum * (1.f / 64.f); float var = 0.f;
#pragma unroll
            for (int nt = 0; nt < 4; ++nt)
#pragma unroll
                for (int i = 0; i < 4; ++i) { const float d = Y[nt][i] - mean; var += d * d; }
            var += __shfl_xor(var, 16); var += __shfl_xor(var, 32);
            const float rs = rsqrtf(var * (1.f / 64.f) + 64e-5f);
            bf16* yo = y + ((size_t)b * SEQ + c * 64 + m) * D + h * 64;
#pragma unroll
            for (int nt = 0; nt < 4; ++nt) {
                const f32x4 a1 = {__uint_as_float(g1[nt].x << 16), __uint_as_float(g1[nt].x & 0xffff0000u), __uint_as_float(g1[nt].y << 16), __uint_as_float(g1[nt].y & 0xffff0000u)};
                const f32x4 a0 = {__uint_as_float(g0[nt].x << 16), __uint_as_float(g0[nt].x & 0xffff0000u), __uint_as_float(g0[nt].y << 16), __uint_as_float(g0[nt].y & 0xffff0000u)};
                const f32x4 o = (Y[nt] - mean) * rs * a1 + a0;
                u32x2 ow; ow.x = pk2(o[0], o[1]); ow.y = pk2(o[2], o[3]);
                *(u32x2*)(yo + 16 * nt + q4) = ow; }
            rf[0] = rfn[0]; rf[1] = rfn[1];
#pragma unroll
            for (int nt = 0; nt < 4; ++nt) { y0[nt] = y0n[nt]; g1[nt] = g1n[nt]; g0[nt] = g0n[nt]; }
        }
#undef R2_LDY
    }
    RW_BAR();
}
}
struct MoeOrder {
    const LAS int* pref; int G, c, npn, mode;
    const char* A; const char* B; const int* lists; const float* wl;
    __device__ __forceinline__ bool next(int i, pg8::Unit& u) const {
        const int total = __builtin_amdgcn_readfirstlane(pref[32]) * npn;
        const long L = (long)i * G + c; if (L >= total) return false;
        int wgid = (int)L; { const int q = total / 8, r = total % 8, xcd = wgid % 8, off = wgid / 8; wgid = (xcd < r ? xcd * (q + 1) : r * (q + 1) + (xcd - r) * q) + off; }
        const int panel = wgid / npn, pn = wgid % npn;
        int e = 0;
        for (int k = 1; k < 32; ++k) { const int pk = __builtin_amdgcn_readfirstlane(pref[k]); if (pk <= panel) e = k; }
        const int tl = panel - __builtin_amdgcn_readfirstlane(pref[e]);
        u.pm = panel; u.pn = pn;
        if (mode == 0) { u.a = A; u.b = B + ((size_t)e * 512 + (size_t)pn * 256) * 2048 * 2; u.rows = lists + e * LCAP + tl * 256; const int rem = __builtin_amdgcn_readfirstlane(pref[40 + e]) - tl * 256; u.nvalid = rem < 256 ? rem : 256; u.wrow = wl + e * LCAP + tl * 256; }
        else { u.a = A + (size_t)panel * 256 * 256 * 2; u.b = B + ((size_t)e * 2048 + (size_t)pn * 256) * 256 * 2; u.rows = nullptr; u.nvalid = 256; u.wrow = nullptr; }
        return true;
    }
};

#define IN(k) (lo <= (k) && (k) < hi)
#define SEAM(k) do { if (IN(k) && IN((k) + 1)) xcd_barrier(bar); } while (0)
#ifndef DUP_PHASE
#define DUP_PHASE -1
#endif
template <int l> __device__ __forceinline__ void ph_n1(Frame& F, const Args& args) {
    using namespace cfg; float* xo = args.out; const float* xin = (l == 0) ? args.in[0] : xo;
    convert_phase(F, args, l);
    if (l == 0) norm_phase<false, false, false>(F, args, xin, nullptr, args.in[3] + l * D, l, l);
    else { build_pref(F, l - 1); norm_phase<true, false, false>(F, args, xin, xo, args.in[3] + l * D, l, l); }
}
template <int l> __device__ __forceinline__ void ph_g1(Frame& F, const Args& args) {
    using namespace cfg;
    pg8::StaticOrder S; S.init((const bf16*)(F.ws + wsm::XN), (const bf16*)(F.ws + wsm::W_IN), M, INC, D, F.G, (int)blockIdx.x);
    pg8::EpiBf16 E{(bf16*)(F.ws + wsm::P), INC};
    pg8::gemm_phase<pg8::EpiBf16, pg8::StaticOrder, false>(F.lds, D, S, E);
}
template <int l> __device__ __forceinline__ void ph_m1(Frame& F, const Args& args, unsigned long long& racc) {
    { int hcur = -1; for (int i = 0; i * F.G < 4096; ++i) { const int u = (F.G == 256) ? ((F.vcu >> 2) << 6) + ((F.vcu & 3) << 4) + i : F.vcu + i * F.G; if (u < 4096) rw::r1_unit(F, args, l, u, racc, hcur); } }

    for (int u = F.vcu; u < 1024; u += F.G) { const int b = u >> 7, hh = (u >> 4) & 7, qb = ((u & 15) + (u >> 8) * 4) & 15; att::attn_unit<0>(F, args, l, b, hh, qb); }
    if (DUP_PHASE == 21 + 100 * l) { for (int u = F.vcu; u < 1024; u += F.G) { const int b = u >> 7, hh = (u >> 4) & 7, qb = ((u & 15) + (u >> 8) * 4) & 15; att::attn_unit<0>(F, args, l, b, hh, qb); } }
    att::conv_items(F, args, l, F.vcu * 512 + F.tid, F.G * 512);
    if (DUP_PHASE == 22 + 100 * l) att::conv_items(F, args, l, F.vcu * 512 + F.tid, F.G * 512);
}
template <int l> __device__ __forceinline__ void ph_m2(Frame& F, const Args& args) {
    for (;;) { const int it = grab(F, l); if (it >= 64 + 512) break;
        if (it < 64) rw::r2_unit(F, args, l, it);
        else { const int j = it - 64, qb = 15 - (j >> 5), b = (j & 31) >> 2, hh = j & 3; att::attn_unit<1>(F, args, l, b, hh, qb); } }
    if (DUP_PHASE == 8 * l + 3) { __syncthreads();
    for (;;) { const int it = grab(F, l + 2); if (it >= 64 + 512) break;
        if (it < 64) rw::r2_unit(F, args, l, it);
        else { const int j = it - 64, qb = 15 - (j >> 5), b = (j & 31) >> 2, hh = j & 3; att::attn_unit<1>(F, args, l, b, hh, qb); } } }
    if (DUP_PHASE == 30 + 100 * l) { if (F.vcu < 64) rw::r2_unit(F, args, l, F.vcu); }
    if (DUP_PHASE == 31 + 100 * l) { for (int u = F.vcu; u < 512; u += F.G) { const int b = u >> 6, hh = (u >> 4) & 3, qb = (u < 256) ? (u & 15) : 15 - (u & 15); att::attn_unit<1>(F, args, l, b, hh, qb); } }
}
template <int l> __device__ __forceinline__ void ph_g2(Frame& F, const Args& args) {
    using namespace cfg; float* xo = args.out; const float* xin = (l == 0) ? args.in[0] : xo;
    pg8::StaticOrder S; S.init((const bf16*)(F.ws + wsm::Y), (const bf16*)(F.ws + wsm::W_OUT), M, D, D, F.G, (int)blockIdx.x);
    pg8::EpiResF32 E{xin, xo, D};
    pg8::gemm_phase<pg8::EpiResF32, pg8::StaticOrder, false>(F.lds, D, S, E);
}
template <int l> __device__ __forceinline__ void ph_n2(Frame& F, const Args& args) { using namespace cfg;
    if (DUP_PHASE == 8 * l + 5) norm_phase<false, true, false>(F, args, args.out, nullptr, args.in[4] + l * D, l, 2);
    norm_phase<false, true, false>(F, args, args.out, nullptr, args.in[4] + l * D, l, l); }
template <int l> __device__ __forceinline__ void ph_e1(Frame& F, const Args& args) {
    using namespace cfg;
    build_pref(F, l);
    MoeOrder S{(const LAS int*)(F.lds + TAB_OFF), F.G, (int)blockIdx.x, 2, 0, (const char*)(F.ws + wsm::XN), (const char*)(F.ws + wsm::W_GU), (const int*)(F.ws + wsm::LISTS), (const float*)(F.ws + wsm::WLIST)};
    pg8::EpiSilu E{(bf16*)(F.ws + wsm::HB)};
    pg8::gemm_phase<pg8::EpiSilu, MoeOrder, true>(F.lds, D, S, E);
}
template <int l> __device__ __forceinline__ void ph_e2(Frame& F, const Args& args) {
    using namespace cfg;
    build_pref(F, l);
    MoeOrder S{(const LAS int*)(F.lds + TAB_OFF), F.G, (int)blockIdx.x, 8, 1, (const char*)(F.ws + wsm::HB), (const char*)(F.ws + wsm::W_D), nullptr, nullptr};
    pg8::EpiBf16 E{(bf16*)(F.ws + wsm::OB), D};
    pg8::gemm_phase<pg8::EpiBf16, MoeOrder, false>(F.lds, EH, S, E);
}
#ifndef PROBE_T
#define PROBE_T -1
#endif
#define RUNPH(k, call) do { if (PROBE_T == (k)) pt0 = __builtin_amdgcn_s_memrealtime(); RUNPH_(k, call); if (PROBE_T == (k)) pt1 = __builtin_amdgcn_s_memrealtime(); } while (0)
#define RUNPH_(k, call) do { if (IN(k)) { call; if (DUP_PHASE == (k) && ((k) & 7) != 3 && ((k) & 7) != 5) { __syncthreads(); call; } } SEAM(k); } while (0)
template <int l>
__device__ __forceinline__ void layer_phases(Frame& F, const Args& args, const XcdBarrier& bar, const int lo, const int hi, unsigned long long& pt0, unsigned long long& pt1) {
    constexpr int pb = 8 * l;
    RUNPH(pb + 0, ph_n1<l>(F, args));
    RUNPH(pb + 1, ph_g1<l>(F, args));
    { unsigned long long racc = 0; RUNPH(pb + 2, ph_m1<l>(F, args, racc)); if (PROBE_R1 >= 0 && l == 0) { pt0 = 0; pt1 = racc; } }
    RUNPH(pb + 3, ph_m2<l>(F, args));
    RUNPH(pb + 4, ph_g2<l>(F, args));
    RUNPH(pb + 5, ph_n2<l>(F, args));
    RUNPH(pb + 6, ph_e1<l>(F, args));
    RUNPH(pb + 7, ph_e2<l>(F, args));
}
__global__ void __launch_bounds__(512, 2) mk_fwd(Args args) {
    extern __shared__ __attribute__((aligned(16))) unsigned char lds_raw[];
    using namespace cfg;
    Frame F;
    F.lds = (LAS unsigned char*)lds_raw; F.ws = args.ws; F.ctl = (unsigned*)(args.ws + wsm::CTL);
    F.tid = threadIdx.x; F.lane = F.tid & 63; F.wave = __builtin_amdgcn_readfirstlane(F.tid >> 6);
    F.G = gridDim.x; { const int bx = blockIdx.x; F.vcu = (F.G % 8 == 0) ? (bx % 8) * (F.G / 8) + bx / 8 : bx; }
    volatile LAS unsigned* MISC = (volatile LAS unsigned*)(F.lds + MISC_OFF);
    for (int u = F.tid; u < (LDS_BYTES - RING_BYTES) / 4; u += 512) ((LAS unsigned*)(F.lds + RING_BYTES))[u] = 0u;
    __syncthreads();
    const int lo = args.ph_lo, hi = args.ph_hi;
    XcdBarrier bar; bar.bar = F.ctl + wsm::CW_BAR; bar.x = 0; bar.st = nullptr;
    if (hi - lo > 1) bar = xcd_barrier_post(F.ctl + wsm::CW_BAR, MISC + 8);
    float* xo = args.out;
    unsigned long long pt0 = 0, pt1 = 0;
    layer_phases<0>(F, args, bar, lo, hi, pt0, pt1);
    layer_phases<1>(F, args, bar, lo, hi, pt0, pt1);
    if (PROBE_T == 16) pt0 = __builtin_amdgcn_s_memrealtime();
    if (IN(16)) {
        build_pref(F, NL - 1); norm_phase<true, false, true>(F, args, xo, xo, args.in[5], 0, 0);
    }
    if (PROBE_T == 16) pt1 = __builtin_amdgcn_s_memrealtime();
    if ((PROBE_T >= 0 || PROBE_R1 >= 0) && blockIdx.x == 0 && F.tid == 0) { const unsigned long long te = __builtin_amdgcn_s_memrealtime(); while (__builtin_amdgcn_s_memrealtime() - te < 4ull * (pt1 - pt0)) __builtin_amdgcn_s_sleep(8); }
#undef IN
#undef SEAM
}
extern "C" void kernel_launch(void* const* d_in, const int* in_sizes, int n_in, void* d_out, int out_size, void* d_ws, size_t ws_size, hipStream_t stream) {
    using namespace cfg;
    static int grid = 0;
    if (grid == 0) {
        if (n_in != 32 || ws_size < wsm::END || out_size != M * D) { fprintf(stderr, "kernel_launch: bad args n_in=%d ws=%zu out=%d\n", n_in, ws_size, out_size); grid = -1; return; }
        int dev = 0, cus = 0;
        if (hipGetDevice(&dev) != hipSuccess || hipDeviceGetAttribute(&cus, hipDeviceAttributeMultiprocessorCount, dev) != hipSuccess) { grid = -1; return; }
        if (hipFuncSetAttribute((const void*)mk_fwd, hipFuncAttributeMaxDynamicSharedMemorySize, LDS_BYTES) != hipSuccess) { fprintf(stderr, "hipFuncSetAttribute failed\n"); grid = -1; return; }
        int per_cu = 0;
        if (hipOccupancyMaxActiveBlocksPerMultiprocessor(&per_cu, (const void*)mk_fwd, 512, LDS_BYTES) != hipSuccess || per_cu < 1) fprintf(stderr, "kernel_launch: occupancy query says %d\n", per_cu);
        (void)hipGetLastError();
        grid = cus;
    }
    if (grid < 0) return;
    unsigned char* w = (unsigned char*)d_ws;
    if (hipMemsetAsync(w + wsm::CTL, 0, wsm::CTL_ZERO_BYTES, stream) != hipSuccess) return;
    Args a{};
    for (int i = 0; i < 32; ++i) a.in[i] = (const float*)d_in[i];
    a.out = (float*)d_out; a.ws = w; a.flags = 7; a.ph_lo = 0; a.ph_hi = 17;
    hipLaunchKernelGGL(mk_fwd, dim3(grid), dim3(512), LDS_BYTES, stream, a);
}
```

```cpp
#define DUP_PHASE -1
#include <hip/hip_runtime.h>
#include <cstdint>
#include <cstdio>
#include <cmath>

typedef unsigned short bf16;
__host__ __device__ __forceinline__ unsigned f2bf(float f) { unsigned u = __builtin_bit_cast(unsigned, f); return (u + 0x7fffu + ((u >> 16) & 1u)) >> 16; }
__host__ __device__ __forceinline__ float bf2f(bf16 b) { return __builtin_bit_cast(float, ((unsigned)b) << 16); }

namespace cfg {
constexpr int D = 2048, BATCH = 8, SEQ = 4096, M = BATCH * SEQ, NL = 2;
constexpr int INC = 6400;
constexpr int OFF_BQ = 1792, OFF_BK = 2304, OFF_BV = 2816, OFF_CQ = 3328, OFF_CK = 3840, OFF_CV = 4352, OFF_D = 4864;
constexpr int NEXP = 32, EH = 256;
}
#define GAS __attribute__((address_space(1)))
#define LAS __attribute__((address_space(3)))
typedef float f32x4 __attribute__((ext_vector_type(4)));
typedef float f32x2 __attribute__((ext_vector_type(2)));
typedef short bf16x8 __attribute__((ext_vector_type(8)));
typedef unsigned u32x4 __attribute__((ext_vector_type(4)));
typedef unsigned u32x2 __attribute__((ext_vector_type(2)));
#define RLX_AGENT __ATOMIC_RELAXED, __HIP_MEMORY_SCOPE_AGENT
#define LDS_WAIT() asm volatile("s_waitcnt lgkmcnt(0)" ::: "memory")
#define VM_WAIT() asm volatile("s_waitcnt vmcnt(0)" ::: "memory")

namespace wsm {
constexpr size_t MiB = 1u << 20;
constexpr size_t CTL = 0, CTL_ZERO_BYTES = 1 * MiB;
constexpr size_t LISTS = 2 * MiB;
constexpr size_t WLIST = 6 * MiB;
constexpr size_t TOKINFO = 10 * MiB;
constexpr size_t ROUTE = 11 * MiB;
constexpr size_t WRT = 12 * MiB;
constexpr size_t W_IN = 16 * MiB;
constexpr size_t W_OUT = 41 * MiB;
constexpr size_t W_GU = 49 * MiB;
constexpr size_t W_D = 113 * MiB;
constexpr size_t XN = 146 * MiB;
constexpr size_t P = 274 * MiB;
constexpr size_t HB = P;
constexpr size_t OB = P + 40 * MiB;
constexpr size_t Y = 674 * MiB;
constexpr size_t RW = 802 * MiB;
constexpr size_t END = 1010 * MiB;
constexpr int CW_BAR = 4096;
constexpr int CW_CNT = 16384;
constexpr int CW_Q = 32768;
}
constexpr int LCAP = 32768;
constexpr int RING_BYTES = 139264;
constexpr int MISC_OFF = RING_BYTES + 320;
constexpr int TAB_OFF = RING_BYTES + 1024;
constexpr int LDS_BYTES = 147456;
constexpr float C2F = 0.125f * 1.4426950408889634f;
constexpr float LOG2E = 1.4426950408889634f;

typedef __bf16 bf16x2_hw __attribute__((ext_vector_type(2)));
__device__ __forceinline__ unsigned pk2(float lo, float hi) { const f32x2 v = {lo, hi}; const bf16x2_hw b = __builtin_convertvector(v, bf16x2_hw); return __builtin_bit_cast(unsigned, b); }
__device__ __forceinline__ bf16 cvt1(float x) { return (bf16)(pk2(x, x) & 0xffffu); }
__device__ __forceinline__ float wave_sum(float v) {
#pragma unroll
    for (int o = 1; o < 64; o <<= 1) v += __shfl_xor(v, o);
    return v;
}

struct Args {
    const float* in[32]; float* out; unsigned char* ws;
    int ph_lo, ph_hi, flags, pad;
};
#define XB_TMO      128
#define XB_XCNT(j)  (256  + 64 * (j))
#define XB_XSUB(j)  (1280 + 64 * (j))
#define XB_XGEN(j)  (2304 + 64 * (j))
#define XB_TOP      3328
#define XB_TOPGEN   3392
#define XCD_BAR_WORDS 3456
#define XB_SPIN_CAP (1u << 22)

__device__ __forceinline__ unsigned xb_ld(unsigned* p)              { return __hip_atomic_load(p, __ATOMIC_RELAXED, __HIP_MEMORY_SCOPE_AGENT); }
__device__ __forceinline__ unsigned xb_add(unsigned* p, unsigned v) { return __hip_atomic_fetch_add(p, v, __ATOMIC_RELAXED, __HIP_MEMORY_SCOPE_AGENT); }
__device__ __forceinline__ unsigned xb_xcc_id() { return (unsigned)__builtin_amdgcn_s_getreg((3 << 11) | 20) & 0xFu; }
#define XB_SPIN(cond, bar) do { unsigned _sp = 0; while (cond) { __builtin_amdgcn_s_sleep(1); \
    if ((++_sp & 255u) == 0u) { if (xb_ld(&(bar)[XB_TMO])) break; if (_sp > XB_SPIN_CAP) { atomicAdd(&(bar)[XB_TMO], 1u); break; } } } } while (0)

struct XcdBarrier {
    unsigned* bar; unsigned x;
    volatile LAS unsigned* st;
};

__device__ __forceinline__ XcdBarrier xcd_barrier_post(unsigned* bar, volatile LAS unsigned* st) {
    XcdBarrier b; b.bar = bar; b.x = xb_xcc_id(); b.st = st;
    if (threadIdx.x == 0) (void)xb_add(&bar[XB_XCNT(b.x)], 1u);
    return b;
}
__device__ __forceinline__ void xcd_barrier_complete(unsigned* bar, unsigned x, unsigned& nloc, unsigned& nx) {
    const unsigned G = gridDim.x * gridDim.y * gridDim.z;
    unsigned sum, cnt, mine, sp = 0u;
    for (;;) {
        sum = 0u; cnt = 0u; mine = 0u;
#pragma unroll
        for (unsigned j = 0; j < 16; ++j) { const unsigned c = xb_ld(&bar[XB_XCNT(j)]); sum += c; cnt += (c > 0u) ? 1u : 0u; mine = (j == x) ? c : mine; }
        if (sum == G) break;
        __builtin_amdgcn_s_sleep(1);
        if ((++sp & 255u) == 0u) { if (xb_ld(&bar[XB_TMO])) break; if (sp > XB_SPIN_CAP) { atomicAdd(&bar[XB_TMO], 1u); break; } }
    }
    nloc = mine > 0u ? mine : 1u; nx = cnt > 0u ? cnt : 1u;
}

__device__ __forceinline__ void xcd_barrier(const XcdBarrier& b) {
    asm volatile("s_waitcnt vmcnt(0)" ::: "memory");
    __syncthreads();
    if (threadIdx.x == 0) {
        unsigned* bar = b.bar;
        __builtin_amdgcn_s_waitcnt(0);
        unsigned nloc = b.st[0], nx = b.st[1];
        if (nloc == 0u) { xcd_barrier_complete(bar, b.x, nloc, nx); b.st[0] = nloc; b.st[1] = nx; }
        const unsigned old = xb_add(&bar[XB_XSUB(b.x)], 1u);
        const unsigned gen = old / nloc;
        if (old + 1u == (gen + 1u) * nloc) {
            __builtin_amdgcn_fence(__ATOMIC_RELEASE, "agent");
            asm volatile("s_waitcnt vmcnt(0)" ::: "memory");
            const unsigned og = xb_add(&bar[XB_TOP], 1u);
            const unsigned tg = og / nx;
            if (og + 1u == (tg + 1u) * nx) xb_add(&bar[XB_TOPGEN], 1u);
            else XB_SPIN(xb_ld(&bar[XB_TOPGEN]) == tg, bar);
            __builtin_amdgcn_fence(__ATOMIC_ACQUIRE, "agent");
            xb_add(&bar[XB_XGEN(b.x)], 1u);
            asm volatile("s_waitcnt vmcnt(0)" ::: "memory");
        } else {
            XB_SPIN(xb_ld(&bar[XB_XGEN(b.x)]) == gen, bar);
            __builtin_amdgcn_fence(__ATOMIC_ACQUIRE, "agent");
            asm volatile("s_waitcnt vmcnt(0)" ::: "memory");
        }
    }
    __syncthreads();
}
namespace pg8 {
#define PG8_LAS __attribute__((address_space(3)))
typedef unsigned short bf16_t;
typedef short bf16x8 __attribute__((ext_vector_type(8)));
typedef float f32x4 __attribute__((ext_vector_type(4)));
typedef unsigned u32x4 __attribute__((ext_vector_type(4)));
typedef unsigned u32x2 __attribute__((ext_vector_type(2)));
typedef int i32x4_t __attribute__((ext_vector_type(4)));
typedef int i32x8_t __attribute__((ext_vector_type(8)));
constexpr float F8_ACT = 16.f, F8_WGT = 512.f, F8_INV = 1.f / (16.f * 512.f);
constexpr int BM = 256, BK = 64, HALF = 128, HTB = HALF * BK * 2, STAGE_BYTES = 8 * HTB, NXCD = 8, WGM = 8;

__host__ __device__ __forceinline__ int lds_byte(int r, int c) { const int st = (r >> 4) * 2 + (c >> 5), rr = r & 15, cc = c & 31, ob = rr * 64 + cc * 2; return st * 1024 + (ob ^ (((ob >> 9) & 1) << 5)); }
__host__ __device__ __forceinline__ void stage_rc(int b, int& R, int& C) { const int st = b / 1024, sb = b % 1024, swz = sb ^ (((sb >> 9) & 1) << 5); R = (st >> 1) * 16 + swz / 64; C = (st & 1) * 32 + (swz % 64) / 2; }
__host__ __device__ __forceinline__ int perm32(int rho) { const int n = rho >> 4, i = rho & 15; return 8 * (i >> 2) + 4 * n + (i & 3); }

struct Unit { int pm, pn; const char* a; const char* b; const int* rows; const float* wrow; int nvalid; int pad_; };

struct StaticOrder {
    int nM, nN, nwg, G, c; const char* A; const char* Bt; size_t tstep;
    __device__ void init(const void* A_, const void* Bt_, int M, int N, int K, int G_, int c_, int esz = 2) { nM = M / BM; nN = N / BM; nwg = nM * nN; G = G_; c = c_; A = (const char*)A_; Bt = (const char*)Bt_; tstep = (size_t)BM * K * esz; }
    __device__ bool next(int i, Unit& u) const {
        const long L = (long)i * G + c; if (L >= nwg) return false;
        int wgid = (int)L; { const int q = nwg / NXCD, r = nwg % NXCD, xcd = wgid % NXCD, off = wgid / NXCD; wgid = (xcd < r ? xcd * (q + 1) : r * (q + 1) + (xcd - r) * q) + off; }
        const int nig = WGM * nN, gid = wgid / nig, fm = gid * WGM, gsz = (nM - fm) < WGM ? (nM - fm) : WGM;
        u.pm = fm + ((wgid % nig) % gsz); u.pn = (wgid % nig) / gsz; u.a = A + (size_t)u.pm * tstep; u.b = Bt + (size_t)u.pn * tstep; u.rows = nullptr; u.wrow = nullptr; u.nvalid = 256; return true;
    }
};

__device__ __forceinline__ unsigned cvt_pk_bf16(float lo, float hi) { unsigned r; asm volatile("v_cvt_pk_bf16_f32 %0, %1, %2" : "=v"(r) : "v"(lo), "v"(hi)); return r; }

struct EpiBf16 {
    static constexpr bool PERM = true;
    bf16_t* O; int ldc; float mul;
    __device__ __forceinline__ void operator()(const f32x4 (&acc)[2][2][4][2], const Unit& u, int wr, int wc, int fr, int fq) const {
        const int row0 = u.pm * BM + wr * 64 + fr; const int col0 = u.pn * BM + wc * 32 + 8 * fq;
#pragma unroll
        for (int ai = 0; ai < 2; ++ai)
#pragma unroll
            for (int m = 0; m < 4; ++m) { bf16_t* rowp = O + (size_t)(row0 + ai * HALF + m * 16) * ldc + col0;
#pragma unroll
                for (int bj = 0; bj < 2; ++bj) { const f32x4 v0 = acc[ai][bj][m][0] * mul, v1 = acc[ai][bj][m][1] * mul;
                    u32x4 w; w.x = cvt_pk_bf16(v0[0], v0[1]); w.y = cvt_pk_bf16(v0[2], v0[3]); w.z = cvt_pk_bf16(v1[0], v1[1]); w.w = cvt_pk_bf16(v1[2], v1[3]);
                    *(u32x4*)(rowp + bj * HALF) = w; } }
    }
};
struct EpiResF32 {
    static constexpr bool PERM = false;
    const float* base; float* C; int ldc;
    __device__ __forceinline__ void operator()(const f32x4 (&acc)[2][2][4][2], const Unit& u, int wr, int wc, int fr, int fq) const {
        const int row0 = u.pm * BM + wr * 64 + fr, col0 = u.pn * BM + wc * 32 + 4 * fq;
#pragma unroll
        for (int ai = 0; ai < 2; ++ai)
#pragma unroll
            for (int m = 0; m < 4; ++m) { const size_t off = (size_t)(row0 + ai * HALF + m * 16) * ldc + col0;
#pragma unroll
                for (int bj = 0; bj < 2; ++bj)
#pragma unroll
                    for (int n = 0; n < 2; ++n) { const f32x4 bs = *(const f32x4*)(base + off + bj * HALF + n * 16); *(f32x4*)(C + off + bj * HALF + n * 16) = bs + acc[ai][bj][m][n]; }
                asm volatile("" ::: "memory"); }
    }
};
struct EpiSilu {
    static constexpr bool PERM = true;
    bf16_t* H;
    __device__ __forceinline__ void operator()(const f32x4 (&acc)[2][2][4][2], const Unit& u, int wr, int wc, int fr, int fq) const {
        const int row0 = u.pm * BM + wr * 64 + fr; const int col0 = u.pn * HALF + wc * 32 + 8 * fq;
#pragma unroll
        for (int ai = 0; ai < 2; ++ai)
#pragma unroll
            for (int m = 0; m < 4; ++m) { const int row = row0 + ai * HALF + m * 16; const float w = u.wrow[wr * 64 + fr + ai * HALF + m * 16];
                float o[8];
#pragma unroll
                for (int n = 0; n < 2; ++n)
#pragma unroll
                    for (int j = 0; j < 4; ++j) { const float g = acc[ai][0][m][n][j], up = acc[ai][1][m][n][j]; o[n * 4 + j] = g * __builtin_amdgcn_rcpf(1.f + __expf(-g)) * up * w; }
                u32x4 wv; wv.x = cvt_pk_bf16(o[0], o[1]); wv.y = cvt_pk_bf16(o[2], o[3]); wv.z = cvt_pk_bf16(o[4], o[5]); wv.w = cvt_pk_bf16(o[6], o[7]);
                *(u32x4*)(H + (size_t)row * 256 + col0) = wv; }
    }
};

template <class Epi, class Sched, bool GATHER, int ESZ = 2>
__device__ __forceinline__ void gemm_phase(PG8_LAS unsigned char* lds, const int K, const Sched& S, const Epi& E) {
    const int tid = threadIdx.x, wid = __builtin_amdgcn_readfirstlane(tid >> 6), lane = tid & 63, wr = wid >> 2, wc = wid & 3, fr = lane & 15, fq = lane >> 4;
    const int KB = K * ESZ;
    const int nt = KB / (BK * 2);
    const size_t kstep = (size_t)(BK * 2);
    const unsigned hstep = (unsigned)HALF * KB;
    int sR[2], sC[2];
    unsigned voffB[2], vc[2][2], vn[2][2];
#pragma unroll
    for (int i = 0; i < 2; ++i) { int R, C; stage_rc(tid * 16 + i * 8192, R, C); sR[i] = R; sC[i] = C; const int Rb = Epi::PERM ? ((R & ~31) + perm32(R & 31)) : R;
        voffB[i] = (unsigned)(Rb * KB + C * 2); vc[0][i] = (unsigned)(R * KB + C * 2); vc[1][i] = vc[0][i] + hstep; vn[0][i] = vc[0][i]; vn[1][i] = vc[1][i]; }
    const unsigned ldsw = (unsigned)wid * 1024u;
    const int aoff = lds_byte(wr * 64 + fr, fq * 8), boff = lds_byte(wc * 32 + fr, fq * 8);
#define PG8_SA(b, h) (((b) * 2 + (h)) * HTB)
#define PG8_SB(b, h) ((4 + (b) * 2 + (h)) * HTB)
#define PG8_STAGE(bufoff, gbase, voff) do { _Pragma("unroll") for (int _i = 0; _i < 2; ++_i) \
        __builtin_amdgcn_global_load_lds((const unsigned*)((const char*)(gbase) + (voff)[_i]), (PG8_LAS unsigned*)(lds + (bufoff) + ldsw + _i * 8192), 16, 0, 0); } while (0)
#define PG8_LD32(addr) __builtin_shufflevector(*(const PG8_LAS i32x4_t*)(addr), *(const PG8_LAS i32x4_t*)((addr) + 1024), 0, 1, 2, 3, 4, 5, 6, 7)
#define PG8_LDA(dst, b, h) do { if constexpr (ESZ == 2) { _Pragma("unroll") for (int m = 0; m < 4; ++m) _Pragma("unroll") for (int k = 0; k < 2; ++k) dst[m][k] = *(const PG8_LAS bf16x8*)(lds + PG8_SA(b, h) + aoff + m * 2048 + k * 1024); } \
        else { _Pragma("unroll") for (int m = 0; m < 4; ++m) dst##8[m] = PG8_LD32(lds + PG8_SA(b, h) + aoff + m * 2048); } } while (0)
#define PG8_LDB(dst, b, h) do { if constexpr (ESZ == 2) { _Pragma("unroll") for (int n = 0; n < 2; ++n) _Pragma("unroll") for (int k = 0; k < 2; ++k) dst[n][k] = *(const PG8_LAS bf16x8*)(lds + PG8_SB(b, h) + boff + n * 2048 + k * 1024); } \
        else { _Pragma("unroll") for (int n = 0; n < 2; ++n) dst##8[n] = PG8_LD32(lds + PG8_SB(b, h) + boff + n * 2048); } } while (0)
#define PG8_F8(x) __builtin_shufflevector(__builtin_bit_cast(i32x4_t, x[0]), __builtin_bit_cast(i32x4_t, x[1]), 0, 1, 2, 3, 4, 5, 6, 7)
#define PG8_MMA(ai, bj, At, Bt) do { __builtin_amdgcn_s_setprio(1); _Pragma("unroll") for (int m = 0; m < 4; ++m) _Pragma("unroll") for (int n = 0; n < 2; ++n) { \
        if constexpr (ESZ == 2) { _Pragma("unroll") for (int k = 0; k < 2; ++k) acc[ai][bj][m][n] = __builtin_amdgcn_mfma_f32_16x16x32_bf16(Bt[n][k], At[m][k], acc[ai][bj][m][n], 0, 0, 0); } \
        else asm volatile("s_nop 1\n\tv_mfma_f32_16x16x128_f8f6f4 %0, %1, %2, %0" : "+v"(acc[ai][bj][m][n]) : "v"(Bt##8[n]), "v"(At##8[m])); } __builtin_amdgcn_s_setprio(0); } while (0)
#define PG8_WAIT_V(n) asm volatile("s_waitcnt vmcnt(" #n ")" ::: "memory")
#define PG8_WAIT_L(n) asm volatile("s_waitcnt lgkmcnt(" #n ")" ::: "memory")
#define PG8_BAR __builtin_amdgcn_s_barrier()
#define PG8_SCHED __builtin_amdgcn_sched_barrier(0)
#define PG8_GV(dst, u) do { if constexpr (GATHER) { _Pragma("unroll") for (int _h = 0; _h < 2; ++_h) _Pragma("unroll") for (int _i = 0; _i < 2; ++_i) { const int _idx = _h * HALF + sR[_i]; \
        const int _tok = (u).rows[_idx < (u).nvalid ? _idx : 0]; dst[_h][_i] = (unsigned)_tok * (unsigned)KB + (unsigned)sC[_i] * 2u; } } } while (0)
    Unit cur, nxt; int ui = 0;
    if (!S.next(0, cur)) return;
    f32x4 acc[2][2][4][2];
#pragma unroll
    for (int a = 0; a < 2; ++a)
#pragma unroll
        for (int b = 0; b < 2; ++b)
#pragma unroll
            for (int m = 0; m < 4; ++m)
#pragma unroll
                for (int n = 0; n < 2; ++n) acc[a][b][m][n] = (f32x4){0.f, 0.f, 0.f, 0.f};
    bf16x8 At[4][2], B0[2][2], B1[2][2];
    i32x8_t At8[4], B08[2], B18[2];
    const char* cA = cur.a; const char* cB = cur.b;
    PG8_GV(vc, cur);
    PG8_STAGE(PG8_SB(0, 0), cB, voffB); PG8_STAGE(PG8_SB(0, 1), cB + hstep, voffB); PG8_STAGE(PG8_SA(0, 0), cA, vc[0]); PG8_STAGE(PG8_SA(0, 1), cA, vc[1]);
    if (wr == 1) PG8_BAR;
    PG8_WAIT_V(2); PG8_BAR;
    PG8_STAGE(PG8_SB(1, 0), cB + kstep, voffB); PG8_STAGE(PG8_SA(1, 0), cA + kstep, vc[0]); PG8_STAGE(PG8_SB(1, 1), cB + hstep + kstep, voffB);
    PG8_WAIT_V(6); PG8_BAR;
    for (;;) {
        const bool has_next = S.next(ui + 1, nxt);
        const char* nA = has_next ? nxt.a : cA; const char* nB = has_next ? nxt.b : cB;
        if constexpr (GATHER) { if (has_next) { PG8_GV(vn, nxt); } else {
#pragma unroll
            for (int h = 0; h < 2; ++h)
#pragma unroll
                for (int i = 0; i < 2; ++i) vn[h][i] = vc[h][i]; } }
#pragma unroll 1
        for (int t = 0; t < nt; t += 2) {
            const bool last = (t == nt - 2);
            const char* a1 = cA + (size_t)(t + 1) * kstep;
            const char* a2 = last ? nA : cA + (size_t)(t + 2) * kstep; const char* b2 = last ? nB : cB + (size_t)(t + 2) * kstep;
            const char* a3 = a2 + kstep; const char* b3 = b2 + kstep;
            unsigned v2[2][2];
#pragma unroll
            for (int h = 0; h < 2; ++h)
#pragma unroll
                for (int i = 0; i < 2; ++i) v2[h][i] = (GATHER && last) ? vn[h][i] : vc[h][i];
            PG8_LDB(B0, 0, 0); PG8_LDB(B1, 0, 1); PG8_SCHED; PG8_LDA(At, 0, 0); PG8_STAGE(PG8_SA(1, 1), a1, vc[1]);
            PG8_WAIT_V(8); PG8_WAIT_L(0); PG8_BAR; PG8_MMA(0, 0, At, B0); PG8_MMA(0, 1, At, B1); PG8_BAR; PG8_SCHED;
            PG8_LDA(At, 0, 1); PG8_STAGE(PG8_SB(0, 0), b2, voffB); PG8_STAGE(PG8_SB(0, 1), b2 + hstep, voffB); PG8_STAGE(PG8_SA(0, 0), a2, v2[0]);
            PG8_WAIT_V(8); PG8_WAIT_L(0); PG8_BAR; PG8_MMA(1, 0, At, B0); PG8_MMA(1, 1, At, B1); PG8_BAR; PG8_SCHED;
            PG8_LDB(B0, 1, 0); PG8_LDB(B1, 1, 1); PG8_SCHED; PG8_LDA(At, 1, 0); PG8_STAGE(PG8_SA(0, 1), a2, v2[1]);
            PG8_WAIT_V(8); PG8_WAIT_L(0); PG8_BAR; PG8_MMA(0, 0, At, B0); PG8_MMA(0, 1, At, B1); PG8_BAR; PG8_SCHED;
            PG8_LDA(At, 1, 1); PG8_STAGE(PG8_SB(1, 0), b3, voffB); PG8_STAGE(PG8_SB(1, 1), b3 + hstep, voffB); PG8_STAGE(PG8_SA(1, 0), a3, v2[0]);
            PG8_WAIT_V(8); PG8_WAIT_L(0); PG8_BAR; PG8_MMA(1, 0, At, B0); PG8_MMA(1, 1, At, B1); PG8_BAR; PG8_SCHED;
        }
        if (wr == 0) PG8_BAR;
        if constexpr (ESZ == 1) asm volatile("s_nop 15\n\ts_nop 7" ::: "memory");
        E(acc, cur, wr, wc, fr, fq);
        if (!has_next) break;
#pragma unroll
        for (int a = 0; a < 2; ++a)
#pragma unroll
            for (int b = 0; b < 2; ++b)
#pragma unroll
                for (int m = 0; m < 4; ++m)
#pragma unroll
                    for (int n = 0; n < 2; ++n) acc[a][b][m][n] = (f32x4){0.f, 0.f, 0.f, 0.f};
        cur = nxt; cA = nA; cB = nB; ++ui;
        if constexpr (GATHER) {
#pragma unroll
            for (int h = 0; h < 2; ++h)
#pragma unroll
                for (int i = 0; i < 2; ++i) vc[h][i] = vn[h][i]; }
        if (wr == 1) PG8_BAR;
    }
    PG8_WAIT_V(0);
    PG8_BAR;
#undef PG8_SA
#undef PG8_SB
#undef PG8_STAGE
#undef PG8_LDA
#undef PG8_LD32
#undef PG8_LDB
#undef PG8_MMA
#undef PG8_F8
#undef PG8_WAIT_V
#undef PG8_WAIT_L
#undef PG8_BAR
#undef PG8_SCHED
#undef PG8_GV
}
}
struct Frame {
    LAS unsigned char* lds; unsigned char* ws; unsigned* ctl;
    int tid, lane, wave, G, vcu;
    unsigned long long pacc;
};

__device__ __forceinline__ void cvt_tile(const float* W, int N, int K, int k0, int n0, bf16* dst, int drow0, float scale, LAS float* scr, int lane) {
#pragma unroll 8
    for (int i = 0; i < 32; ++i) { const int kk = 2 * i + (lane >> 5); scr[kk * 33 + (lane & 31)] = W[(size_t)(k0 + kk) * N + n0 + (lane & 31)]; }
    LDS_WAIT(); asm volatile("" ::: "memory");
    const int c = lane & 7;
#pragma unroll
    for (int j = 0; j < 4; ++j) { const int n = (lane >> 3) + 8 * j; const LAS float* s = scr + (8 * c) * 33 + n;
        u32x4 o; o.x = pk2(s[0 * 33] * scale, s[1 * 33] * scale); o.y = pk2(s[2 * 33] * scale, s[3 * 33] * scale); o.z = pk2(s[4 * 33] * scale, s[5 * 33] * scale); o.w = pk2(s[6 * 33] * scale, s[7 * 33] * scale);
        *(u32x4*)(dst + (size_t)(drow0 + n) * K + k0 + 8 * c) = o; }
    LDS_WAIT(); asm volatile("" ::: "memory");
}
__device__ __forceinline__ unsigned pk4_fp8(float a, float b, float c, float d) { int w = 0; w = __builtin_amdgcn_cvt_pk_fp8_f32(a, b, w, false); w = __builtin_amdgcn_cvt_pk_fp8_f32(c, d, w, true); return (unsigned)w; }
__device__ __forceinline__ void cvt_tile8(const float* W, int N, int K, int k0, int n0, unsigned char* dst, int drow0, float scale, LAS float* scr, int lane) {
#pragma unroll 8
    for (int i = 0; i < 32; ++i) { const int kk = 2 * i + (lane >> 5); scr[kk * 33 + (lane & 31)] = W[(size_t)(k0 + kk) * N + n0 + (lane & 31)]; }
    LDS_WAIT(); asm volatile("" ::: "memory");
    const int c = lane & 7;
#pragma unroll
    for (int j = 0; j < 4; ++j) { const int n = (lane >> 3) + 8 * j; const LAS float* s = scr + (8 * c) * 33 + n;
        u32x2 o; o.x = pk4_fp8(s[0 * 33] * scale, s[1 * 33] * scale, s[2 * 33] * scale, s[3 * 33] * scale); o.y = pk4_fp8(s[4 * 33] * scale, s[5 * 33] * scale, s[6 * 33] * scale, s[7 * 33] * scale);
        *(u32x2*)(dst + (size_t)(drow0 + n) * K + k0 + 8 * c) = o; }
    LDS_WAIT(); asm volatile("" ::: "memory");
}
constexpr int F8_LAYER = 1;
__device__ __forceinline__ void convert_phase(Frame& F, const Args& a, int l) {
    using namespace cfg;
    LAS float* scr = (LAS float*)(F.lds + F.wave * 16384);
    const int gw = F.vcu * 8 + F.wave, NGW = F.G * 8;
    const float* w_in = a.in[1] + (size_t)l * D * INC; const float* w_out = a.in[2] + (size_t)l * D * D;
    const size_t es = (size_t)NEXP * D * EH;
    const float* wg = a.in[29] + l * es; const float* wu = a.in[30] + l * es; const float* wd = a.in[31] + l * es;
    bf16* Wi = (bf16*)(F.ws + wsm::W_IN); bf16* Wo = (bf16*)(F.ws + wsm::W_OUT); bf16* Wgu = (bf16*)(F.ws + wsm::W_GU); bf16* Wd = (bf16*)(F.ws + wsm::W_D);
    constexpr int I_IN = 32 * 200, I_OUT = 32 * 64, I_G = 32 * 256, I_D = 32 * 256;
    constexpr int NITEMS = I_IN + I_OUT + 2 * I_G + I_D;
    for (int it = gw; it < NITEMS; it += NGW) {
        int r = it;
        if (r < I_IN) { const int kb = r / 200, nb = r % 200, n0 = nb * 32; const bool isq = (n0 >= OFF_BQ && n0 < OFF_BK) || (n0 >= OFF_CQ && n0 < OFF_CK);
            if (l == F8_LAYER) cvt_tile8(w_in, INC, D, kb * 64, n0, (unsigned char*)Wi, n0, (isq ? C2F : 1.f) * pg8::F8_WGT, scr, F.lane); else cvt_tile(w_in, INC, D, kb * 64, n0, Wi, n0, isq ? C2F : 1.f, scr, F.lane); continue; } r -= I_IN;
        if (r < I_OUT) { const int kb = r / 64, nb = r % 64; cvt_tile(w_out, D, D, kb * 64, nb * 32, Wo, nb * 32, 1.f, scr, F.lane); continue; } r -= I_OUT;
        if (r < 2 * I_G) { const int up = r >= I_G; if (up) r -= I_G; const int e = r >> 8, q = r & 255, kb = q >> 3, nb = q & 7, n0 = nb * 32;
            cvt_tile((up ? wu : wg) + (size_t)e * D * EH, EH, D, kb * 64, n0, Wgu, e * 512 + 256 * (n0 >> 7) + (n0 & 127) + (up ? 128 : 0), 1.f, scr, F.lane); continue; } r -= 2 * I_G;
        { const int e = r >> 8, q = r & 255, kb = q >> 6, nb = q & 63; cvt_tile(wd + (size_t)e * EH * D, D, EH, kb * 64, nb * 32, Wd + (size_t)e * D * EH, nb * 32, 1.f, scr, F.lane); }
    }
    bf16* Wr = (bf16*)(F.ws + wsm::WRT); const float* rg = a.in[25] + (size_t)l * D * 4; const float* re = a.in[27] + (size_t)l * D * 32;
    for (int idx = (F.vcu * 512 + F.tid); idx < 48 * 2048; idx += F.G * 512) { const int n = idx >> 11, k = idx & 2047;
        const float v = n < 4 ? rg[k * 4 + n] : (n < 36 ? re[k * 32 + n - 4] : 0.f); Wr[idx] = cvt1(v); }
    bf16* w2t = (bf16*)(F.ws + wsm::WRT + 262144); bf16* a2t = w2t + 512 * 64; bf16* g2t = a2t + 512 * 64;
    const float* w2 = a.in[8] + (size_t)l * 64 * 512; const float* a2 = a.in[10] + (size_t)l * 64 * 512; const float* g2 = a.in[11] + (size_t)l * 128 * 512;
    for (int idx = (F.vcu * 512 + F.tid); idx < 512 * 256; idx += F.G * 512) { const int ch = idx & 511, j = idx >> 9;
        if (j < 64) w2t[ch * 64 + j] = cvt1(w2[j * 512 + ch]); else if (j < 128) a2t[ch * 64 + (j - 64)] = cvt1(a2[(j - 64) * 512 + ch]); else g2t[ch * 128 + (j - 128)] = cvt1(g2[(j - 128) * 512 + ch]); }
}

__device__ __forceinline__ int grab(Frame& F, int q) {
    volatile LAS int* slot = (volatile LAS int*)(F.lds + MISC_OFF + 64);
    if (F.tid == 0) *slot = (int)__hip_atomic_fetch_add(F.ctl + wsm::CW_Q + q * 64, 1u, RLX_AGENT);
    __syncthreads();
    const int v = *slot;
    __syncthreads();
    return __builtin_amdgcn_readfirstlane(v);
}
__device__ __forceinline__ void build_pref(Frame& F, int l) {
    LAS int* pref = (LAS int*)(F.lds + TAB_OFF);
    if (F.tid == 0) { int s = 0; for (int e = 0; e < 32; ++e) { pref[e] = s; const unsigned c = __hip_atomic_load(F.ctl + wsm::CW_CNT + (l * 32 + e) * 64, RLX_AGENT); pref[40 + e] = (int)c; s += (int)((c + 255u) >> 8); } pref[32] = s; }
    __syncthreads();
}

template <bool COMBINE, bool ROUTER, bool FINAL, bool F8 = false>
__device__ __forceinline__ void norm_phase(Frame& F, const Args& a, const float* xsrc, float* xout, const float* gain, int l, int lc) {
    using namespace cfg;
    constexpr int PITCHB = 4112;
    LAS unsigned char* tile = F.lds;
    LAS float* part = (LAS float*)(F.lds + 67584);
    LAS int* pref = (LAS int*)(F.lds + TAB_OFF);
    bf16* xn = (bf16*)(F.ws + wsm::XN);
    const bf16* OB = (const bf16*)(F.ws + wsm::OB);
    const int4* tokinfo = (const int4*)(F.ws + wsm::TOKINFO);
    const int lane = F.lane, w = F.wave;
    f32x4 g4[8];
#pragma unroll
    for (int j = 0; j < 8; ++j) g4[j] = *(const f32x4*)(gain + 4 * lane + 256 * j);
    for (int pass = F.vcu; pass < M / 16; pass += F.G) {
#pragma unroll
        for (int rr = 0; rr < 2; ++rr) {
            const int rt = 2 * w + rr, row = pass * 16 + rt;
            const float* xr = xsrc + (size_t)row * D + 4 * lane;
            f32x4 v[8];
#pragma unroll
            for (int j = 0; j < 8; ++j) v[j] = *(const f32x4*)(xr + 256 * j);
            if constexpr (COMBINE) {
                const int4 ti = tokinfo[row];
                const bf16* o0 = OB + ((size_t)pref[ti.x] * 256 + ti.y) * D + 4 * lane; const bf16* o1 = OB + ((size_t)pref[ti.z] * 256 + ti.w) * D + 4 * lane;
#pragma unroll
                for (int j = 0; j < 8; ++j) { const u32x2 p0 = *(const u32x2*)(o0 + 256 * j), p1 = *(const u32x2*)(o1 + 256 * j);
                    v[j].x += __uint_as_float(p0.x << 16) + __uint_as_float(p1.x << 16); v[j].y += __uint_as_float(p0.x & 0xffff0000u) + __uint_as_float(p1.x & 0xffff0000u);
                    v[j].z += __uint_as_float(p0.y << 16) + __uint_as_float(p1.y << 16); v[j].w += __uint_as_float(p0.y & 0xffff0000u) + __uint_as_float(p1.y & 0xffff0000u); }
                if constexpr (!FINAL) {
#pragma unroll
                    for (int j = 0; j < 8; ++j) *(f32x4*)(xout + (size_t)row * D + 4 * lane + 256 * j) = v[j];
                }
            }
            float s = 0.f;
#pragma unroll
            for (int j = 0; j < 8; ++j) s += (v[j].x * v[j].x + v[j].y * v[j].y) + (v[j].z * v[j].z + v[j].w * v[j].w);
            const float rstd = rsqrtf(wave_sum(s) * (1.f / D) + 1e-6f);
#pragma unroll
            for (int j = 0; j < 8; ++j) { const f32x4 o = v[j] * rstd * g4[j];
                if constexpr (FINAL) *(f32x4*)(xout + (size_t)row * D + 4 * lane + 256 * j) = o;
                else if constexpr (F8) { *(unsigned*)((unsigned char*)xn + (size_t)row * D + 4 * lane + 256 * j) = pk4_fp8(o.x * pg8::F8_ACT, o.y * pg8::F8_ACT, o.z * pg8::F8_ACT, o.w * pg8::F8_ACT); }
                else { u32x2 pk; pk.x = pk2(o.x, o.y); pk.y = pk2(o.z, o.w);
                    *(u32x2*)(xn + (size_t)row * D + 4 * lane + 256 * j) = pk;
                    if constexpr (ROUTER) *(LAS u32x2*)(tile + rt * PITCHB + (4 * lane + 256 * j) * 2) = pk; } }
        }
        if constexpr (ROUTER) {
            __syncthreads();
            const bf16* Wr = (const bf16*)(F.ws + wsm::WRT);
            f32x4 acc[3] = {(f32x4){0.f, 0.f, 0.f, 0.f}, (f32x4){0.f, 0.f, 0.f, 0.f}, (f32x4){0.f, 0.f, 0.f, 0.f}};
#pragma unroll
            for (int s8 = 0; s8 < 8; ++s8) { const int k = 256 * w + 32 * s8 + 8 * (lane >> 4);
                const bf16x8 af = *(const LAS bf16x8*)(tile + (lane & 15) * PITCHB + k * 2);
#pragma unroll
                for (int nt = 0; nt < 3; ++nt) { const bf16x8 bfr = *(const bf16x8*)(Wr + (size_t)(16 * nt + (lane & 15)) * D + k);
                    acc[nt] = __builtin_amdgcn_mfma_f32_16x16x32_bf16(af, bfr, acc[nt], 0, 0, 0); } }
#pragma unroll
            for (int nt = 0; nt < 3; ++nt)
#pragma unroll
                for (int i = 0; i < 4; ++i) part[(w * 16 + (lane >> 4) * 4 + i) * 48 + 16 * nt + (lane & 15)] = acc[nt][i];
            __syncthreads();
            if (F.tid < 16) {
                const int m = F.tid, tok = pass * 16 + m;
                const float* bg = a.in[26] + l * 4; const float* be = a.in[28] + l * 32;
                float lg[4];
#pragma unroll
                for (int o = 0; o < 4; ++o) { float sacc = bg[o];
#pragma unroll
                    for (int ww = 0; ww < 8; ++ww) sacc += part[(ww * 16 + m) * 48 + o]; lg[o] = sacc; }
                int gi = 0; float gm = lg[0];
#pragma unroll
                for (int o = 1; o < 4; ++o) if (lg[o] > gm) { gm = lg[o]; gi = o; }
                float gs = 0.f;
#pragma unroll
                for (int o = 0; o < 4; ++o) gs += __expf(lg[o] - gm);
                const float gw = 1.f / gs;
                float el[8];
#pragma unroll
                for (int o = 0; o < 8; ++o) { float sacc = be[gi * 8 + o];
#pragma unroll
                    for (int ww = 0; ww < 8; ++ww) sacc += part[(ww * 16 + m) * 48 + 4 + gi * 8 + o]; el[o] = sacc; }
                int i1 = 0; float m1 = el[0];
#pragma unroll
                for (int o = 1; o < 8; ++o) if (el[o] > m1) { m1 = el[o]; i1 = o; }
                int i2 = 0; float m2 = -3e38f;
#pragma unroll
                for (int o = 0; o < 8; ++o) if (o != i1 && el[o] > m2) { m2 = el[o]; i2 = o; }
                const float e2x = __expf(m2 - m1); const float w1 = gw / (1.f + e2x), w2 = gw * e2x / (1.f + e2x);
                const int e1 = gi * 8 + i1, e2 = gi * 8 + i2;
                const int p1 = (int)__hip_atomic_fetch_add(F.ctl + wsm::CW_CNT + (lc * 32 + e1) * 64, 1u, RLX_AGENT);
                const int p2 = (int)__hip_atomic_fetch_add(F.ctl + wsm::CW_CNT + (lc * 32 + e2) * 64, 1u, RLX_AGENT);
                int* lists = (int*)(F.ws + wsm::LISTS); float* wl = (float*)(F.ws + wsm::WLIST);
                lists[e1 * LCAP + p1] = tok; lists[e2 * LCAP + p2] = tok; wl[e1 * LCAP + p1] = w1; wl[e2 * LCAP + p2] = w2;
                ((int4*)(F.ws + wsm::TOKINFO))[tok] = make_int4(e1, p1, e2, p2);
                ((int4*)(F.ws + wsm::ROUTE))[tok] = make_int4(e1, e2, __float_as_int(w1), __float_as_int(w2));
            }
            __syncthreads();
        }
    }
}
namespace att {
typedef float f32x16 __attribute__((ext_vector_type(16)));
typedef short s16x4 __attribute__((ext_vector_type(4)));
constexpr int L_K = 0, L_V = 16384, L_WSF = 135168, L_TAB = 137216;
__device__ __forceinline__ int crow(int r, int hi) { return (r & 3) + 8 * (r >> 2) + 4 * hi; }
__device__ __forceinline__ int t5_bucket(int rel) {
    const int ret = rel > 0 ? 16 : 0; const int n = rel < 0 ? -rel : rel; int bk;
    if (n < 8) bk = n; else if (n < 12) bk = 8; else if (n < 16) bk = 9; else if (n < 23) bk = 10; else if (n < 32) bk = 11;
    else if (n < 46) bk = 12; else if (n < 64) bk = 13; else if (n < 91) bk = 14; else bk = 15;
    return ret + bk;
}
__device__ __forceinline__ unsigned cvtpk(float lo, float hi) { return pk2(lo, hi); }
__device__ __forceinline__ void qkt(f32x16& p0, f32x16& p1, const LAS unsigned char* Kslot, const bf16x8* qr, const f32x16& c0, const f32x16& c1, int r32, int hi) {
    const LAS unsigned char* kb = Kslot + hi * 1024 + r32 * 16;
#pragma unroll
    for (int d0 = 0; d0 < 4; ++d0) {
        const bf16x8 b0 = *(const LAS bf16x8*)(kb + d0 * 2048);
        const bf16x8 b1 = *(const LAS bf16x8*)(kb + d0 * 2048 + 512);
        if (d0 == 0) { p0 = __builtin_amdgcn_mfma_f32_32x32x16_bf16(b0, qr[0], c0, 0, 0, 0); p1 = __builtin_amdgcn_mfma_f32_32x32x16_bf16(b1, qr[0], c1, 0, 0, 0); }
        else { p0 = __builtin_amdgcn_mfma_f32_32x32x16_bf16(b0, qr[d0], p0, 0, 0, 0); p1 = __builtin_amdgcn_mfma_f32_32x32x16_bf16(b1, qr[d0], p1, 0, 0, 0); } }
}
__device__ __forceinline__ float rowmax(const f32x16& p0, const f32x16& p1) {
    float a = fmaxf(fmaxf(p0[0], p0[1]), p1[0]), b = fmaxf(fmaxf(p0[2], p0[3]), p1[1]); a = fmaxf(fmaxf(a, p1[2]), p1[3]);
#pragma unroll
    for (int r = 4; r < 16; r += 4) { a = fmaxf(fmaxf(a, p0[r]), p0[r + 1]); b = fmaxf(fmaxf(b, p0[r + 2]), p0[r + 3]); a = fmaxf(fmaxf(a, p1[r]), p1[r + 1]); b = fmaxf(fmaxf(b, p1[r + 2]), p1[r + 3]); }
    const float m = fmaxf(a, b);
    auto rr = __builtin_amdgcn_permlane32_swap(__float_as_uint(m), __float_as_uint(m), false, false);
    return fmaxf(__uint_as_float(rr[0]), __uint_as_float(rr[1]));
}
template <int ND>
__device__ __forceinline__ void pv(f32x16* o, int vb, bf16x8 pa0, bf16x8 pa1, bf16x8 pa2, bf16x8 pa3) {
#pragma unroll
    for (int d0 = 0; d0 < ND; ++d0) { s16x4 lo[4], hi[4];
#pragma unroll
        for (int ks = 0; ks < 4; ++ks) {
            asm volatile("ds_read_b64_tr_b16 %0,%1 offset:%c2" : "=&v"(lo[ks]) : "v"(vb), "i"(d0 * 4096 + ks * 1024) : "memory");
            asm volatile("ds_read_b64_tr_b16 %0,%1 offset:%c2" : "=&v"(hi[ks]) : "v"(vb), "i"(d0 * 4096 + ks * 1024 + 512) : "memory"); }
        asm volatile("s_waitcnt lgkmcnt(0)" ::: "memory"); __builtin_amdgcn_sched_barrier(0);
#define ATT_PK(k) (bf16x8){lo[k][0], lo[k][1], lo[k][2], lo[k][3], hi[k][0], hi[k][1], hi[k][2], hi[k][3]}
        o[d0] = __builtin_amdgcn_mfma_f32_32x32x16_bf16(pa0, ATT_PK(0), o[d0], 0, 0, 0);
        o[d0] = __builtin_amdgcn_mfma_f32_32x32x16_bf16(pa1, ATT_PK(1), o[d0], 0, 0, 0);
        o[d0] = __builtin_amdgcn_mfma_f32_32x32x16_bf16(pa2, ATT_PK(2), o[d0], 0, 0, 0);
        o[d0] = __builtin_amdgcn_mfma_f32_32x32x16_bf16(pa3, ATT_PK(3), o[d0], 0, 0, 0);
#undef ATT_PK
    }
}
#define ATT_WAIT_BAR(N) asm volatile("s_waitcnt vmcnt(" #N ") lgkmcnt(0)\n\ts_barrier" ::: "memory")
#ifndef PROBE_ATT
#define PROBE_ATT -1
#endif
#define ATT_NOW() __builtin_amdgcn_s_memrealtime()
#define ATT_SBAR() __builtin_amdgcn_sched_barrier(0)
#define ATT_PIN(x) asm volatile("" : "+v"(x))
#define ATT_MFMA(a, b, c) __builtin_amdgcn_mfma_f32_32x32x16_bf16(a, b, c, 0, 0, 0)
typedef const LAS char* lds_cptr;
typedef short v4i16_t __attribute__((ext_vector_type(4)));
__device__ __forceinline__ void glds16(const void* g, unsigned lds_base) {
    unsigned sv; asm volatile("s_mov_b32 %0, m0\n\ts_mov_b32 m0, %2\n\ts_nop 0\n\tglobal_load_lds_dwordx4 %1, off\n\ts_mov_b32 m0, %0" : "=&s"(sv) : "v"(g), "s"(lds_base) : "memory"); }
__device__ __forceinline__ void kload2(bf16x8* kf, lds_cptr kp, int d0) { kf[2 * d0] = *(const LAS bf16x8*)(kp + d0 * 2048); kf[2 * d0 + 1] = *(const LAS bf16x8*)(kp + d0 * 2048 + 512); }
__device__ __forceinline__ s16x4 vtr(lds_cptr q) { return __builtin_bit_cast(s16x4, __builtin_amdgcn_ds_read_tr16_b64_v4i16((LAS v4i16_t*)q)); }

template <int MODE>
__device__ __forceinline__ void attn_unit(Frame& F, const Args& a, const int l, const int b, const int hh, const int qb) {
    using namespace cfg;
    constexpr int ND = MODE ? 4 : 2, VSLOT = ND * 4096, NV = MODE ? 2 : 1, EPG = 8 / ND, KRD0 = MODE ? 8 : 2, VLEAD = 5;
    constexpr int NS = 4, LK = 0, LV = NS * 8192, LQ = 98304;
    constexpr float THR = 8.f;
    unsigned long long pu0_ = 0; if (PROBE_ATT == 3) pu0_ = ATT_NOW();
    const int lane = F.lane, r32 = lane & 31, hi = lane >> 5, wid = F.wave;
    const bf16* p = (const bf16*)(F.ws + wsm::P);
    bf16* y = (bf16*)(F.ws + wsm::Y);
    float* O1s = (float*)(F.ws + wsm::XN);
    LAS unsigned char* lds = F.lds;
    LAS float* wsf = (LAS float*)(lds + L_WSF) + wid * 64;
    LAS float* tab = (LAS float*)(lds + L_TAB);
    const size_t rowbase = (size_t)b * SEQ;
    if (F.tid < 320) { const int i = F.tid; float v;
        if (MODE == 0) { int d = i - 64; d = d < -128 ? -128 : (d > 128 ? 128 : d); v = a.in[17][(size_t)(l * 8 + hh) * 257 + d + 128]; }
        else v = a.in[18][t5_bucket(-(i - 64)) * 4 + hh];
        tab[i] = v * LOG2E; }
    const int t0 = MODE == 0 ? (4 * qb - 8 > 0 ? 4 * qb - 8 : 0) : 0, t1 = 4 * qb + 3;
    const int cw = 4 * qb + (wid >> 1);
    const int va = MODE == 0 ? (cw - 8 > 0 ? cw - 8 : 0) : 0, vb = cw;
    const int q0w = qb * 256 + 32 * wid, myq = q0w + r32;
    const unsigned lds0 = (unsigned)(uintptr_t)lds;
    const lds_cptr kp0 = (lds_cptr)lds + LK + hi * 1024 + r32 * 16;
    const lds_cptr vp0 = (lds_cptr)lds + LV + ((lane >> 4) & 1) * 32 + (lane & 3) * 8 + (4 * hi + ((lane & 15) >> 2)) * 64;
#pragma unroll 1
    for (int sub = 0; sub < (MODE ? 2 : 1); ++sub) {
        const int qcol = MODE ? OFF_CQ + (hh * 2 + sub) * 64 : OFF_BQ + hh * 64;
        const int kcol = MODE ? OFF_CK + (hh * 2 + sub) * 64 : OFF_BK + hh * 64;
        const int vcol = MODE ? OFF_CV + hh * 128 : OFF_BV + hh * 64;
        const bf16* Kh = p + rowbase * INC + kcol; const bf16* Vh = p + rowbase * INC + vcol;
        const bf16* ksrc = Kh + (size_t)lane * INC + wid * 8;
        const bf16* vsrc0 = Vh + (size_t)(16 * (wid & 3) + (lane >> 2)) * INC + (wid >> 2) * 32 + (lane & 3) * 8;
        const unsigned kdst = lds0 + LK + wid * 1024, vdst = lds0 + LV + wid * 1024;
#define ATT_DMA_K(t, s) glds16(ksrc + (size_t)(t) * 64 * INC, (unsigned)__builtin_amdgcn_readfirstlane(kdst + (s) * 8192))
#define ATT_DMA_V(t, s) do { glds16(vsrc0 + (size_t)(t) * 64 * INC, (unsigned)__builtin_amdgcn_readfirstlane(vdst + (s) * VSLOT)); \
        if (MODE) glds16(vsrc0 + (size_t)(t) * 64 * INC + 64, (unsigned)__builtin_amdgcn_readfirstlane(vdst + (s) * VSLOT + 8192)); } while (0)
        { const bf16* Qw = p + (rowbase + q0w) * INC + qcol + (size_t)r32 * INC + hi * 8;
#pragma unroll
          for (int d0 = 0; d0 < 4; ++d0) glds16(Qw + d0 * 16, (unsigned)__builtin_amdgcn_readfirstlane(lds0 + LQ + wid * 4096 + d0 * 1024)); }
        ATT_DMA_K(t0, 0); ATT_DMA_V(t0, 0); ATT_DMA_K(t0 + 1, 1); ATT_DMA_K(t0 + 2, 2); ATT_DMA_K(t0 + 3, 3); ATT_DMA_V(t0 + 1, 1);
        float mhat = 0.f, l_reg = 0.f;
        f32x16 o[ND];
#pragma unroll
        for (int d0 = 0; d0 < ND; ++d0)
#pragma unroll
            for (int r = 0; r < 16; ++r) o[d0][r] = 0.f;
        { LAS unsigned char* z = lds + LV + 3 * VSLOT + F.tid * (VSLOT / 512);
#pragma unroll
          for (int i = 0; i < VSLOT / 512 / 16; ++i) *(LAS u32x4*)(z + 16 * i) = (u32x4){0u, 0u, 0u, 0u}; }
        if (MODE) { ATT_WAIT_BAR(4); } else { ATT_WAIT_BAR(3); }
        const float cf = tab[300];
        bf16x8 qr[4];
#pragma unroll
        for (int d0 = 0; d0 < 4; ++d0) qr[d0] = *(const LAS bf16x8*)(lds + LQ + wid * 4096 + d0 * 1024 + lane * 16);
        bf16x8 kf[8];
#pragma unroll
        for (int d0 = 0; d0 < 4; ++d0) kload2(kf, kp0, d0);
        asm volatile("s_waitcnt lgkmcnt(0)\n\ts_barrier" ::: "memory");
        f32x16 C0, C1; u32x4 pw[4];
#pragma unroll
        for (int r = 0; r < 16; ++r) { C0[r] = 0.f; C1[r] = 0.f; }
#pragma unroll
        for (int g = 0; g < 4; ++g) pw[g] = (u32x4){0u, 0u, 0u, 0u};
#define ATT_CE(e) (((e) < 16) ? C0[(e) & 15] : C1[(e) & 15])
#define ATT_CEXP(e) do { if ((e) < 16) C0[(e) & 15] = __builtin_amdgcn_exp2f(C0[(e) & 15]); else C1[(e) & 15] = __builtin_amdgcn_exp2f(C1[(e) & 15]); } while (0)
#define ATT_VRD(ks, d0) do { vlo[(ks) * ND + (d0)] = vtr(vpp + (d0) * 4096 + (ks) * 1024); vhi[(ks) * ND + (d0)] = vtr(vpp + (d0) * 4096 + (ks) * 1024 + 512); } while (0)
#define ATT_VRDF(f) ATT_VRD((f) / ND, (f) % ND)
#define ATT_VFR(i) (bf16x8){vlo[i][0], vlo[i][1], vlo[i][2], vlo[i][3], vhi[i][0], vhi[i][1], vhi[i][2], vhi[i][3]}
#define ATT_PAF(g) __builtin_bit_cast(bf16x8, pw[g])
        unsigned long long pl0_ = 0; if (PROBE_ATT == 2) pl0_ = ATT_NOW(); if (PROBE_ATT == 4) pl0_ = __builtin_amdgcn_s_memtime();
#pragma unroll 1
        for (int t = t0; t <= t1; ++t) {
            const bool gk = (t + 4 <= t1), gv = (t + 2 <= t1);
            const int s_cur = (t - t0) & 3, s_prev = (t - t0 - 1) & 3, s_next = (t - t0 + 1) & 3, s_nn = (t - t0 + 2) & 3;
            const lds_cptr vpp = vp0 + s_prev * VSLOT;
            const lds_cptr kpn = kp0 + s_next * 8192;
            bool resc = false;
            ATT_SBAR();
            {
                s16x4 vlo[4 * ND], vhi[4 * ND];
                const bool msk = (t > vb) || (t < va);
                const bool nearb = !msk && (q0w - (t * 64 + 63)) < 128;
                if (nearb) {
                    const LAS float* tb = tab + (myq - t * 64 - 4 * hi + 64 - 27 - 32);
#pragma unroll
                    for (int r = 0; r < 16; ++r) { C1[r] = tb[27 - ((r & 3) + 8 * (r >> 2))] - mhat; C0[r] = tb[32 + 27 - ((r & 3) + 8 * (r >> 2))] - mhat; }
                    ATT_SBAR();
                    C0 = ATT_MFMA(kf[0], qr[0], C0); ATT_SBAR(); C1 = ATT_MFMA(kf[1], qr[0], C1); ATT_SBAR();
                } else {
                    f32x16 cfm; const float cfv = msk ? -1e30f : cf - mhat;
#pragma unroll
                    for (int r = 0; r < 16; ++r) cfm[r] = cfv;
                    ATT_SBAR();
                    C0 = ATT_MFMA(kf[0], qr[0], cfm); ATT_SBAR(); C1 = ATT_MFMA(kf[1], qr[0], cfm); ATT_SBAR();
                }
#pragma unroll
                for (int i = 2; i < 8; ++i) {
                    if (i >= 8 - VLEAD) { ATT_VRDF(i - (8 - VLEAD)); ATT_SBAR(); }
                    if (i & 1) C1 = ATT_MFMA(kf[i], qr[i >> 1], C1); else C0 = ATT_MFMA(kf[i], qr[i >> 1], C0);
                    ATT_SBAR();
                }
                if (gk) ATT_DMA_K(t + 4, s_cur);
                if (gv) ATT_DMA_V(t + 2, s_nn);
                const float rm = rowmax(C0, C1);
                const bool firstv = (t == va);
                if (__builtin_expect(firstv || __any(rm > THR), 0)) {
                    const float dl = firstv ? rm : fmaxf(rm, 0.f); mhat += dl;
#pragma unroll
                    for (int r = 0; r < 16; ++r) { C0[r] -= dl; C1[r] -= dl; }
                    const float f = firstv ? 1.f : __builtin_amdgcn_exp2f(-dl); l_reg *= f; if (hi == 0) wsf[r32] = f; resc = !firstv;
                }
                ATT_SBAR();
                float sa = 0.f, sb = 0.f;
#pragma unroll
                for (int m = 0; m < 4 * ND; ++m) {
                    const int g = m / ND, d0 = m % ND;
                    if (m + VLEAD < 4 * ND) { ATT_VRDF(m + VLEAD); ATT_SBAR(); }
                    if (m >= KRD0 && m < KRD0 + 4) { kload2(kf, kpn, m - KRD0); ATT_SBAR(); }
                    o[d0] = ATT_MFMA(ATT_PAF(g), ATT_VFR(g * ND + d0), o[d0]);
#pragma unroll
                    for (int jj = 0; jj < EPG; ++jj) ATT_CEXP(8 * g + EPG * d0 + jj);
                    if (g >= 1) {
#pragma unroll
                        for (int jj = 0; jj < EPG; jj += 2) { const int e = 8 * (g - 1) + EPG * d0 + jj; sa += ATT_CE(e); sb += ATT_CE(e + 1); pw[g - 1][(EPG * d0 + jj) >> 1] = pk2(ATT_CE(e), ATT_CE(e + 1)); }
                        ATT_PIN(pw[g - 1]); ATT_PIN(sa); ATT_PIN(sb);
                    }
                    if (g < 2) ATT_PIN(C0); else ATT_PIN(C1);
                    ATT_SBAR();
                }
#pragma unroll
                for (int jj = 0; jj < 8; jj += 2) { const int e = 24 + jj; sa += ATT_CE(e); sb += ATT_CE(e + 1); pw[3][jj >> 1] = pk2(ATT_CE(e), ATT_CE(e + 1)); }
                l_reg += sa + sb;
            }
            ATT_SBAR();
            unsigned long long pw0_ = 0; if (PROBE_ATT == 0) pw0_ = ATT_NOW();
            { const int dleft = t1 - t;
              if (dleft >= 4) { if (MODE) { ATT_WAIT_BAR(6); } else { ATT_WAIT_BAR(4); } }
              else if (dleft == 3) { if (MODE) { ATT_WAIT_BAR(5); } else { ATT_WAIT_BAR(3); } }
              else if (dleft == 2) { if (MODE) { ATT_WAIT_BAR(4); } else { ATT_WAIT_BAR(2); } }
              else if (dleft == 1) { if (MODE) { ATT_WAIT_BAR(2); } else { ATT_WAIT_BAR(1); } }
              else { ATT_WAIT_BAR(0); } }
            if (PROBE_ATT == 0) F.pacc += ATT_NOW() - pw0_;
            if (resc) {
#pragma unroll
                for (int r = 0; r < 16; ++r) { const float fr = wsf[crow(r, hi)];
#pragma unroll
                    for (int d0 = 0; d0 < ND; ++d0) o[d0][r] *= fr; }
            }
        }
        if (PROBE_ATT == 2) F.pacc += ATT_NOW() - pl0_; if (PROBE_ATT == 4) F.pacc += (__builtin_amdgcn_s_memtime() - pl0_) / 100;
        {
            const lds_cptr vpp = vp0 + ((t1 - t0) & 3) * VSLOT;
            s16x4 vlo[4 * ND], vhi[4 * ND];
#pragma unroll
            for (int ks = 0; ks < 4; ++ks) {
#pragma unroll
                for (int d0 = 0; d0 < ND; ++d0) ATT_VRD(ks, d0);
#pragma unroll
                for (int d0 = 0; d0 < ND; ++d0) o[d0] = ATT_MFMA(ATT_PAF(ks), ATT_VFR(ks * ND + d0), o[d0]);
            }
            asm volatile("s_waitcnt lgkmcnt(0)\n\ts_barrier" ::: "memory");
        }
#undef ATT_DMA_K
#undef ATT_DMA_V
#undef ATT_CE
#undef ATT_CEXP
#undef ATT_VRD
#undef ATT_VFR
#undef ATT_VRDF
#undef ATT_PAF
        float lh = l_reg;
        int ln = lane; asm volatile("" : "+v"(ln));
        const int e32 = ln & 31, ehi = ln >> 5;
        { auto rr = __builtin_amdgcn_permlane32_swap(__float_as_uint(lh), __float_as_uint(lh), false, false); lh = __uint_as_float(rr[0]) + __uint_as_float(rr[1]); }
        if (ehi == 0) wsf[32 + e32] = lh;
        LDS_WAIT();
        constexpr int SP = ND * 128 + 16;
        LAS unsigned char* stg = lds + wid * (32 * SP);
#pragma unroll
        for (int r = 0; r < 16; ++r) { const float rl = __builtin_amdgcn_rcpf(wsf[32 + crow(r, ehi)]);
#pragma unroll
            for (int d0 = 0; d0 < ND; ++d0) *(LAS float*)(stg + crow(r, ehi) * SP + (d0 * 32 + e32) * 4) = o[d0][r] * rl; }
        LDS_WAIT();
        const size_t tok0 = rowbase + (size_t)(qb * 256 + 32 * wid);
        if (MODE == 0) {
#pragma unroll 4
            for (int row = 0; row < 32; ++row) { const float v = *(const LAS float*)(stg + row * SP + ln * 4); y[(tok0 + row) * D + 512 + hh * 64 + ln] = cvt1(v); }
        } else if (sub == 0) {
#pragma unroll 4
            for (int row = 0; row < 32; ++row) { const f32x2 v = *(const LAS f32x2*)(stg + row * SP + ln * 8); *(f32x2*)(O1s + ((tok0 + row) * 4 + hh) * 128 + 2 * ln) = v; }
        } else {
            const float lam_init = l == 0 ? 0.2f : (float)(0.8 - 0.6 * 0.7408182206817179);
            const float lam = __expf(wave_sum(a.in[19][l * 64 + ln] * a.in[20][l * 64 + ln])) - __expf(wave_sum(a.in[21][l * 64 + ln] * a.in[22][l * 64 + ln])) + lam_init;
            const float* sw = a.in[23] + l * 128;
            const float sw0 = sw[2 * ln] * (1.f - lam_init), sw1 = sw[2 * ln + 1] * (1.f - lam_init);
#pragma unroll 2
            for (int row = 0; row < 32; ++row) { const f32x2 v2 = *(const LAS f32x2*)(stg + row * SP + ln * 8); const f32x2 o1 = *(const f32x2*)(O1s + ((tok0 + row) * 4 + hh) * 128 + 2 * ln);
                const float v0 = o1.x - lam * v2.x, v1 = o1.y - lam * v2.y;
                const float ms = wave_sum(v0 * v0 + v1 * v1);
                const float rs = rsqrtf(ms * (1.f / 128.f) + 1e-5f);
                *(unsigned*)(y + (tok0 + row) * D + 1024 + hh * 128 + 2 * ln) = pk2(v0 * rs * sw0, v1 * rs * sw1); }
        }
        asm volatile("s_waitcnt vmcnt(0) lgkmcnt(0)\n\ts_barrier" ::: "memory");
    }
    if (PROBE_ATT == 3) F.pacc += ATT_NOW() - pu0_;
}

__device__ __forceinline__ void conv_items(Frame& F, const Args& a, const int l, const int start, const int stride) {
    using namespace cfg;
    const bf16* p = (const bf16*)(F.ws + wsm::P); bf16* y = (bf16*)(F.ws + wsm::Y);
    const float* cw = a.in[24] + l * 3 * 512;
    for (int it = start; it < M * 64; it += stride) {
        const int tok = it >> 6, cg = (it & 63) * 8, t = tok & (SEQ - 1);
        const bf16* r0 = p + (size_t)tok * INC + OFF_D + cg;
        const u32x4 bg = *(const u32x4*)r0;
        u32x4 c0 = *(const u32x4*)(r0 + 512), h0 = *(const u32x4*)(r0 + 1024);
        u32x4 c1 = (u32x4){0, 0, 0, 0}, h1 = c1, c2 = c1, h2 = c1;
        if (t >= 1) { c1 = *(const u32x4*)(r0 - INC + 512); h1 = *(const u32x4*)(r0 - INC + 1024); }
        if (t >= 2) { c2 = *(const u32x4*)(r0 - 2 * INC + 512); h2 = *(const u32x4*)(r0 - 2 * INC + 1024); }
        unsigned ow[4];
#pragma unroll
        for (int j = 0; j < 4; ++j) {
            float res[2];
#pragma unroll
            for (int e = 0; e < 2; ++e) {
                const int ch = cg + 2 * j + e;
#define ATT_UP(w) (e ? __uint_as_float((w) & 0xffff0000u) : __uint_as_float((w) << 16))
                const float u0 = ATT_UP(c0[j]) * ATT_UP(h0[j]), u1 = ATT_UP(c1[j]) * ATT_UP(h1[j]), u2 = ATT_UP(c2[j]) * ATT_UP(h2[j]);
                res[e] = ATT_UP(bg[j]) * (cw[ch] * u2 + cw[512 + ch] * u1 + cw[1024 + ch] * u0);
#undef ATT_UP
            }
            ow[j] = pk2(res[0], res[1]);
        }
        *(u32x4*)(y + (size_t)tok * D + 1536 + cg) = (u32x4){ow[0], ow[1], ow[2], ow[3]};
    }
}
}
namespace rw {
constexpr int PB = 144, PB2 = 272;
constexpr int SLOT = 9216;
constexpr int R0 = 0, R1B = 49152;
constexpr int O_P0 = 0, O_P0T = 9216, O_AAK = 18432, O_ARB = 27648, O_ARK = 36864;
constexpr int O_SEG = R1B + 9 * SLOT, O_BON = O_SEG + 2048;
constexpr size_t UNIT_BYTES = 49152;
constexpr size_t WL_OFF = (size_t)4096 * UNIT_BYTES;
#define RW_S(i) (R1B + (i) * SLOT)

__device__ __forceinline__ bf16x8 ldfrag(const LAS unsigned char* base, int pitch, int row0, int lane, int s) {
    return *(const LAS bf16x8*)(base + (row0 + (lane & 15)) * pitch + (32 * s + 8 * (lane >> 4)) * 2);
}
template <int KS>
__device__ __forceinline__ f32x4 tile_mm(f32x4 acc, const LAS unsigned char* X, int px, int m0, const LAS unsigned char* Y, int py, int n0, int lane) {
#pragma unroll
    for (int s = 0; s < KS; ++s) acc = __builtin_amdgcn_mfma_f32_16x16x32_bf16(ldfrag(Y, py, n0, lane, s), ldfrag(X, px, m0, lane, s), acc, 0, 0, 0);
    return acc;
}
__device__ __forceinline__ void st_rm(LAS unsigned char* base, int pitch, int m, int n0, f32x4 v) {
    u32x2 w; w.x = pk2(v[0], v[1]); w.y = pk2(v[2], v[3]); *(LAS u32x2*)(base + m * pitch + n0 * 2) = w;
}
__device__ __forceinline__ void st_tr(LAS unsigned char* base, int pitch, int m, int n0, f32x4 v) {
    const unsigned p01 = pk2(v[0], v[1]), p23 = pk2(v[2], v[3]);
    *(LAS bf16*)(base + (n0 + 0) * pitch + m * 2) = (bf16)(p01 & 0xffffu); *(LAS bf16*)(base + (n0 + 1) * pitch + m * 2) = (bf16)(p01 >> 16);
    *(LAS bf16*)(base + (n0 + 2) * pitch + m * 2) = (bf16)(p23 & 0xffffu); *(LAS bf16*)(base + (n0 + 3) * pitch + m * 2) = (bf16)(p23 >> 16);
}
__device__ __forceinline__ f32x4 ld_rm(const LAS unsigned char* base, int pitch, int m, int n0) {
    const u32x2 w = *(const LAS u32x2*)(base + m * pitch + n0 * 2);
    return (f32x4){__uint_as_float(w.x << 16), __uint_as_float(w.x & 0xffff0000u), __uint_as_float(w.y << 16), __uint_as_float(w.y & 0xffff0000u)};
}
__device__ __forceinline__ void unpack8(const u32x4 w, float* f) {
#pragma unroll
    for (int j = 0; j < 4; ++j) { f[2 * j] = __uint_as_float(w[j] << 16); f[2 * j + 1] = __uint_as_float(w[j] & 0xffff0000u); }
}
__device__ __forceinline__ u32x4 pack8(const float* f) { return (u32x4){pk2(f[0], f[1]), pk2(f[2], f[3]), pk2(f[4], f[5]), pk2(f[6], f[7])}; }
__device__ __forceinline__ float sigm(float x) { return __builtin_amdgcn_rcpf(1.f + __expf(-x)); }
#define RW_BAR() do { asm volatile("s_waitcnt lgkmcnt(0)" ::: "memory"); __builtin_amdgcn_s_barrier(); asm volatile("" ::: "memory"); } while (0)

#ifndef PROBE_R1
#define PROBE_R1 -1
#endif
#define R1_STAMP(k) do { if (PROBE_R1 >= 0) { const unsigned long long now_ = __builtin_amdgcn_s_memrealtime(); if (PROBE_R1 == (k)) racc += now_ - rlast; rlast = now_; } } while (0)
struct R1Raw { u32x4 c[7], p[7]; };
__device__ __forceinline__ void r1_load(Frame& F, const int u, R1Raw& raw, const int tid) {
    using namespace cfg;
    const int c = u & 63, h = (u >> 6) & 7, b = u >> 9, t = tid >> 3, j0 = (tid & 7) * 8;
    const bf16* cur = (const bf16*)(F.ws + wsm::P) + ((size_t)b * SEQ + c * 64 + t) * INC + j0; const bf16* prv = cur - INC;
#pragma unroll
    for (int i = 0; i < 7; ++i) { const int col = i < 4 ? 1536 + 64 * i : (i - 4) * 512 + h * 64; raw.c[i] = *(const u32x4*)(cur + col); raw.p[i] = *(const u32x4*)(prv + col); }
}
__device__ __forceinline__ void r1_unit(Frame& F, const Args& a, const int l, const int u, const int unext, R1Raw& raw, unsigned long long& racc, int& hcur) {
    using namespace cfg;
    unsigned long long rlast = PROBE_R1 >= 0 ? __builtin_amdgcn_s_memrealtime() : 0ull;
    int tid_ = F.tid; asm volatile("" : "+v"(tid_));
    const int tid = tid_, lane = tid & 63, w = F.wave;
    const int c = u & 63, h = (u >> 6) & 7, b = u >> 9;
    unsigned lbase_ = (unsigned)(uintptr_t)F.lds; asm volatile("" : "+s"(lbase_));
    LAS unsigned char* lds = (LAS unsigned char*)(uintptr_t)lbase_;
    const bf16* p = (const bf16*)(F.ws + wsm::P);
    const bf16* w2t = (const bf16*)(F.ws + wsm::WRT + 262144);
    const bf16* a2t = w2t + 512 * 64; const bf16* g2t = a2t + 512 * 64;
    unsigned char* gout = F.ws + wsm::RW + (size_t)u * UNIT_BYTES;
    float* wl_out = (float*)(F.ws + wsm::RW + WL_OFF) + (size_t)u * 64;
    const float* mu = a.in[6] + l * 1792;
    const size_t tok0 = (size_t)b * SEQ + c * 64;
    const int t = tid >> 3, j0 = (tid & 7) * 8;
    const bool hasprev = (c > 0) || (t > 0);
    const bf16* cur = p + (tok0 + t) * INC; const bf16* prv = cur - INC;
    LAS float* WPRE = (LAS float*)(lds + 0); LAS float* APRE = (LAS float*)(lds + 16384); LAS float* GG = (LAS float*)(lds + 32768);
    LAS float* PAR = (LAS float*)(lds + 134400);
    const int mtA = w >> 1;
    bf16x8 fw[2][2], fa[2][2], fg[2][4];
    if (h != hcur) {
        RW_BAR();
        if (w < 7) { const int pidx = w == 0 ? 7 : (w == 1 ? 9 : 10 + w); PAR[w * 64 + lane] = a.in[pidx][l * 512 + h * 64 + lane]; }
        if (tid < 448) { const int col = tid < 192 ? (tid >> 6) * 512 + h * 64 + (tid & 63) : 1536 + (tid - 192); PAR[448 + tid] = mu[col]; }
        hcur = h;
        RW_BAR();
    }
    float r[8], k[8], v[8];
    {
        auto mix8 = [&](int i, int mo, float* o) { float cv[8], pv[8], m8[8]; unpack8(raw.c[i], cv);
            if (hasprev) unpack8(raw.p[i], pv); else {
#pragma unroll
                for (int j = 0; j < 8; ++j) pv[j] = 0.f; }
            *(f32x4*)m8 = *(const LAS f32x4*)(PAR + 448 + mo); *(f32x4*)(m8 + 4) = *(const LAS f32x4*)(PAR + 448 + mo + 4);
#pragma unroll
            for (int j = 0; j < 8; ++j) o[j] = cv[j] + (pv[j] - cv[j]) * m8[j]; };
        float x[8];
        mix8(0, 192 + j0, x);
#pragma unroll
        for (int j = 0; j < 8; ++j) { const float e2 = __expf(2.f * x[j]); x[j] = 1.f - 2.f * __builtin_amdgcn_rcpf(e2 + 1.f); }
        *(LAS u32x4*)(lds + RW_S(0) + t * PB + j0 * 2) = pack8(x);
        mix8(1, 256 + j0, x);
        *(LAS u32x4*)(lds + RW_S(1) + t * PB + j0 * 2) = pack8(x);
        asm volatile("" ::: "memory");
        mix8(2, 320 + j0, x);
#pragma unroll
        for (int j = 0; j < 8; ++j) x[j] = sigm(x[j]);
        *(LAS u32x4*)(lds + RW_S(2) + t * PB2 + j0 * 2) = pack8(x);
        mix8(3, 384 + j0, x);
#pragma unroll
        for (int j = 0; j < 8; ++j) x[j] = sigm(x[j]);
        *(LAS u32x4*)(lds + RW_S(2) + t * PB2 + (64 + j0) * 2) = pack8(x);
        asm volatile("" ::: "memory");
#pragma unroll
        for (int q = 0; q < 2; ++q) { const int ch = h * 64 + 16 * (2 * (w & 1) + q) + (lane & 15);
#pragma unroll
            for (int s2 = 0; s2 < 2; ++s2) { const int kq = 32 * s2 + 8 * (lane >> 4); fw[q][s2] = *(const bf16x8*)(w2t + ch * 64 + kq); fa[q][s2] = *(const bf16x8*)(a2t + ch * 64 + kq); }
#pragma unroll
            for (int s2 = 0; s2 < 4; ++s2) fg[q][s2] = *(const bf16x8*)(g2t + ch * 128 + 32 * s2 + 8 * (lane >> 4)); }
        mix8(4, j0, r); mix8(5, 64 + j0, k); mix8(6, 128 + j0, v);
        r1_load(F, unext, raw, tid);
    }
    RW_BAR(); R1_STAMP(0);
    {
#pragma unroll
        for (int q = 0; q < 2; ++q) { const int nt = 2 * (w & 1) + q;
            f32x4 aw = {0.f, 0.f, 0.f, 0.f}, aa = aw, ag = aw;
#pragma unroll
            for (int s2 = 0; s2 < 2; ++s2) {
                aw = __builtin_amdgcn_mfma_f32_16x16x32_bf16(fw[q][s2], ldfrag(lds + RW_S(0), PB, 16 * mtA, lane, s2), aw, 0, 0, 0);
                aa = __builtin_amdgcn_mfma_f32_16x16x32_bf16(fa[q][s2], ldfrag(lds + RW_S(1), PB, 16 * mtA, lane, s2), aa, 0, 0, 0); }
#pragma unroll
            for (int s2 = 0; s2 < 4; ++s2) ag = __builtin_amdgcn_mfma_f32_16x16x32_bf16(fg[q][s2], ldfrag(lds + RW_S(2), PB2, 16 * mtA, lane, s2), ag, 0, 0, 0);
            const int m = 16 * mtA + (lane & 15), n0 = 16 * nt + 4 * (lane >> 4);
            const f32x4 w04 = *(const LAS f32x4*)(PAR + n0), a04 = *(const LAS f32x4*)(PAR + 64 + n0);
#pragma unroll
            for (int i = 0; i < 4; ++i) { const float nx = -(w04[i] + aw[i]); const float sp = nx > 20.f ? nx : __logf(1.f + __expf(nx)); aw[i] = -__expf(-sp - 0.5f); aa[i] = sigm(a04[i] + aa[i]); }
            *(LAS f32x4*)(WPRE + m * 64 + n0) = aw; *(LAS f32x4*)(APRE + m * 64 + n0) = aa; *(LAS f32x4*)(GG + m * 64 + n0) = ag; }
    }
    RW_BAR(); R1_STAMP(1); R1_STAMP(2);
    {
        LAS float* SEG = (LAS float*)(lds + O_SEG);
        const int ch = tid & 63, seg = tid >> 6;
        float pf[8]; float run = 0.f;
#pragma unroll
        for (int i = 0; i < 8; ++i) { run += WPRE[(8 * seg + i) * 64 + ch]; pf[i] = run; }
        SEG[seg * 64 + ch] = run;
        RW_BAR();
        float off = 0.f;
        for (int s2 = 0; s2 < seg; ++s2) off += SEG[s2 * 64 + ch];
#pragma unroll
        for (int i = 0; i < 8; ++i) WPRE[(8 * seg + i) * 64 + ch] = off + pf[i];
    }
    RW_BAR(); R1_STAMP(3);
    {
        float kk[8], k2[8], aic[8]; float ss = 0.f, bon = 0.f;
        { float pkk[8], pka[8], prk[8];
#define R1_LD8(dst, src) do { *(f32x4*)(dst) = *(const LAS f32x4*)(src); *(f32x4*)((dst) + 4) = *(const LAS f32x4*)((src) + 4); } while (0)
          R1_LD8(aic, APRE + t * 64 + j0); R1_LD8(pkk, PAR + 128 + j0); R1_LD8(pka, PAR + 192 + j0); R1_LD8(prk, PAR + 256 + j0);
#undef R1_LD8
#pragma unroll
          for (int j = 0; j < 8; ++j) { kk[j] = k[j] * pkk[j]; ss += kk[j] * kk[j]; k2[j] = k[j] * (1.f + (aic[j] - 1.f) * pka[j]); bon += r[j] * k2[j] * prk[j]; } }
        ss += __shfl_xor(ss, 1); ss += __shfl_xor(ss, 2); ss += __shfl_xor(ss, 4);
        bon += __shfl_xor(bon, 1); bon += __shfl_xor(bon, 2); bon += __shfl_xor(bon, 4);
        const float inv = 1.f / fmaxf(sqrtf(ss), 1e-12f);
        unsigned g1w[4], g0w[4];
#pragma unroll
        for (int jp = 0; jp < 8; jp += 2) {
            const f32x2 cum = *(const LAS f32x2*)(WPRE + t * 64 + j0 + jp), tot = *(const LAS f32x2*)(WPRE + 63 * 64 + j0 + jp), gg = *(const LAS f32x2*)(GG + t * 64 + j0 + jp);
            f32x2 cpv = {0.f, 0.f}; if (t > 0) cpv = *(const LAS f32x2*)(WPRE + (t - 1) * 64 + j0 + jp);
            const f32x2 pgw = *(const LAS f32x2*)(PAR + 320 + j0 + jp), pgb = *(const LAS f32x2*)(PAR + 384 + j0 + jp);
            float xa[2], xr[2], xb[2], xk[2], xbh[2], xkh[2], g1[2], g0[2];
#pragma unroll
            for (int e = 0; e < 2; ++e) { const int j = jp + e; const float kn = kk[j] * inv, bv = kn * aic[j];
                const float e_ex = __expf(cpv[e]), e_in = __expf(cum[e]), e_ng = __expf(-cum[e]), e_tt = __expf(tot[e] - cum[e]);
                xa[e] = -kn * e_ex; xr[e] = r[j] * e_in; xb[e] = bv * e_ng; xk[e] = k2[j] * e_ng; xbh[e] = bv * e_tt; xkh[e] = k2[j] * e_tt;
                g1[e] = pgw[e] * gg[e]; g0[e] = (pgb[e] + bon * v[j]) * gg[e];
                if (t == 63) wl_out[j0 + j] = __expf(tot[e]); }
            const unsigned pa = pk2(xa[0], xa[1]), pr = pk2(xr[0], xr[1]), pb = pk2(xb[0], xb[1]), pkn = pk2(xk[0], xk[1]), pv2 = pk2(v[jp], v[jp + 1]), pbh = pk2(xbh[0], xbh[1]), pkh = pk2(xkh[0], xkh[1]);
            *(LAS unsigned*)(lds + RW_S(0) + t * PB + (j0 + jp) * 2) = pa; *(LAS unsigned*)(lds + RW_S(1) + t * PB + (j0 + jp) * 2) = pr;
            *(LAS unsigned*)(lds + RW_S(2) + t * PB + (j0 + jp) * 2) = pb; *(LAS unsigned*)(lds + RW_S(3) + t * PB + (j0 + jp) * 2) = pkn;
            *(LAS bf16*)(lds + RW_S(4) + (j0 + jp) * PB + t * 2) = (bf16)(pa & 0xffffu); *(LAS bf16*)(lds + RW_S(4) + (j0 + jp + 1) * PB + t * 2) = (bf16)(pa >> 16);
            *(LAS bf16*)(lds + RW_S(5) + (j0 + jp) * PB + t * 2) = (bf16)(pv2 & 0xffffu); *(LAS bf16*)(lds + RW_S(5) + (j0 + jp + 1) * PB + t * 2) = (bf16)(pv2 >> 16);
            *(LAS bf16*)(lds + RW_S(6) + (j0 + jp) * PB + t * 2) = (bf16)(pbh & 0xffffu); *(LAS bf16*)(lds + RW_S(6) + (j0 + jp + 1) * PB + t * 2) = (bf16)(pbh >> 16);
            *(LAS bf16*)(lds + RW_S(7) + (j0 + jp) * PB + t * 2) = (bf16)(pkh & 0xffffu); *(LAS bf16*)(lds + RW_S(7) + (j0 + jp + 1) * PB + t * 2) = (bf16)(pkh >> 16);
            g1w[jp >> 1] = pk2(g1[0], g1[1]); g0w[jp >> 1] = pk2(g0[0], g0[1]);
        }
        *(u32x4*)(gout + 32768 + (t * 64 + j0) * 2) = (u32x4){g1w[0], g1w[1], g1w[2], g1w[3]};
        *(u32x4*)(gout + 40960 + (t * 64 + j0) * 2) = (u32x4){g0w[0], g0w[1], g0w[2], g0w[3]};
    }
    RW_BAR(); R1_STAMP(4);
    {
        const int mi = w >> 1;
        const LAS unsigned char* X = lds + RW_S(mi < 2 ? 0 : 1); const LAS unsigned char* Y = lds + RW_S((mi & 1) ? 3 : 2);
        LAS unsigned char* dst = lds + (mi == 0 ? O_P0 : mi == 1 ? O_AAK : mi == 2 ? O_ARB : O_ARK);
        const bool incl = mi >= 2;
#pragma unroll
        for (int q = 0; q < 2; ++q) { const int mt = 2 * (w & 1) + q; const int m = 16 * mt + (lane & 15);
#pragma unroll
            for (int nt = 0; nt < 4; ++nt) { f32x4 acc = {0.f, 0.f, 0.f, 0.f};
                if (nt <= mt) acc = tile_mm<2>(acc, X, PB, 16 * mt, Y, PB, 16 * nt, lane);
                const int n0 = 16 * nt + 4 * (lane >> 4);
#pragma unroll
                for (int i = 0; i < 4; ++i) { const int n = n0 + i; if (!(incl ? n <= m : n < m)) acc[i] = 0.f; }
                st_rm(dst, PB, m, n0, acc);
                if (mi == 0) st_tr(lds + O_P0T, PB, m, n0, acc); } }
    }
    RW_BAR(); R1_STAMP(5);
    {
        f32x4 T[4];
        const int wr = w & 3, m = 16 * wr + (lane & 15);
        LAS unsigned char* Trm = lds + RW_S(8);
        if (w < 4) {
#pragma unroll
            for (int nt = 0; nt < 4; ++nt) { const int n0 = 16 * nt + 4 * (lane >> 4); T[nt] = ld_rm(lds + O_P0, PB, m, n0);
#pragma unroll
                for (int i = 0; i < 4; ++i) if (n0 + i == m) T[nt][i] += 1.f;
                st_rm(Trm, PB, m, n0, T[nt]); }
#pragma unroll
            for (int nt = 0; nt < 4; ++nt) { f32x4 acc = {0.f, 0.f, 0.f, 0.f}; acc = tile_mm<2>(acc, lds + RW_S(5), PB, 16 * wr, lds + O_AAK, PB, 16 * nt, lane); st_rm(lds + RW_S(0), PB, m, 16 * nt + 4 * (lane >> 4), acc); }
        } else {
#pragma unroll
            for (int nt = 0; nt < 4; ++nt) { f32x4 acc = {0.f, 0.f, 0.f, 0.f}; acc = tile_mm<2>(acc, lds + O_P0, PB, 16 * wr, lds + O_P0T, PB, 16 * nt, lane);
                const int n0 = 16 * nt + 4 * (lane >> 4); st_rm(lds + RW_S(2), PB, m, n0, acc); st_tr(lds + RW_S(3), PB, m, n0, acc); }
        }
        RW_BAR();
#pragma unroll 1
        for (int s = 1; s <= 5; ++s) {
            const int cb = s & 1;
            const LAS unsigned char* Pc = lds + (cb ? RW_S(2) : O_P0); const LAS unsigned char* PcT = lds + (cb ? RW_S(3) : O_P0T);
            LAS unsigned char* Pn = lds + (cb ? O_P0 : RW_S(2)); LAS unsigned char* PnT = lds + (cb ? O_P0T : RW_S(3));
            if (w < 4) {
                f32x4 d[4];
#pragma unroll
                for (int nt = 0; nt < 4; ++nt) { d[nt] = (f32x4){0.f, 0.f, 0.f, 0.f}; d[nt] = tile_mm<2>(d[nt], Trm, PB, 16 * wr, PcT, PB, 16 * nt, lane); }
                LDS_WAIT();
#pragma unroll
                for (int nt = 0; nt < 4; ++nt) { T[nt] += d[nt]; st_rm(Trm, PB, m, 16 * nt + 4 * (lane >> 4), T[nt]); }
            } else if (s < 5) {
#pragma unroll
                for (int nt = 0; nt < 4; ++nt) { f32x4 acc = {0.f, 0.f, 0.f, 0.f}; acc = tile_mm<2>(acc, Pc, PB, 16 * wr, PcT, PB, 16 * nt, lane);
                    const int n0 = 16 * nt + 4 * (lane >> 4); st_rm(Pn, PB, m, n0, acc); st_tr(PnT, PB, m, n0, acc); }
            }
            RW_BAR();
        }
    }
    R1_STAMP(6);
    {
        const LAS unsigned char* Z = lds + (w < 4 ? RW_S(4) : RW_S(0)); const int zr0 = 16 * (w & 3);
        f32x4 acc[4];
#pragma unroll
        for (int nt = 0; nt < 4; ++nt) { acc[nt] = (f32x4){0.f, 0.f, 0.f, 0.f}; acc[nt] = tile_mm<2>(acc[nt], Z, PB, zr0, lds + RW_S(8), PB, 16 * nt, lane); }
#pragma unroll
        for (int nt = 0; nt < 4; ++nt) st_rm(lds + RW_S(2), PB, 16 * w + (lane & 15), 16 * nt + 4 * (lane >> 4), acc[nt]);
    }
    RW_BAR(); R1_STAMP(7);
    {
        const int job = w >> 1;
        const LAS unsigned char* XTt = lds + RW_S(2); const LAS unsigned char* XTb = lds + RW_S(2) + 64 * PB;
#pragma unroll
        for (int q = 0; q < 2; ++q) { const int mt = 2 * (w & 1) + q; const int m = 16 * mt + (lane & 15);
#pragma unroll
            for (int nt = 0; nt < 4; ++nt) { f32x4 acc = {0.f, 0.f, 0.f, 0.f}; const int n0 = 16 * nt + 4 * (lane >> 4);
                if (job == 0) { acc = ld_rm(lds + RW_S(1), PB, m, n0); acc = tile_mm<2>(acc, lds + O_ARB, PB, 16 * mt, XTt, PB, 16 * nt, lane); }
                else if (job == 1) { acc = tile_mm<2>(acc, lds + O_ARB, PB, 16 * mt, XTb, PB, 16 * nt, lane); acc = tile_mm<2>(acc, lds + O_ARK, PB, 16 * mt, lds + RW_S(5), PB, 16 * nt, lane); }
                else if (job == 2) { acc = tile_mm<2>(acc, lds + RW_S(6), PB, 16 * mt, XTt, PB, 16 * nt, lane); }
                else { acc = tile_mm<2>(acc, XTb, PB, 16 * mt, lds + RW_S(6), PB, 16 * nt, lane); acc = tile_mm<2>(acc, lds + RW_S(5), PB, 16 * mt, lds + RW_S(7), PB, 16 * nt, lane); }
                u32x2 o; o.x = pk2(acc[0], acc[1]); o.y = pk2(acc[2], acc[3]);
                *(u32x2*)(gout + job * 8192 + (m * 64 + n0) * 2) = o; } }
    }
    RW_BAR(); R1_STAMP(8);
}

__device__ __forceinline__ void r2_unit(Frame& F, const Args& a, const int l, const int bh) {
    using namespace cfg;
    const int lane = F.lane, w = F.wave, wr = w & 3;
    LAS unsigned char* lds = F.lds;
    bf16* y = (bf16*)(F.ws + wsm::Y);
    const unsigned char* gin = F.ws + wsm::RW + (size_t)bh * 64 * UNIT_BYTES;
    const float* wlp = (const float*)(F.ws + wsm::RW + WL_OFF) + (size_t)bh * 64 * 64;
    const int b = bh >> 3, h = bh & 7;
    const int m = 16 * wr + (lane & 15), q4 = 4 * (lane >> 4);
    if (w < 4) {
        f32x4 S[4];
#pragma unroll
        for (int nt = 0; nt < 4; ++nt) { S[nt] = (f32x4){0.f, 0.f, 0.f, 0.f}; st_rm(lds, PB, m, 16 * nt + q4, S[nt]); }
        bf16x8 mtf[4][2], mtn[4][2]; u32x2 cf[4], cfn[4]; f32x4 wl[4], wln[4];
#define R2_LDS(c_, M_, C_, W_) do { const unsigned char* g_ = gin + (size_t)(c_) * UNIT_BYTES; _Pragma("unroll") for (int nt = 0; nt < 4; ++nt) { \
            _Pragma("unroll") for (int s_ = 0; s_ < 2; ++s_) M_[nt][s_] = *(const bf16x8*)(g_ + 16384 + ((16 * nt + (lane & 15)) * 64 + 32 * s_ + 8 * (lane >> 4)) * 2); \
            C_[nt] = *(const u32x2*)(g_ + 24576 + (m * 64 + 16 * nt + q4) * 2); W_[nt] = *(const f32x4*)(wlp + (c_) * 64 + 16 * nt + q4); } } while (0)
        R2_LDS(0, mtf, cf, wl);
#pragma unroll 1
        for (int c = 0; c < 64; ++c) {
            LAS unsigned char* Scur = lds + (c & 1) * SLOT; LAS unsigned char* Snxt = lds + ((c + 1) & 1) * SLOT;
            const int cn = c < 63 ? c + 1 : 63;
            R2_LDS(cn, mtn, cfn, wln);
            RW_BAR();
            bf16x8 sf[2];
#pragma unroll
            for (int s = 0; s < 2; ++s) sf[s] = ldfrag(Scur, PB, 16 * wr, lane, s);
#pragma unroll
            for (int nt = 0; nt < 4; ++nt) {
                f32x4 acc = S[nt] * wl[nt];
                acc[0] += __uint_as_float(cf[nt].x << 16); acc[1] += __uint_as_float(cf[nt].x & 0xffff0000u); acc[2] += __uint_as_float(cf[nt].y << 16); acc[3] += __uint_as_float(cf[nt].y & 0xffff0000u);
#pragma unroll
                for (int s = 0; s < 2; ++s) acc = __builtin_amdgcn_mfma_f32_16x16x32_bf16(mtf[nt][s], sf[s], acc, 0, 0, 0);
                S[nt] = acc; st_rm(Snxt, PB, m, 16 * nt + q4, acc); }
#pragma unroll
            for (int nt = 0; nt < 4; ++nt) { mtf[nt][0] = mtn[nt][0]; mtf[nt][1] = mtn[nt][1]; cf[nt] = cfn[nt]; wl[nt] = wln[nt]; }
        }
#undef R2_LDS
    } else {
        bf16x8 rf[2], rfn[2]; u32x2 y0[4], g1[4], g0[4], y0n[4], g1n[4], g0n[4];
#define R2_LDY(c_, R_, Y_, G1_, G0_) do { const unsigned char* g_ = gin + (size_t)(c_) * UNIT_BYTES; \
            _Pragma("unroll") for (int s_ = 0; s_ < 2; ++s_) R_[s_] = *(const bf16x8*)(g_ + (m * 64 + 32 * s_ + 8 * (lane >> 4)) * 2); \
            _Pragma("unroll") for (int nt = 0; nt < 4; ++nt) { const int o_ = (m * 64 + 16 * nt + q4) * 2; Y_[nt] = *(const u32x2*)(g_ + 8192 + o_); G1_[nt] = *(const u32x2*)(g_ + 32768 + o_); G0_[nt] = *(const u32x2*)(g_ + 40960 + o_); } } while (0)
        R2_LDY(0, rf, y0, g1, g0);
#pragma unroll 1
        for (int c = 0; c < 64; ++c) {
            LAS unsigned char* Scur = lds + (c & 1) * SLOT;
            const int cn = c < 63 ? c + 1 : 63;
            R2_LDY(cn, rfn, y0n, g1n, g0n);
            RW_BAR();
            f32x4 Y[4]; float sum = 0.f;
#pragma unroll
            for (int nt = 0; nt < 4; ++nt) {
                f32x4 acc = {__uint_as_float(y0[nt].x << 16), __uint_as_float(y0[nt].x & 0xffff0000u), __uint_as_float(y0[nt].y << 16), __uint_as_float(y0[nt].y & 0xffff0000u)};
#pragma unroll
                for (int s = 0; s < 2; ++s) acc = __builtin_amdgcn_mfma_f32_16x16x32_bf16(ldfrag(Scur, PB, 16 * nt, lane, s), rf[s], acc, 0, 0, 0);
                Y[nt] = acc; sum += (acc[0] + acc[1]) + (acc[2] + acc[3]); }
            sum += __shfl_xor(sum, 16); sum += __shfl_xor(sum, 32);
            const float mean = sum * (1.f / 64.f); float var = 0.f;
#pragma unroll
            for (int nt = 0; nt < 4; ++nt)
#pragma unroll
                for (int i = 0; i < 4; ++i) { const float d = Y[nt][i] - mean; var += d * d; }
            var += __shfl_xor(var, 16); var += __shfl_xor(var, 32);
            const float rs = rsqrtf(var * (1.f / 64.f) + 64e-5f);
            bf16* yo = y + ((size_t)b * SEQ + c * 64 + m) * D + h * 64;
#pragma unroll
            for (int nt = 0; nt < 4; ++nt) {
                const f32x4 a1 = {__uint_as_float(g1[nt].x << 16), __uint_as_float(g1[nt].x & 0xffff0000u), __uint_as_float(g1[nt].y << 16), __uint_as_float(g1[nt].y & 0xffff0000u)};
                const f32x4 a0 = {__uint_as_float(g0[nt].x << 16), __uint_as_float(g0[nt].x & 0xffff0000u), __uint_as_float(g0[nt].y << 16), __uint_as_float(g0[nt].y & 0xffff0000u)};
                const f32x4 o = (Y[nt] - mean) * rs * a1 + a0;
                u32x2 ow; ow.x = pk2(o[0], o[1]); ow.y = pk2(o[2], o[3]);
                *(u32x2*)(yo + 16 * nt + q4) = ow; }
            rf[0] = rfn[0]; rf[1] = rfn[1];
#pragma unroll
            for (int nt = 0; nt < 4; ++nt) { y0[nt] = y0n[nt]; g1[nt] = g1n[nt]; g0[nt] = g0n[nt]; }
        }
#undef R2_LDY
    }
    RW_BAR();
}
}
struct MoeOrder {
    const LAS int* pref; int G, c, npn, mode;
    const char* A; const char* B; const int* lists; const float* wl;
    __device__ __forceinline__ bool next(int i, pg8::Unit& u) const {
        const int total = __builtin_amdgcn_readfirstlane(pref[32]) * npn;
        const long L = (long)i * G + c; if (L >= total) return false;
        int wgid = (int)L; { const int q = total / 8, r = total % 8, xcd = wgid % 8, off = wgid / 8; wgid = (xcd < r ? xcd * (q + 1) : r * (q + 1) + (xcd - r) * q) + off; }
        const int panel = wgid / npn, pn = wgid % npn;
        int e = 0;
        for (int k = 1; k < 32; ++k) { const int pk = __builtin_amdgcn_readfirstlane(pref[k]); if (pk <= panel) e = k; }
        const int tl = panel - __builtin_amdgcn_readfirstlane(pref[e]);
        u.pm = panel; u.pn = pn;
        if (mode == 0) { u.a = A; u.b = B + ((size_t)e * 512 + (size_t)pn * 256) * 2048 * 2; u.rows = lists + e * LCAP + tl * 256; const int rem = __builtin_amdgcn_readfirstlane(pref[40 + e]) - tl * 256; u.nvalid = rem < 256 ? rem : 256; u.wrow = wl + e * LCAP + tl * 256; }
        else { u.a = A + (size_t)panel * 256 * 256 * 2; u.b = B + ((size_t)e * 2048 + (size_t)pn * 256) * 256 * 2; u.rows = nullptr; u.nvalid = 256; u.wrow = nullptr; }
        return true;
    }
};

#define IN(k) (lo <= (k) && (k) < hi)
#define SEAM(k) do { if (IN(k) && IN((k) + 1)) xcd_barrier(bar); } while (0)
#ifndef DUP_PHASE
#define DUP_PHASE -1
#endif
template <int l> __device__ __forceinline__ void ph_n1(Frame& F, const Args& args) {
    using namespace cfg; float* xo = args.out; const float* xin = (l == 0) ? args.in[0] : xo;
    convert_phase(F, args, l);
    if (l == 0) norm_phase<false, false, false, l == F8_LAYER>(F, args, xin, nullptr, args.in[3] + l * D, l, l);
    else { build_pref(F, l - 1); norm_phase<true, false, false, l == F8_LAYER>(F, args, xin, xo, args.in[3] + l * D, l, l); }
}
template <int l> __device__ __forceinline__ void ph_g1(Frame& F, const Args& args) {
    using namespace cfg;
    constexpr int ESZ = (l == F8_LAYER) ? 1 : 2;
    pg8::StaticOrder S; S.init(F.ws + wsm::XN, F.ws + wsm::W_IN, M, INC, D, F.G, (int)blockIdx.x, ESZ);
    pg8::EpiBf16 E{(bf16*)(F.ws + wsm::P), INC, ESZ == 1 ? pg8::F8_INV : 1.f};
    pg8::gemm_phase<pg8::EpiBf16, pg8::StaticOrder, false, ESZ>(F.lds, D, S, E);
}
template <int l> __device__ __forceinline__ void ph_m1(Frame& F, const Args& args, unsigned long long& racc) {
    { int hcur = -1; rw::R1Raw raw;
      auto unit_of = [&](int i) { return (F.G == 256) ? ((F.vcu >> 2) << 6) + ((F.vcu & 3) << 4) + i : F.vcu + i * F.G; };
      if (unit_of(0) < 4096) rw::r1_load(F, unit_of(0), raw, F.tid);
      for (int i = 0; unit_of(i) < 4096 && i * F.G < 4096; ++i) { const int u = unit_of(i); const int un = ((i + 1) * F.G < 4096 && unit_of(i + 1) < 4096) ? unit_of(i + 1) : u; rw::r1_unit(F, args, l, u, un, raw, racc, hcur); } }

    for (int u = F.vcu; u < 1024; u += F.G) { const int b = u >> 7, hh = (u >> 4) & 7, qb = ((u & 15) + (u >> 8) * 4) & 15; att::attn_unit<0>(F, args, l, b, hh, qb); }
    if (DUP_PHASE == 21 + 100 * l) { for (int u = F.vcu; u < 1024; u += F.G) { const int b = u >> 7, hh = (u >> 4) & 7, qb = ((u & 15) + (u >> 8) * 4) & 15; att::attn_unit<0>(F, args, l, b, hh, qb); } }
    att::conv_items(F, args, l, F.vcu * 512 + F.tid, F.G * 512);
    if (DUP_PHASE == 22 + 100 * l) att::conv_items(F, args, l, F.vcu * 512 + F.tid, F.G * 512);
}
template <int l> __device__ __forceinline__ void ph_m2(Frame& F, const Args& args) {
    for (;;) { const int it = grab(F, l); if (it >= 64 + 512) break;
        if (it < 64) rw::r2_unit(F, args, l, it);
        else { const int j = it - 64, qb = 15 - (j >> 5), b = (j & 31) >> 2, hh = j & 3; att::attn_unit<1>(F, args, l, b, hh, qb); } }
    if (DUP_PHASE == 8 * l + 3) { __syncthreads();
    for (;;) { const int it = grab(F, l + 2); if (it >= 64 + 512) break;
        if (it < 64) rw::r2_unit(F, args, l, it);
        else { const int j = it - 64, qb = 15 - (j >> 5), b = (j & 31) >> 2, hh = j & 3; att::attn_unit<1>(F, args, l, b, hh, qb); } } }
    if (DUP_PHASE == 30 + 100 * l) { if (F.vcu < 64) rw::r2_unit(F, args, l, F.vcu); }
    if (DUP_PHASE == 31 + 100 * l) { for (int u = F.vcu; u < 512; u += F.G) { const int b = u >> 6, hh = (u >> 4) & 3, qb = (u < 256) ? (u & 15) : 15 - (u & 15); att::attn_unit<1>(F, args, l, b, hh, qb); } }
}
template <int l> __device__ __forceinline__ void ph_g2(Frame& F, const Args& args) {
    using namespace cfg; float* xo = args.out; const float* xin = (l == 0) ? args.in[0] : xo;
    pg8::StaticOrder S; S.init((const bf16*)(F.ws + wsm::Y), (const bf16*)(F.ws + wsm::W_OUT), M, D, D, F.G, (int)blockIdx.x);
    pg8::EpiResF32 E{xin, xo, D};
    pg8::gemm_phase<pg8::EpiResF32, pg8::StaticOrder, false>(F.lds, D, S, E);
}
template <int l> __device__ __forceinline__ void ph_n2(Frame& F, const Args& args) { using namespace cfg;
    if (DUP_PHASE == 8 * l + 5) norm_phase<false, true, false>(F, args, args.out, nullptr, args.in[4] + l * D, l, 2);
    norm_phase<false, true, false>(F, args, args.out, nullptr, args.in[4] + l * D, l, l); }
template <int l> __device__ __forceinline__ void ph_e1(Frame& F, const Args& args) {
    using namespace cfg;
    build_pref(F, l);
    MoeOrder S{(const LAS int*)(F.lds + TAB_OFF), F.G, (int)blockIdx.x, 2, 0, (const char*)(F.ws + wsm::XN), (const char*)(F.ws + wsm::W_GU), (const int*)(F.ws + wsm::LISTS), (const float*)(F.ws + wsm::WLIST)};
    pg8::EpiSilu E{(bf16*)(F.ws + wsm::HB)};
    pg8::gemm_phase<pg8::EpiSilu, MoeOrder, true>(F.lds, D, S, E);
}
template <int l> __device__ __forceinline__ void ph_e2(Frame& F, const Args& args) {
    using namespace cfg;
    build_pref(F, l);
    MoeOrder S{(const LAS int*)(F.lds + TAB_OFF), F.G, (int)blockIdx.x, 8, 1, (const char*)(F.ws + wsm::HB), (const char*)(F.ws + wsm::W_D), nullptr, nullptr};
    pg8::EpiBf16 E{(bf16*)(F.ws + wsm::OB), D, 1.f};
    pg8::gemm_phase<pg8::EpiBf16, MoeOrder, false>(F.lds, EH, S, E);
}
#ifndef PROBE_T
#define PROBE_T -1
#endif
#define RUNPH(k, call) do { if (PROBE_T == (k)) pt0 = __builtin_amdgcn_s_memrealtime(); RUNPH_(k, call); if (PROBE_T == (k)) pt1 = __builtin_amdgcn_s_memrealtime(); } while (0)
#define RUNPH_(k, call) do { if (IN(k)) { call; if (DUP_PHASE == (k) && ((k) & 7) != 3 && ((k) & 7) != 5) { __syncthreads(); call; } } SEAM(k); } while (0)
template <int l>
__device__ __forceinline__ void layer_phases(Frame& F, const Args& args, const XcdBarrier& bar, const int lo, const int hi, unsigned long long& pt0, unsigned long long& pt1) {
    constexpr int pb = 8 * l;
    RUNPH(pb + 0, ph_n1<l>(F, args));
    RUNPH(pb + 1, ph_g1<l>(F, args));
    { unsigned long long racc = 0; RUNPH(pb + 2, ph_m1<l>(F, args, racc)); if (PROBE_R1 >= 0 && l == 0) { pt0 = 0; pt1 = racc; } }
    RUNPH(pb + 3, ph_m2<l>(F, args));
    RUNPH(pb + 4, ph_g2<l>(F, args));
    RUNPH(pb + 5, ph_n2<l>(F, args));
    RUNPH(pb + 6, ph_e1<l>(F, args));
    RUNPH(pb + 7, ph_e2<l>(F, args));
}
__global__ void __launch_bounds__(512, 2) mk_fwd(Args args) {
    extern __shared__ __attribute__((aligned(16))) unsigned char lds_raw[];
    using namespace cfg;
    Frame F;
    F.lds = (LAS unsigned char*)lds_raw; F.ws = args.ws; F.ctl = (unsigned*)(args.ws + wsm::CTL);
    F.tid = threadIdx.x; F.lane = F.tid & 63; F.wave = __builtin_amdgcn_readfirstlane(F.tid >> 6);
    F.pacc = 0ull;
    F.G = gridDim.x; { const int bx = blockIdx.x; F.vcu = (F.G % 8 == 0) ? (bx % 8) * (F.G / 8) + bx / 8 : bx; }
    volatile LAS unsigned* MISC = (volatile LAS unsigned*)(F.lds + MISC_OFF);
    for (int u = F.tid; u < (LDS_BYTES - RING_BYTES) / 4; u += 512) ((LAS unsigned*)(F.lds + RING_BYTES))[u] = 0u;
    __syncthreads();
    const int lo = args.ph_lo, hi = args.ph_hi;
    XcdBarrier bar; bar.bar = F.ctl + wsm::CW_BAR; bar.x = 0; bar.st = nullptr;
    if (hi - lo > 1) bar = xcd_barrier_post(F.ctl + wsm::CW_BAR, MISC + 8);
    float* xo = args.out;
    unsigned long long pt0 = 0, pt1 = 0;
    layer_phases<0>(F, args, bar, lo, hi, pt0, pt1);
    layer_phases<1>(F, args, bar, lo, hi, pt0, pt1);
    if (PROBE_T == 16) pt0 = __builtin_amdgcn_s_memrealtime();
    if (IN(16)) {
        build_pref(F, NL - 1); norm_phase<true, false, true>(F, args, xo, xo, args.in[5], 0, 0);
    }
    if (PROBE_T == 16) pt1 = __builtin_amdgcn_s_memrealtime();
    if (PROBE_ATT >= 0 && blockIdx.x == 0 && F.tid == 448) { const unsigned long long te = __builtin_amdgcn_s_memrealtime(); while (__builtin_amdgcn_s_memrealtime() - te < 4ull * F.pacc) __builtin_amdgcn_s_sleep(8); }
    if ((PROBE_T >= 0 || PROBE_R1 >= 0) && blockIdx.x == 0 && F.tid == 0) { const unsigned long long te = __builtin_amdgcn_s_memrealtime(); while (__builtin_amdgcn_s_memrealtime() - te < 4ull * (pt1 - pt0)) __builtin_amdgcn_s_sleep(8); }
#undef IN
#undef SEAM
}
extern "C" void kernel_launch(void* const* d_in, const int* in_sizes, int n_in, void* d_out, int out_size, void* d_ws, size_t ws_size, hipStream_t stream) {
    using namespace cfg;
    static int grid = 0;
    if (grid == 0) {
        if (n_in != 32 || ws_size < wsm::END || out_size != M * D) { fprintf(stderr, "kernel_launch: bad args n_in=%d ws=%zu out=%d\n", n_in, ws_size, out_size); grid = -1; return; }
        int dev = 0, cus = 0;
        if (hipGetDevice(&dev) != hipSuccess || hipDeviceGetAttribute(&cus, hipDeviceAttributeMultiprocessorCount, dev) != hipSuccess) { grid = -1; return; }
        if (hipFuncSetAttribute((const void*)mk_fwd, hipFuncAttributeMaxDynamicSharedMemorySize, LDS_BYTES) != hipSuccess) { fprintf(stderr, "hipFuncSetAttribute failed\n"); grid = -1; return; }
        int per_cu = 0;
        if (hipOccupancyMaxActiveBlocksPerMultiprocessor(&per_cu, (const void*)mk_fwd, 512, LDS_BYTES) != hipSuccess || per_cu < 1) fprintf(stderr, "kernel_launch: occupancy query says %d\n", per_cu);
        (void)hipGetLastError();
        grid = cus;
    }
    if (grid < 0) return;
    unsigned char* w = (unsigned char*)d_ws;
    if (hipMemsetAsync(w + wsm::CTL, 0, wsm::CTL_ZERO_BYTES, stream) != hipSuccess) return;
    Args a{};
    for (int i = 0; i < 32; ++i) a.in[i] = (const float*)d_in[i];
    a.out = (float*)d_out; a.ws = w; a.flags = 7; a.ph_lo = 0; a.ph_hi = 17;
    hipLaunchKernelGGL(mk_fwd, dim3(grid), dim3(512), LDS_BYTES, stream, a);
}
```

```cpp
#define DUP_PHASE -1
#include <hip/hip_runtime.h>
#include <cstdint>
#include <cstdio>
#include <cmath>

typedef unsigned short bf16;
__host__ __device__ __forceinline__ unsigned f2bf(float f) { unsigned u = __builtin_bit_cast(unsigned, f); return (u + 0x7fffu + ((u >> 16) & 1u)) >> 16; }
__host__ __device__ __forceinline__ float bf2f(bf16 b) { return __builtin_bit_cast(float, ((unsigned)b) << 16); }

namespace cfg {
constexpr int D = 2048, BATCH = 8, SEQ = 4096, M = BATCH * SEQ, NL = 2;
constexpr int INC = 6400;
constexpr int OFF_BQ = 1792, OFF_BK = 2304, OFF_BV = 2816, OFF_CQ = 3328, OFF_CK = 3840, OFF_CV = 4352, OFF_D = 4864;
constexpr int NEXP = 32, EH = 256;
}
#define GAS __attribute__((address_space(1)))
#define LAS __attribute__((address_space(3)))
typedef float f32x4 __attribute__((ext_vector_type(4)));
typedef float f32x2 __attribute__((ext_vector_type(2)));
typedef short bf16x8 __attribute__((ext_vector_type(8)));
typedef unsigned u32x4 __attribute__((ext_vector_type(4)));
typedef unsigned u32x2 __attribute__((ext_vector_type(2)));
#define RLX_AGENT __ATOMIC_RELAXED, __HIP_MEMORY_SCOPE_AGENT
#define LDS_WAIT() asm volatile("s_waitcnt lgkmcnt(0)" ::: "memory")
#define VM_WAIT() asm volatile("s_waitcnt vmcnt(0)" ::: "memory")

namespace wsm {
constexpr size_t MiB = 1u << 20;
constexpr size_t CTL = 0, CTL_ZERO_BYTES = 1 * MiB;
constexpr size_t LISTS = 2 * MiB;
constexpr size_t WLIST = 6 * MiB;
constexpr size_t TOKINFO = 10 * MiB;
constexpr size_t ROUTE = 11 * MiB;
constexpr size_t WRT = 12 * MiB;
constexpr size_t W_IN = 16 * MiB;
constexpr size_t W_OUT = 41 * MiB;
constexpr size_t W_GU = 49 * MiB;
constexpr size_t W_D = 113 * MiB;
constexpr size_t XN = 146 * MiB;
constexpr size_t P = 274 * MiB;
constexpr size_t HB = P;
constexpr size_t OB = P + 40 * MiB;
constexpr size_t Y = 674 * MiB;
constexpr size_t RW = 802 * MiB;
constexpr size_t END = 1010 * MiB;
constexpr int CW_BAR = 4096;
constexpr int CW_CNT = 16384;
constexpr int CW_Q = 32768;
}
constexpr int LCAP = 32768;
constexpr int RING_BYTES = 139264;
constexpr int MISC_OFF = RING_BYTES + 320;
constexpr int TAB_OFF = RING_BYTES + 1024;
constexpr int LDS_BYTES = 147456;
constexpr float C2F = 0.125f * 1.4426950408889634f;
constexpr float LOG2E = 1.4426950408889634f;

typedef __bf16 bf16x2_hw __attribute__((ext_vector_type(2)));
__device__ __forceinline__ unsigned pk2(float lo, float hi) { const f32x2 v = {lo, hi}; const bf16x2_hw b = __builtin_convertvector(v, bf16x2_hw); return __builtin_bit_cast(unsigned, b); }
__device__ __forceinline__ bf16 cvt1(float x) { return (bf16)(pk2(x, x) & 0xffffu); }
__device__ __forceinline__ float f8clamp(float x) { return __builtin_amdgcn_fmed3f(x, -448.f, 448.f); }
__device__ __forceinline__ unsigned pk2_fp8(float a, float b) { int w = 0; w = __builtin_amdgcn_cvt_pk_fp8_f32(f8clamp(a), f8clamp(b), w, false); return (unsigned)w & 0xffffu; }
__device__ __forceinline__ unsigned pk4_fp8(float a, float b, float c, float d) { int w = 0; w = __builtin_amdgcn_cvt_pk_fp8_f32(f8clamp(a), f8clamp(b), w, false); w = __builtin_amdgcn_cvt_pk_fp8_f32(f8clamp(c), f8clamp(d), w, true); return (unsigned)w; }
constexpr int F8_IN_MASK = 2, F8_OUT_MASK = 2;
#define F8IN(l) (((F8_IN_MASK >> (l)) & 1) != 0)
#define F8OUT(l) (((F8_OUT_MASK >> (l)) & 1) != 0)
constexpr float F8_Y = 16.f;
constexpr int F8_MOE_MASK = 3;
__device__ __forceinline__ float wave_sum(float v) {
#pragma unroll
    for (int o = 1; o < 64; o <<= 1) v += __shfl_xor(v, o);
    return v;
}

struct Args {
    const float* in[32]; float* out; unsigned char* ws;
    int ph_lo, ph_hi, flags, pad;
};
#define XB_TMO      128
#define XB_XCNT(j)  (256  + 64 * (j))
#define XB_XSUB(j)  (1280 + 64 * (j))
#define XB_XGEN(j)  (2304 + 64 * (j))
#define XB_TOP      3328
#define XB_TOPGEN   3392
#define XCD_BAR_WORDS 3456
#define XB_SPIN_CAP (1u << 22)

__device__ __forceinline__ unsigned xb_ld(unsigned* p)              { return __hip_atomic_load(p, __ATOMIC_RELAXED, __HIP_MEMORY_SCOPE_AGENT); }
__device__ __forceinline__ unsigned xb_add(unsigned* p, unsigned v) { return __hip_atomic_fetch_add(p, v, __ATOMIC_RELAXED, __HIP_MEMORY_SCOPE_AGENT); }
__device__ __forceinline__ unsigned xb_xcc_id() { return (unsigned)__builtin_amdgcn_s_getreg((3 << 11) | 20) & 0xFu; }
#define XB_SPIN(cond, bar) do { unsigned _sp = 0; while (cond) { __builtin_amdgcn_s_sleep(1); \
    if ((++_sp & 255u) == 0u) { if (xb_ld(&(bar)[XB_TMO])) break; if (_sp > XB_SPIN_CAP) { atomicAdd(&(bar)[XB_TMO], 1u); break; } } } } while (0)

struct XcdBarrier {
    unsigned* bar; unsigned x;
    volatile LAS unsigned* st;
};

__device__ __forceinline__ XcdBarrier xcd_barrier_post(unsigned* bar, volatile LAS unsigned* st) {
    XcdBarrier b; b.bar = bar; b.x = xb_xcc_id(); b.st = st;
    if (threadIdx.x == 0) (void)xb_add(&bar[XB_XCNT(b.x)], 1u);
    return b;
}
__device__ __forceinline__ void xcd_barrier_complete(unsigned* bar, unsigned x, unsigned& nloc, unsigned& nx) {
    const unsigned G = gridDim.x * gridDim.y * gridDim.z;
    unsigned sum, cnt, mine, sp = 0u;
    for (;;) {
        sum = 0u; cnt = 0u; mine = 0u;
#pragma unroll
        for (unsigned j = 0; j < 16; ++j) { const unsigned c = xb_ld(&bar[XB_XCNT(j)]); sum += c; cnt += (c > 0u) ? 1u : 0u; mine = (j == x) ? c : mine; }
        if (sum == G) break;
        __builtin_amdgcn_s_sleep(1);
        if ((++sp & 255u) == 0u) { if (xb_ld(&bar[XB_TMO])) break; if (sp > XB_SPIN_CAP) { atomicAdd(&bar[XB_TMO], 1u); break; } }
    }
    nloc = mine > 0u ? mine : 1u; nx = cnt > 0u ? cnt : 1u;
}

__device__ __forceinline__ void xcd_barrier(const XcdBarrier& b) {
    asm volatile("s_waitcnt vmcnt(0)" ::: "memory");
    __syncthreads();
    if (threadIdx.x == 0) {
        unsigned* bar = b.bar;
        __builtin_amdgcn_s_waitcnt(0);
        unsigned nloc = b.st[0], nx = b.st[1];
        if (nloc == 0u) { xcd_barrier_complete(bar, b.x, nloc, nx); b.st[0] = nloc; b.st[1] = nx; }
        const unsigned old = xb_add(&bar[XB_XSUB(b.x)], 1u);
        const unsigned gen = old / nloc;
        if (old + 1u == (gen + 1u) * nloc) {
            __builtin_amdgcn_fence(__ATOMIC_RELEASE, "agent");
            asm volatile("s_waitcnt vmcnt(0)" ::: "memory");
            const unsigned og = xb_add(&bar[XB_TOP], 1u);
            const unsigned tg = og / nx;
            if (og + 1u == (tg + 1u) * nx) xb_add(&bar[XB_TOPGEN], 1u);
            else XB_SPIN(xb_ld(&bar[XB_TOPGEN]) == tg, bar);
            __builtin_amdgcn_fence(__ATOMIC_ACQUIRE, "agent");
            xb_add(&bar[XB_XGEN(b.x)], 1u);
            asm volatile("s_waitcnt vmcnt(0)" ::: "memory");
        } else {
            XB_SPIN(xb_ld(&bar[XB_XGEN(b.x)]) == gen, bar);
            __builtin_amdgcn_fence(__ATOMIC_ACQUIRE, "agent");
            asm volatile("s_waitcnt vmcnt(0)" ::: "memory");
        }
    }
    __syncthreads();
}
namespace pg8 {
#define PG8_LAS __attribute__((address_space(3)))
typedef unsigned short bf16_t;
typedef short bf16x8 __attribute__((ext_vector_type(8)));
typedef float f32x4 __attribute__((ext_vector_type(4)));
typedef unsigned u32x4 __attribute__((ext_vector_type(4)));
typedef unsigned u32x2 __attribute__((ext_vector_type(2)));
typedef int i32x4_t __attribute__((ext_vector_type(4)));
typedef int i32x8_t __attribute__((ext_vector_type(8)));
constexpr float F8_ACT = 16.f, F8_WGT = 512.f, F8_INV = 1.f / (16.f * 512.f);
constexpr int BM = 256, BK = 64, HALF = 128, HTB = HALF * BK * 2, STAGE_BYTES = 8 * HTB, NXCD = 8, WGM = 8;

__host__ __device__ __forceinline__ int lds_byte(int r, int c) { const int st = (r >> 4) * 2 + (c >> 5), rr = r & 15, cc = c & 31, ob = rr * 64 + cc * 2; return st * 1024 + (ob ^ (((ob >> 9) & 1) << 5)); }
__host__ __device__ __forceinline__ void stage_rc(int b, int& R, int& C) { const int st = b / 1024, sb = b % 1024, swz = sb ^ (((sb >> 9) & 1) << 5); R = (st >> 1) * 16 + swz / 64; C = (st & 1) * 32 + (swz % 64) / 2; }
__host__ __device__ __forceinline__ int perm32(int rho) { const int n = rho >> 4, i = rho & 15; return 8 * (i >> 2) + 4 * n + (i & 3); }

struct Unit { int pm, pn; const char* a; const char* b; const int* rows; const float* wrow; int nvalid; int pad_; };

struct StaticOrder {
    int nM, nN, nwg, G, c; const char* A; const char* Bt; size_t tstep;
    __device__ void init(const void* A_, const void* Bt_, int M, int N, int K, int G_, int c_, int esz = 2) { nM = M / BM; nN = N / BM; nwg = nM * nN; G = G_; c = c_; A = (const char*)A_; Bt = (const char*)Bt_; tstep = (size_t)BM * K * esz; }
    __device__ bool next(int i, Unit& u) const {
        const long L = (long)i * G + c; if (L >= nwg) return false;
        int wgid = (int)L; { const int q = nwg / NXCD, r = nwg % NXCD, xcd = wgid % NXCD, off = wgid / NXCD; wgid = (xcd < r ? xcd * (q + 1) : r * (q + 1) + (xcd - r) * q) + off; }
        const int nig = WGM * nN, gid = wgid / nig, fm = gid * WGM, gsz = (nM - fm) < WGM ? (nM - fm) : WGM;
        u.pm = fm + ((wgid % nig) % gsz); u.pn = (wgid % nig) / gsz; u.a = A + (size_t)u.pm * tstep; u.b = Bt + (size_t)u.pn * tstep; u.rows = nullptr; u.wrow = nullptr; u.nvalid = 256; return true;
    }
};

__device__ __forceinline__ unsigned cvt_pk_bf16(float lo, float hi) { unsigned r; asm volatile("v_cvt_pk_bf16_f32 %0, %1, %2" : "=v"(r) : "v"(lo), "v"(hi)); return r; }

struct EpiBf16 {
    static constexpr bool PERM = true;
    bf16_t* O; int ldc; float mul;
    __device__ __forceinline__ void operator()(const f32x4 (&acc)[2][2][4][2], const Unit& u, int wr, int wc, int fr, int fq) const {
        const int row0 = u.pm * BM + wr * 64 + fr; const int col0 = u.pn * BM + wc * 32 + 8 * fq;
#pragma unroll
        for (int ai = 0; ai < 2; ++ai)
#pragma unroll
            for (int m = 0; m < 4; ++m) { bf16_t* rowp = O + (size_t)(row0 + ai * HALF + m * 16) * ldc + col0;
#pragma unroll
                for (int bj = 0; bj < 2; ++bj) { const f32x4 v0 = acc[ai][bj][m][0] * mul, v1 = acc[ai][bj][m][1] * mul;
                    u32x4 w; w.x = cvt_pk_bf16(v0[0], v0[1]); w.y = cvt_pk_bf16(v0[2], v0[3]); w.z = cvt_pk_bf16(v1[0], v1[1]); w.w = cvt_pk_bf16(v1[2], v1[3]);
                    *(u32x4*)(rowp + bj * HALF) = w; } }
    }
};
struct EpiResF32 {
    static constexpr bool PERM = false;
    const float* base; float* C; int ldc; float mul;
    __device__ __forceinline__ void operator()(const f32x4 (&acc)[2][2][4][2], const Unit& u, int wr, int wc, int fr, int fq) const {
        const int row0 = u.pm * BM + wr * 64 + fr, col0 = u.pn * BM + wc * 32 + 4 * fq;
#pragma unroll
        for (int ai = 0; ai < 2; ++ai)
#pragma unroll
            for (int m = 0; m < 4; ++m) { const size_t off = (size_t)(row0 + ai * HALF + m * 16) * ldc + col0;
#pragma unroll
                for (int bj = 0; bj < 2; ++bj)
#pragma unroll
                    for (int n = 0; n < 2; ++n) { const f32x4 bs = *(const f32x4*)(base + off + bj * HALF + n * 16); *(f32x4*)(C + off + bj * HALF + n * 16) = bs + acc[ai][bj][m][n] * mul; }
                asm volatile("" ::: "memory"); }
    }
};
struct EpiSilu {
    static constexpr bool PERM = true;
    bf16_t* H; float mul;
    __device__ __forceinline__ void operator()(const f32x4 (&acc)[2][2][4][2], const Unit& u, int wr, int wc, int fr, int fq) const {
        const int row0 = u.pm * BM + wr * 64 + fr; const int col0 = u.pn * HALF + wc * 32 + 8 * fq;
#pragma unroll
        for (int ai = 0; ai < 2; ++ai)
#pragma unroll
            for (int m = 0; m < 4; ++m) { const int row = row0 + ai * HALF + m * 16; const float w = u.wrow[wr * 64 + fr + ai * HALF + m * 16];
                float o[8];
#pragma unroll
                for (int n = 0; n < 2; ++n)
#pragma unroll
                    for (int j = 0; j < 4; ++j) { const float g = acc[ai][0][m][n][j] * mul, up = acc[ai][1][m][n][j] * mul; o[n * 4 + j] = g * __builtin_amdgcn_rcpf(1.f + __expf(-g)) * up * w; }
                u32x4 wv; wv.x = cvt_pk_bf16(o[0], o[1]); wv.y = cvt_pk_bf16(o[2], o[3]); wv.z = cvt_pk_bf16(o[4], o[5]); wv.w = cvt_pk_bf16(o[6], o[7]);
                *(u32x4*)(H + (size_t)row * 256 + col0) = wv; }
    }
};

template <class Epi, class Sched, bool GATHER, int ESZ = 2>
__device__ __forceinline__ void gemm_phase(PG8_LAS unsigned char* lds, const int K, const Sched& S, const Epi& E) {
    const int tid = threadIdx.x, wid = __builtin_amdgcn_readfirstlane(tid >> 6), lane = tid & 63, wr = wid >> 2, wc = wid & 3, fr = lane & 15, fq = lane >> 4;
    const int KB = K * ESZ;
    const int nt = KB / (BK * 2);
    const size_t kstep = (size_t)(BK * 2);
    const unsigned hstep = (unsigned)HALF * KB;
    int sR[2], sC[2];
    unsigned voffB[2], vc[2][2], vn[2][2];
#pragma unroll
    for (int i = 0; i < 2; ++i) { int R, C; stage_rc(tid * 16 + i * 8192, R, C); sR[i] = R; sC[i] = C; const int Rb = Epi::PERM ? ((R & ~31) + perm32(R & 31)) : R;
        voffB[i] = (unsigned)(Rb * KB + C * 2); vc[0][i] = (unsigned)(R * KB + C * 2); vc[1][i] = vc[0][i] + hstep; vn[0][i] = vc[0][i]; vn[1][i] = vc[1][i]; }
    const unsigned ldsw = (unsigned)wid * 1024u;
    const int aoff = lds_byte(wr * 64 + fr, fq * 8), boff = lds_byte(wc * 32 + fr, fq * 8);
#define PG8_SA(b, h) (((b) * 2 + (h)) * HTB)
#define PG8_SB(b, h) ((4 + (b) * 2 + (h)) * HTB)
#define PG8_STAGE(bufoff, gbase, voff) do { _Pragma("unroll") for (int _i = 0; _i < 2; ++_i) \
        __builtin_amdgcn_global_load_lds((const unsigned*)((const char*)(gbase) + (voff)[_i]), (PG8_LAS unsigned*)(lds + (bufoff) + ldsw + _i * 8192), 16, 0, 0); } while (0)
#define PG8_LD32(addr) __builtin_shufflevector(*(const PG8_LAS i32x4_t*)(addr), *(const PG8_LAS i32x4_t*)((addr) + 1024), 0, 1, 2, 3, 4, 5, 6, 7)
#define PG8_LDA(dst, b, h) do { if constexpr (ESZ == 2) { _Pragma("unroll") for (int m = 0; m < 4; ++m) _Pragma("unroll") for (int k = 0; k < 2; ++k) dst[m][k] = *(const PG8_LAS bf16x8*)(lds + PG8_SA(b, h) + aoff + m * 2048 + k * 1024); } \
        else { _Pragma("unroll") for (int m = 0; m < 4; ++m) dst##8[m] = PG8_LD32(lds + PG8_SA(b, h) + aoff + m * 2048); } } while (0)
#define PG8_LDB(dst, b, h) do { if constexpr (ESZ == 2) { _Pragma("unroll") for (int n = 0; n < 2; ++n) _Pragma("unroll") for (int k = 0; k < 2; ++k) dst[n][k] = *(const PG8_LAS bf16x8*)(lds + PG8_SB(b, h) + boff + n * 2048 + k * 1024); } \
        else { _Pragma("unroll") for (int n = 0; n < 2; ++n) dst##8[n] = PG8_LD32(lds + PG8_SB(b, h) + boff + n * 2048); } } while (0)
#define PG8_F8(x) __builtin_shufflevector(__builtin_bit_cast(i32x4_t, x[0]), __builtin_bit_cast(i32x4_t, x[1]), 0, 1, 2, 3, 4, 5, 6, 7)
#define PG8_MMA(ai, bj, At, Bt) do { __builtin_amdgcn_s_setprio(1); _Pragma("unroll") for (int m = 0; m < 4; ++m) _Pragma("unroll") for (int n = 0; n < 2; ++n) { \
        if constexpr (ESZ == 2) { _Pragma("unroll") for (int k = 0; k < 2; ++k) acc[ai][bj][m][n] = __builtin_amdgcn_mfma_f32_16x16x32_bf16(Bt[n][k], At[m][k], acc[ai][bj][m][n], 0, 0, 0); } \
        else asm volatile("s_nop 1\n\tv_mfma_f32_16x16x128_f8f6f4 %0, %1, %2, %0" : "+v"(acc[ai][bj][m][n]) : "v"(Bt##8[n]), "v"(At##8[m])); } __builtin_amdgcn_s_setprio(0); } while (0)
#define PG8_WAIT_V(n) asm volatile("s_waitcnt vmcnt(" #n ")" ::: "memory")
#define PG8_WAIT_L(n) asm volatile("s_waitcnt lgkmcnt(" #n ")" ::: "memory")
#define PG8_BAR __builtin_amdgcn_s_barrier()
#define PG8_SCHED __builtin_amdgcn_sched_barrier(0)
#define PG8_GV(dst, u) do { if constexpr (GATHER) { _Pragma("unroll") for (int _h = 0; _h < 2; ++_h) _Pragma("unroll") for (int _i = 0; _i < 2; ++_i) { const int _idx = _h * HALF + sR[_i]; \
        const int _tok = (u).rows[_idx < (u).nvalid ? _idx : 0]; dst[_h][_i] = (unsigned)_tok * (unsigned)KB + (unsigned)sC[_i] * 2u; } } } while (0)
    Unit cur, nxt; int ui = 0;
    if (!S.next(0, cur)) return;
    f32x4 acc[2][2][4][2];
#pragma unroll
    for (int a = 0; a < 2; ++a)
#pragma unroll
        for (int b = 0; b < 2; ++b)
#pragma unroll
            for (int m = 0; m < 4; ++m)
#pragma unroll
                for (int n = 0; n < 2; ++n) acc[a][b][m][n] = (f32x4){0.f, 0.f, 0.f, 0.f};
    bf16x8 At[4][2], B0[2][2], B1[2][2];
    i32x8_t At8[4], B08[2], B18[2];
    const char* cA = cur.a; const char* cB = cur.b;
    PG8_GV(vc, cur);
    PG8_STAGE(PG8_SB(0, 0), cB, voffB); PG8_STAGE(PG8_SB(0, 1), cB + hstep, voffB); PG8_STAGE(PG8_SA(0, 0), cA, vc[0]); PG8_STAGE(PG8_SA(0, 1), cA, vc[1]);
    if (wr == 1) PG8_BAR;
    PG8_WAIT_V(2); PG8_BAR;
    PG8_STAGE(PG8_SB(1, 0), cB + kstep, voffB); PG8_STAGE(PG8_SA(1, 0), cA + kstep, vc[0]); PG8_STAGE(PG8_SB(1, 1), cB + hstep + kstep, voffB);
    PG8_WAIT_V(6); PG8_BAR;
    for (;;) {
        const bool has_next = S.next(ui + 1, nxt);
        const char* nA = has_next ? nxt.a : cA; const char* nB = has_next ? nxt.b : cB;
        if constexpr (GATHER) { if (has_next) { PG8_GV(vn, nxt); } else {
#pragma unroll
            for (int h = 0; h < 2; ++h)
#pragma unroll
                for (int i = 0; i < 2; ++i) vn[h][i] = vc[h][i]; } }
#pragma unroll 1
        for (int t = 0; t < nt; t += 2) {
            const bool last = (t == nt - 2);
            const char* a1 = cA + (size_t)(t + 1) * kstep;
            const char* a2 = last ? nA : cA + (size_t)(t + 2) * kstep; const char* b2 = last ? nB : cB + (size_t)(t + 2) * kstep;
            const char* a3 = a2 + kstep; const char* b3 = b2 + kstep;
            unsigned v2[2][2];
#pragma unroll
            for (int h = 0; h < 2; ++h)
#pragma unroll
                for (int i = 0; i < 2; ++i) v2[h][i] = (GATHER && last) ? vn[h][i] : vc[h][i];
            PG8_LDB(B0, 0, 0); PG8_LDB(B1, 0, 1); PG8_SCHED; PG8_LDA(At, 0, 0); PG8_STAGE(PG8_SA(1, 1), a1, vc[1]);
            PG8_WAIT_V(8); PG8_WAIT_L(0); PG8_BAR; PG8_MMA(0, 0, At, B0); PG8_MMA(0, 1, At, B1); PG8_BAR; PG8_SCHED;
            PG8_LDA(At, 0, 1); PG8_STAGE(PG8_SB(0, 0), b2, voffB); PG8_STAGE(PG8_SB(0, 1), b2 + hstep, voffB); PG8_STAGE(PG8_SA(0, 0), a2, v2[0]);
            PG8_WAIT_V(8); PG8_WAIT_L(0); PG8_BAR; PG8_MMA(1, 0, At, B0); PG8_MMA(1, 1, At, B1); PG8_BAR; PG8_SCHED;
            PG8_LDB(B0, 1, 0); PG8_LDB(B1, 1, 1); PG8_SCHED; PG8_LDA(At, 1, 0); PG8_STAGE(PG8_SA(0, 1), a2, v2[1]);
            PG8_WAIT_V(8); PG8_WAIT_L(0); PG8_BAR; PG8_MMA(0, 0, At, B0); PG8_MMA(0, 1, At, B1); PG8_BAR; PG8_SCHED;
            PG8_LDA(At, 1, 1); PG8_STAGE(PG8_SB(1, 0), b3, voffB); PG8_STAGE(PG8_SB(1, 1), b3 + hstep, voffB); PG8_STAGE(PG8_SA(1, 0), a3, v2[0]);
            PG8_WAIT_V(8); PG8_WAIT_L(0); PG8_BAR; PG8_MMA(1, 0, At, B0); PG8_MMA(1, 1, At, B1); PG8_BAR; PG8_SCHED;
        }
        if (wr == 0) PG8_BAR;
        if constexpr (ESZ == 1) asm volatile("s_nop 15\n\ts_nop 7" ::: "memory");
        E(acc, cur, wr, wc, fr, fq);
        if (!has_next) break;
#pragma unroll
        for (int a = 0; a < 2; ++a)
#pragma unroll
            for (int b = 0; b < 2; ++b)
#pragma unroll
                for (int m = 0; m < 4; ++m)
#pragma unroll
                    for (int n = 0; n < 2; ++n) acc[a][b][m][n] = (f32x4){0.f, 0.f, 0.f, 0.f};
        cur = nxt; cA = nA; cB = nB; ++ui;
        if constexpr (GATHER) {
#pragma unroll
            for (int h = 0; h < 2; ++h)
#pragma unroll
                for (int i = 0; i < 2; ++i) vc[h][i] = vn[h][i]; }
        if (wr == 1) PG8_BAR;
    }
    PG8_WAIT_V(0);
    PG8_BAR;
#undef PG8_SA
#undef PG8_SB
#undef PG8_STAGE
#undef PG8_LDA
#undef PG8_LD32
#undef PG8_LDB
#undef PG8_MMA
#undef PG8_F8
#undef PG8_WAIT_V
#undef PG8_WAIT_L
#undef PG8_BAR
#undef PG8_SCHED
#undef PG8_GV
}
}
struct Frame {
    LAS unsigned char* lds; unsigned char* ws; unsigned* ctl;
    int tid, lane, wave, G, vcu;
    unsigned long long pacc;
};

__device__ __forceinline__ void cvt_tile(const float* W, int N, int K, int k0, int n0, bf16* dst, int drow0, float scale, LAS float* scr, int lane) {
#pragma unroll 8
    for (int i = 0; i < 32; ++i) { const int kk = 2 * i + (lane >> 5); scr[kk * 33 + (lane & 31)] = W[(size_t)(k0 + kk) * N + n0 + (lane & 31)]; }
    LDS_WAIT(); asm volatile("" ::: "memory");
    const int c = lane & 7;
#pragma unroll
    for (int j = 0; j < 4; ++j) { const int n = (lane >> 3) + 8 * j; const LAS float* s = scr + (8 * c) * 33 + n;
        u32x4 o; o.x = pk2(s[0 * 33] * scale, s[1 * 33] * scale); o.y = pk2(s[2 * 33] * scale, s[3 * 33] * scale); o.z = pk2(s[4 * 33] * scale, s[5 * 33] * scale); o.w = pk2(s[6 * 33] * scale, s[7 * 33] * scale);
        *(u32x4*)(dst + (size_t)(drow0 + n) * K + k0 + 8 * c) = o; }
    LDS_WAIT(); asm volatile("" ::: "memory");
}
__device__ __forceinline__ void cvt_tile8(const float* W, int N, int K, int k0, int n0, unsigned char* dst, int drow0, float scale, LAS float* scr, int lane) {
#pragma unroll 8
    for (int i = 0; i < 32; ++i) { const int kk = 2 * i + (lane >> 5); scr[kk * 33 + (lane & 31)] = W[(size_t)(k0 + kk) * N + n0 + (lane & 31)]; }
    LDS_WAIT(); asm volatile("" ::: "memory");
    const int c = lane & 7;
#pragma unroll
    for (int j = 0; j < 4; ++j) { const int n = (lane >> 3) + 8 * j; const LAS float* s = scr + (8 * c) * 33 + n;
        u32x2 o; o.x = pk4_fp8(s[0 * 33] * scale, s[1 * 33] * scale, s[2 * 33] * scale, s[3 * 33] * scale); o.y = pk4_fp8(s[4 * 33] * scale, s[5 * 33] * scale, s[6 * 33] * scale, s[7 * 33] * scale);
        *(u32x2*)(dst + (size_t)(drow0 + n) * K + k0 + 8 * c) = o; }
    LDS_WAIT(); asm volatile("" ::: "memory");
}
__device__ __forceinline__ void convert_phase(Frame& F, const Args& a, int l) {
    using namespace cfg;
    LAS float* scr = (LAS float*)(F.lds + F.wave * 16384);
    const int gw = F.vcu * 8 + F.wave, NGW = F.G * 8;
    const float* w_in = a.in[1] + (size_t)l * D * INC; const float* w_out = a.in[2] + (size_t)l * D * D;
    const size_t es = (size_t)NEXP * D * EH;
    const float* wg = a.in[29] + l * es; const float* wu = a.in[30] + l * es; const float* wd = a.in[31] + l * es;
    bf16* Wi = (bf16*)(F.ws + wsm::W_IN); bf16* Wo = (bf16*)(F.ws + wsm::W_OUT); bf16* Wgu = (bf16*)(F.ws + wsm::W_GU); bf16* Wd = (bf16*)(F.ws + wsm::W_D);
    constexpr int I_IN = 32 * 200, I_OUT = 32 * 64, I_G = 32 * 256, I_D = 32 * 256;
    constexpr int NITEMS = I_IN + I_OUT + 2 * I_G + I_D;
    for (int it = gw; it < NITEMS; it += NGW) {
        int r = it;
        if (r < I_IN) { const int kb = r / 200, nb = r % 200, n0 = nb * 32; const bool isq = (n0 >= OFF_BQ && n0 < OFF_BK) || (n0 >= OFF_CQ && n0 < OFF_CK);
            if (F8IN(l)) cvt_tile8(w_in, INC, D, kb * 64, n0, (unsigned char*)Wi, n0, (isq ? C2F : 1.f) * pg8::F8_WGT, scr, F.lane); else cvt_tile(w_in, INC, D, kb * 64, n0, Wi, n0, isq ? C2F : 1.f, scr, F.lane); continue; } r -= I_IN;
        if (r < I_OUT) { const int kb = r / 64, nb = r % 64; if (F8OUT(l)) cvt_tile8(w_out, D, D, kb * 64, nb * 32, (unsigned char*)Wo, nb * 32, pg8::F8_WGT, scr, F.lane); else cvt_tile(w_out, D, D, kb * 64, nb * 32, Wo, nb * 32, 1.f, scr, F.lane); continue; } r -= I_OUT;
        if (r < 2 * I_G) { const int up = r >= I_G; if (up) r -= I_G; const int e = r >> 8, q = r & 255, kb = q >> 3, nb = q & 7, n0 = nb * 32;
            if ((F8_MOE_MASK >> l) & 1) cvt_tile8((up ? wu : wg) + (size_t)e * D * EH, EH, D, kb * 64, n0, (unsigned char*)Wgu, e * 512 + 256 * (n0 >> 7) + (n0 & 127) + (up ? 128 : 0), pg8::F8_WGT, scr, F.lane);
            else cvt_tile((up ? wu : wg) + (size_t)e * D * EH, EH, D, kb * 64, n0, Wgu, e * 512 + 256 * (n0 >> 7) + (n0 & 127) + (up ? 128 : 0), 1.f, scr, F.lane); continue; } r -= 2 * I_G;
        { const int e = r >> 8, q = r & 255, kb = q >> 6, nb = q & 63; cvt_tile(wd + (size_t)e * EH * D, D, EH, kb * 64, nb * 32, Wd + (size_t)e * D * EH, nb * 32, 1.f, scr, F.lane); }
    }
    bf16* Wr = (bf16*)(F.ws + wsm::WRT); const float* rg = a.in[25] + (size_t)l * D * 4; const float* re = a.in[27] + (size_t)l * D * 32;
    for (int idx = (F.vcu * 512 + F.tid); idx < 48 * 2048; idx += F.G * 512) { const int n = idx >> 11, k = idx & 2047;
        const float v = n < 4 ? rg[k * 4 + n] : (n < 36 ? re[k * 32 + n - 4] : 0.f); Wr[idx] = cvt1(v); }
    bf16* w2t = (bf16*)(F.ws + wsm::WRT + 262144); bf16* a2t = w2t + 512 * 64; bf16* g2t = a2t + 512 * 64;
    const float* w2 = a.in[8] + (size_t)l * 64 * 512; const float* a2 = a.in[10] + (size_t)l * 64 * 512; const float* g2 = a.in[11] + (size_t)l * 128 * 512;
    for (int idx = (F.vcu * 512 + F.tid); idx < 512 * 256; idx += F.G * 512) { const int ch = idx & 511, j = idx >> 9;
        if (j < 64) w2t[ch * 64 + j] = cvt1(w2[j * 512 + ch]); else if (j < 128) a2t[ch * 64 + (j - 64)] = cvt1(a2[(j - 64) * 512 + ch]); else g2t[ch * 128 + (j - 128)] = cvt1(g2[(j - 128) * 512 + ch]); }
}

__device__ __forceinline__ int grab(Frame& F, int q) {
    volatile LAS int* slot = (volatile LAS int*)(F.lds + MISC_OFF + 64);
    if (F.tid == 0) *slot = (int)__hip_atomic_fetch_add(F.ctl + wsm::CW_Q + q * 64, 1u, RLX_AGENT);
    __syncthreads();
    const int v = *slot;
    __syncthreads();
    return __builtin_amdgcn_readfirstlane(v);
}
__device__ __forceinline__ void build_pref(Frame& F, int l) {
    LAS int* pref = (LAS int*)(F.lds + TAB_OFF);
    if (F.tid == 0) { int s = 0; for (int e = 0; e < 32; ++e) { pref[e] = s; const unsigned c = __hip_atomic_load(F.ctl + wsm::CW_CNT + (l * 32 + e) * 64, RLX_AGENT); pref[40 + e] = (int)c; s += (int)((c + 255u) >> 8); } pref[32] = s; }
    __syncthreads();
}

template <bool COMBINE, bool ROUTER, bool FINAL, bool F8 = false>
__device__ __forceinline__ void norm_phase(Frame& F, const Args& a, const float* xsrc, float* xout, const float* gain, int l, int lc) {
    using namespace cfg;
    constexpr int PITCHB = 4112;
    LAS unsigned char* tile = F.lds;
    LAS float* part = (LAS float*)(F.lds + 67584);
    LAS int* pref = (LAS int*)(F.lds + TAB_OFF);
    bf16* xn = (bf16*)(F.ws + wsm::XN);
    const bf16* OB = (const bf16*)(F.ws + wsm::OB);
    const int4* tokinfo = (const int4*)(F.ws + wsm::TOKINFO);
    const int lane = F.lane, w = F.wave;
    f32x4 g4[8];
#pragma unroll
    for (int j = 0; j < 8; ++j) g4[j] = *(const f32x4*)(gain + 4 * lane + 256 * j);
    for (int pass = F.vcu; pass < M / 16; pass += F.G) {
#pragma unroll
        for (int rr = 0; rr < 2; ++rr) {
            const int rt = 2 * w + rr, row = pass * 16 + rt;
            const float* xr = xsrc + (size_t)row * D + 4 * lane;
            f32x4 v[8];
#pragma unroll
            for (int j = 0; j < 8; ++j) v[j] = *(const f32x4*)(xr + 256 * j);
            if constexpr (COMBINE) {
                const int4 ti = tokinfo[row];
                const bf16* o0 = OB + ((size_t)pref[ti.x] * 256 + ti.y) * D + 4 * lane; const bf16* o1 = OB + ((size_t)pref[ti.z] * 256 + ti.w) * D + 4 * lane;
#pragma unroll
                for (int j = 0; j < 8; ++j) { const u32x2 p0 = *(const u32x2*)(o0 + 256 * j), p1 = *(const u32x2*)(o1 + 256 * j);
                    v[j].x += __uint_as_float(p0.x << 16) + __uint_as_float(p1.x << 16); v[j].y += __uint_as_float(p0.x & 0xffff0000u) + __uint_as_float(p1.x & 0xffff0000u);
                    v[j].z += __uint_as_float(p0.y << 16) + __uint_as_float(p1.y << 16); v[j].w += __uint_as_float(p0.y & 0xffff0000u) + __uint_as_float(p1.y & 0xffff0000u); }
                if constexpr (!FINAL) {
#pragma unroll
                    for (int j = 0; j < 8; ++j) *(f32x4*)(xout + (size_t)row * D + 4 * lane + 256 * j) = v[j];
                }
            }
            float s = 0.f;
#pragma unroll
            for (int j = 0; j < 8; ++j) s += (v[j].x * v[j].x + v[j].y * v[j].y) + (v[j].z * v[j].z + v[j].w * v[j].w);
            const float rstd = rsqrtf(wave_sum(s) * (1.f / D) + 1e-6f);
#pragma unroll
            for (int j = 0; j < 8; ++j) { const f32x4 o = v[j] * rstd * g4[j];
                if constexpr (FINAL) *(f32x4*)(xout + (size_t)row * D + 4 * lane + 256 * j) = o;
                else if constexpr (F8) { *(unsigned*)((unsigned char*)xn + (size_t)row * D + 4 * lane + 256 * j) = pk4_fp8(o.x * pg8::F8_ACT, o.y * pg8::F8_ACT, o.z * pg8::F8_ACT, o.w * pg8::F8_ACT);
                    if constexpr (ROUTER) { u32x2 pk; pk.x = pk2(o.x, o.y); pk.y = pk2(o.z, o.w); *(LAS u32x2*)(tile + rt * PITCHB + (4 * lane + 256 * j) * 2) = pk; } }
                else { u32x2 pk; pk.x = pk2(o.x, o.y); pk.y = pk2(o.z, o.w);
                    *(u32x2*)(xn + (size_t)row * D + 4 * lane + 256 * j) = pk;
                    if constexpr (ROUTER) *(LAS u32x2*)(tile + rt * PITCHB + (4 * lane + 256 * j) * 2) = pk; } }
        }
        if constexpr (ROUTER) {
            __syncthreads();
            const bf16* Wr = (const bf16*)(F.ws + wsm::WRT);
            f32x4 acc[3] = {(f32x4){0.f, 0.f, 0.f, 0.f}, (f32x4){0.f, 0.f, 0.f, 0.f}, (f32x4){0.f, 0.f, 0.f, 0.f}};
#pragma unroll
            for (int s8 = 0; s8 < 8; ++s8) { const int k = 256 * w + 32 * s8 + 8 * (lane >> 4);
                const bf16x8 af = *(const LAS bf16x8*)(tile + (lane & 15) * PITCHB + k * 2);
#pragma unroll
                for (int nt = 0; nt < 3; ++nt) { const bf16x8 bfr = *(const bf16x8*)(Wr + (size_t)(16 * nt + (lane & 15)) * D + k);
                    acc[nt] = __builtin_amdgcn_mfma_f32_16x16x32_bf16(af, bfr, acc[nt], 0, 0, 0); } }
#pragma unroll
            for (int nt = 0; nt < 3; ++nt)
#pragma unroll
                for (int i = 0; i < 4; ++i) part[(w * 16 + (lane >> 4) * 4 + i) * 48 + 16 * nt + (lane & 15)] = acc[nt][i];
            __syncthreads();
            if (F.tid < 16) {
                const int m = F.tid, tok = pass * 16 + m;
                const float* bg = a.in[26] + l * 4; const float* be = a.in[28] + l * 32;
                float lg[4];
#pragma unroll
                for (int o = 0; o < 4; ++o) { float sacc = bg[o];
#pragma unroll
                    for (int ww = 0; ww < 8; ++ww) sacc += part[(ww * 16 + m) * 48 + o]; lg[o] = sacc; }
                int gi = 0; float gm = lg[0];
#pragma unroll
                for (int o = 1; o < 4; ++o) if (lg[o] > gm) { gm = lg[o]; gi = o; }
                float gs = 0.f;
#pragma unroll
                for (int o = 0; o < 4; ++o) gs += __expf(lg[o] - gm);
                const float gw = 1.f / gs;
                float el[8];
#pragma unroll
                for (int o = 0; o < 8; ++o) { float sacc = be[gi * 8 + o];
#pragma unroll
                    for (int ww = 0; ww < 8; ++ww) sacc += part[(ww * 16 + m) * 48 + 4 + gi * 8 + o]; el[o] = sacc; }
                int i1 = 0; float m1 = el[0];
#pragma unroll
                for (int o = 1; o < 8; ++o) if (el[o] > m1) { m1 = el[o]; i1 = o; }
                int i2 = 0; float m2 = -3e38f;
#pragma unroll
                for (int o = 0; o < 8; ++o) if (o != i1 && el[o] > m2) { m2 = el[o]; i2 = o; }
                const float e2x = __expf(m2 - m1); const float w1 = gw / (1.f + e2x), w2 = gw * e2x / (1.f + e2x);
                const int e1 = gi * 8 + i1, e2 = gi * 8 + i2;
                const int p1 = (int)__hip_atomic_fetch_add(F.ctl + wsm::CW_CNT + (lc * 32 + e1) * 64, 1u, RLX_AGENT);
                const int p2 = (int)__hip_atomic_fetch_add(F.ctl + wsm::CW_CNT + (lc * 32 + e2) * 64, 1u, RLX_AGENT);
                int* lists = (int*)(F.ws + wsm::LISTS); float* wl = (float*)(F.ws + wsm::WLIST);
                lists[e1 * LCAP + p1] = tok; lists[e2 * LCAP + p2] = tok; wl[e1 * LCAP + p1] = w1; wl[e2 * LCAP + p2] = w2;
                ((int4*)(F.ws + wsm::TOKINFO))[tok] = make_int4(e1, p1, e2, p2);
                ((int4*)(F.ws + wsm::ROUTE))[tok] = make_int4(e1, e2, __float_as_int(w1), __float_as_int(w2));
            }
            __syncthreads();
        }
    }
}
namespace att {
typedef float f32x16 __attribute__((ext_vector_type(16)));
typedef short s16x4 __attribute__((ext_vector_type(4)));
constexpr int L_K = 0, L_V = 16384, L_WSF = 135168, L_TAB = 137216;
__device__ __forceinline__ int crow(int r, int hi) { return (r & 3) + 8 * (r >> 2) + 4 * hi; }
__device__ __forceinline__ int t5_bucket(int rel) {
    const int ret = rel > 0 ? 16 : 0; const int n = rel < 0 ? -rel : rel; int bk;
    if (n < 8) bk = n; else if (n < 12) bk = 8; else if (n < 16) bk = 9; else if (n < 23) bk = 10; else if (n < 32) bk = 11;
    else if (n < 46) bk = 12; else if (n < 64) bk = 13; else if (n < 91) bk = 14; else bk = 15;
    return ret + bk;
}
__device__ __forceinline__ unsigned cvtpk(float lo, float hi) { return pk2(lo, hi); }
__device__ __forceinline__ void qkt(f32x16& p0, f32x16& p1, const LAS unsigned char* Kslot, const bf16x8* qr, const f32x16& c0, const f32x16& c1, int r32, int hi) {
    const LAS unsigned char* kb = Kslot + hi * 1024 + r32 * 16;
#pragma unroll
    for (int d0 = 0; d0 < 4; ++d0) {
        const bf16x8 b0 = *(const LAS bf16x8*)(kb + d0 * 2048);
        const bf16x8 b1 = *(const LAS bf16x8*)(kb + d0 * 2048 + 512);
        if (d0 == 0) { p0 = __builtin_amdgcn_mfma_f32_32x32x16_bf16(b0, qr[0], c0, 0, 0, 0); p1 = __builtin_amdgcn_mfma_f32_32x32x16_bf16(b1, qr[0], c1, 0, 0, 0); }
        else { p0 = __builtin_amdgcn_mfma_f32_32x32x16_bf16(b0, qr[d0], p0, 0, 0, 0); p1 = __builtin_amdgcn_mfma_f32_32x32x16_bf16(b1, qr[d0], p1, 0, 0, 0); } }
}
__device__ __forceinline__ float rowmax(const f32x16& p0, const f32x16& p1) {
    float a = fmaxf(fmaxf(p0[0], p0[1]), p1[0]), b = fmaxf(fmaxf(p0[2], p0[3]), p1[1]); a = fmaxf(fmaxf(a, p1[2]), p1[3]);
#pragma unroll
    for (int r = 4; r < 16; r += 4) { a = fmaxf(fmaxf(a, p0[r]), p0[r + 1]); b = fmaxf(fmaxf(b, p0[r + 2]), p0[r + 3]); a = fmaxf(fmaxf(a, p1[r]), p1[r + 1]); b = fmaxf(fmaxf(b, p1[r + 2]), p1[r + 3]); }
    const float m = fmaxf(a, b);
    auto rr = __builtin_amdgcn_permlane32_swap(__float_as_uint(m), __float_as_uint(m), false, false);
    return fmaxf(__uint_as_float(rr[0]), __uint_as_float(rr[1]));
}
template <int ND>
__device__ __forceinline__ void pv(f32x16* o, int vb, bf16x8 pa0, bf16x8 pa1, bf16x8 pa2, bf16x8 pa3) {
#pragma unroll
    for (int d0 = 0; d0 < ND; ++d0) { s16x4 lo[4], hi[4];
#pragma unroll
        for (int ks = 0; ks < 4; ++ks) {
            asm volatile("ds_read_b64_tr_b16 %0,%1 offset:%c2" : "=&v"(lo[ks]) : "v"(vb), "i"(d0 * 4096 + ks * 1024) : "memory");
            asm volatile("ds_read_b64_tr_b16 %0,%1 offset:%c2" : "=&v"(hi[ks]) : "v"(vb), "i"(d0 * 4096 + ks * 1024 + 512) : "memory"); }
        asm volatile("s_waitcnt lgkmcnt(0)" ::: "memory"); __builtin_amdgcn_sched_barrier(0);
#define ATT_PK(k) (bf16x8){lo[k][0], lo[k][1], lo[k][2], lo[k][3], hi[k][0], hi[k][1], hi[k][2], hi[k][3]}
        o[d0] = __builtin_amdgcn_mfma_f32_32x32x16_bf16(pa0, ATT_PK(0), o[d0], 0, 0, 0);
        o[d0] = __builtin_amdgcn_mfma_f32_32x32x16_bf16(pa1, ATT_PK(1), o[d0], 0, 0, 0);
        o[d0] = __builtin_amdgcn_mfma_f32_32x32x16_bf16(pa2, ATT_PK(2), o[d0], 0, 0, 0);
        o[d0] = __builtin_amdgcn_mfma_f32_32x32x16_bf16(pa3, ATT_PK(3), o[d0], 0, 0, 0);
#undef ATT_PK
    }
}
#define ATT_WAIT_BAR(N) asm volatile("s_waitcnt vmcnt(" #N ") lgkmcnt(0)\n\ts_barrier" ::: "memory")
#ifndef PROBE_ATT
#define PROBE_ATT -1
#endif
#define ATT_NOW() __builtin_amdgcn_s_memrealtime()
#define ATT_SBAR() __builtin_amdgcn_sched_barrier(0)
#define ATT_PIN(x) asm volatile("" : "+v"(x))
#define ATT_MFMA(a, b, c) __builtin_amdgcn_mfma_f32_32x32x16_bf16(a, b, c, 0, 0, 0)
typedef const LAS char* lds_cptr;
typedef short v4i16_t __attribute__((ext_vector_type(4)));
__device__ __forceinline__ void glds16(const void* g, unsigned lds_base) {
    unsigned sv; asm volatile("s_mov_b32 %0, m0\n\ts_mov_b32 m0, %2\n\ts_nop 0\n\tglobal_load_lds_dwordx4 %1, off\n\ts_mov_b32 m0, %0" : "=&s"(sv) : "v"(g), "s"(lds_base) : "memory"); }
__device__ __forceinline__ void kload2(bf16x8* kf, lds_cptr kp, int d0) { kf[2 * d0] = *(const LAS bf16x8*)(kp + d0 * 2048); kf[2 * d0 + 1] = *(const LAS bf16x8*)(kp + d0 * 2048 + 512); }
__device__ __forceinline__ s16x4 vtr(lds_cptr q) { return __builtin_bit_cast(s16x4, __builtin_amdgcn_ds_read_tr16_b64_v4i16((LAS v4i16_t*)q)); }

template <int MODE>
__device__ __forceinline__ void attn_unit(Frame& F, const Args& a, const int l, const int b, const int hh, const int qb) {
    using namespace cfg;
    constexpr int ND = MODE ? 4 : 2, VSLOT = ND * 4096, NV = MODE ? 2 : 1, EPG = 8 / ND, KRD0 = MODE ? 8 : 2, VLEAD = 5;
    constexpr int NS = 4, LK = 0, LV = NS * 8192, LQ = 98304;
    constexpr float THR = 8.f;
    unsigned long long pu0_ = 0; if (PROBE_ATT == 3) pu0_ = ATT_NOW();
    const int lane = F.lane, r32 = lane & 31, hi = lane >> 5, wid = F.wave;
    const bf16* p = (const bf16*)(F.ws + wsm::P);
    bf16* y = (bf16*)(F.ws + wsm::Y);
    float* O1s = (float*)(F.ws + wsm::XN);
    LAS unsigned char* lds = F.lds;
    LAS float* wsf = (LAS float*)(lds + L_WSF) + wid * 64;
    LAS float* tab = (LAS float*)(lds + L_TAB);
    const size_t rowbase = (size_t)b * SEQ;
    if (F.tid < 320) { const int i = F.tid; float v;
        if (MODE == 0) { int d = i - 64; d = d < -128 ? -128 : (d > 128 ? 128 : d); v = a.in[17][(size_t)(l * 8 + hh) * 257 + d + 128]; }
        else v = a.in[18][t5_bucket(-(i - 64)) * 4 + hh];
        tab[i] = v * LOG2E; }
    const int t0 = MODE == 0 ? (4 * qb - 8 > 0 ? 4 * qb - 8 : 0) : 0, t1 = 4 * qb + 3;
    const int cw = 4 * qb + (wid >> 1);
    const int va = MODE == 0 ? (cw - 8 > 0 ? cw - 8 : 0) : 0, vb = cw;
    const int q0w = qb * 256 + 32 * wid, myq = q0w + r32;
    const unsigned lds0 = (unsigned)(uintptr_t)lds;
    const lds_cptr kp0 = (lds_cptr)lds + LK + hi * 1024 + r32 * 16;
    const lds_cptr vp0 = (lds_cptr)lds + LV + ((lane >> 4) & 1) * 32 + (lane & 3) * 8 + (4 * hi + ((lane & 15) >> 2)) * 64;
#pragma unroll 1
    for (int sub = 0; sub < (MODE ? 2 : 1); ++sub) {
        const int qcol = MODE ? OFF_CQ + (hh * 2 + sub) * 64 : OFF_BQ + hh * 64;
        const int kcol = MODE ? OFF_CK + (hh * 2 + sub) * 64 : OFF_BK + hh * 64;
        const int vcol = MODE ? OFF_CV + hh * 128 : OFF_BV + hh * 64;
        const bf16* Kh = p + rowbase * INC + kcol; const bf16* Vh = p + rowbase * INC + vcol;
        const bf16* ksrc = Kh + (size_t)lane * INC + wid * 8;
        const bf16* vsrc0 = Vh + (size_t)(16 * (wid & 3) + (lane >> 2)) * INC + (wid >> 2) * 32 + (lane & 3) * 8;
        const unsigned kdst = lds0 + LK + wid * 1024, vdst = lds0 + LV + wid * 1024;
#define ATT_DMA_K(t, s) glds16(ksrc + (size_t)(t) * 64 * INC, (unsigned)__builtin_amdgcn_readfirstlane(kdst + (s) * 8192))
#define ATT_DMA_V(t, s) do { glds16(vsrc0 + (size_t)(t) * 64 * INC, (unsigned)__builtin_amdgcn_readfirstlane(vdst + (s) * VSLOT)); \
        if (MODE) glds16(vsrc0 + (size_t)(t) * 64 * INC + 64, (unsigned)__builtin_amdgcn_readfirstlane(vdst + (s) * VSLOT + 8192)); } while (0)
        { const bf16* Qw = p + (rowbase + q0w) * INC + qcol + (size_t)r32 * INC + hi * 8;
#pragma unroll
          for (int d0 = 0; d0 < 4; ++d0) glds16(Qw + d0 * 16, (unsigned)__builtin_amdgcn_readfirstlane(lds0 + LQ + wid * 4096 + d0 * 1024)); }
        ATT_DMA_K(t0, 0); ATT_DMA_V(t0, 0); ATT_DMA_K(t0 + 1, 1); ATT_DMA_K(t0 + 2, 2); ATT_DMA_K(t0 + 3, 3); ATT_DMA_V(t0 + 1, 1);
        float mhat = 0.f, l_reg = 0.f;
        f32x16 o[ND];
#pragma unroll
        for (int d0 = 0; d0 < ND; ++d0)
#pragma unroll
            for (int r = 0; r < 16; ++r) o[d0][r] = 0.f;
        { LAS unsigned char* z = lds + LV + 3 * VSLOT + F.tid * (VSLOT / 512);
#pragma unroll
          for (int i = 0; i < VSLOT / 512 / 16; ++i) *(LAS u32x4*)(z + 16 * i) = (u32x4){0u, 0u, 0u, 0u}; }
        if (MODE) { ATT_WAIT_BAR(4); } else { ATT_WAIT_BAR(3); }
        const float cf = tab[300];
        bf16x8 qr[4];
#pragma unroll
        for (int d0 = 0; d0 < 4; ++d0) qr[d0] = *(const LAS bf16x8*)(lds + LQ + wid * 4096 + d0 * 1024 + lane * 16);
        bf16x8 kf[8];
#pragma unroll
        for (int d0 = 0; d0 < 4; ++d0) kload2(kf, kp0, d0);
        asm volatile("s_waitcnt lgkmcnt(0)\n\ts_barrier" ::: "memory");
        f32x16 C0, C1; u32x4 pw[4];
#pragma unroll
        for (int r = 0; r < 16; ++r) { C0[r] = 0.f; C1[r] = 0.f; }
#pragma unroll
        for (int g = 0; g < 4; ++g) pw[g] = (u32x4){0u, 0u, 0u, 0u};
#define ATT_CE(e) (((e) < 16) ? C0[(e) & 15] : C1[(e) & 15])
#define ATT_CEXP(e) do { if ((e) < 16) C0[(e) & 15] = __builtin_amdgcn_exp2f(C0[(e) & 15]); else C1[(e) & 15] = __builtin_amdgcn_exp2f(C1[(e) & 15]); } while (0)
#define ATT_VRD(ks, d0) do { vlo[(ks) * ND + (d0)] = vtr(vpp + (d0) * 4096 + (ks) * 1024); vhi[(ks) * ND + (d0)] = vtr(vpp + (d0) * 4096 + (ks) * 1024 + 512); } while (0)
#define ATT_VRDF(f) ATT_VRD((f) / ND, (f) % ND)
#define ATT_VFR(i) (bf16x8){vlo[i][0], vlo[i][1], vlo[i][2], vlo[i][3], vhi[i][0], vhi[i][1], vhi[i][2], vhi[i][3]}
#define ATT_PAF(g) __builtin_bit_cast(bf16x8, pw[g])
        unsigned long long pl0_ = 0; if (PROBE_ATT == 2) pl0_ = ATT_NOW(); if (PROBE_ATT == 4) pl0_ = __builtin_amdgcn_s_memtime();
#pragma unroll 1
        for (int t = t0; t <= t1; ++t) {
            const bool gk = (t + 4 <= t1), gv = (t + 2 <= t1);
            const int s_cur = (t - t0) & 3, s_prev = (t - t0 - 1) & 3, s_next = (t - t0 + 1) & 3, s_nn = (t - t0 + 2) & 3;
            const lds_cptr vpp = vp0 + s_prev * VSLOT;
            const lds_cptr kpn = kp0 + s_next * 8192;
            bool resc = false;
            ATT_SBAR();
            {
                s16x4 vlo[4 * ND], vhi[4 * ND];
                const bool msk = (t > vb) || (t < va);
                const bool nearb = !msk && (q0w - (t * 64 + 63)) < 128;
                if (nearb) {
                    const LAS float* tb = tab + (myq - t * 64 - 4 * hi + 64 - 27 - 32);
#pragma unroll
                    for (int r = 0; r < 16; ++r) { C1[r] = tb[27 - ((r & 3) + 8 * (r >> 2))] - mhat; C0[r] = tb[32 + 27 - ((r & 3) + 8 * (r >> 2))] - mhat; }
                    ATT_SBAR();
                    C0 = ATT_MFMA(kf[0], qr[0], C0); ATT_SBAR(); C1 = ATT_MFMA(kf[1], qr[0], C1); ATT_SBAR();
                } else {
                    f32x16 cfm; const float cfv = msk ? -1e30f : cf - mhat;
#pragma unroll
                    for (int r = 0; r < 16; ++r) cfm[r] = cfv;
                    ATT_SBAR();
                    C0 = ATT_MFMA(kf[0], qr[0], cfm); ATT_SBAR(); C1 = ATT_MFMA(kf[1], qr[0], cfm); ATT_SBAR();
                }
#pragma unroll
                for (int i = 2; i < 8; ++i) {
                    if (i >= 8 - VLEAD) { ATT_VRDF(i - (8 - VLEAD)); ATT_SBAR(); }
                    if (i & 1) C1 = ATT_MFMA(kf[i], qr[i >> 1], C1); else C0 = ATT_MFMA(kf[i], qr[i >> 1], C0);
                    ATT_SBAR();
                }
                if (gk) ATT_DMA_K(t + 4, s_cur);
                if (gv) ATT_DMA_V(t + 2, s_nn);
                const float rm = rowmax(C0, C1);
                const bool firstv = (t == va);
                if (__builtin_expect(firstv || __any(rm > THR), 0)) {
                    const float dl = firstv ? rm : fmaxf(rm, 0.f); mhat += dl;
#pragma unroll
                    for (int r = 0; r < 16; ++r) { C0[r] -= dl; C1[r] -= dl; }
                    const float f = firstv ? 1.f : __builtin_amdgcn_exp2f(-dl); l_reg *= f; if (hi == 0) wsf[r32] = f; resc = !firstv;
                }
                ATT_SBAR();
                float sa = 0.f, sb = 0.f;
#pragma unroll
                for (int m = 0; m < 4 * ND; ++m) {
                    const int g = m / ND, d0 = m % ND;
                    if (m + VLEAD < 4 * ND) { ATT_VRDF(m + VLEAD); ATT_SBAR(); }
                    if (m >= KRD0 && m < KRD0 + 4) { kload2(kf, kpn, m - KRD0); ATT_SBAR(); }
                    o[d0] = ATT_MFMA(ATT_PAF(g), ATT_VFR(g * ND + d0), o[d0]);
#pragma unroll
                    for (int jj = 0; jj < EPG; ++jj) ATT_CEXP(8 * g + EPG * d0 + jj);
                    if (g >= 1) {
#pragma unroll
                        for (int jj = 0; jj < EPG; jj += 2) { const int e = 8 * (g - 1) + EPG * d0 + jj; sa += ATT_CE(e); sb += ATT_CE(e + 1); pw[g - 1][(EPG * d0 + jj) >> 1] = pk2(ATT_CE(e), ATT_CE(e + 1)); }
                        ATT_PIN(pw[g - 1]); ATT_PIN(sa); ATT_PIN(sb);
                    }
                    if (g < 2) ATT_PIN(C0); else ATT_PIN(C1);
                    ATT_SBAR();
                }
#pragma unroll
                for (int jj = 0; jj < 8; jj += 2) { const int e = 24 + jj; sa += ATT_CE(e); sb += ATT_CE(e + 1); pw[3][jj >> 1] = pk2(ATT_CE(e), ATT_CE(e + 1)); }
                l_reg += sa + sb;
            }
            ATT_SBAR();
            unsigned long long pw0_ = 0; if (PROBE_ATT == 0) pw0_ = ATT_NOW();
            { const int dleft = t1 - t;
              if (dleft >= 4) { if (MODE) { ATT_WAIT_BAR(6); } else { ATT_WAIT_BAR(4); } }
              else if (dleft == 3) { if (MODE) { ATT_WAIT_BAR(5); } else { ATT_WAIT_BAR(3); } }
              else if (dleft == 2) { if (MODE) { ATT_WAIT_BAR(4); } else { ATT_WAIT_BAR(2); } }
              else if (dleft == 1) { if (MODE) { ATT_WAIT_BAR(2); } else { ATT_WAIT_BAR(1); } }
              else { ATT_WAIT_BAR(0); } }
            if (PROBE_ATT == 0) F.pacc += ATT_NOW() - pw0_;
            if (resc) {
#pragma unroll
                for (int r = 0; r < 16; ++r) { const float fr = wsf[crow(r, hi)];
#pragma unroll
                    for (int d0 = 0; d0 < ND; ++d0) o[d0][r] *= fr; }
            }
        }
        if (PROBE_ATT == 2) F.pacc += ATT_NOW() - pl0_; if (PROBE_ATT == 4) F.pacc += (__builtin_amdgcn_s_memtime() - pl0_) / 100;
        {
            const lds_cptr vpp = vp0 + ((t1 - t0) & 3) * VSLOT;
            s16x4 vlo[4 * ND], vhi[4 * ND];
#pragma unroll
            for (int ks = 0; ks < 4; ++ks) {
#pragma unroll
                for (int d0 = 0; d0 < ND; ++d0) ATT_VRD(ks, d0);
#pragma unroll
                for (int d0 = 0; d0 < ND; ++d0) o[d0] = ATT_MFMA(ATT_PAF(ks), ATT_VFR(ks * ND + d0), o[d0]);
            }
            asm volatile("s_waitcnt lgkmcnt(0)\n\ts_barrier" ::: "memory");
        }
#undef ATT_DMA_K
#undef ATT_DMA_V
#undef ATT_CE
#undef ATT_CEXP
#undef ATT_VRD
#undef ATT_VFR
#undef ATT_VRDF
#undef ATT_PAF
        float lh = l_reg;
        int ln = lane; asm volatile("" : "+v"(ln));
        const int e32 = ln & 31, ehi = ln >> 5;
        { auto rr = __builtin_amdgcn_permlane32_swap(__float_as_uint(lh), __float_as_uint(lh), false, false); lh = __uint_as_float(rr[0]) + __uint_as_float(rr[1]); }
        if (ehi == 0) wsf[32 + e32] = lh;
        LDS_WAIT();
        constexpr int SP = ND * 128 + 16;
        LAS unsigned char* stg = lds + wid * (32 * SP);
#pragma unroll
        for (int r = 0; r < 16; ++r) { const float rl = __builtin_amdgcn_rcpf(wsf[32 + crow(r, ehi)]);
#pragma unroll
            for (int d0 = 0; d0 < ND; ++d0) *(LAS float*)(stg + crow(r, ehi) * SP + (d0 * 32 + e32) * 4) = o[d0][r] * rl; }
        LDS_WAIT();
        const size_t tok0 = rowbase + (size_t)(qb * 256 + 32 * wid);
        if (MODE == 0) {
#pragma unroll 4
            for (int row = 0; row < 32; ++row) { const float v = *(const LAS float*)(stg + row * SP + ln * 4);
                if (F8OUT(l)) ((unsigned char*)y)[(tok0 + row) * D + 512 + hh * 64 + ln] = (unsigned char)(pk2_fp8(v * F8_Y, 0.f) & 0xffu); else y[(tok0 + row) * D + 512 + hh * 64 + ln] = cvt1(v); }
        } else if (sub == 0) {
#pragma unroll 4
            for (int row = 0; row < 32; ++row) { const f32x2 v = *(const LAS f32x2*)(stg + row * SP + ln * 8); *(f32x2*)(O1s + ((tok0 + row) * 4 + hh) * 128 + 2 * ln) = v; }
        } else {
            const float lam_init = l == 0 ? 0.2f : (float)(0.8 - 0.6 * 0.7408182206817179);
            const float lam = __expf(wave_sum(a.in[19][l * 64 + ln] * a.in[20][l * 64 + ln])) - __expf(wave_sum(a.in[21][l * 64 + ln] * a.in[22][l * 64 + ln])) + lam_init;
            const float* sw = a.in[23] + l * 128;
            const float sw0 = sw[2 * ln] * (1.f - lam_init), sw1 = sw[2 * ln + 1] * (1.f - lam_init);
#pragma unroll 2
            for (int row = 0; row < 32; ++row) { const f32x2 v2 = *(const LAS f32x2*)(stg + row * SP + ln * 8); const f32x2 o1 = *(const f32x2*)(O1s + ((tok0 + row) * 4 + hh) * 128 + 2 * ln);
                const float v0 = o1.x - lam * v2.x, v1 = o1.y - lam * v2.y;
                const float ms = wave_sum(v0 * v0 + v1 * v1);
                const float rs = rsqrtf(ms * (1.f / 128.f) + 1e-5f);
                if (F8OUT(l)) *(unsigned short*)((unsigned char*)y + (tok0 + row) * D + 1024 + hh * 128 + 2 * ln) = (unsigned short)pk2_fp8(v0 * rs * sw0 * F8_Y, v1 * rs * sw1 * F8_Y);
                else *(unsigned*)(y + (tok0 + row) * D + 1024 + hh * 128 + 2 * ln) = pk2(v0 * rs * sw0, v1 * rs * sw1); }
        }
        asm volatile("s_waitcnt vmcnt(0) lgkmcnt(0)\n\ts_barrier" ::: "memory");
    }
    if (PROBE_ATT == 3) F.pacc += ATT_NOW() - pu0_;
}

__device__ __forceinline__ void conv_items(Frame& F, const Args& a, const int l, const int start, const int stride) {
    using namespace cfg;
    const bf16* p = (const bf16*)(F.ws + wsm::P); bf16* y = (bf16*)(F.ws + wsm::Y);
    const float* cw = a.in[24] + l * 3 * 512;
    for (int it = start; it < M * 64; it += stride) {
        const int tok = it >> 6, cg = (it & 63) * 8, t = tok & (SEQ - 1);
        const bf16* r0 = p + (size_t)tok * INC + OFF_D + cg;
        const u32x4 bg = *(const u32x4*)r0;
        u32x4 c0 = *(const u32x4*)(r0 + 512), h0 = *(const u32x4*)(r0 + 1024);
        u32x4 c1 = (u32x4){0, 0, 0, 0}, h1 = c1, c2 = c1, h2 = c1;
        if (t >= 1) { c1 = *(const u32x4*)(r0 - INC + 512); h1 = *(const u32x4*)(r0 - INC + 1024); }
        if (t >= 2) { c2 = *(const u32x4*)(r0 - 2 * INC + 512); h2 = *(const u32x4*)(r0 - 2 * INC + 1024); }
        unsigned ow[4];
#pragma unroll
        for (int j = 0; j < 4; ++j) {
            float res[2];
#pragma unroll
            for (int e = 0; e < 2; ++e) {
                const int ch = cg + 2 * j + e;
#define ATT_UP(w) (e ? __uint_as_float((w) & 0xffff0000u) : __uint_as_float((w) << 16))
                const float u0 = ATT_UP(c0[j]) * ATT_UP(h0[j]), u1 = ATT_UP(c1[j]) * ATT_UP(h1[j]), u2 = ATT_UP(c2[j]) * ATT_UP(h2[j]);
                res[e] = ATT_UP(bg[j]) * (cw[ch] * u2 + cw[512 + ch] * u1 + cw[1024 + ch] * u0);
#undef ATT_UP
            }
            ow[j] = (F8OUT(l)) ? pk2_fp8(res[0] * F8_Y, res[1] * F8_Y) : pk2(res[0], res[1]);
        }
        if (F8OUT(l)) *(u32x2*)((unsigned char*)y + (size_t)tok * D + 1536 + cg) = (u32x2){ow[0] | (ow[1] << 16), ow[2] | (ow[3] << 16)};
        else *(u32x4*)(y + (size_t)tok * D + 1536 + cg) = (u32x4){ow[0], ow[1], ow[2], ow[3]};
    }
}
}
namespace rw {
constexpr int PB = 144, PB2 = 272;
constexpr int SLOT = 9216;
constexpr int R0 = 0, R1B = 49152;
constexpr int O_P0 = 0, O_P0T = 9216, O_AAK = 18432, O_ARB = 27648, O_ARK = 36864;
constexpr int O_SEG = R1B + 9 * SLOT, O_BON = O_SEG + 2048;
constexpr size_t UNIT_BYTES = 49152;
constexpr size_t WL_OFF = (size_t)4096 * UNIT_BYTES;
#define RW_S(i) (R1B + (i) * SLOT)

__device__ __forceinline__ bf16x8 ldfrag(const LAS unsigned char* base, int pitch, int row0, int lane, int s) {
    return *(const LAS bf16x8*)(base + (row0 + (lane & 15)) * pitch + (32 * s + 8 * (lane >> 4)) * 2);
}
template <int KS>
__device__ __forceinline__ f32x4 tile_mm(f32x4 acc, const LAS unsigned char* X, int px, int m0, const LAS unsigned char* Y, int py, int n0, int lane) {
#pragma unroll
    for (int s = 0; s < KS; ++s) acc = __builtin_amdgcn_mfma_f32_16x16x32_bf16(ldfrag(Y, py, n0, lane, s), ldfrag(X, px, m0, lane, s), acc, 0, 0, 0);
    return acc;
}
__device__ __forceinline__ void st_rm(LAS unsigned char* base, int pitch, int m, int n0, f32x4 v) {
    u32x2 w; w.x = pk2(v[0], v[1]); w.y = pk2(v[2], v[3]); *(LAS u32x2*)(base + m * pitch + n0 * 2) = w;
}
__device__ __forceinline__ void st_tr(LAS unsigned char* base, int pitch, int m, int n0, f32x4 v) {
    const unsigned p01 = pk2(v[0], v[1]), p23 = pk2(v[2], v[3]);
    *(LAS bf16*)(base + (n0 + 0) * pitch + m * 2) = (bf16)(p01 & 0xffffu); *(LAS bf16*)(base + (n0 + 1) * pitch + m * 2) = (bf16)(p01 >> 16);
    *(LAS bf16*)(base + (n0 + 2) * pitch + m * 2) = (bf16)(p23 & 0xffffu); *(LAS bf16*)(base + (n0 + 3) * pitch + m * 2) = (bf16)(p23 >> 16);
}
__device__ __forceinline__ f32x4 ld_rm(const LAS unsigned char* base, int pitch, int m, int n0) {
    const u32x2 w = *(const LAS u32x2*)(base + m * pitch + n0 * 2);
    return (f32x4){__uint_as_float(w.x << 16), __uint_as_float(w.x & 0xffff0000u), __uint_as_float(w.y << 16), __uint_as_float(w.y & 0xffff0000u)};
}
__device__ __forceinline__ void unpack8(const u32x4 w, float* f) {
#pragma unroll
    for (int j = 0; j < 4; ++j) { f[2 * j] = __uint_as_float(w[j] << 16); f[2 * j + 1] = __uint_as_float(w[j] & 0xffff0000u); }
}
__device__ __forceinline__ u32x4 pack8(const float* f) { return (u32x4){pk2(f[0], f[1]), pk2(f[2], f[3]), pk2(f[4], f[5]), pk2(f[6], f[7])}; }
__device__ __forceinline__ float sigm(float x) { return __builtin_amdgcn_rcpf(1.f + __expf(-x)); }
#define RW_BAR() do { asm volatile("s_waitcnt lgkmcnt(0)" ::: "memory"); __builtin_amdgcn_s_barrier(); asm volatile("" ::: "memory"); } while (0)

#ifndef PROBE_R1
#define PROBE_R1 -1
#endif
#define R1_STAMP(k) do { if (PROBE_R1 >= 0) { const unsigned long long now_ = __builtin_amdgcn_s_memrealtime(); if (PROBE_R1 == (k)) racc += now_ - rlast; rlast = now_; } } while (0)
struct R1Raw { u32x4 c[7], p[7]; };
__device__ __forceinline__ void r1_load(Frame& F, const int u, R1Raw& raw, const int tid) {
    using namespace cfg;
    const int c = u & 63, h = (u >> 6) & 7, b = u >> 9, t = tid >> 3, j0 = (tid & 7) * 8;
    const bf16* cur = (const bf16*)(F.ws + wsm::P) + ((size_t)b * SEQ + c * 64 + t) * INC + j0; const bf16* prv = cur - INC;
#pragma unroll
    for (int i = 0; i < 7; ++i) { const int col = i < 4 ? 1536 + 64 * i : (i - 4) * 512 + h * 64; raw.c[i] = *(const u32x4*)(cur + col); raw.p[i] = *(const u32x4*)(prv + col); }
}
__device__ __forceinline__ void r1_unit(Frame& F, const Args& a, const int l, const int u, const int unext, R1Raw& raw, unsigned long long& racc, int& hcur) {
    using namespace cfg;
    unsigned long long rlast = PROBE_R1 >= 0 ? __builtin_amdgcn_s_memrealtime() : 0ull;
    int tid_ = F.tid; asm volatile("" : "+v"(tid_));
    const int tid = tid_, lane = tid & 63, w = F.wave;
    const int c = u & 63, h = (u >> 6) & 7, b = u >> 9;
    unsigned lbase_ = (unsigned)(uintptr_t)F.lds; asm volatile("" : "+s"(lbase_));
    LAS unsigned char* lds = (LAS unsigned char*)(uintptr_t)lbase_;
    const bf16* p = (const bf16*)(F.ws + wsm::P);
    const bf16* w2t = (const bf16*)(F.ws + wsm::WRT + 262144);
    const bf16* a2t = w2t + 512 * 64; const bf16* g2t = a2t + 512 * 64;
    unsigned char* gout = F.ws + wsm::RW + (size_t)u * UNIT_BYTES;
    float* wl_out = (float*)(F.ws + wsm::RW + WL_OFF) + (size_t)u * 64;
    const float* mu = a.in[6] + l * 1792;
    const size_t tok0 = (size_t)b * SEQ + c * 64;
    const int t = tid >> 3, j0 = (tid & 7) * 8;
    const bool hasprev = (c > 0) || (t > 0);
    const bf16* cur = p + (tok0 + t) * INC; const bf16* prv = cur - INC;
    LAS float* WPRE = (LAS float*)(lds + 0); LAS float* APRE = (LAS float*)(lds + 16384); LAS float* GG = (LAS float*)(lds + 32768);
    LAS float* PAR = (LAS float*)(lds + 134400);
    const int mtA = w >> 1;
    bf16x8 fw[2][2], fa[2][2], fg[2][4];
    if (h != hcur) {
        RW_BAR();
        if (w < 7) { const int pidx = w == 0 ? 7 : (w == 1 ? 9 : 10 + w); PAR[w * 64 + lane] = a.in[pidx][l * 512 + h * 64 + lane]; }
        if (tid < 448) { const int col = tid < 192 ? (tid >> 6) * 512 + h * 64 + (tid & 63) : 1536 + (tid - 192); PAR[448 + tid] = mu[col]; }
        hcur = h;
        RW_BAR();
    }
    float r[8], k[8], v[8];
    {
        auto mix8 = [&](int i, int mo, float* o) { float cv[8], pv[8], m8[8]; unpack8(raw.c[i], cv);
            if (hasprev) unpack8(raw.p[i], pv); else {
#pragma unroll
                for (int j = 0; j < 8; ++j) pv[j] = 0.f; }
            *(f32x4*)m8 = *(const LAS f32x4*)(PAR + 448 + mo); *(f32x4*)(m8 + 4) = *(const LAS f32x4*)(PAR + 448 + mo + 4);
#pragma unroll
            for (int j = 0; j < 8; ++j) o[j] = cv[j] + (pv[j] - cv[j]) * m8[j]; };
        float x[8];
        mix8(0, 192 + j0, x);
#pragma unroll
        for (int j = 0; j < 8; ++j) { const float e2 = __expf(2.f * x[j]); x[j] = 1.f - 2.f * __builtin_amdgcn_rcpf(e2 + 1.f); }
        *(LAS u32x4*)(lds + RW_S(0) + t * PB + j0 * 2) = pack8(x);
        mix8(1, 256 + j0, x);
        *(LAS u32x4*)(lds + RW_S(1) + t * PB + j0 * 2) = pack8(x);
        asm volatile("" ::: "memory");
        mix8(2, 320 + j0, x);
#pragma unroll
        for (int j = 0; j < 8; ++j) x[j] = sigm(x[j]);
        *(LAS u32x4*)(lds + RW_S(2) + t * PB2 + j0 * 2) = pack8(x);
        mix8(3, 384 + j0, x);
#pragma unroll
        for (int j = 0; j < 8; ++j) x[j] = sigm(x[j]);
        *(LAS u32x4*)(lds + RW_S(2) + t * PB2 + (64 + j0) * 2) = pack8(x);
        asm volatile("" ::: "memory");
#pragma unroll
        for (int q = 0; q < 2; ++q) { const int ch = h * 64 + 16 * (2 * (w & 1) + q) + (lane & 15);
#pragma unroll
            for (int s2 = 0; s2 < 2; ++s2) { const int kq = 32 * s2 + 8 * (lane >> 4); fw[q][s2] = *(const bf16x8*)(w2t + ch * 64 + kq); fa[q][s2] = *(const bf16x8*)(a2t + ch * 64 + kq); }
#pragma unroll
            for (int s2 = 0; s2 < 4; ++s2) fg[q][s2] = *(const bf16x8*)(g2t + ch * 128 + 32 * s2 + 8 * (lane >> 4)); }
        mix8(4, j0, r); mix8(5, 64 + j0, k); mix8(6, 128 + j0, v);
        r1_load(F, unext, raw, tid);
    }
    RW_BAR(); R1_STAMP(0);
    {
#pragma unroll
        for (int q = 0; q < 2; ++q) { const int nt = 2 * (w & 1) + q;
            f32x4 aw = {0.f, 0.f, 0.f, 0.f}, aa = aw, ag = aw;
#pragma unroll
            for (int s2 = 0; s2 < 2; ++s2) {
                aw = __builtin_amdgcn_mfma_f32_16x16x32_bf16(fw[q][s2], ldfrag(lds + RW_S(0), PB, 16 * mtA, lane, s2), aw, 0, 0, 0);
                aa = __builtin_amdgcn_mfma_f32_16x16x32_bf16(fa[q][s2], ldfrag(lds + RW_S(1), PB, 16 * mtA, lane, s2), aa, 0, 0, 0); }
#pragma unroll
            for (int s2 = 0; s2 < 4; ++s2) ag = __builtin_amdgcn_mfma_f32_16x16x32_bf16(fg[q][s2], ldfrag(lds + RW_S(2), PB2, 16 * mtA, lane, s2), ag, 0, 0, 0);
            const int m = 16 * mtA + (lane & 15), n0 = 16 * nt + 4 * (lane >> 4);
            const f32x4 w04 = *(const LAS f32x4*)(PAR + n0), a04 = *(const LAS f32x4*)(PAR + 64 + n0);
#pragma unroll
            for (int i = 0; i < 4; ++i) { const float nx = -(w04[i] + aw[i]); const float sp = nx > 20.f ? nx : __logf(1.f + __expf(nx)); aw[i] = -__expf(-sp - 0.5f); aa[i] = sigm(a04[i] + aa[i]); }
            *(LAS f32x4*)(WPRE + m * 64 + n0) = aw; *(LAS f32x4*)(APRE + m * 64 + n0) = aa; *(LAS f32x4*)(GG + m * 64 + n0) = ag; }
    }
    RW_BAR(); R1_STAMP(1); R1_STAMP(2);
    {
        LAS float* SEG = (LAS float*)(lds + O_SEG);
        const int ch = tid & 63, seg = tid >> 6;
        float pf[8]; float run = 0.f;
#pragma unroll
        for (int i = 0; i < 8; ++i) { run += WPRE[(8 * seg + i) * 64 + ch]; pf[i] = run; }
        SEG[seg * 64 + ch] = run;
        RW_BAR();
        float off = 0.f;
        for (int s2 = 0; s2 < seg; ++s2) off += SEG[s2 * 64 + ch];
#pragma unroll
        for (int i = 0; i < 8; ++i) WPRE[(8 * seg + i) * 64 + ch] = off + pf[i];
    }
    RW_BAR(); R1_STAMP(3);
    {
        float kk[8], k2[8], aic[8]; float ss = 0.f, bon = 0.f;
        { float pkk[8], pka[8], prk[8];
#define R1_LD8(dst, src) do { *(f32x4*)(dst) = *(const LAS f32x4*)(src); *(f32x4*)((dst) + 4) = *(const LAS f32x4*)((src) + 4); } while (0)
          R1_LD8(aic, APRE + t * 64 + j0); R1_LD8(pkk, PAR + 128 + j0); R1_LD8(pka, PAR + 192 + j0); R1_LD8(prk, PAR + 256 + j0);
#undef R1_LD8
#pragma unroll
          for (int j = 0; j < 8; ++j) { kk[j] = k[j] * pkk[j]; ss += kk[j] * kk[j]; k2[j] = k[j] * (1.f + (aic[j] - 1.f) * pka[j]); bon += r[j] * k2[j] * prk[j]; } }
        ss += __shfl_xor(ss, 1); ss += __shfl_xor(ss, 2); ss += __shfl_xor(ss, 4);
        bon += __shfl_xor(bon, 1); bon += __shfl_xor(bon, 2); bon += __shfl_xor(bon, 4);
        const float inv = 1.f / fmaxf(sqrtf(ss), 1e-12f);
        unsigned g1w[4], g0w[4];
#pragma unroll
        for (int jp = 0; jp < 8; jp += 2) {
            const f32x2 cum = *(const LAS f32x2*)(WPRE + t * 64 + j0 + jp), tot = *(const LAS f32x2*)(WPRE + 63 * 64 + j0 + jp), gg = *(const LAS f32x2*)(GG + t * 64 + j0 + jp);
            f32x2 cpv = {0.f, 0.f}; if (t > 0) cpv = *(const LAS f32x2*)(WPRE + (t - 1) * 64 + j0 + jp);
            const f32x2 pgw = *(const LAS f32x2*)(PAR + 320 + j0 + jp), pgb = *(const LAS f32x2*)(PAR + 384 + j0 + jp);
            float xa[2], xr[2], xb[2], xk[2], xbh[2], xkh[2], g1[2], g0[2];
#pragma unroll
            for (int e = 0; e < 2; ++e) { const int j = jp + e; const float kn = kk[j] * inv, bv = kn * aic[j];
                const float e_ex = __expf(cpv[e]), e_in = __expf(cum[e]), e_ng = __expf(-cum[e]), e_tt = __expf(tot[e] - cum[e]);
                xa[e] = -kn * e_ex; xr[e] = r[j] * e_in; xb[e] = bv * e_ng; xk[e] = k2[j] * e_ng; xbh[e] = bv * e_tt; xkh[e] = k2[j] * e_tt;
                g1[e] = pgw[e] * gg[e]; g0[e] = (pgb[e] + bon * v[j]) * gg[e];
                if (t == 63) wl_out[j0 + j] = __expf(tot[e]); }
            const unsigned pa = pk2(xa[0], xa[1]), pr = pk2(xr[0], xr[1]), pb = pk2(xb[0], xb[1]), pkn = pk2(xk[0], xk[1]), pv2 = pk2(v[jp], v[jp + 1]), pbh = pk2(xbh[0], xbh[1]), pkh = pk2(xkh[0], xkh[1]);
            *(LAS unsigned*)(lds + RW_S(0) + t * PB + (j0 + jp) * 2) = pa; *(LAS unsigned*)(lds + RW_S(1) + t * PB + (j0 + jp) * 2) = pr;
            *(LAS unsigned*)(lds + RW_S(2) + t * PB + (j0 + jp) * 2) = pb; *(LAS unsigned*)(lds + RW_S(3) + t * PB + (j0 + jp) * 2) = pkn;
            *(LAS bf16*)(lds + RW_S(4) + (j0 + jp) * PB + t * 2) = (bf16)(pa & 0xffffu); *(LAS bf16*)(lds + RW_S(4) + (j0 + jp + 1) * PB + t * 2) = (bf16)(pa >> 16);
            *(LAS bf16*)(lds + RW_S(5) + (j0 + jp) * PB + t * 2) = (bf16)(pv2 & 0xffffu); *(LAS bf16*)(lds + RW_S(5) + (j0 + jp + 1) * PB + t * 2) = (bf16)(pv2 >> 16);
            *(LAS bf16*)(lds + RW_S(6) + (j0 + jp) * PB + t * 2) = (bf16)(pbh & 0xffffu); *(LAS bf16*)(lds + RW_S(6) + (j0 + jp + 1) * PB + t * 2) = (bf16)(pbh >> 16);
            *(LAS bf16*)(lds + RW_S(7) + (j0 + jp) * PB + t * 2) = (bf16)(pkh & 0xffffu); *(LAS bf16*)(lds + RW_S(7) + (j0 + jp + 1) * PB + t * 2) = (bf16)(pkh >> 16);
            g1w[jp >> 1] = pk2(g1[0], g1[1]); g0w[jp >> 1] = pk2(g0[0], g0[1]);
        }
        *(u32x4*)(gout + 32768 + (t * 64 + j0) * 2) = (u32x4){g1w[0], g1w[1], g1w[2], g1w[3]};
        *(u32x4*)(gout + 40960 + (t * 64 + j0) * 2) = (u32x4){g0w[0], g0w[1], g0w[2], g0w[3]};
    }
    RW_BAR(); R1_STAMP(4);
    {
        const int mi = w >> 1;
        const LAS unsigned char* X = lds + RW_S(mi < 2 ? 0 : 1); const LAS unsigned char* Y = lds + RW_S((mi & 1) ? 3 : 2);
        LAS unsigned char* dst = lds + (mi == 0 ? O_P0 : mi == 1 ? O_AAK : mi == 2 ? O_ARB : O_ARK);
        const bool incl = mi >= 2;
#pragma unroll
        for (int q = 0; q < 2; ++q) { const int mt = 2 * (w & 1) + q; const int m = 16 * mt + (lane & 15);
#pragma unroll
            for (int nt = 0; nt < 4; ++nt) { f32x4 acc = {0.f, 0.f, 0.f, 0.f};
                if (nt <= mt) acc = tile_mm<2>(acc, X, PB, 16 * mt, Y, PB, 16 * nt, lane);
                const int n0 = 16 * nt + 4 * (lane >> 4);
#pragma unroll
                for (int i = 0; i < 4; ++i) { const int n = n0 + i; if (!(incl ? n <= m : n < m)) acc[i] = 0.f; }
                st_rm(dst, PB, m, n0, acc);
                if (mi == 0) st_tr(lds + O_P0T, PB, m, n0, acc); } }
    }
    RW_BAR(); R1_STAMP(5);
    {
        f32x4 T[4];
        const int wr = w & 3, m = 16 * wr + (lane & 15);
        LAS unsigned char* Trm = lds + RW_S(8);
        if (w < 4) {
#pragma unroll
            for (int nt = 0; nt < 4; ++nt) { const int n0 = 16 * nt + 4 * (lane >> 4); T[nt] = ld_rm(lds + O_P0, PB, m, n0);
#pragma unroll
                for (int i = 0; i < 4; ++i) if (n0 + i == m) T[nt][i] += 1.f;
                st_rm(Trm, PB, m, n0, T[nt]); }
#pragma unroll
            for (int nt = 0; nt < 4; ++nt) { f32x4 acc = {0.f, 0.f, 0.f, 0.f}; acc = tile_mm<2>(acc, lds + RW_S(5), PB, 16 * wr, lds + O_AAK, PB, 16 * nt, lane); st_rm(lds + RW_S(0), PB, m, 16 * nt + 4 * (lane >> 4), acc); }
        } else {
#pragma unroll
            for (int nt = 0; nt < 4; ++nt) { f32x4 acc = {0.f, 0.f, 0.f, 0.f}; acc = tile_mm<2>(acc, lds + O_P0, PB, 16 * wr, lds + O_P0T, PB, 16 * nt, lane);
                const int n0 = 16 * nt + 4 * (lane >> 4); st_rm(lds + RW_S(2), PB, m, n0, acc); st_tr(lds + RW_S(3), PB, m, n0, acc); }
        }
        RW_BAR();
#pragma unroll 1
        for (int s = 1; s <= 5; ++s) {
            const int cb = s & 1;
            const LAS unsigned char* Pc = lds + (cb ? RW_S(2) : O_P0); const LAS unsigned char* PcT = lds + (cb ? RW_S(3) : O_P0T);
            LAS unsigned char* Pn = lds + (cb ? O_P0 : RW_S(2)); LAS unsigned char* PnT = lds + (cb ? O_P0T : RW_S(3));
            if (w < 4) {
                f32x4 d[4];
#pragma unroll
                for (int nt = 0; nt < 4; ++nt) { d[nt] = (f32x4){0.f, 0.f, 0.f, 0.f}; d[nt] = tile_mm<2>(d[nt], Trm, PB, 16 * wr, PcT, PB, 16 * nt, lane); }
                LDS_WAIT();
#pragma unroll
                for (int nt = 0; nt < 4; ++nt) { T[nt] += d[nt]; st_rm(Trm, PB, m, 16 * nt + 4 * (lane >> 4), T[nt]); }
            } else if (s < 5) {
#pragma unroll
                for (int nt = 0; nt < 4; ++nt) { f32x4 acc = {0.f, 0.f, 0.f, 0.f}; acc = tile_mm<2>(acc, Pc, PB, 16 * wr, PcT, PB, 16 * nt, lane);
                    const int n0 = 16 * nt + 4 * (lane >> 4); st_rm(Pn, PB, m, n0, acc); st_tr(PnT, PB, m, n0, acc); }
            }
            RW_BAR();
        }
    }
    R1_STAMP(6);
    {
        const LAS unsigned char* Z = lds + (w < 4 ? RW_S(4) : RW_S(0)); const int zr0 = 16 * (w & 3);
        f32x4 acc[4];
#pragma unroll
        for (int nt = 0; nt < 4; ++nt) { acc[nt] = (f32x4){0.f, 0.f, 0.f, 0.f}; acc[nt] = tile_mm<2>(acc[nt], Z, PB, zr0, lds + RW_S(8), PB, 16 * nt, lane); }
#pragma unroll
        for (int nt = 0; nt < 4; ++nt) st_rm(lds + RW_S(2), PB, 16 * w + (lane & 15), 16 * nt + 4 * (lane >> 4), acc[nt]);
    }
    RW_BAR(); R1_STAMP(7);
    {
        const int job = w >> 1;
        const LAS unsigned char* XTt = lds + RW_S(2); const LAS unsigned char* XTb = lds + RW_S(2) + 64 * PB;
#pragma unroll
        for (int q = 0; q < 2; ++q) { const int mt = 2 * (w & 1) + q; const int m = 16 * mt + (lane & 15);
#pragma unroll
            for (int nt = 0; nt < 4; ++nt) { f32x4 acc = {0.f, 0.f, 0.f, 0.f}; const int n0 = 16 * nt + 4 * (lane >> 4);
                if (job == 0) { acc = ld_rm(lds + RW_S(1), PB, m, n0); acc = tile_mm<2>(acc, lds + O_ARB, PB, 16 * mt, XTt, PB, 16 * nt, lane); }
                else if (job == 1) { acc = tile_mm<2>(acc, lds + O_ARB, PB, 16 * mt, XTb, PB, 16 * nt, lane); acc = tile_mm<2>(acc, lds + O_ARK, PB, 16 * mt, lds + RW_S(5), PB, 16 * nt, lane); }
                else if (job == 2) { acc = tile_mm<2>(acc, lds + RW_S(6), PB, 16 * mt, XTt, PB, 16 * nt, lane); }
                else { acc = tile_mm<2>(acc, XTb, PB, 16 * mt, lds + RW_S(6), PB, 16 * nt, lane); acc = tile_mm<2>(acc, lds + RW_S(5), PB, 16 * mt, lds + RW_S(7), PB, 16 * nt, lane); }
                u32x2 o; o.x = pk2(acc[0], acc[1]); o.y = pk2(acc[2], acc[3]);
                *(u32x2*)(gout + job * 8192 + (m * 64 + n0) * 2) = o; } }
    }
    RW_BAR(); R1_STAMP(8);
}

__device__ __forceinline__ void r2_unit(Frame& F, const Args& a, const int l, const int bh) {
    using namespace cfg;
    const int lane = F.lane, w = F.wave, wr = w & 3;
    LAS unsigned char* lds = F.lds;
    bf16* y = (bf16*)(F.ws + wsm::Y);
    const unsigned char* gin = F.ws + wsm::RW + (size_t)bh * 64 * UNIT_BYTES;
    const float* wlp = (const float*)(F.ws + wsm::RW + WL_OFF) + (size_t)bh * 64 * 64;
    const int b = bh >> 3, h = bh & 7;
    const int m = 16 * wr + (lane & 15), q4 = 4 * (lane >> 4);
    if (w < 4) {
        f32x4 S[4];
#pragma unroll
        for (int nt = 0; nt < 4; ++nt) { S[nt] = (f32x4){0.f, 0.f, 0.f, 0.f}; st_rm(lds, PB, m, 16 * nt + q4, S[nt]); }
        bf16x8 mtf[4][2], mtn[4][2]; u32x2 cf[4], cfn[4]; f32x4 wl[4], wln[4];
#define R2_LDS(c_, M_, C_, W_) do { const unsigned char* g_ = gin + (size_t)(c_) * UNIT_BYTES; _Pragma("unroll") for (int nt = 0; nt < 4; ++nt) { \
            _Pragma("unroll") for (int s_ = 0; s_ < 2; ++s_) M_[nt][s_] = *(const bf16x8*)(g_ + 16384 + ((16 * nt + (lane & 15)) * 64 + 32 * s_ + 8 * (lane >> 4)) * 2); \
            C_[nt] = *(const u32x2*)(g_ + 24576 + (m * 64 + 16 * nt + q4) * 2); W_[nt] = *(const f32x4*)(wlp + (c_) * 64 + 16 * nt + q4); } } while (0)
        R2_LDS(0, mtf, cf, wl);
#pragma unroll 1
        for (int c = 0; c < 64; ++c) {
            LAS unsigned char* Scur = lds + (c & 1) * SLOT; LAS unsigned char* Snxt = lds + ((c + 1) & 1) * SLOT;
            const int cn = c < 63 ? c + 1 : 63;
            R2_LDS(cn, mtn, cfn, wln);
            RW_BAR();
            bf16x8 sf[2];
#pragma unroll
            for (int s = 0; s < 2; ++s) sf[s] = ldfrag(Scur, PB, 16 * wr, lane, s);
#pragma unroll
            for (int nt = 0; nt < 4; ++nt) {
                f32x4 acc = S[nt] * wl[nt];
                acc[0] += __uint_as_float(cf[nt].x << 16); acc[1] += __uint_as_float(cf[nt].x & 0xffff0000u); acc[2] += __uint_as_float(cf[nt].y << 16); acc[3] += __uint_as_float(cf[nt].y & 0xffff0000u);
#pragma unroll
                for (int s = 0; s < 2; ++s) acc = __builtin_amdgcn_mfma_f32_16x16x32_bf16(mtf[nt][s], sf[s], acc, 0, 0, 0);
                S[nt] = acc; st_rm(Snxt, PB, m, 16 * nt + q4, acc); }
#pragma unroll
            for (int nt = 0; nt < 4; ++nt) { mtf[nt][0] = mtn[nt][0]; mtf[nt][1] = mtn[nt][1]; cf[nt] = cfn[nt]; wl[nt] = wln[nt]; }
        }
#undef R2_LDS
    } else {
        bf16x8 rf[2], rfn[2]; u32x2 y0[4], g1[4], g0[4], y0n[4], g1n[4], g0n[4];
#define R2_LDY(c_, R_, Y_, G1_, G0_) do { const unsigned char* g_ = gin + (size_t)(c_) * UNIT_BYTES; \
            _Pragma("unroll") for (int s_ = 0; s_ < 2; ++s_) R_[s_] = *(const bf16x8*)(g_ + (m * 64 + 32 * s_ + 8 * (lane >> 4)) * 2); \
            _Pragma("unroll") for (int nt = 0; nt < 4; ++nt) { const int o_ = (m * 64 + 16 * nt + q4) * 2; Y_[nt] = *(const u32x2*)(g_ + 8192 + o_); G1_[nt] = *(const u32x2*)(g_ + 32768 + o_); G0_[nt] = *(const u32x2*)(g_ + 40960 + o_); } } while (0)
        R2_LDY(0, rf, y0, g1, g0);
#pragma unroll 1
        for (int c = 0; c < 64; ++c) {
            LAS unsigned char* Scur = lds + (c & 1) * SLOT;
            const int cn = c < 63 ? c + 1 : 63;
            R2_LDY(cn, rfn, y0n, g1n, g0n);
            RW_BAR();
            f32x4 Y[4]; float sum = 0.f;
#pragma unroll
            for (int nt = 0; nt < 4; ++nt) {
                f32x4 acc = {__uint_as_float(y0[nt].x << 16), __uint_as_float(y0[nt].x & 0xffff0000u), __uint_as_float(y0[nt].y << 16), __uint_as_float(y0[nt].y & 0xffff0000u)};
#pragma unroll
                for (int s = 0; s < 2; ++s) acc = __builtin_amdgcn_mfma_f32_16x16x32_bf16(ldfrag(Scur, PB, 16 * nt, lane, s), rf[s], acc, 0, 0, 0);
                Y[nt] = acc; sum += (acc[0] + acc[1]) + (acc[2] + acc[3]); }
            sum += __shfl_xor(sum, 16); sum += __shfl_xor(sum, 32);
            const float mean = sum * (1.f / 64.f); float var = 0.f;
#pragma unroll
            for (int nt = 0; nt < 4; ++nt)
#pragma unroll
                for (int i = 0; i < 4; ++i) { const float d = Y[nt][i] - mean; var += d * d; }
            var += __shfl_xor(var, 16); var += __shfl_xor(var, 32);
            const float rs = rsqrtf(var * (1.f / 64.f) + 64e-5f);
            bf16* yo = y + ((size_t)b * SEQ + c * 64 + m) * D + h * 64;
#pragma unroll
            for (int nt = 0; nt < 4; ++nt) {
                const f32x4 a1 = {__uint_as_float(g1[nt].x << 16), __uint_as_float(g1[nt].x & 0xffff0000u), __uint_as_float(g1[nt].y << 16), __uint_as_float(g1[nt].y & 0xffff0000u)};
                const f32x4 a0 = {__uint_as_float(g0[nt].x << 16), __uint_as_float(g0[nt].x & 0xffff0000u), __uint_as_float(g0[nt].y << 16), __uint_as_float(g0[nt].y & 0xffff0000u)};
                const f32x4 o = (Y[nt] - mean) * rs * a1 + a0;
                if (F8OUT(l)) *(unsigned*)((unsigned char*)y + ((size_t)b * SEQ + c * 64 + m) * D + h * 64 + 16 * nt + q4) = pk4_fp8(o[0] * F8_Y, o[1] * F8_Y, o[2] * F8_Y, o[3] * F8_Y);
                else { u32x2 ow; ow.x = pk2(o[0], o[1]); ow.y = pk2(o[2], o[3]); *(u32x2*)(yo + 16 * nt + q4) = ow; } }
            rf[0] = rfn[0]; rf[1] = rfn[1];
#pragma unroll
            for (int nt = 0; nt < 4; ++nt) { y0[nt] = y0n[nt]; g1[nt] = g1n[nt]; g0[nt] = g0n[nt]; }
        }
#undef R2_LDY
    }
    RW_BAR();
}
}
struct MoeOrder {
    const LAS int* pref; int G, c, npn, mode;
    const char* A; const char* B; const int* lists; const float* wl; int esz;
    __device__ __forceinline__ bool next(int i, pg8::Unit& u) const {
        const int total = __builtin_amdgcn_readfirstlane(pref[32]) * npn;
        const long L = (long)i * G + c; if (L >= total) return false;
        int wgid = (int)L; { const int q = total / 8, r = total % 8, xcd = wgid % 8, off = wgid / 8; wgid = (xcd < r ? xcd * (q + 1) : r * (q + 1) + (xcd - r) * q) + off; }
        const int panel = wgid / npn, pn = wgid % npn;
        int e = 0;
        for (int k = 1; k < 32; ++k) { const int pk = __builtin_amdgcn_readfirstlane(pref[k]); if (pk <= panel) e = k; }
        const int tl = panel - __builtin_amdgcn_readfirstlane(pref[e]);
        u.pm = panel; u.pn = pn;
        if (mode == 0) { u.a = A; u.b = B + ((size_t)e * 512 + (size_t)pn * 256) * 2048 * esz; u.rows = lists + e * LCAP + tl * 256; const int rem = __builtin_amdgcn_readfirstlane(pref[40 + e]) - tl * 256; u.nvalid = rem < 256 ? rem : 256; u.wrow = wl + e * LCAP + tl * 256; }
        else { u.a = A + (size_t)panel * 256 * 256 * 2; u.b = B + ((size_t)e * 2048 + (size_t)pn * 256) * 256 * 2; u.rows = nullptr; u.nvalid = 256; u.wrow = nullptr; }
        return true;
    }
};

#define IN(k) (lo <= (k) && (k) < hi)
#define SEAM(k) do { if (IN(k) && IN((k) + 1)) xcd_barrier(bar); } while (0)
#ifndef DUP_PHASE
#define DUP_PHASE -1
#endif
template <int l> __device__ __forceinline__ void ph_n1(Frame& F, const Args& args) {
    using namespace cfg; float* xo = args.out; const float* xin = (l == 0) ? args.in[0] : xo;
    convert_phase(F, args, l);
    if (l == 0) norm_phase<false, false, false, F8IN(l)>(F, args, xin, nullptr, args.in[3] + l * D, l, l);
    else { build_pref(F, l - 1); norm_phase<true, false, false, F8IN(l)>(F, args, xin, xo, args.in[3] + l * D, l, l); }
}
template <int l> __device__ __forceinline__ void ph_g1(Frame& F, const Args& args) {
    using namespace cfg;
    constexpr int ESZ = F8IN(l) ? 1 : 2;
    pg8::StaticOrder S; S.init(F.ws + wsm::XN, F.ws + wsm::W_IN, M, INC, D, F.G, (int)blockIdx.x, ESZ);
    pg8::EpiBf16 E{(bf16*)(F.ws + wsm::P), INC, ESZ == 1 ? pg8::F8_INV : 1.f};
    pg8::gemm_phase<pg8::EpiBf16, pg8::StaticOrder, false, ESZ>(F.lds, D, S, E);
}
template <int l> __device__ __forceinline__ void ph_m1(Frame& F, const Args& args, unsigned long long& racc) {
    { int hcur = -1; rw::R1Raw raw;
      auto unit_of = [&](int i) { return (F.G == 256) ? ((F.vcu >> 2) << 6) + ((F.vcu & 3) << 4) + i : F.vcu + i * F.G; };
      if (unit_of(0) < 4096) rw::r1_load(F, unit_of(0), raw, F.tid);
      for (int i = 0; unit_of(i) < 4096 && i * F.G < 4096; ++i) { const int u = unit_of(i); const int un = ((i + 1) * F.G < 4096 && unit_of(i + 1) < 4096) ? unit_of(i + 1) : u; rw::r1_unit(F, args, l, u, un, raw, racc, hcur); } }

    for (int u = F.vcu; u < 1024; u += F.G) { const int b = u >> 7, hh = (u >> 4) & 7, qb = ((u & 15) + (u >> 8) * 4) & 15; att::attn_unit<0>(F, args, l, b, hh, qb); }
    if (DUP_PHASE == 21 + 100 * l) { for (int u = F.vcu; u < 1024; u += F.G) { const int b = u >> 7, hh = (u >> 4) & 7, qb = ((u & 15) + (u >> 8) * 4) & 15; att::attn_unit<0>(F, args, l, b, hh, qb); } }
    att::conv_items(F, args, l, F.vcu * 512 + F.tid, F.G * 512);
    if (DUP_PHASE == 22 + 100 * l) att::conv_items(F, args, l, F.vcu * 512 + F.tid, F.G * 512);
}
template <int l> __device__ __forceinline__ void ph_m2(Frame& F, const Args& args) {
    for (;;) { const int it = grab(F, l); if (it >= 64 + 512) break;
        if (it < 64) rw::r2_unit(F, args, l, it);
        else { const int j = it - 64, qb = 15 - (j >> 5), b = (j & 31) >> 2, hh = j & 3; att::attn_unit<1>(F, args, l, b, hh, qb); } }
    if (DUP_PHASE == 8 * l + 3) { __syncthreads();
    for (;;) { const int it = grab(F, l + 2); if (it >= 64 + 512) break;
        if (it < 64) rw::r2_unit(F, args, l, it);
        else { const int j = it - 64, qb = 15 - (j >> 5), b = (j & 31) >> 2, hh = j & 3; att::attn_unit<1>(F, args, l, b, hh, qb); } } }
    if (DUP_PHASE == 30 + 100 * l) { if (F.vcu < 64) rw::r2_unit(F, args, l, F.vcu); }
    if (DUP_PHASE == 31 + 100 * l) { for (int u = F.vcu; u < 512; u += F.G) { const int b = u >> 6, hh = (u >> 4) & 3, qb = (u < 256) ? (u & 15) : 15 - (u & 15); att::attn_unit<1>(F, args, l, b, hh, qb); } }
}
template <int l> __device__ __forceinline__ void ph_g2(Frame& F, const Args& args) {
    using namespace cfg; float* xo = args.out; const float* xin = (l == 0) ? args.in[0] : xo;
    constexpr int ESZ = F8OUT(l) ? 1 : 2;
    pg8::StaticOrder S; S.init(F.ws + wsm::Y, F.ws + wsm::W_OUT, M, D, D, F.G, (int)blockIdx.x, ESZ);
    pg8::EpiResF32 E{xin, xo, D, ESZ == 1 ? 1.f / (F8_Y * pg8::F8_WGT) : 1.f};
    pg8::gemm_phase<pg8::EpiResF32, pg8::StaticOrder, false, ESZ>(F.lds, D, S, E);
}
template <int l> __device__ __forceinline__ void ph_n2(Frame& F, const Args& args) { using namespace cfg;
    if (DUP_PHASE == 8 * l + 5) norm_phase<false, true, false>(F, args, args.out, nullptr, args.in[4] + l * D, l, 2);
    norm_phase<false, true, false, ((F8_MOE_MASK >> l) & 1) != 0>(F, args, args.out, nullptr, args.in[4] + l * D, l, l); }
template <int l> __device__ __forceinline__ void ph_e1(Frame& F, const Args& args) {
    using namespace cfg;
    build_pref(F, l);
    constexpr int ESZ = ((F8_MOE_MASK >> l) & 1) ? 1 : 2;
    MoeOrder S{(const LAS int*)(F.lds + TAB_OFF), F.G, (int)blockIdx.x, 2, 0, (const char*)(F.ws + wsm::XN), (const char*)(F.ws + wsm::W_GU), (const int*)(F.ws + wsm::LISTS), (const float*)(F.ws + wsm::WLIST), ESZ};
    pg8::EpiSilu E{(bf16*)(F.ws + wsm::HB), ESZ == 1 ? pg8::F8_INV : 1.f};
    pg8::gemm_phase<pg8::EpiSilu, MoeOrder, true, ESZ>(F.lds, D, S, E);
}
template <int l> __device__ __forceinline__ void ph_e2(Frame& F, const Args& args) {
    using namespace cfg;
    build_pref(F, l);
    MoeOrder S{(const LAS int*)(F.lds + TAB_OFF), F.G, (int)blockIdx.x, 8, 1, (const char*)(F.ws + wsm::HB), (const char*)(F.ws + wsm::W_D), nullptr, nullptr, 2};
    pg8::EpiBf16 E{(bf16*)(F.ws + wsm::OB), D, 1.f};
    pg8::gemm_phase<pg8::EpiBf16, MoeOrder, false>(F.lds, EH, S, E);
}
#ifndef PROBE_T
#define PROBE_T -1
#endif
#define RUNPH(k, call) do { if (PROBE_T == (k)) pt0 = __builtin_amdgcn_s_memrealtime(); RUNPH_(k, call); if (PROBE_T == (k)) pt1 = __builtin_amdgcn_s_memrealtime(); } while (0)
#define RUNPH_(k, call) do { if (IN(k)) { call; if (DUP_PHASE == (k) && ((k) & 7) != 3 && ((k) & 7) != 5) { __syncthreads(); call; } } SEAM(k); } while (0)
template <int l>
__device__ __forceinline__ void layer_phases(Frame& F, const Args& args, const XcdBarrier& bar, const int lo, const int hi, unsigned long long& pt0, unsigned long long& pt1) {
    constexpr int pb = 8 * l;
    RUNPH(pb + 0, ph_n1<l>(F, args));
    RUNPH(pb + 1, ph_g1<l>(F, args));
    { unsigned long long racc = 0; RUNPH(pb + 2, ph_m1<l>(F, args, racc)); if (PROBE_R1 >= 0 && l == 0) { pt0 = 0; pt1 = racc; } }
    RUNPH(pb + 3, ph_m2<l>(F, args));
    RUNPH(pb + 4, ph_g2<l>(F, args));
    RUNPH(pb + 5, ph_n2<l>(F, args));
    RUNPH(pb + 6, ph_e1<l>(F, args));
    RUNPH(pb + 7, ph_e2<l>(F, args));
}
__global__ void __launch_bounds__(512, 2) mk_fwd(Args args) {
    extern __shared__ __attribute__((aligned(16))) unsigned char lds_raw[];
    using namespace cfg;
    Frame F;
    F.lds = (LAS unsigned char*)lds_raw; F.ws = args.ws; F.ctl = (unsigned*)(args.ws + wsm::CTL);
    F.tid = threadIdx.x; F.lane = F.tid & 63; F.wave = __builtin_amdgcn_readfirstlane(F.tid >> 6);
    F.pacc = 0ull;
    F.G = gridDim.x; { const int bx = blockIdx.x; F.vcu = (F.G % 8 == 0) ? (bx % 8) * (F.G / 8) + bx / 8 : bx; }
    volatile LAS unsigned* MISC = (volatile LAS unsigned*)(F.lds + MISC_OFF);
    for (int u = F.tid; u < (LDS_BYTES - RING_BYTES) / 4; u += 512) ((LAS unsigned*)(F.lds + RING_BYTES))[u] = 0u;
    __syncthreads();
    const int lo = args.ph_lo, hi = args.ph_hi;
    XcdBarrier bar; bar.bar = F.ctl + wsm::CW_BAR; bar.x = 0; bar.st = nullptr;
    if (hi - lo > 1) bar = xcd_barrier_post(F.ctl + wsm::CW_BAR, MISC + 8);
    float* xo = args.out;
    unsigned long long pt0 = 0, pt1 = 0;
    layer_phases<0>(F, args, bar, lo, hi, pt0, pt1);
    layer_phases<1>(F, args, bar, lo, hi, pt0, pt1);
    if (PROBE_T == 16) pt0 = __builtin_amdgcn_s_memrealtime();
    if (IN(16)) {
        build_pref(F, NL - 1); norm_phase<true, false, true>(F, args, xo, xo, args.in[5], 0, 0);
    }
    if (PROBE_T == 16) pt1 = __builtin_amdgcn_s_memrealtime();
    if (PROBE_ATT >= 0 && blockIdx.x == 0 && F.tid == 448) { const unsigned long long te = __builtin_amdgcn_s_memrealtime(); while (__builtin_amdgcn_s_memrealtime() - te < 4ull * F.pacc) __builtin_amdgcn_s_sleep(8); }
    if ((PROBE_T >= 0 || PROBE_R1 >= 0) && blockIdx.x == 0 && F.tid == 0) { const unsigned long long te = __builtin_amdgcn_s_memrealtime(); while (__builtin_amdgcn_s_memrealtime() - te < 4ull * (pt1 - pt0)) __builtin_amdgcn_s_sleep(8); }
#undef IN
#undef SEAM
}
extern "C" void kernel_launch(void* const* d_in, const int* in_sizes, int n_in, void* d_out, int out_size, void* d_ws, size_t ws_size, hipStream_t stream) {
    using namespace cfg;
    static int grid = 0;
    if (grid == 0) {
        if (n_in != 32 || ws_size < wsm::END || out_size != M * D) { fprintf(stderr, "kernel_launch: bad args n_in=%d ws=%zu out=%d\n", n_in, ws_size, out_size); grid = -1; return; }
        int dev = 0, cus = 0;
        if (hipGetDevice(&dev) != hipSuccess || hipDeviceGetAttribute(&cus, hipDeviceAttributeMultiprocessorCount, dev) != hipSuccess) { grid = -1; return; }
        if (hipFuncSetAttribute((const void*)mk_fwd, hipFuncAttributeMaxDynamicSharedMemorySize, LDS_BYTES) != hipSuccess) { fprintf(stderr, "hipFuncSetAttribute failed\n"); grid = -1; return; }
        int per_cu = 0;
        if (hipOccupancyMaxActiveBlocksPerMultiprocessor(&per_cu, (const void*)mk_fwd, 512, LDS_BYTES) != hipSuccess || per_cu < 1) fprintf(stderr, "kernel_launch: occupancy query says %d\n", per_cu);
        (void)hipGetLastError();
        grid = cus;
    }
    if (grid < 0) return;
    unsigned char* w = (unsigned char*)d_ws;
    if (hipMemsetAsync(w + wsm::CTL, 0, wsm::CTL_ZERO_BYTES, stream) != hipSuccess) return;
    Args a{};
    for (int i = 0; i < 32; ++i) a.in[i] = (const float*)d_in[i];
    a.out = (float*)d_out; a.ws = w; a.flags = 7; a.ph_lo = 0; a.ph_hi = 17;
    hipLaunchKernelGGL(mk_fwd, dim3(grid), dim3(512), LDS_BYTES, stream, a);
}
```

```cpp
#define DUP_PHASE -1
#include <hip/hip_runtime.h>
#include <cstdint>
#include <cstdio>
#include <cmath>

typedef unsigned short bf16;
__host__ __device__ __forceinline__ unsigned f2bf(float f) { unsigned u = __builtin_bit_cast(unsigned, f); return (u + 0x7fffu + ((u >> 16) & 1u)) >> 16; }
__host__ __device__ __forceinline__ float bf2f(bf16 b) { return __builtin_bit_cast(float, ((unsigned)b) << 16); }

namespace cfg {
constexpr int D = 2048, BATCH = 8, SEQ = 4096, M = BATCH * SEQ, NL = 2;
constexpr int INC = 6400;
constexpr int OFF_BQ = 1792, OFF_BK = 2304, OFF_BV = 2816, OFF_CQ = 3328, OFF_CK = 3840, OFF_CV = 4352, OFF_D = 4864;
constexpr int NEXP = 32, EH = 256;
}
#define GAS __attribute__((address_space(1)))
#define LAS __attribute__((address_space(3)))
typedef float f32x4 __attribute__((ext_vector_type(4)));
typedef float f32x2 __attribute__((ext_vector_type(2)));
typedef short bf16x8 __attribute__((ext_vector_type(8)));
typedef unsigned u32x4 __attribute__((ext_vector_type(4)));
typedef unsigned u32x2 __attribute__((ext_vector_type(2)));
#define RLX_AGENT __ATOMIC_RELAXED, __HIP_MEMORY_SCOPE_AGENT
#define LDS_WAIT() asm volatile("s_waitcnt lgkmcnt(0)" ::: "memory")
#define VM_WAIT() asm volatile("s_waitcnt vmcnt(0)" ::: "memory")

namespace wsm {
constexpr size_t MiB = 1u << 20;
constexpr size_t CTL = 0, CTL_ZERO_BYTES = 1 * MiB;
constexpr size_t LISTS = 2 * MiB;
constexpr size_t WLIST = 6 * MiB;
constexpr size_t TOKINFO = 10 * MiB;
constexpr size_t ROUTE = 11 * MiB;
constexpr size_t WRT = 12 * MiB;
constexpr size_t W_IN = 16 * MiB;
constexpr size_t W_OUT = 41 * MiB;
constexpr size_t W_GU = 49 * MiB;
constexpr size_t W_D = 113 * MiB;
constexpr size_t XN = 146 * MiB;
constexpr size_t P = 274 * MiB;
constexpr size_t HB = P;
constexpr size_t OB = P + 40 * MiB;
constexpr size_t XB2 = P + 200 * MiB;
constexpr size_t Y = 674 * MiB;
constexpr size_t RW = 802 * MiB;
constexpr size_t END = 1010 * MiB;
constexpr int CW_BAR = 4096;
constexpr int CW_CNT = 16384;
constexpr int CW_Q = 32768;
}
constexpr int LCAP = 32768;
constexpr int RING_BYTES = 139264;
constexpr int MISC_OFF = RING_BYTES + 320;
constexpr int TAB_OFF = RING_BYTES + 1024;
constexpr int LDS_BYTES = 147456;
constexpr float C2F = 0.125f * 1.4426950408889634f;
constexpr float LOG2E = 1.4426950408889634f;

typedef __bf16 bf16x2_hw __attribute__((ext_vector_type(2)));
__device__ __forceinline__ unsigned pk2(float lo, float hi) { const f32x2 v = {lo, hi}; const bf16x2_hw b = __builtin_convertvector(v, bf16x2_hw); return __builtin_bit_cast(unsigned, b); }
__device__ __forceinline__ bf16 cvt1(float x) { return (bf16)(pk2(x, x) & 0xffffu); }
__device__ __forceinline__ float f8clamp(float x) { return __builtin_amdgcn_fmed3f(x, -448.f, 448.f); }
__device__ __forceinline__ unsigned pk2_fp8(float a, float b) { int w = 0; w = __builtin_amdgcn_cvt_pk_fp8_f32(f8clamp(a), f8clamp(b), w, false); return (unsigned)w & 0xffffu; }
__device__ __forceinline__ unsigned pk4_fp8(float a, float b, float c, float d) { int w = 0; w = __builtin_amdgcn_cvt_pk_fp8_f32(f8clamp(a), f8clamp(b), w, false); w = __builtin_amdgcn_cvt_pk_fp8_f32(f8clamp(c), f8clamp(d), w, true); return (unsigned)w; }
constexpr int F8_IN_MASK = 2, F8_OUT_MASK = 2;
#define F8IN(l) (((F8_IN_MASK >> (l)) & 1) != 0)
#define F8OUT(l) (((F8_OUT_MASK >> (l)) & 1) != 0)
constexpr float F8_Y = 16.f, F8_OB = 8.f;
constexpr int F8_MOE_MASK = 3;
__device__ __forceinline__ float wave_sum(float v) {
#pragma unroll
    for (int o = 1; o < 64; o <<= 1) v += __shfl_xor(v, o);
    return v;
}

struct Args {
    const float* in[32]; float* out; unsigned char* ws;
    int ph_lo, ph_hi, flags, pad;
};
#define XB_TMO      128
#define XB_XCNT(j)  (256  + 64 * (j))
#define XB_XSUB(j)  (1280 + 64 * (j))
#define XB_XGEN(j)  (2304 + 64 * (j))
#define XB_TOP      3328
#define XB_TOPGEN   3392
#define XCD_BAR_WORDS 3456
#define XB_SPIN_CAP (1u << 22)

__device__ __forceinline__ unsigned xb_ld(unsigned* p)              { return __hip_atomic_load(p, __ATOMIC_RELAXED, __HIP_MEMORY_SCOPE_AGENT); }
__device__ __forceinline__ unsigned xb_add(unsigned* p, unsigned v) { return __hip_atomic_fetch_add(p, v, __ATOMIC_RELAXED, __HIP_MEMORY_SCOPE_AGENT); }
__device__ __forceinline__ unsigned xb_xcc_id() { return (unsigned)__builtin_amdgcn_s_getreg((3 << 11) | 20) & 0xFu; }
#define XB_SPIN(cond, bar) do { unsigned _sp = 0; while (cond) { __builtin_amdgcn_s_sleep(1); \
    if ((++_sp & 255u) == 0u) { if (xb_ld(&(bar)[XB_TMO])) break; if (_sp > XB_SPIN_CAP) { atomicAdd(&(bar)[XB_TMO], 1u); break; } } } } while (0)

struct XcdBarrier {
    unsigned* bar; unsigned x;
    volatile LAS unsigned* st;
};

__device__ __forceinline__ XcdBarrier xcd_barrier_post(unsigned* bar, volatile LAS unsigned* st) {
    XcdBarrier b; b.bar = bar; b.x = xb_xcc_id(); b.st = st;
    if (threadIdx.x == 0) (void)xb_add(&bar[XB_XCNT(b.x)], 1u);
    return b;
}
__device__ __forceinline__ void xcd_barrier_complete(unsigned* bar, unsigned x, unsigned& nloc, unsigned& nx) {
    const unsigned G = gridDim.x * gridDim.y * gridDim.z;
    unsigned sum, cnt, mine, sp = 0u;
    for (;;) {
        sum = 0u; cnt = 0u; mine = 0u;
#pragma unroll
        for (unsigned j = 0; j < 16; ++j) { const unsigned c = xb_ld(&bar[XB_XCNT(j)]); sum += c; cnt += (c > 0u) ? 1u : 0u; mine = (j == x) ? c : mine; }
        if (sum == G) break;
        __builtin_amdgcn_s_sleep(1);
        if ((++sp & 255u) == 0u) { if (xb_ld(&bar[XB_TMO])) break; if (sp > XB_SPIN_CAP) { atomicAdd(&bar[XB_TMO], 1u); break; } }
    }
    nloc = mine > 0u ? mine : 1u; nx = cnt > 0u ? cnt : 1u;
}

__device__ __forceinline__ void xcd_barrier(const XcdBarrier& b) {
    asm volatile("s_waitcnt vmcnt(0)" ::: "memory");
    __syncthreads();
    if (threadIdx.x == 0) {
        unsigned* bar = b.bar;
        __builtin_amdgcn_s_waitcnt(0);
        unsigned nloc = b.st[0], nx = b.st[1];
        if (nloc == 0u) { xcd_barrier_complete(bar, b.x, nloc, nx); b.st[0] = nloc; b.st[1] = nx; }
        const unsigned old = xb_add(&bar[XB_XSUB(b.x)], 1u);
        const unsigned gen = old / nloc;
        if (old + 1u == (gen + 1u) * nloc) {
            __builtin_amdgcn_fence(__ATOMIC_RELEASE, "agent");
            asm volatile("s_waitcnt vmcnt(0)" ::: "memory");
            const unsigned og = xb_add(&bar[XB_TOP], 1u);
            const unsigned tg = og / nx;
            if (og + 1u == (tg + 1u) * nx) xb_add(&bar[XB_TOPGEN], 1u);
            else XB_SPIN(xb_ld(&bar[XB_TOPGEN]) == tg, bar);
            __builtin_amdgcn_fence(__ATOMIC_ACQUIRE, "agent");
            xb_add(&bar[XB_XGEN(b.x)], 1u);
            asm volatile("s_waitcnt vmcnt(0)" ::: "memory");
        } else {
            XB_SPIN(xb_ld(&bar[XB_XGEN(b.x)]) == gen, bar);
            __builtin_amdgcn_fence(__ATOMIC_ACQUIRE, "agent");
            asm volatile("s_waitcnt vmcnt(0)" ::: "memory");
        }
    }
    __syncthreads();
}
namespace pg8 {
#define PG8_LAS __attribute__((address_space(3)))
typedef unsigned short bf16_t;
typedef short bf16x8 __attribute__((ext_vector_type(8)));
typedef float f32x4 __attribute__((ext_vector_type(4)));
typedef unsigned u32x4 __attribute__((ext_vector_type(4)));
typedef unsigned u32x2 __attribute__((ext_vector_type(2)));
typedef int i32x4_t __attribute__((ext_vector_type(4)));
typedef int i32x8_t __attribute__((ext_vector_type(8)));
constexpr float F8_ACT = 16.f, F8_WGT = 512.f, F8_INV = 1.f / (16.f * 512.f);
constexpr int BM = 256, BK = 64, HALF = 128, HTB = HALF * BK * 2, STAGE_BYTES = 8 * HTB, NXCD = 8, WGM = 8;

__host__ __device__ __forceinline__ int lds_byte(int r, int c) { const int st = (r >> 4) * 2 + (c >> 5), rr = r & 15, cc = c & 31, ob = rr * 64 + cc * 2; return st * 1024 + (ob ^ (((ob >> 9) & 1) << 5)); }
__host__ __device__ __forceinline__ void stage_rc(int b, int& R, int& C) { const int st = b / 1024, sb = b % 1024, swz = sb ^ (((sb >> 9) & 1) << 5); R = (st >> 1) * 16 + swz / 64; C = (st & 1) * 32 + (swz % 64) / 2; }
__host__ __device__ __forceinline__ int perm32(int rho) { const int n = rho >> 4, i = rho & 15; return 8 * (i >> 2) + 4 * n + (i & 3); }

struct Unit { int pm, pn; const char* a; const char* b; const int* rows; const float* wrow; int nvalid; int pad_; };

struct StaticOrder {
    int nM, nN, nwg, G, c; const char* A; const char* Bt; size_t tstep;
    __device__ void init(const void* A_, const void* Bt_, int M, int N, int K, int G_, int c_, int esz = 2) { nM = M / BM; nN = N / BM; nwg = nM * nN; G = G_; c = c_; A = (const char*)A_; Bt = (const char*)Bt_; tstep = (size_t)BM * K * esz; }
    __device__ bool next(int i, Unit& u) const {
        const long L = (long)i * G + c; if (L >= nwg) return false;
        int wgid = (int)L; { const int q = nwg / NXCD, r = nwg % NXCD, xcd = wgid % NXCD, off = wgid / NXCD; wgid = (xcd < r ? xcd * (q + 1) : r * (q + 1) + (xcd - r) * q) + off; }
        const int nig = WGM * nN, gid = wgid / nig, fm = gid * WGM, gsz = (nM - fm) < WGM ? (nM - fm) : WGM;
        u.pm = fm + ((wgid % nig) % gsz); u.pn = (wgid % nig) / gsz; u.a = A + (size_t)u.pm * tstep; u.b = Bt + (size_t)u.pn * tstep; u.rows = nullptr; u.wrow = nullptr; u.nvalid = 256; return true;
    }
};

__device__ __forceinline__ unsigned cvt_pk_bf16(float lo, float hi) { unsigned r; asm volatile("v_cvt_pk_bf16_f32 %0, %1, %2" : "=v"(r) : "v"(lo), "v"(hi)); return r; }

struct EpiBf16 {
    static constexpr bool PERM = true;
    bf16_t* O; int ldc; float mul;
    __device__ __forceinline__ void operator()(const f32x4 (&acc)[2][2][4][2], const Unit& u, int wr, int wc, int fr, int fq) const {
        const int row0 = u.pm * BM + wr * 64 + fr; const int col0 = u.pn * BM + wc * 32 + 8 * fq;
#pragma unroll
        for (int ai = 0; ai < 2; ++ai)
#pragma unroll
            for (int m = 0; m < 4; ++m) { bf16_t* rowp = O + (size_t)(row0 + ai * HALF + m * 16) * ldc + col0;
#pragma unroll
                for (int bj = 0; bj < 2; ++bj) { const f32x4 v0 = acc[ai][bj][m][0] * mul, v1 = acc[ai][bj][m][1] * mul;
                    u32x4 w; w.x = cvt_pk_bf16(v0[0], v0[1]); w.y = cvt_pk_bf16(v0[2], v0[3]); w.z = cvt_pk_bf16(v1[0], v1[1]); w.w = cvt_pk_bf16(v1[2], v1[3]);
                    *(u32x4*)(rowp + bj * HALF) = w; } }
    }
};
struct EpiF8 {
    static constexpr bool PERM = true;
    unsigned char* O; int ldc; float mul;
    __device__ __forceinline__ void operator()(const f32x4 (&acc)[2][2][4][2], const Unit& u, int wr, int wc, int fr, int fq) const {
        const int row0 = u.pm * BM + wr * 64 + fr; const int col0 = u.pn * BM + wc * 32 + 8 * fq;
#pragma unroll
        for (int ai = 0; ai < 2; ++ai)
#pragma unroll
            for (int m = 0; m < 4; ++m) { unsigned char* rowp = O + (size_t)(row0 + ai * HALF + m * 16) * ldc + col0;
#pragma unroll
                for (int bj = 0; bj < 2; ++bj) { const f32x4 v0 = acc[ai][bj][m][0] * mul, v1 = acc[ai][bj][m][1] * mul;
                    u32x2 w; w.x = ::pk4_fp8(v0[0], v0[1], v0[2], v0[3]); w.y = ::pk4_fp8(v1[0], v1[1], v1[2], v1[3]);
                    *(u32x2*)(rowp + bj * HALF) = w; } }
    }
};
template <bool BASE_BF16>
struct EpiRes {
    static constexpr bool PERM = false;
    const void* base; bf16_t* C; int ldc; float mul;
    __device__ __forceinline__ void operator()(const f32x4 (&acc)[2][2][4][2], const Unit& u, int wr, int wc, int fr, int fq) const {
        const int row0 = u.pm * BM + wr * 64 + fr, col0 = u.pn * BM + wc * 32 + 4 * fq;
#pragma unroll
        for (int ai = 0; ai < 2; ++ai)
#pragma unroll
            for (int m = 0; m < 4; ++m) { const size_t off = (size_t)(row0 + ai * HALF + m * 16) * ldc + col0;
#pragma unroll
                for (int bj = 0; bj < 2; ++bj)
#pragma unroll
                    for (int n = 0; n < 2; ++n) { const size_t o2 = off + bj * HALF + n * 16; f32x4 bs;
                        if constexpr (BASE_BF16) { const u32x2 w = *(const u32x2*)((const bf16_t*)base + o2); bs = (f32x4){__uint_as_float(w.x << 16), __uint_as_float(w.x & 0xffff0000u), __uint_as_float(w.y << 16), __uint_as_float(w.y & 0xffff0000u)}; }
                        else bs = *(const f32x4*)((const float*)base + o2);
                        const f32x4 r = bs + acc[ai][bj][m][n] * mul;
                        u32x2 ow; ow.x = ::pk2(r[0], r[1]); ow.y = ::pk2(r[2], r[3]); *(u32x2*)(C + o2) = ow; }
                asm volatile("" ::: "memory"); }
    }
};
struct EpiSilu {
    static constexpr bool PERM = true;
    bf16_t* H; float mul;
    __device__ __forceinline__ void operator()(const f32x4 (&acc)[2][2][4][2], const Unit& u, int wr, int wc, int fr, int fq) const {
        const int row0 = u.pm * BM + wr * 64 + fr; const int col0 = u.pn * HALF + wc * 32 + 8 * fq;
#pragma unroll
        for (int ai = 0; ai < 2; ++ai)
#pragma unroll
            for (int m = 0; m < 4; ++m) { const int row = row0 + ai * HALF + m * 16; const float w = u.wrow[wr * 64 + fr + ai * HALF + m * 16];
                float o[8];
#pragma unroll
                for (int n = 0; n < 2; ++n)
#pragma unroll
                    for (int j = 0; j < 4; ++j) { const float g = acc[ai][0][m][n][j] * mul, up = acc[ai][1][m][n][j] * mul; o[n * 4 + j] = g * __builtin_amdgcn_rcpf(1.f + __expf(-g)) * up * w; }
                u32x4 wv; wv.x = cvt_pk_bf16(o[0], o[1]); wv.y = cvt_pk_bf16(o[2], o[3]); wv.z = cvt_pk_bf16(o[4], o[5]); wv.w = cvt_pk_bf16(o[6], o[7]);
                *(u32x4*)(H + (size_t)row * 256 + col0) = wv; }
    }
};

template <class Epi, class Sched, bool GATHER, int ESZ = 2>
__device__ __forceinline__ void gemm_phase(PG8_LAS unsigned char* lds, const int K, const Sched& S, const Epi& E) {
    const int tid = threadIdx.x, wid = __builtin_amdgcn_readfirstlane(tid >> 6), lane = tid & 63, wr = wid >> 2, wc = wid & 3, fr = lane & 15, fq = lane >> 4;
    const int KB = K * ESZ;
    const int nt = KB / (BK * 2);
    const size_t kstep = (size_t)(BK * 2);
    const unsigned hstep = (unsigned)HALF * KB;
    int sR[2], sC[2];
    unsigned voffB[2], vc[2][2], vn[2][2];
#pragma unroll
    for (int i = 0; i < 2; ++i) { int R, C; stage_rc(tid * 16 + i * 8192, R, C); sR[i] = R; sC[i] = C; const int Rb = Epi::PERM ? ((R & ~31) + perm32(R & 31)) : R;
        voffB[i] = (unsigned)(Rb * KB + C * 2); vc[0][i] = (unsigned)(R * KB + C * 2); vc[1][i] = vc[0][i] + hstep; vn[0][i] = vc[0][i]; vn[1][i] = vc[1][i]; }
    const unsigned ldsw = (unsigned)wid * 1024u;
    const int aoff = lds_byte(wr * 64 + fr, fq * 8), boff = lds_byte(wc * 32 + fr, fq * 8);
#define PG8_SA(b, h) (((b) * 2 + (h)) * HTB)
#define PG8_SB(b, h) ((4 + (b) * 2 + (h)) * HTB)
#define PG8_STAGE(bufoff, gbase, voff) do { _Pragma("unroll") for (int _i = 0; _i < 2; ++_i) \
        __builtin_amdgcn_global_load_lds((const unsigned*)((const char*)(gbase) + (voff)[_i]), (PG8_LAS unsigned*)(lds + (bufoff) + ldsw + _i * 8192), 16, 0, 0); } while (0)
#define PG8_LD32(addr) __builtin_shufflevector(*(const PG8_LAS i32x4_t*)(addr), *(const PG8_LAS i32x4_t*)((addr) + 1024), 0, 1, 2, 3, 4, 5, 6, 7)
#define PG8_LDA(dst, b, h) do { if constexpr (ESZ == 2) { _Pragma("unroll") for (int m = 0; m < 4; ++m) _Pragma("unroll") for (int k = 0; k < 2; ++k) dst[m][k] = *(const PG8_LAS bf16x8*)(lds + PG8_SA(b, h) + aoff + m * 2048 + k * 1024); } \
        else { _Pragma("unroll") for (int m = 0; m < 4; ++m) dst##8[m] = PG8_LD32(lds + PG8_SA(b, h) + aoff + m * 2048); } } while (0)
#define PG8_LDB(dst, b, h) do { if constexpr (ESZ == 2) { _Pragma("unroll") for (int n = 0; n < 2; ++n) _Pragma("unroll") for (int k = 0; k < 2; ++k) dst[n][k] = *(const PG8_LAS bf16x8*)(lds + PG8_SB(b, h) + boff + n * 2048 + k * 1024); } \
        else { _Pragma("unroll") for (int n = 0; n < 2; ++n) dst##8[n] = PG8_LD32(lds + PG8_SB(b, h) + boff + n * 2048); } } while (0)
#define PG8_F8(x) __builtin_shufflevector(__builtin_bit_cast(i32x4_t, x[0]), __builtin_bit_cast(i32x4_t, x[1]), 0, 1, 2, 3, 4, 5, 6, 7)
#define PG8_MMA(ai, bj, At, Bt) do { __builtin_amdgcn_s_setprio(1); _Pragma("unroll") for (int m = 0; m < 4; ++m) _Pragma("unroll") for (int n = 0; n < 2; ++n) { \
        if constexpr (ESZ == 2) { _Pragma("unroll") for (int k = 0; k < 2; ++k) acc[ai][bj][m][n] = __builtin_amdgcn_mfma_f32_16x16x32_bf16(Bt[n][k], At[m][k], acc[ai][bj][m][n], 0, 0, 0); } \
        else asm volatile("s_nop 1\n\tv_mfma_f32_16x16x128_f8f6f4 %0, %1, %2, %0" : "+v"(acc[ai][bj][m][n]) : "v"(Bt##8[n]), "v"(At##8[m])); } __builtin_amdgcn_s_setprio(0); } while (0)
#define PG8_WAIT_V(n) asm volatile("s_waitcnt vmcnt(" #n ")" ::: "memory")
#define PG8_WAIT_L(n) asm volatile("s_waitcnt lgkmcnt(" #n ")" ::: "memory")
#define PG8_BAR __builtin_amdgcn_s_barrier()
#define PG8_SCHED __builtin_amdgcn_sched_barrier(0)
#define PG8_GV(dst, u) do { if constexpr (GATHER) { _Pragma("unroll") for (int _h = 0; _h < 2; ++_h) _Pragma("unroll") for (int _i = 0; _i < 2; ++_i) { const int _idx = _h * HALF + sR[_i]; \
        const int _tok = (u).rows[_idx < (u).nvalid ? _idx : 0]; dst[_h][_i] = (unsigned)_tok * (unsigned)KB + (unsigned)sC[_i] * 2u; } } } while (0)
    Unit cur, nxt; int ui = 0;
    if (!S.next(0, cur)) return;
    f32x4 acc[2][2][4][2];
#pragma unroll
    for (int a = 0; a < 2; ++a)
#pragma unroll
        for (int b = 0; b < 2; ++b)
#pragma unroll
            for (int m = 0; m < 4; ++m)
#pragma unroll
                for (int n = 0; n < 2; ++n) acc[a][b][m][n] = (f32x4){0.f, 0.f, 0.f, 0.f};
    bf16x8 At[4][2], B0[2][2], B1[2][2];
    i32x8_t At8[4], B08[2], B18[2];
    const char* cA = cur.a; const char* cB = cur.b;
    PG8_GV(vc, cur);
    PG8_STAGE(PG8_SB(0, 0), cB, voffB); PG8_STAGE(PG8_SB(0, 1), cB + hstep, voffB); PG8_STAGE(PG8_SA(0, 0), cA, vc[0]); PG8_STAGE(PG8_SA(0, 1), cA, vc[1]);
    if (wr == 1) PG8_BAR;
    PG8_WAIT_V(2); PG8_BAR;
    PG8_STAGE(PG8_SB(1, 0), cB + kstep, voffB); PG8_STAGE(PG8_SA(1, 0), cA + kstep, vc[0]); PG8_STAGE(PG8_SB(1, 1), cB + hstep + kstep, voffB);
    PG8_WAIT_V(6); PG8_BAR;
    for (;;) {
        const bool has_next = S.next(ui + 1, nxt);
        const char* nA = has_next ? nxt.a : cA; const char* nB = has_next ? nxt.b : cB;
        if constexpr (GATHER) { if (has_next) { PG8_GV(vn, nxt); } else {
#pragma unroll
            for (int h = 0; h < 2; ++h)
#pragma unroll
                for (int i = 0; i < 2; ++i) vn[h][i] = vc[h][i]; } }
#pragma unroll 1
        for (int t = 0; t < nt; t += 2) {
            const bool last = (t == nt - 2);
            const char* a1 = cA + (size_t)(t + 1) * kstep;
            const char* a2 = last ? nA : cA + (size_t)(t + 2) * kstep; const char* b2 = last ? nB : cB + (size_t)(t + 2) * kstep;
            const char* a3 = a2 + kstep; const char* b3 = b2 + kstep;
            unsigned v2[2][2];
#pragma unroll
            for (int h = 0; h < 2; ++h)
#pragma unroll
                for (int i = 0; i < 2; ++i) v2[h][i] = (GATHER && last) ? vn[h][i] : vc[h][i];
            PG8_LDB(B0, 0, 0); PG8_LDB(B1, 0, 1); PG8_SCHED; PG8_LDA(At, 0, 0); PG8_STAGE(PG8_SA(1, 1), a1, vc[1]);
            PG8_WAIT_V(8); PG8_WAIT_L(0); PG8_BAR; PG8_MMA(0, 0, At, B0); PG8_MMA(0, 1, At, B1); PG8_BAR; PG8_SCHED;
            PG8_LDA(At, 0, 1); PG8_STAGE(PG8_SB(0, 0), b2, voffB); PG8_STAGE(PG8_SB(0, 1), b2 + hstep, voffB); PG8_STAGE(PG8_SA(0, 0), a2, v2[0]);
            PG8_WAIT_V(8); PG8_WAIT_L(0); PG8_BAR; PG8_MMA(1, 0, At, B0); PG8_MMA(1, 1, At, B1); PG8_BAR; PG8_SCHED;
            PG8_LDB(B0, 1, 0); PG8_LDB(B1, 1, 1); PG8_SCHED; PG8_LDA(At, 1, 0); PG8_STAGE(PG8_SA(0, 1), a2, v2[1]);
            PG8_WAIT_V(8); PG8_WAIT_L(0); PG8_BAR; PG8_MMA(0, 0, At, B0); PG8_MMA(0, 1, At, B1); PG8_BAR; PG8_SCHED;
            PG8_LDA(At, 1, 1); PG8_STAGE(PG8_SB(1, 0), b3, voffB); PG8_STAGE(PG8_SB(1, 1), b3 + hstep, voffB); PG8_STAGE(PG8_SA(1, 0), a3, v2[0]);
            PG8_WAIT_V(8); PG8_WAIT_L(0); PG8_BAR; PG8_MMA(1, 0, At, B0); PG8_MMA(1, 1, At, B1); PG8_BAR; PG8_SCHED;
        }
        if (wr == 0) PG8_BAR;
        if constexpr (ESZ == 1) asm volatile("s_nop 15\n\ts_nop 7" ::: "memory");
        E(acc, cur, wr, wc, fr, fq);
        if (!has_next) break;
#pragma unroll
        for (int a = 0; a < 2; ++a)
#pragma unroll
            for (int b = 0; b < 2; ++b)
#pragma unroll
                for (int m = 0; m < 4; ++m)
#pragma unroll
                    for (int n = 0; n < 2; ++n) acc[a][b][m][n] = (f32x4){0.f, 0.f, 0.f, 0.f};
        cur = nxt; cA = nA; cB = nB; ++ui;
        if constexpr (GATHER) {
#pragma unroll
            for (int h = 0; h < 2; ++h)
#pragma unroll
                for (int i = 0; i < 2; ++i) vc[h][i] = vn[h][i]; }
        if (wr == 1) PG8_BAR;
    }
    PG8_WAIT_V(0);
    PG8_BAR;
#undef PG8_SA
#undef PG8_SB
#undef PG8_STAGE
#undef PG8_LDA
#undef PG8_LD32
#undef PG8_LDB
#undef PG8_MMA
#undef PG8_F8
#undef PG8_WAIT_V
#undef PG8_WAIT_L
#undef PG8_BAR
#undef PG8_SCHED
#undef PG8_GV
}
}
struct Frame {
    LAS unsigned char* lds; unsigned char* ws; unsigned* ctl;
    int tid, lane, wave, G, vcu;
    unsigned long long pacc;
};

__device__ __forceinline__ void cvt_tile(const float* W, int N, int K, int k0, int n0, bf16* dst, int drow0, float scale, LAS float* scr, int lane) {
#pragma unroll 8
    for (int i = 0; i < 32; ++i) { const int kk = 2 * i + (lane >> 5); scr[kk * 33 + (lane & 31)] = W[(size_t)(k0 + kk) * N + n0 + (lane & 31)]; }
    LDS_WAIT(); asm volatile("" ::: "memory");
    const int c = lane & 7;
#pragma unroll
    for (int j = 0; j < 4; ++j) { const int n = (lane >> 3) + 8 * j; const LAS float* s = scr + (8 * c) * 33 + n;
        u32x4 o; o.x = pk2(s[0 * 33] * scale, s[1 * 33] * scale); o.y = pk2(s[2 * 33] * scale, s[3 * 33] * scale); o.z = pk2(s[4 * 33] * scale, s[5 * 33] * scale); o.w = pk2(s[6 * 33] * scale, s[7 * 33] * scale);
        *(u32x4*)(dst + (size_t)(drow0 + n) * K + k0 + 8 * c) = o; }
    LDS_WAIT(); asm volatile("" ::: "memory");
}
__device__ __forceinline__ void cvt_tile8(const float* W, int N, int K, int k0, int n0, unsigned char* dst, int drow0, float scale, LAS float* scr, int lane) {
#pragma unroll 8
    for (int i = 0; i < 32; ++i) { const int kk = 2 * i + (lane >> 5); scr[kk * 33 + (lane & 31)] = W[(size_t)(k0 + kk) * N + n0 + (lane & 31)]; }
    LDS_WAIT(); asm volatile("" ::: "memory");
    const int c = lane & 7;
#pragma unroll
    for (int j = 0; j < 4; ++j) { const int n = (lane >> 3) + 8 * j; const LAS float* s = scr + (8 * c) * 33 + n;
        u32x2 o; o.x = pk4_fp8(s[0 * 33] * scale, s[1 * 33] * scale, s[2 * 33] * scale, s[3 * 33] * scale); o.y = pk4_fp8(s[4 * 33] * scale, s[5 * 33] * scale, s[6 * 33] * scale, s[7 * 33] * scale);
        *(u32x2*)(dst + (size_t)(drow0 + n) * K + k0 + 8 * c) = o; }
    LDS_WAIT(); asm volatile("" ::: "memory");
}
__device__ __forceinline__ void convert_phase(Frame& F, const Args& a, int l) {
    using namespace cfg;
    LAS float* scr = (LAS float*)(F.lds + F.wave * 16384);
    const int gw = F.vcu * 8 + F.wave, NGW = F.G * 8;
    const float* w_in = a.in[1] + (size_t)l * D * INC; const float* w_out = a.in[2] + (size_t)l * D * D;
    const size_t es = (size_t)NEXP * D * EH;
    const float* wg = a.in[29] + l * es; const float* wu = a.in[30] + l * es; const float* wd = a.in[31] + l * es;
    bf16* Wi = (bf16*)(F.ws + wsm::W_IN); bf16* Wo = (bf16*)(F.ws + wsm::W_OUT); bf16* Wgu = (bf16*)(F.ws + wsm::W_GU); bf16* Wd = (bf16*)(F.ws + wsm::W_D);
    constexpr int I_IN = 32 * 200, I_OUT = 32 * 64, I_G = 32 * 256, I_D = 32 * 256;
    constexpr int NITEMS = I_IN + I_OUT + 2 * I_G + I_D;
    for (int it = gw; it < NITEMS; it += NGW) {
        int r = it;
        if (r < I_IN) { const int kb = r / 200, nb = r % 200, n0 = nb * 32; const bool isq = (n0 >= OFF_BQ && n0 < OFF_BK) || (n0 >= OFF_CQ && n0 < OFF_CK);
            if (F8IN(l)) cvt_tile8(w_in, INC, D, kb * 64, n0, (unsigned char*)Wi, n0, (isq ? C2F : 1.f) * pg8::F8_WGT, scr, F.lane); else cvt_tile(w_in, INC, D, kb * 64, n0, Wi, n0, isq ? C2F : 1.f, scr, F.lane); continue; } r -= I_IN;
        if (r < I_OUT) { const int kb = r / 64, nb = r % 64; if (F8OUT(l)) cvt_tile8(w_out, D, D, kb * 64, nb * 32, (unsigned char*)Wo, nb * 32, pg8::F8_WGT, scr, F.lane); else cvt_tile(w_out, D, D, kb * 64, nb * 32, Wo, nb * 32, 1.f, scr, F.lane); continue; } r -= I_OUT;
        if (r < 2 * I_G) { const int up = r >= I_G; if (up) r -= I_G; const int e = r >> 8, q = r & 255, kb = q >> 3, nb = q & 7, n0 = nb * 32;
            if ((F8_MOE_MASK >> l) & 1) cvt_tile8((up ? wu : wg) + (size_t)e * D * EH, EH, D, kb * 64, n0, (unsigned char*)Wgu, e * 512 + 256 * (n0 >> 7) + (n0 & 127) + (up ? 128 : 0), pg8::F8_WGT, scr, F.lane);
            else cvt_tile((up ? wu : wg) + (size_t)e * D * EH, EH, D, kb * 64, n0, Wgu, e * 512 + 256 * (n0 >> 7) + (n0 & 127) + (up ? 128 : 0), 1.f, scr, F.lane); continue; } r -= 2 * I_G;
        { const int e = r >> 8, q = r & 255, kb = q >> 6, nb = q & 63; cvt_tile(wd + (size_t)e * EH * D, D, EH, kb * 64, nb * 32, Wd + (size_t)e * D * EH, nb * 32, 1.f, scr, F.lane); }
    }
    bf16* Wr = (bf16*)(F.ws + wsm::WRT); const float* rg = a.in[25] + (size_t)l * D * 4; const float* re = a.in[27] + (size_t)l * D * 32;
    for (int idx = (F.vcu * 512 + F.tid); idx < 48 * 2048; idx += F.G * 512) { const int n = idx >> 11, k = idx & 2047;
        const float v = n < 4 ? rg[k * 4 + n] : (n < 36 ? re[k * 32 + n - 4] : 0.f); Wr[idx] = cvt1(v); }
    bf16* w2t = (bf16*)(F.ws + wsm::WRT + 262144); bf16* a2t = w2t + 512 * 64; bf16* g2t = a2t + 512 * 64;
    const float* w2 = a.in[8] + (size_t)l * 64 * 512; const float* a2 = a.in[10] + (size_t)l * 64 * 512; const float* g2 = a.in[11] + (size_t)l * 128 * 512;
    for (int idx = (F.vcu * 512 + F.tid); idx < 512 * 256; idx += F.G * 512) { const int ch = idx & 511, j = idx >> 9;
        if (j < 64) w2t[ch * 64 + j] = cvt1(w2[j * 512 + ch]); else if (j < 128) a2t[ch * 64 + (j - 64)] = cvt1(a2[(j - 64) * 512 + ch]); else g2t[ch * 128 + (j - 128)] = cvt1(g2[(j - 128) * 512 + ch]); }
}

__device__ __forceinline__ int grab(Frame& F, int q) {
    volatile LAS int* slot = (volatile LAS int*)(F.lds + MISC_OFF + 64);
    if (F.tid == 0) *slot = (int)__hip_atomic_fetch_add(F.ctl + wsm::CW_Q + q * 64, 1u, RLX_AGENT);
    __syncthreads();
    const int v = *slot;
    __syncthreads();
    return __builtin_amdgcn_readfirstlane(v);
}
__device__ __forceinline__ void build_pref(Frame& F, int l) {
    LAS int* pref = (LAS int*)(F.lds + TAB_OFF);
    if (F.tid == 0) { int s = 0; for (int e = 0; e < 32; ++e) { pref[e] = s; const unsigned c = __hip_atomic_load(F.ctl + wsm::CW_CNT + (l * 32 + e) * 64, RLX_AGENT); pref[40 + e] = (int)c; s += (int)((c + 255u) >> 8); } pref[32] = s; }
    __syncthreads();
}

template <bool COMBINE, bool ROUTER, bool FINAL, bool F8 = false, bool XBF = false>
__device__ __forceinline__ void norm_phase(Frame& F, const Args& a, const float* xsrc, float* xout, const float* gain, int l, int lc) {
    using namespace cfg;
    constexpr int PITCHB = 4112;
    LAS unsigned char* tile = F.lds;
    LAS float* part = (LAS float*)(F.lds + 67584);
    LAS int* pref = (LAS int*)(F.lds + TAB_OFF);
    bf16* xn = (bf16*)(F.ws + wsm::XN);
    const bf16* OB = (const bf16*)(F.ws + wsm::OB);
    const int4* tokinfo = (const int4*)(F.ws + wsm::TOKINFO);
    const int lane = F.lane, w = F.wave;
    f32x4 g4[8];
#pragma unroll
    for (int j = 0; j < 8; ++j) g4[j] = *(const f32x4*)(gain + 4 * lane + 256 * j);
    for (int pass = F.vcu; pass < M / 16; pass += F.G) {
#pragma unroll
        for (int rr = 0; rr < 2; ++rr) {
            const int rt = 2 * w + rr, row = pass * 16 + rt;
            f32x4 v[8];
            if constexpr (XBF) { const bf16* xr = (const bf16*)xsrc + (size_t)row * D + 4 * lane;
#pragma unroll
                for (int j = 0; j < 8; ++j) { const u32x2 w = *(const u32x2*)(xr + 256 * j); v[j] = (f32x4){__uint_as_float(w.x << 16), __uint_as_float(w.x & 0xffff0000u), __uint_as_float(w.y << 16), __uint_as_float(w.y & 0xffff0000u)}; }
            } else { const float* xr = xsrc + (size_t)row * D + 4 * lane;
#pragma unroll
                for (int j = 0; j < 8; ++j) v[j] = *(const f32x4*)(xr + 256 * j); }
            if constexpr (COMBINE) {
                const int4 ti = tokinfo[row];
                const unsigned char* o0 = (const unsigned char*)OB + ((size_t)pref[ti.x] * 256 + ti.y) * D + 4 * lane; const unsigned char* o1 = (const unsigned char*)OB + ((size_t)pref[ti.z] * 256 + ti.w) * D + 4 * lane;
#pragma unroll
                for (int j = 0; j < 8; ++j) { const int p0 = *(const int*)(o0 + 256 * j), p1 = *(const int*)(o1 + 256 * j);
                    const f32x2 a0 = __builtin_amdgcn_cvt_pk_f32_fp8(p0, false), a1 = __builtin_amdgcn_cvt_pk_f32_fp8(p0, true), b0 = __builtin_amdgcn_cvt_pk_f32_fp8(p1, false), b1 = __builtin_amdgcn_cvt_pk_f32_fp8(p1, true);
                    v[j].x += (a0.x + b0.x) * (1.f / F8_OB); v[j].y += (a0.y + b0.y) * (1.f / F8_OB); v[j].z += (a1.x + b1.x) * (1.f / F8_OB); v[j].w += (a1.y + b1.y) * (1.f / F8_OB); }
                if constexpr (!FINAL) {
#pragma unroll
                    for (int j = 0; j < 8; ++j) { if constexpr (XBF) { u32x2 w; w.x = pk2(v[j].x, v[j].y); w.y = pk2(v[j].z, v[j].w); *(u32x2*)((bf16*)xout + (size_t)row * D + 4 * lane + 256 * j) = w; }
                        else *(f32x4*)(xout + (size_t)row * D + 4 * lane + 256 * j) = v[j]; }
                }
            }
            float s = 0.f;
#pragma unroll
            for (int j = 0; j < 8; ++j) s += (v[j].x * v[j].x + v[j].y * v[j].y) + (v[j].z * v[j].z + v[j].w * v[j].w);
            const float rstd = rsqrtf(wave_sum(s) * (1.f / D) + 1e-6f);
#pragma unroll
            for (int j = 0; j < 8; ++j) { const f32x4 o = v[j] * rstd * g4[j];
                if constexpr (FINAL) *(f32x4*)(xout + (size_t)row * D + 4 * lane + 256 * j) = o;
                else if constexpr (F8) { *(unsigned*)((unsigned char*)xn + (size_t)row * D + 4 * lane + 256 * j) = pk4_fp8(o.x * pg8::F8_ACT, o.y * pg8::F8_ACT, o.z * pg8::F8_ACT, o.w * pg8::F8_ACT);
                    if constexpr (ROUTER) { u32x2 pk; pk.x = pk2(o.x, o.y); pk.y = pk2(o.z, o.w); *(LAS u32x2*)(tile + rt * PITCHB + (4 * lane + 256 * j) * 2) = pk; } }
                else { u32x2 pk; pk.x = pk2(o.x, o.y); pk.y = pk2(o.z, o.w);
                    *(u32x2*)(xn + (size_t)row * D + 4 * lane + 256 * j) = pk;
                    if constexpr (ROUTER) *(LAS u32x2*)(tile + rt * PITCHB + (4 * lane + 256 * j) * 2) = pk; } }
        }
        if constexpr (ROUTER) {
            __syncthreads();
            const bf16* Wr = (const bf16*)(F.ws + wsm::WRT);
            f32x4 acc[3] = {(f32x4){0.f, 0.f, 0.f, 0.f}, (f32x4){0.f, 0.f, 0.f, 0.f}, (f32x4){0.f, 0.f, 0.f, 0.f}};
#pragma unroll
            for (int s8 = 0; s8 < 8; ++s8) { const int k = 256 * w + 32 * s8 + 8 * (lane >> 4);
                const bf16x8 af = *(const LAS bf16x8*)(tile + (lane & 15) * PITCHB + k * 2);
#pragma unroll
                for (int nt = 0; nt < 3; ++nt) { const bf16x8 bfr = *(const bf16x8*)(Wr + (size_t)(16 * nt + (lane & 15)) * D + k);
                    acc[nt] = __builtin_amdgcn_mfma_f32_16x16x32_bf16(af, bfr, acc[nt], 0, 0, 0); } }
#pragma unroll
            for (int nt = 0; nt < 3; ++nt)
#pragma unroll
                for (int i = 0; i < 4; ++i) part[(w * 16 + (lane >> 4) * 4 + i) * 48 + 16 * nt + (lane & 15)] = acc[nt][i];
            __syncthreads();
            if (F.tid < 16) {
                const int m = F.tid, tok = pass * 16 + m;
                const float* bg = a.in[26] + l * 4; const float* be = a.in[28] + l * 32;
                float lg[4];
#pragma unroll
                for (int o = 0; o < 4; ++o) { float sacc = bg[o];
#pragma unroll
                    for (int ww = 0; ww < 8; ++ww) sacc += part[(ww * 16 + m) * 48 + o]; lg[o] = sacc; }
                int gi = 0; float gm = lg[0];
#pragma unroll
                for (int o = 1; o < 4; ++o) if (lg[o] > gm) { gm = lg[o]; gi = o; }
                float gs = 0.f;
#pragma unroll
                for (int o = 0; o < 4; ++o) gs += __expf(lg[o] - gm);
                const float gw = 1.f / gs;
                float el[8];
#pragma unroll
                for (int o = 0; o < 8; ++o) { float sacc = be[gi * 8 + o];
#pragma unroll
                    for (int ww = 0; ww < 8; ++ww) sacc += part[(ww * 16 + m) * 48 + 4 + gi * 8 + o]; el[o] = sacc; }
                int i1 = 0; float m1 = el[0];
#pragma unroll
                for (int o = 1; o < 8; ++o) if (el[o] > m1) { m1 = el[o]; i1 = o; }
                int i2 = 0; float m2 = -3e38f;
#pragma unroll
                for (int o = 0; o < 8; ++o) if (o != i1 && el[o] > m2) { m2 = el[o]; i2 = o; }
                const float e2x = __expf(m2 - m1); const float w1 = gw / (1.f + e2x), w2 = gw * e2x / (1.f + e2x);
                const int e1 = gi * 8 + i1, e2 = gi * 8 + i2;
                const int p1 = (int)__hip_atomic_fetch_add(F.ctl + wsm::CW_CNT + (lc * 32 + e1) * 64, 1u, RLX_AGENT);
                const int p2 = (int)__hip_atomic_fetch_add(F.ctl + wsm::CW_CNT + (lc * 32 + e2) * 64, 1u, RLX_AGENT);
                int* lists = (int*)(F.ws + wsm::LISTS); float* wl = (float*)(F.ws + wsm::WLIST);
                lists[e1 * LCAP + p1] = tok; lists[e2 * LCAP + p2] = tok; wl[e1 * LCAP + p1] = w1; wl[e2 * LCAP + p2] = w2;
                ((int4*)(F.ws + wsm::TOKINFO))[tok] = make_int4(e1, p1, e2, p2);
                ((int4*)(F.ws + wsm::ROUTE))[tok] = make_int4(e1, e2, __float_as_int(w1), __float_as_int(w2));
            }
            __syncthreads();
        }
    }
}
namespace att {
typedef float f32x16 __attribute__((ext_vector_type(16)));
typedef short s16x4 __attribute__((ext_vector_type(4)));
constexpr int L_K = 0, L_V = 16384, L_WSF = 135168, L_TAB = 137216;
__device__ __forceinline__ int crow(int r, int hi) { return (r & 3) + 8 * (r >> 2) + 4 * hi; }
__device__ __forceinline__ int t5_bucket(int rel) {
    const int ret = rel > 0 ? 16 : 0; const int n = rel < 0 ? -rel : rel; int bk;
    if (n < 8) bk = n; else if (n < 12) bk = 8; else if (n < 16) bk = 9; else if (n < 23) bk = 10; else if (n < 32) bk = 11;
    else if (n < 46) bk = 12; else if (n < 64) bk = 13; else if (n < 91) bk = 14; else bk = 15;
    return ret + bk;
}
__device__ __forceinline__ unsigned cvtpk(float lo, float hi) { return pk2(lo, hi); }
__device__ __forceinline__ void qkt(f32x16& p0, f32x16& p1, const LAS unsigned char* Kslot, const bf16x8* qr, const f32x16& c0, const f32x16& c1, int r32, int hi) {
    const LAS unsigned char* kb = Kslot + hi * 1024 + r32 * 16;
#pragma unroll
    for (int d0 = 0; d0 < 4; ++d0) {
        const bf16x8 b0 = *(const LAS bf16x8*)(kb + d0 * 2048);
        const bf16x8 b1 = *(const LAS bf16x8*)(kb + d0 * 2048 + 512);
        if (d0 == 0) { p0 = __builtin_amdgcn_mfma_f32_32x32x16_bf16(b0, qr[0], c0, 0, 0, 0); p1 = __builtin_amdgcn_mfma_f32_32x32x16_bf16(b1, qr[0], c1, 0, 0, 0); }
        else { p0 = __builtin_amdgcn_mfma_f32_32x32x16_bf16(b0, qr[d0], p0, 0, 0, 0); p1 = __builtin_amdgcn_mfma_f32_32x32x16_bf16(b1, qr[d0], p1, 0, 0, 0); } }
}
__device__ __forceinline__ float rowmax(const f32x16& p0, const f32x16& p1) {
    float a = fmaxf(fmaxf(p0[0], p0[1]), p1[0]), b = fmaxf(fmaxf(p0[2], p0[3]), p1[1]); a = fmaxf(fmaxf(a, p1[2]), p1[3]);
#pragma unroll
    for (int r = 4; r < 16; r += 4) { a = fmaxf(fmaxf(a, p0[r]), p0[r + 1]); b = fmaxf(fmaxf(b, p0[r + 2]), p0[r + 3]); a = fmaxf(fmaxf(a, p1[r]), p1[r + 1]); b = fmaxf(fmaxf(b, p1[r + 2]), p1[r + 3]); }
    const float m = fmaxf(a, b);
    auto rr = __builtin_amdgcn_permlane32_swap(__float_as_uint(m), __float_as_uint(m), false, false);
    return fmaxf(__uint_as_float(rr[0]), __uint_as_float(rr[1]));
}
template <int ND>
__device__ __forceinline__ void pv(f32x16* o, int vb, bf16x8 pa0, bf16x8 pa1, bf16x8 pa2, bf16x8 pa3) {
#pragma unroll
    for (int d0 = 0; d0 < ND; ++d0) { s16x4 lo[4], hi[4];
#pragma unroll
        for (int ks = 0; ks < 4; ++ks) {
            asm volatile("ds_read_b64_tr_b16 %0,%1 offset:%c2" : "=&v"(lo[ks]) : "v"(vb), "i"(d0 * 4096 + ks * 1024) : "memory");
            asm volatile("ds_read_b64_tr_b16 %0,%1 offset:%c2" : "=&v"(hi[ks]) : "v"(vb), "i"(d0 * 4096 + ks * 1024 + 512) : "memory"); }
        asm volatile("s_waitcnt lgkmcnt(0)" ::: "memory"); __builtin_amdgcn_sched_barrier(0);
#define ATT_PK(k) (bf16x8){lo[k][0], lo[k][1], lo[k][2], lo[k][3], hi[k][0], hi[k][1], hi[k][2], hi[k][3]}
        o[d0] = __builtin_amdgcn_mfma_f32_32x32x16_bf16(pa0, ATT_PK(0), o[d0], 0, 0, 0);
        o[d0] = __builtin_amdgcn_mfma_f32_32x32x16_bf16(pa1, ATT_PK(1), o[d0], 0, 0, 0);
        o[d0] = __builtin_amdgcn_mfma_f32_32x32x16_bf16(pa2, ATT_PK(2), o[d0], 0, 0, 0);
        o[d0] = __builtin_amdgcn_mfma_f32_32x32x16_bf16(pa3, ATT_PK(3), o[d0], 0, 0, 0);
#undef ATT_PK
    }
}
#define ATT_WAIT_BAR(N) asm volatile("s_waitcnt vmcnt(" #N ") lgkmcnt(0)\n\ts_barrier" ::: "memory")
#ifndef PROBE_ATT
#define PROBE_ATT -1
#endif
#define ATT_NOW() __builtin_amdgcn_s_memrealtime()
#define ATT_SBAR() __builtin_amdgcn_sched_barrier(0)
#define ATT_PIN(x) asm volatile("" : "+v"(x))
#define ATT_MFMA(a, b, c) __builtin_amdgcn_mfma_f32_32x32x16_bf16(a, b, c, 0, 0, 0)
typedef const LAS char* lds_cptr;
typedef short v4i16_t __attribute__((ext_vector_type(4)));
__device__ __forceinline__ void glds16(const void* g, unsigned lds_base) {
    unsigned sv; asm volatile("s_mov_b32 %0, m0\n\ts_mov_b32 m0, %2\n\ts_nop 0\n\tglobal_load_lds_dwordx4 %1, off\n\ts_mov_b32 m0, %0" : "=&s"(sv) : "v"(g), "s"(lds_base) : "memory"); }
__device__ __forceinline__ void kload2(bf16x8* kf, lds_cptr kp, int d0) { kf[2 * d0] = *(const LAS bf16x8*)(kp + d0 * 2048); kf[2 * d0 + 1] = *(const LAS bf16x8*)(kp + d0 * 2048 + 512); }
__device__ __forceinline__ s16x4 vtr(lds_cptr q) { return __builtin_bit_cast(s16x4, __builtin_amdgcn_ds_read_tr16_b64_v4i16((LAS v4i16_t*)q)); }

template <int MODE>
__device__ __forceinline__ void attn_unit(Frame& F, const Args& a, const int l, const int b, const int hh, const int qb) {
    using namespace cfg;
    constexpr int ND = MODE ? 4 : 2, VSLOT = ND * 4096, NV = MODE ? 2 : 1, EPG = 8 / ND, KRD0 = MODE ? 8 : 2, VLEAD = 5;
    constexpr int NS = 4, LK = 0, LV = NS * 8192, LQ = 98304;
    constexpr float THR = 8.f;
    unsigned long long pu0_ = 0; if (PROBE_ATT == 3) pu0_ = ATT_NOW();
    const int lane = F.lane, r32 = lane & 31, hi = lane >> 5, wid = F.wave;
    const bf16* p = (const bf16*)(F.ws + wsm::P);
    bf16* y = (bf16*)(F.ws + wsm::Y);
    float* O1s = (float*)(F.ws + wsm::XN);
    LAS unsigned char* lds = F.lds;
    LAS float* wsf = (LAS float*)(lds + L_WSF) + wid * 64;
    LAS float* tab = (LAS float*)(lds + L_TAB);
    const size_t rowbase = (size_t)b * SEQ;
    if (F.tid < 320) { const int i = F.tid; float v;
        if (MODE == 0) { int d = i - 64; d = d < -128 ? -128 : (d > 128 ? 128 : d); v = a.in[17][(size_t)(l * 8 + hh) * 257 + d + 128]; }
        else v = a.in[18][t5_bucket(-(i - 64)) * 4 + hh];
        tab[i] = v * LOG2E; }
    const int t0 = MODE == 0 ? (4 * qb - 8 > 0 ? 4 * qb - 8 : 0) : 0, t1 = 4 * qb + 3;
    const int cw = 4 * qb + (wid >> 1);
    const int va = MODE == 0 ? (cw - 8 > 0 ? cw - 8 : 0) : 0, vb = cw;
    const int q0w = qb * 256 + 32 * wid, myq = q0w + r32;
    const unsigned lds0 = (unsigned)(uintptr_t)lds;
    const lds_cptr kp0 = (lds_cptr)lds + LK + hi * 1024 + r32 * 16;
    const lds_cptr vp0 = (lds_cptr)lds + LV + ((lane >> 4) & 1) * 32 + (lane & 3) * 8 + (4 * hi + ((lane & 15) >> 2)) * 64;
#pragma unroll 1
    for (int sub = 0; sub < (MODE ? 2 : 1); ++sub) {
        const int qcol = MODE ? OFF_CQ + (hh * 2 + sub) * 64 : OFF_BQ + hh * 64;
        const int kcol = MODE ? OFF_CK + (hh * 2 + sub) * 64 : OFF_BK + hh * 64;
        const int vcol = MODE ? OFF_CV + hh * 128 : OFF_BV + hh * 64;
        const bf16* Kh = p + rowbase * INC + kcol; const bf16* Vh = p + rowbase * INC + vcol;
        const bf16* ksrc = Kh + (size_t)lane * INC + wid * 8;
        const bf16* vsrc0 = Vh + (size_t)(16 * (wid & 3) + (lane >> 2)) * INC + (wid >> 2) * 32 + (lane & 3) * 8;
        const unsigned kdst = lds0 + LK + wid * 1024, vdst = lds0 + LV + wid * 1024;
#define ATT_DMA_K(t, s) glds16(ksrc + (size_t)(t) * 64 * INC, (unsigned)__builtin_amdgcn_readfirstlane(kdst + (s) * 8192))
#define ATT_DMA_V(t, s) do { glds16(vsrc0 + (size_t)(t) * 64 * INC, (unsigned)__builtin_amdgcn_readfirstlane(vdst + (s) * VSLOT)); \
        if (MODE) glds16(vsrc0 + (size_t)(t) * 64 * INC + 64, (unsigned)__builtin_amdgcn_readfirstlane(vdst + (s) * VSLOT + 8192)); } while (0)
        { const bf16* Qw = p + (rowbase + q0w) * INC + qcol + (size_t)r32 * INC + hi * 8;
#pragma unroll
          for (int d0 = 0; d0 < 4; ++d0) glds16(Qw + d0 * 16, (unsigned)__builtin_amdgcn_readfirstlane(lds0 + LQ + wid * 4096 + d0 * 1024)); }
        ATT_DMA_K(t0, 0); ATT_DMA_V(t0, 0); ATT_DMA_K(t0 + 1, 1); ATT_DMA_K(t0 + 2, 2); ATT_DMA_K(t0 + 3, 3); ATT_DMA_V(t0 + 1, 1);
        float mhat = 0.f, l_reg = 0.f;
        f32x16 o[ND];
#pragma unroll
        for (int d0 = 0; d0 < ND; ++d0)
#pragma unroll
            for (int r = 0; r < 16; ++r) o[d0][r] = 0.f;
        { LAS unsigned char* z = lds + LV + 3 * VSLOT + F.tid * (VSLOT / 512);
#pragma unroll
          for (int i = 0; i < VSLOT / 512 / 16; ++i) *(LAS u32x4*)(z + 16 * i) = (u32x4){0u, 0u, 0u, 0u}; }
        if (MODE) { ATT_WAIT_BAR(4); } else { ATT_WAIT_BAR(3); }
        const float cf = tab[300];
        bf16x8 qr[4];
#pragma unroll
        for (int d0 = 0; d0 < 4; ++d0) qr[d0] = *(const LAS bf16x8*)(lds + LQ + wid * 4096 + d0 * 1024 + lane * 16);
        bf16x8 kf[8];
#pragma unroll
        for (int d0 = 0; d0 < 4; ++d0) kload2(kf, kp0, d0);
        asm volatile("s_waitcnt lgkmcnt(0)\n\ts_barrier" ::: "memory");
        f32x16 C0, C1; u32x4 pw[4];
#pragma unroll
        for (int r = 0; r < 16; ++r) { C0[r] = 0.f; C1[r] = 0.f; }
#pragma unroll
        for (int g = 0; g < 4; ++g) pw[g] = (u32x4){0u, 0u, 0u, 0u};
#define ATT_CE(e) (((e) < 16) ? C0[(e) & 15] : C1[(e) & 15])
#define ATT_CEXP(e) do { if ((e) < 16) C0[(e) & 15] = __builtin_amdgcn_exp2f(C0[(e) & 15]); else C1[(e) & 15] = __builtin_amdgcn_exp2f(C1[(e) & 15]); } while (0)
#define ATT_VRD(ks, d0) do { vlo[(ks) * ND + (d0)] = vtr(vpp + (d0) * 4096 + (ks) * 1024); vhi[(ks) * ND + (d0)] = vtr(vpp + (d0) * 4096 + (ks) * 1024 + 512); } while (0)
#define ATT_VRDF(f) ATT_VRD((f) / ND, (f) % ND)
#define ATT_VFR(i) (bf16x8){vlo[i][0], vlo[i][1], vlo[i][2], vlo[i][3], vhi[i][0], vhi[i][1], vhi[i][2], vhi[i][3]}
#define ATT_PAF(g) __builtin_bit_cast(bf16x8, pw[g])
        unsigned long long pl0_ = 0; if (PROBE_ATT == 2) pl0_ = ATT_NOW(); if (PROBE_ATT == 4) pl0_ = __builtin_amdgcn_s_memtime();
#pragma unroll 1
        for (int t = t0; t <= t1; ++t) {
            const bool gk = (t + 4 <= t1), gv = (t + 2 <= t1);
            const int s_cur = (t - t0) & 3, s_prev = (t - t0 - 1) & 3, s_next = (t - t0 + 1) & 3, s_nn = (t - t0 + 2) & 3;
            const lds_cptr vpp = vp0 + s_prev * VSLOT;
            const lds_cptr kpn = kp0 + s_next * 8192;
            bool resc = false;
            ATT_SBAR();
            {
                s16x4 vlo[4 * ND], vhi[4 * ND];
                const bool msk = (t > vb) || (t < va);
                const bool nearb = !msk && (q0w - (t * 64 + 63)) < 128;
                if (nearb) {
                    const LAS float* tb = tab + (myq - t * 64 - 4 * hi + 64 - 27 - 32);
#pragma unroll
                    for (int r = 0; r < 16; ++r) { C1[r] = tb[27 - ((r & 3) + 8 * (r >> 2))] - mhat; C0[r] = tb[32 + 27 - ((r & 3) + 8 * (r >> 2))] - mhat; }
                    ATT_SBAR();
                    C0 = ATT_MFMA(kf[0], qr[0], C0); ATT_SBAR(); C1 = ATT_MFMA(kf[1], qr[0], C1); ATT_SBAR();
                } else {
                    f32x16 cfm; const float cfv = msk ? -1e30f : cf - mhat;
#pragma unroll
                    for (int r = 0; r < 16; ++r) cfm[r] = cfv;
                    ATT_SBAR();
                    C0 = ATT_MFMA(kf[0], qr[0], cfm); ATT_SBAR(); C1 = ATT_MFMA(kf[1], qr[0], cfm); ATT_SBAR();
                }
#pragma unroll
                for (int i = 2; i < 8; ++i) {
                    if (i >= 8 - VLEAD) { ATT_VRDF(i - (8 - VLEAD)); ATT_SBAR(); }
                    if (i & 1) C1 = ATT_MFMA(kf[i], qr[i >> 1], C1); else C0 = ATT_MFMA(kf[i], qr[i >> 1], C0);
                    ATT_SBAR();
                }
                if (gk) ATT_DMA_K(t + 4, s_cur);
                if (gv) ATT_DMA_V(t + 2, s_nn);
                const float rm = rowmax(C0, C1);
                const bool firstv = (t == va);
                if (__builtin_expect(firstv || __any(rm > THR), 0)) {
                    const float dl = firstv ? rm : fmaxf(rm, 0.f); mhat += dl;
#pragma unroll
                    for (int r = 0; r < 16; ++r) { C0[r] -= dl; C1[r] -= dl; }
                    const float f = firstv ? 1.f : __builtin_amdgcn_exp2f(-dl); l_reg *= f; if (hi == 0) wsf[r32] = f; resc = !firstv;
                }
                ATT_SBAR();
                float sa = 0.f, sb = 0.f;
#pragma unroll
                for (int m = 0; m < 4 * ND; ++m) {
                    const int g = m / ND, d0 = m % ND;
                    if (m + VLEAD < 4 * ND) { ATT_VRDF(m + VLEAD); ATT_SBAR(); }
                    if (m >= KRD0 && m < KRD0 + 4) { kload2(kf, kpn, m - KRD0); ATT_SBAR(); }
                    o[d0] = ATT_MFMA(ATT_PAF(g), ATT_VFR(g * ND + d0), o[d0]);
#pragma unroll
                    for (int jj = 0; jj < EPG; ++jj) ATT_CEXP(8 * g + EPG * d0 + jj);
                    if (g >= 1) {
#pragma unroll
                        for (int jj = 0; jj < EPG; jj += 2) { const int e = 8 * (g - 1) + EPG * d0 + jj; sa += ATT_CE(e); sb += ATT_CE(e + 1); pw[g - 1][(EPG * d0 + jj) >> 1] = pk2(ATT_CE(e), ATT_CE(e + 1)); }
                        ATT_PIN(pw[g - 1]); ATT_PIN(sa); ATT_PIN(sb);
                    }
                    if (g < 2) ATT_PIN(C0); else ATT_PIN(C1);
                    ATT_SBAR();
                }
#pragma unroll
                for (int jj = 0; jj < 8; jj += 2) { const int e = 24 + jj; sa += ATT_CE(e); sb += ATT_CE(e + 1); pw[3][jj >> 1] = pk2(ATT_CE(e), ATT_CE(e + 1)); }
                l_reg += sa + sb;
            }
            ATT_SBAR();
            unsigned long long pw0_ = 0; if (PROBE_ATT == 0) pw0_ = ATT_NOW();
            { const int dleft = t1 - t;
              if (dleft >= 4) { if (MODE) { ATT_WAIT_BAR(6); } else { ATT_WAIT_BAR(4); } }
              else if (dleft == 3) { if (MODE) { ATT_WAIT_BAR(5); } else { ATT_WAIT_BAR(3); } }
              else if (dleft == 2) { if (MODE) { ATT_WAIT_BAR(4); } else { ATT_WAIT_BAR(2); } }
              else if (dleft == 1) { if (MODE) { ATT_WAIT_BAR(2); } else { ATT_WAIT_BAR(1); } }
              else { ATT_WAIT_BAR(0); } }
            if (PROBE_ATT == 0) F.pacc += ATT_NOW() - pw0_;
            if (resc) {
#pragma unroll
                for (int r = 0; r < 16; ++r) { const float fr = wsf[crow(r, hi)];
#pragma unroll
                    for (int d0 = 0; d0 < ND; ++d0) o[d0][r] *= fr; }
            }
        }
        if (PROBE_ATT == 2) F.pacc += ATT_NOW() - pl0_; if (PROBE_ATT == 4) F.pacc += (__builtin_amdgcn_s_memtime() - pl0_) / 100;
        {
            const lds_cptr vpp = vp0 + ((t1 - t0) & 3) * VSLOT;
            s16x4 vlo[4 * ND], vhi[4 * ND];
#pragma unroll
            for (int ks = 0; ks < 4; ++ks) {
#pragma unroll
                for (int d0 = 0; d0 < ND; ++d0) ATT_VRD(ks, d0);
#pragma unroll
                for (int d0 = 0; d0 < ND; ++d0) o[d0] = ATT_MFMA(ATT_PAF(ks), ATT_VFR(ks * ND + d0), o[d0]);
            }
            asm volatile("s_waitcnt lgkmcnt(0)\n\ts_barrier" ::: "memory");
        }
#undef ATT_DMA_K
#undef ATT_DMA_V
#undef ATT_CE
#undef ATT_CEXP
#undef ATT_VRD
#undef ATT_VFR
#undef ATT_VRDF
#undef ATT_PAF
        float lh = l_reg;
        int ln = lane; asm volatile("" : "+v"(ln));
        const int e32 = ln & 31, ehi = ln >> 5;
        { auto rr = __builtin_amdgcn_permlane32_swap(__float_as_uint(lh), __float_as_uint(lh), false, false); lh = __uint_as_float(rr[0]) + __uint_as_float(rr[1]); }
        if (ehi == 0) wsf[32 + e32] = lh;
        LDS_WAIT();
        constexpr int SP = ND * 128 + 16;
        LAS unsigned char* stg = lds + wid * (32 * SP);
#pragma unroll
        for (int r = 0; r < 16; ++r) { const float rl = __builtin_amdgcn_rcpf(wsf[32 + crow(r, ehi)]);
#pragma unroll
            for (int d0 = 0; d0 < ND; ++d0) *(LAS float*)(stg + crow(r, ehi) * SP + (d0 * 32 + e32) * 4) = o[d0][r] * rl; }
        LDS_WAIT();
        const size_t tok0 = rowbase + (size_t)(qb * 256 + 32 * wid);
        if (MODE == 0) {
#pragma unroll 4
            for (int row = 0; row < 32; ++row) { const float v = *(const LAS float*)(stg + row * SP + ln * 4);
                if (F8OUT(l)) ((unsigned char*)y)[(tok0 + row) * D + 512 + hh * 64 + ln] = (unsigned char)(pk2_fp8(v * F8_Y, 0.f) & 0xffu); else y[(tok0 + row) * D + 512 + hh * 64 + ln] = cvt1(v); }
        } else if (sub == 0) {
#pragma unroll 4
            for (int row = 0; row < 32; ++row) { const f32x2 v = *(const LAS f32x2*)(stg + row * SP + ln * 8); *(f32x2*)(O1s + ((tok0 + row) * 4 + hh) * 128 + 2 * ln) = v; }
        } else {
            const float lam_init = l == 0 ? 0.2f : (float)(0.8 - 0.6 * 0.7408182206817179);
            const float lam = __expf(wave_sum(a.in[19][l * 64 + ln] * a.in[20][l * 64 + ln])) - __expf(wave_sum(a.in[21][l * 64 + ln] * a.in[22][l * 64 + ln])) + lam_init;
            const float* sw = a.in[23] + l * 128;
            const float sw0 = sw[2 * ln] * (1.f - lam_init), sw1 = sw[2 * ln + 1] * (1.f - lam_init);
#pragma unroll 2
            for (int row = 0; row < 32; ++row) { const f32x2 v2 = *(const LAS f32x2*)(stg + row * SP + ln * 8); const f32x2 o1 = *(const f32x2*)(O1s + ((tok0 + row) * 4 + hh) * 128 + 2 * ln);
                const float v0 = o1.x - lam * v2.x, v1 = o1.y - lam * v2.y;
                const float ms = wave_sum(v0 * v0 + v1 * v1);
                const float rs = rsqrtf(ms * (1.f / 128.f) + 1e-5f);
                if (F8OUT(l)) *(unsigned short*)((unsigned char*)y + (tok0 + row) * D + 1024 + hh * 128 + 2 * ln) = (unsigned short)pk2_fp8(v0 * rs * sw0 * F8_Y, v1 * rs * sw1 * F8_Y);
                else *(unsigned*)(y + (tok0 + row) * D + 1024 + hh * 128 + 2 * ln) = pk2(v0 * rs * sw0, v1 * rs * sw1); }
        }
        asm volatile("s_waitcnt vmcnt(0) lgkmcnt(0)\n\ts_barrier" ::: "memory");
    }
    if (PROBE_ATT == 3) F.pacc += ATT_NOW() - pu0_;
}

__device__ __forceinline__ void conv_items(Frame& F, const Args& a, const int l, const int start, const int stride) {
    using namespace cfg;
    const bf16* p = (const bf16*)(F.ws + wsm::P); bf16* y = (bf16*)(F.ws + wsm::Y);
    const float* cw = a.in[24] + l * 3 * 512;
    for (int it = start; it < M * 64; it += stride) {
        const int tok = it >> 6, cg = (it & 63) * 8, t = tok & (SEQ - 1);
        const bf16* r0 = p + (size_t)tok * INC + OFF_D + cg;
        const u32x4 bg = *(const u32x4*)r0;
        u32x4 c0 = *(const u32x4*)(r0 + 512), h0 = *(const u32x4*)(r0 + 1024);
        u32x4 c1 = (u32x4){0, 0, 0, 0}, h1 = c1, c2 = c1, h2 = c1;
        if (t >= 1) { c1 = *(const u32x4*)(r0 - INC + 512); h1 = *(const u32x4*)(r0 - INC + 1024); }
        if (t >= 2) { c2 = *(const u32x4*)(r0 - 2 * INC + 512); h2 = *(const u32x4*)(r0 - 2 * INC + 1024); }
        unsigned ow[4];
#pragma unroll
        for (int j = 0; j < 4; ++j) {
            float res[2];
#pragma unroll
            for (int e = 0; e < 2; ++e) {
                const int ch = cg + 2 * j + e;
#define ATT_UP(w) (e ? __uint_as_float((w) & 0xffff0000u) : __uint_as_float((w) << 16))
                const float u0 = ATT_UP(c0[j]) * ATT_UP(h0[j]), u1 = ATT_UP(c1[j]) * ATT_UP(h1[j]), u2 = ATT_UP(c2[j]) * ATT_UP(h2[j]);
                res[e] = ATT_UP(bg[j]) * (cw[ch] * u2 + cw[512 + ch] * u1 + cw[1024 + ch] * u0);
#undef ATT_UP
            }
            ow[j] = (F8OUT(l)) ? pk2_fp8(res[0] * F8_Y, res[1] * F8_Y) : pk2(res[0], res[1]);
        }
        if (F8OUT(l)) *(u32x2*)((unsigned char*)y + (size_t)tok * D + 1536 + cg) = (u32x2){ow[0] | (ow[1] << 16), ow[2] | (ow[3] << 16)};
        else *(u32x4*)(y + (size_t)tok * D + 1536 + cg) = (u32x4){ow[0], ow[1], ow[2], ow[3]};
    }
}
}
namespace rw {
constexpr int PB = 144, PB2 = 272;
constexpr int SLOT = 9216;
constexpr int R0 = 0, R1B = 49152;
constexpr int O_P0 = 0, O_P0T = 9216, O_AAK = 18432, O_ARB = 27648, O_ARK = 36864;
constexpr int O_SEG = R1B + 9 * SLOT, O_BON = O_SEG + 2048;
constexpr size_t UNIT_BYTES = 49152;
constexpr size_t WL_OFF = (size_t)4096 * UNIT_BYTES;
#define RW_S(i) (R1B + (i) * SLOT)

__device__ __forceinline__ bf16x8 ldfrag(const LAS unsigned char* base, int pitch, int row0, int lane, int s) {
    return *(const LAS bf16x8*)(base + (row0 + (lane & 15)) * pitch + (32 * s + 8 * (lane >> 4)) * 2);
}
template <int KS>
__device__ __forceinline__ f32x4 tile_mm(f32x4 acc, const LAS unsigned char* X, int px, int m0, const LAS unsigned char* Y, int py, int n0, int lane) {
#pragma unroll
    for (int s = 0; s < KS; ++s) acc = __builtin_amdgcn_mfma_f32_16x16x32_bf16(ldfrag(Y, py, n0, lane, s), ldfrag(X, px, m0, lane, s), acc, 0, 0, 0);
    return acc;
}
__device__ __forceinline__ void st_rm(LAS unsigned char* base, int pitch, int m, int n0, f32x4 v) {
    u32x2 w; w.x = pk2(v[0], v[1]); w.y = pk2(v[2], v[3]); *(LAS u32x2*)(base + m * pitch + n0 * 2) = w;
}
__device__ __forceinline__ void st_tr(LAS unsigned char* base, int pitch, int m, int n0, f32x4 v) {
    const unsigned p01 = pk2(v[0], v[1]), p23 = pk2(v[2], v[3]);
    *(LAS bf16*)(base + (n0 + 0) * pitch + m * 2) = (bf16)(p01 & 0xffffu); *(LAS bf16*)(base + (n0 + 1) * pitch + m * 2) = (bf16)(p01 >> 16);
    *(LAS bf16*)(base + (n0 + 2) * pitch + m * 2) = (bf16)(p23 & 0xffffu); *(LAS bf16*)(base + (n0 + 3) * pitch + m * 2) = (bf16)(p23 >> 16);
}
__device__ __forceinline__ f32x4 ld_rm(const LAS unsigned char* base, int pitch, int m, int n0) {
    const u32x2 w = *(const LAS u32x2*)(base + m * pitch + n0 * 2);
    return (f32x4){__uint_as_float(w.x << 16), __uint_as_float(w.x & 0xffff0000u), __uint_as_float(w.y << 16), __uint_as_float(w.y & 0xffff0000u)};
}
__device__ __forceinline__ void unpack8(const u32x4 w, float* f) {
#pragma unroll
    for (int j = 0; j < 4; ++j) { f[2 * j] = __uint_as_float(w[j] << 16); f[2 * j + 1] = __uint_as_float(w[j] & 0xffff0000u); }
}
__device__ __forceinline__ u32x4 pack8(const float* f) { return (u32x4){pk2(f[0], f[1]), pk2(f[2], f[3]), pk2(f[4], f[5]), pk2(f[6], f[7])}; }
__device__ __forceinline__ float sigm(float x) { return __builtin_amdgcn_rcpf(1.f + __expf(-x)); }
#define RW_BAR() do { asm volatile("s_waitcnt lgkmcnt(0)" ::: "memory"); __builtin_amdgcn_s_barrier(); asm volatile("" ::: "memory"); } while (0)

#ifndef PROBE_R1
#define PROBE_R1 -1
#endif
#define R1_STAMP(k) do { if (PROBE_R1 >= 0) { const unsigned long long now_ = __builtin_amdgcn_s_memrealtime(); if (PROBE_R1 == (k)) racc += now_ - rlast; rlast = now_; } } while (0)
struct R1Raw { u32x4 c[7], p[7]; };
__device__ __forceinline__ void r1_load(Frame& F, const int u, R1Raw& raw, const int tid) {
    using namespace cfg;
    const int c = u & 63, h = (u >> 6) & 7, b = u >> 9, t = tid >> 3, j0 = (tid & 7) * 8;
    const bf16* cur = (const bf16*)(F.ws + wsm::P) + ((size_t)b * SEQ + c * 64 + t) * INC + j0; const bf16* prv = cur - INC;
#pragma unroll
    for (int i = 0; i < 7; ++i) { const int col = i < 4 ? 1536 + 64 * i : (i - 4) * 512 + h * 64; raw.c[i] = *(const u32x4*)(cur + col); raw.p[i] = *(const u32x4*)(prv + col); }
}
__device__ __forceinline__ void r1_unit(Frame& F, const Args& a, const int l, const int u, const int unext, R1Raw& raw, unsigned long long& racc, int& hcur) {
    using namespace cfg;
    unsigned long long rlast = PROBE_R1 >= 0 ? __builtin_amdgcn_s_memrealtime() : 0ull;
    int tid_ = F.tid; asm volatile("" : "+v"(tid_));
    const int tid = tid_, lane = tid & 63, w = F.wave;
    const int c = u & 63, h = (u >> 6) & 7, b = u >> 9;
    unsigned lbase_ = (unsigned)(uintptr_t)F.lds; asm volatile("" : "+s"(lbase_));
    LAS unsigned char* lds = (LAS unsigned char*)(uintptr_t)lbase_;
    const bf16* p = (const bf16*)(F.ws + wsm::P);
    const bf16* w2t = (const bf16*)(F.ws + wsm::WRT + 262144);
    const bf16* a2t = w2t + 512 * 64; const bf16* g2t = a2t + 512 * 64;
    unsigned char* gout = F.ws + wsm::RW + (size_t)u * UNIT_BYTES;
    float* wl_out = (float*)(F.ws + wsm::RW + WL_OFF) + (size_t)u * 64;
    const float* mu = a.in[6] + l * 1792;
    const size_t tok0 = (size_t)b * SEQ + c * 64;
    const int t = tid >> 3, j0 = (tid & 7) * 8;
    const bool hasprev = (c > 0) || (t > 0);
    const bf16* cur = p + (tok0 + t) * INC; const bf16* prv = cur - INC;
    LAS float* WPRE = (LAS float*)(lds + 0); LAS float* APRE = (LAS float*)(lds + 16384); LAS float* GG = (LAS float*)(lds + 32768);
    LAS float* PAR = (LAS float*)(lds + 134400);
    const int mtA = w >> 1;
    bf16x8 fw[2][2], fa[2][2], fg[2][4];
    if (h != hcur) {
        RW_BAR();
        if (w < 7) { const int pidx = w == 0 ? 7 : (w == 1 ? 9 : 10 + w); PAR[w * 64 + lane] = a.in[pidx][l * 512 + h * 64 + lane]; }
        if (tid < 448) { const int col = tid < 192 ? (tid >> 6) * 512 + h * 64 + (tid & 63) : 1536 + (tid - 192); PAR[448 + tid] = mu[col]; }
        hcur = h;
        RW_BAR();
    }
    float r[8], k[8], v[8];
    {
        auto mix8 = [&](int i, int mo, float* o) { float cv[8], pv[8], m8[8]; unpack8(raw.c[i], cv);
            if (hasprev) unpack8(raw.p[i], pv); else {
#pragma unroll
                for (int j = 0; j < 8; ++j) pv[j] = 0.f; }
            *(f32x4*)m8 = *(const LAS f32x4*)(PAR + 448 + mo); *(f32x4*)(m8 + 4) = *(const LAS f32x4*)(PAR + 448 + mo + 4);
#pragma unroll
            for (int j = 0; j < 8; ++j) o[j] = cv[j] + (pv[j] - cv[j]) * m8[j]; };
        float x[8];
        mix8(0, 192 + j0, x);
#pragma unroll
        for (int j = 0; j < 8; ++j) { const float e2 = __expf(2.f * x[j]); x[j] = 1.f - 2.f * __builtin_amdgcn_rcpf(e2 + 1.f); }
        *(LAS u32x4*)(lds + RW_S(0) + t * PB + j0 * 2) = pack8(x);
        mix8(1, 256 + j0, x);
        *(LAS u32x4*)(lds + RW_S(1) + t * PB + j0 * 2) = pack8(x);
        asm volatile("" ::: "memory");
        mix8(2, 320 + j0, x);
#pragma unroll
        for (int j = 0; j < 8; ++j) x[j] = sigm(x[j]);
        *(LAS u32x4*)(lds + RW_S(2) + t * PB2 + j0 * 2) = pack8(x);
        mix8(3, 384 + j0, x);
#pragma unroll
        for (int j = 0; j < 8; ++j) x[j] = sigm(x[j]);
        *(LAS u32x4*)(lds + RW_S(2) + t * PB2 + (64 + j0) * 2) = pack8(x);
        asm volatile("" ::: "memory");
#pragma unroll
        for (int q = 0; q < 2; ++q) { const int ch = h * 64 + 16 * (2 * (w & 1) + q) + (lane & 15);
#pragma unroll
            for (int s2 = 0; s2 < 2; ++s2) { const int kq = 32 * s2 + 8 * (lane >> 4); fw[q][s2] = *(const bf16x8*)(w2t + ch * 64 + kq); fa[q][s2] = *(const bf16x8*)(a2t + ch * 64 + kq); }
#pragma unroll
            for (int s2 = 0; s2 < 4; ++s2) fg[q][s2] = *(const bf16x8*)(g2t + ch * 128 + 32 * s2 + 8 * (lane >> 4)); }
        mix8(4, j0, r); mix8(5, 64 + j0, k); mix8(6, 128 + j0, v);
        r1_load(F, unext, raw, tid);
    }
    RW_BAR(); R1_STAMP(0);
    {
#pragma unroll
        for (int q = 0; q < 2; ++q) { const int nt = 2 * (w & 1) + q;
            f32x4 aw = {0.f, 0.f, 0.f, 0.f}, aa = aw, ag = aw;
#pragma unroll
            for (int s2 = 0; s2 < 2; ++s2) {
                aw = __builtin_amdgcn_mfma_f32_16x16x32_bf16(fw[q][s2], ldfrag(lds + RW_S(0), PB, 16 * mtA, lane, s2), aw, 0, 0, 0);
                aa = __builtin_amdgcn_mfma_f32_16x16x32_bf16(fa[q][s2], ldfrag(lds + RW_S(1), PB, 16 * mtA, lane, s2), aa, 0, 0, 0); }
#pragma unroll
            for (int s2 = 0; s2 < 4; ++s2) ag = __builtin_amdgcn_mfma_f32_16x16x32_bf16(fg[q][s2], ldfrag(lds + RW_S(2), PB2, 16 * mtA, lane, s2), ag, 0, 0, 0);
            const int m = 16 * mtA + (lane & 15), n0 = 16 * nt + 4 * (lane >> 4);
            const f32x4 w04 = *(const LAS f32x4*)(PAR + n0), a04 = *(const LAS f32x4*)(PAR + 64 + n0);
#pragma unroll
            for (int i = 0; i < 4; ++i) { const float nx = -(w04[i] + aw[i]); const float sp = nx > 20.f ? nx : __logf(1.f + __expf(nx)); aw[i] = -__expf(-sp - 0.5f); aa[i] = sigm(a04[i] + aa[i]); }
            *(LAS f32x4*)(WPRE + m * 64 + n0) = aw; *(LAS f32x4*)(APRE + m * 64 + n0) = aa; *(LAS f32x4*)(GG + m * 64 + n0) = ag; }
    }
    RW_BAR(); R1_STAMP(1); R1_STAMP(2);
    {
        LAS float* SEG = (LAS float*)(lds + O_SEG);
        const int ch = tid & 63, seg = tid >> 6;
        float pf[8]; float run = 0.f;
#pragma unroll
        for (int i = 0; i < 8; ++i) { run += WPRE[(8 * seg + i) * 64 + ch]; pf[i] = run; }
        SEG[seg * 64 + ch] = run;
        RW_BAR();
        float off = 0.f;
        for (int s2 = 0; s2 < seg; ++s2) off += SEG[s2 * 64 + ch];
#pragma unroll
        for (int i = 0; i < 8; ++i) WPRE[(8 * seg + i) * 64 + ch] = off + pf[i];
    }
    RW_BAR(); R1_STAMP(3);
    {
        float kk[8], k2[8], aic[8]; float ss = 0.f, bon = 0.f;
        { float pkk[8], pka[8], prk[8];
#define R1_LD8(dst, src) do { *(f32x4*)(dst) = *(const LAS f32x4*)(src); *(f32x4*)((dst) + 4) = *(const LAS f32x4*)((src) + 4); } while (0)
          R1_LD8(aic, APRE + t * 64 + j0); R1_LD8(pkk, PAR + 128 + j0); R1_LD8(pka, PAR + 192 + j0); R1_LD8(prk, PAR + 256 + j0);
#undef R1_LD8
#pragma unroll
          for (int j = 0; j < 8; ++j) { kk[j] = k[j] * pkk[j]; ss += kk[j] * kk[j]; k2[j] = k[j] * (1.f + (aic[j] - 1.f) * pka[j]); bon += r[j] * k2[j] * prk[j]; } }
        ss += __shfl_xor(ss, 1); ss += __shfl_xor(ss, 2); ss += __shfl_xor(ss, 4);
        bon += __shfl_xor(bon, 1); bon += __shfl_xor(bon, 2); bon += __shfl_xor(bon, 4);
        const float inv = 1.f / fmaxf(sqrtf(ss), 1e-12f);
        unsigned g1w[4], g0w[4];
#pragma unroll
        for (int jp = 0; jp < 8; jp += 2) {
            const f32x2 cum = *(const LAS f32x2*)(WPRE + t * 64 + j0 + jp), tot = *(const LAS f32x2*)(WPRE + 63 * 64 + j0 + jp), gg = *(const LAS f32x2*)(GG + t * 64 + j0 + jp);
            f32x2 cpv = {0.f, 0.f}; if (t > 0) cpv = *(const LAS f32x2*)(WPRE + (t - 1) * 64 + j0 + jp);
            const f32x2 pgw = *(const LAS f32x2*)(PAR + 320 + j0 + jp), pgb = *(const LAS f32x2*)(PAR + 384 + j0 + jp);
            float xa[2], xr[2], xb[2], xk[2], xbh[2], xkh[2], g1[2], g0[2];
#pragma unroll
            for (int e = 0; e < 2; ++e) { const int j = jp + e; const float kn = kk[j] * inv, bv = kn * aic[j];
                const float e_ex = __expf(cpv[e]), e_in = __expf(cum[e]), e_ng = __expf(-cum[e]), e_tt = __expf(tot[e] - cum[e]);
                xa[e] = -kn * e_ex; xr[e] = r[j] * e_in; xb[e] = bv * e_ng; xk[e] = k2[j] * e_ng; xbh[e] = bv * e_tt; xkh[e] = k2[j] * e_tt;
                g1[e] = pgw[e] * gg[e]; g0[e] = (pgb[e] + bon * v[j]) * gg[e];
                if (t == 63) wl_out[j0 + j] = __expf(tot[e]); }
            const unsigned pa = pk2(xa[0], xa[1]), pr = pk2(xr[0], xr[1]), pb = pk2(xb[0], xb[1]), pkn = pk2(xk[0], xk[1]), pv2 = pk2(v[jp], v[jp + 1]), pbh = pk2(xbh[0], xbh[1]), pkh = pk2(xkh[0], xkh[1]);
            *(LAS unsigned*)(lds + RW_S(0) + t * PB + (j0 + jp) * 2) = pa; *(LAS unsigned*)(lds + RW_S(1) + t * PB + (j0 + jp) * 2) = pr;
            *(LAS unsigned*)(lds + RW_S(2) + t * PB + (j0 + jp) * 2) = pb; *(LAS unsigned*)(lds + RW_S(3) + t * PB + (j0 + jp) * 2) = pkn;
            *(LAS bf16*)(lds + RW_S(4) + (j0 + jp) * PB + t * 2) = (bf16)(pa & 0xffffu); *(LAS bf16*)(lds + RW_S(4) + (j0 + jp + 1) * PB + t * 2) = (bf16)(pa >> 16);
            *(LAS bf16*)(lds + RW_S(5) + (j0 + jp) * PB + t * 2) = (bf16)(pv2 & 0xffffu); *(LAS bf16*)(lds + RW_S(5) + (j0 + jp + 1) * PB + t * 2) = (bf16)(pv2 >> 16);
            *(LAS bf16*)(lds + RW_S(6) + (j0 + jp) * PB + t * 2) = (bf16)(pbh & 0xffffu); *(LAS bf16*)(lds + RW_S(6) + (j0 + jp + 1) * PB + t * 2) = (bf16)(pbh >> 16);
            *(LAS bf16*)(lds + RW_S(7) + (j0 + jp) * PB + t * 2) = (bf16)(pkh & 0xffffu); *(LAS bf16*)(lds + RW_S(7) + (j0 + jp + 1) * PB + t * 2) = (bf16)(pkh >> 16);
            g1w[jp >> 1] = pk2(g1[0], g1[1]); g0w[jp >> 1] = pk2(g0[0], g0[1]);
        }
        *(u32x4*)(gout + 32768 + (t * 64 + j0) * 2) = (u32x4){g1w[0], g1w[1], g1w[2], g1w[3]};
        *(u32x4*)(gout + 40960 + (t * 64 + j0) * 2) = (u32x4){g0w[0], g0w[1], g0w[2], g0w[3]};
    }
    RW_BAR(); R1_STAMP(4);
    {
        const int mi = w >> 1;
        const LAS unsigned char* X = lds + RW_S(mi < 2 ? 0 : 1); const LAS unsigned char* Y = lds + RW_S((mi & 1) ? 3 : 2);
        LAS unsigned char* dst = lds + (mi == 0 ? O_P0 : mi == 1 ? O_AAK : mi == 2 ? O_ARB : O_ARK);
        const bool incl = mi >= 2;
#pragma unroll
        for (int q = 0; q < 2; ++q) { const int mt = 2 * (w & 1) + q; const int m = 16 * mt + (lane & 15);
#pragma unroll
            for (int nt = 0; nt < 4; ++nt) { f32x4 acc = {0.f, 0.f, 0.f, 0.f};
                if (nt <= mt) acc = tile_mm<2>(acc, X, PB, 16 * mt, Y, PB, 16 * nt, lane);
                const int n0 = 16 * nt + 4 * (lane >> 4);
#pragma unroll
                for (int i = 0; i < 4; ++i) { const int n = n0 + i; if (!(incl ? n <= m : n < m)) acc[i] = 0.f; }
                st_rm(dst, PB, m, n0, acc);
                if (mi == 0) st_tr(lds + O_P0T, PB, m, n0, acc); } }
    }
    RW_BAR(); R1_STAMP(5);
    {
        f32x4 T[4];
        const int wr = w & 3, m = 16 * wr + (lane & 15);
        LAS unsigned char* Trm = lds + RW_S(8);
        if (w < 4) {
#pragma unroll
            for (int nt = 0; nt < 4; ++nt) { const int n0 = 16 * nt + 4 * (lane >> 4); T[nt] = ld_rm(lds + O_P0, PB, m, n0);
#pragma unroll
                for (int i = 0; i < 4; ++i) if (n0 + i == m) T[nt][i] += 1.f;
                st_rm(Trm, PB, m, n0, T[nt]); }
#pragma unroll
            for (int nt = 0; nt < 4; ++nt) { f32x4 acc = {0.f, 0.f, 0.f, 0.f}; acc = tile_mm<2>(acc, lds + RW_S(5), PB, 16 * wr, lds + O_AAK, PB, 16 * nt, lane); st_rm(lds + RW_S(0), PB, m, 16 * nt + 4 * (lane >> 4), acc); }
        } else {
#pragma unroll
            for (int nt = 0; nt < 4; ++nt) { f32x4 acc = {0.f, 0.f, 0.f, 0.f}; acc = tile_mm<2>(acc, lds + O_P0, PB, 16 * wr, lds + O_P0T, PB, 16 * nt, lane);
                const int n0 = 16 * nt + 4 * (lane >> 4); st_rm(lds + RW_S(2), PB, m, n0, acc); st_tr(lds + RW_S(3), PB, m, n0, acc); }
        }
        RW_BAR();
#pragma unroll 1
        for (int s = 1; s <= 5; ++s) {
            const int cb = s & 1;
            const LAS unsigned char* Pc = lds + (cb ? RW_S(2) : O_P0); const LAS unsigned char* PcT = lds + (cb ? RW_S(3) : O_P0T);
            LAS unsigned char* Pn = lds + (cb ? O_P0 : RW_S(2)); LAS unsigned char* PnT = lds + (cb ? O_P0T : RW_S(3));
            if (w < 4) {
                f32x4 d[4];
#pragma unroll
                for (int nt = 0; nt < 4; ++nt) { d[nt] = (f32x4){0.f, 0.f, 0.f, 0.f}; d[nt] = tile_mm<2>(d[nt], Trm, PB, 16 * wr, PcT, PB, 16 * nt, lane); }
                LDS_WAIT();
#pragma unroll
                for (int nt = 0; nt < 4; ++nt) { T[nt] += d[nt]; st_rm(Trm, PB, m, 16 * nt + 4 * (lane >> 4), T[nt]); }
            } else if (s < 5) {
#pragma unroll
                for (int nt = 0; nt < 4; ++nt) { f32x4 acc = {0.f, 0.f, 0.f, 0.f}; acc = tile_mm<2>(acc, Pc, PB, 16 * wr, PcT, PB, 16 * nt, lane);
                    const int n0 = 16 * nt + 4 * (lane >> 4); st_rm(Pn, PB, m, n0, acc); st_tr(PnT, PB, m, n0, acc); }
            }
            RW_BAR();
        }
    }
    R1_STAMP(6);
    {
        const LAS unsigned char* Z = lds + (w < 4 ? RW_S(4) : RW_S(0)); const int zr0 = 16 * (w & 3);
        f32x4 acc[4];
#pragma unroll
        for (int nt = 0; nt < 4; ++nt) { acc[nt] = (f32x4){0.f, 0.f, 0.f, 0.f}; acc[nt] = tile_mm<2>(acc[nt], Z, PB, zr0, lds + RW_S(8), PB, 16 * nt, lane); }
#pragma unroll
        for (int nt = 0; nt < 4; ++nt) st_rm(lds + RW_S(2), PB, 16 * w + (lane & 15), 16 * nt + 4 * (lane >> 4), acc[nt]);
    }
    RW_BAR(); R1_STAMP(7);
    {
        const int job = w >> 1;
        const LAS unsigned char* XTt = lds + RW_S(2); const LAS unsigned char* XTb = lds + RW_S(2) + 64 * PB;
#pragma unroll
        for (int q = 0; q < 2; ++q) { const int mt = 2 * (w & 1) + q; const int m = 16 * mt + (lane & 15);
#pragma unroll
            for (int nt = 0; nt < 4; ++nt) { f32x4 acc = {0.f, 0.f, 0.f, 0.f}; const int n0 = 16 * nt + 4 * (lane >> 4);
                if (job == 0) { acc = ld_rm(lds + RW_S(1), PB, m, n0); acc = tile_mm<2>(acc, lds + O_ARB, PB, 16 * mt, XTt, PB, 16 * nt, lane); }
                else if (job == 1) { acc = tile_mm<2>(acc, lds + O_ARB, PB, 16 * mt, XTb, PB, 16 * nt, lane); acc = tile_mm<2>(acc, lds + O_ARK, PB, 16 * mt, lds + RW_S(5), PB, 16 * nt, lane); }
                else if (job == 2) { acc = tile_mm<2>(acc, lds + RW_S(6), PB, 16 * mt, XTt, PB, 16 * nt, lane); }
                else { acc = tile_mm<2>(acc, XTb, PB, 16 * mt, lds + RW_S(6), PB, 16 * nt, lane); acc = tile_mm<2>(acc, lds + RW_S(5), PB, 16 * mt, lds + RW_S(7), PB, 16 * nt, lane); }
                u32x2 o; o.x = pk2(acc[0], acc[1]); o.y = pk2(acc[2], acc[3]);
                *(u32x2*)(gout + job * 8192 + (m * 64 + n0) * 2) = o; } }
    }
    RW_BAR(); R1_STAMP(8);
}

__device__ __forceinline__ void r2_unit(Frame& F, const Args& a, const int l, const int bh) {
    using namespace cfg;
    const int lane = F.lane, w = F.wave, wr = w & 3;
    LAS unsigned char* lds = F.lds;
    bf16* y = (bf16*)(F.ws + wsm::Y);
    const unsigned char* gin = F.ws + wsm::RW + (size_t)bh * 64 * UNIT_BYTES;
    const float* wlp = (const float*)(F.ws + wsm::RW + WL_OFF) + (size_t)bh * 64 * 64;
    const int b = bh >> 3, h = bh & 7;
    const int m = 16 * wr + (lane & 15), q4 = 4 * (lane >> 4);
    if (w < 4) {
        f32x4 S[4];
#pragma unroll
        for (int nt = 0; nt < 4; ++nt) { S[nt] = (f32x4){0.f, 0.f, 0.f, 0.f}; st_rm(lds, PB, m, 16 * nt + q4, S[nt]); }
        bf16x8 mtf[4][2], mtn[4][2]; u32x2 cf[4], cfn[4]; f32x4 wl[4], wln[4];
#define R2_LDS(c_, M_, C_, W_) do { const unsigned char* g_ = gin + (size_t)(c_) * UNIT_BYTES; _Pragma("unroll") for (int nt = 0; nt < 4; ++nt) { \
            _Pragma("unroll") for (int s_ = 0; s_ < 2; ++s_) M_[nt][s_] = *(const bf16x8*)(g_ + 16384 + ((16 * nt + (lane & 15)) * 64 + 32 * s_ + 8 * (lane >> 4)) * 2); \
            C_[nt] = *(const u32x2*)(g_ + 24576 + (m * 64 + 16 * nt + q4) * 2); W_[nt] = *(const f32x4*)(wlp + (c_) * 64 + 16 * nt + q4); } } while (0)
        R2_LDS(0, mtf, cf, wl);
#pragma unroll 1
        for (int c = 0; c < 64; ++c) {
            LAS unsigned char* Scur = lds + (c & 1) * SLOT; LAS unsigned char* Snxt = lds + ((c + 1) & 1) * SLOT;
            const int cn = c < 63 ? c + 1 : 63;
            R2_LDS(cn, mtn, cfn, wln);
            RW_BAR();
            bf16x8 sf[2];
#pragma unroll
            for (int s = 0; s < 2; ++s) sf[s] = ldfrag(Scur, PB, 16 * wr, lane, s);
#pragma unroll
            for (int nt = 0; nt < 4; ++nt) {
                f32x4 acc = S[nt] * wl[nt];
                acc[0] += __uint_as_float(cf[nt].x << 16); acc[1] += __uint_as_float(cf[nt].x & 0xffff0000u); acc[2] += __uint_as_float(cf[nt].y << 16); acc[3] += __uint_as_float(cf[nt].y & 0xffff0000u);
#pragma unroll
                for (int s = 0; s < 2; ++s) acc = __builtin_amdgcn_mfma_f32_16x16x32_bf16(mtf[nt][s], sf[s], acc, 0, 0, 0);
                S[nt] = acc; st_rm(Snxt, PB, m, 16 * nt + q4, acc); }
#pragma unroll
            for (int nt = 0; nt < 4; ++nt) { mtf[nt][0] = mtn[nt][0]; mtf[nt][1] = mtn[nt][1]; cf[nt] = cfn[nt]; wl[nt] = wln[nt]; }
        }
#undef R2_LDS
    } else {
        bf16x8 rf[2], rfn[2]; u32x2 y0[4], g1[4], g0[4], y0n[4], g1n[4], g0n[4];
#define R2_LDY(c_, R_, Y_, G1_, G0_) do { const unsigned char* g_ = gin + (size_t)(c_) * UNIT_BYTES; \
            _Pragma("unroll") for (int s_ = 0; s_ < 2; ++s_) R_[s_] = *(const bf16x8*)(g_ + (m * 64 + 32 * s_ + 8 * (lane >> 4)) * 2); \
            _Pragma("unroll") for (int nt = 0; nt < 4; ++nt) { const int o_ = (m * 64 + 16 * nt + q4) * 2; Y_[nt] = *(const u32x2*)(g_ + 8192 + o_); G1_[nt] = *(const u32x2*)(g_ + 32768 + o_); G0_[nt] = *(const u32x2*)(g_ + 40960 + o_); } } while (0)
        R2_LDY(0, rf, y0, g1, g0);
#pragma unroll 1
        for (int c = 0; c < 64; ++c) {
            LAS unsigned char* Scur = lds + (c & 1) * SLOT;
            const int cn = c < 63 ? c + 1 : 63;
            R2_LDY(cn, rfn, y0n, g1n, g0n);
            RW_BAR();
            f32x4 Y[4]; float sum = 0.f;
#pragma unroll
            for (int nt = 0; nt < 4; ++nt) {
                f32x4 acc = {__uint_as_float(y0[nt].x << 16), __uint_as_float(y0[nt].x & 0xffff0000u), __uint_as_float(y0[nt].y << 16), __uint_as_float(y0[nt].y & 0xffff0000u)};
#pragma unroll
                for (int s = 0; s < 2; ++s) acc = __builtin_amdgcn_mfma_f32_16x16x32_bf16(ldfrag(Scur, PB, 16 * nt, lane, s), rf[s], acc, 0, 0, 0);
                Y[nt] = acc; sum += (acc[0] + acc[1]) + (acc[2] + acc[3]); }
            sum += __shfl_xor(sum, 16); sum += __shfl_xor(sum, 32);
            const float mean = sum * (1.f / 64.f); float var = 0.f;
#pragma unroll
            for (int nt = 0; nt < 4; ++nt)
#pragma unroll
                for (int i = 0; i < 4; ++i) { const float d = Y[nt][i] - mean; var += d * d; }
            var += __shfl_xor(var, 16); var += __shfl_xor(var, 32);
            const float rs = rsqrtf(var * (1.f / 64.f) + 64e-5f);
            bf16* yo = y + ((size_t)b * SEQ + c * 64 + m) * D + h * 64;
#pragma unroll
            for (int nt = 0; nt < 4; ++nt) {
                const f32x4 a1 = {__uint_as_float(g1[nt].x << 16), __uint_as_float(g1[nt].x & 0xffff0000u), __uint_as_float(g1[nt].y << 16), __uint_as_float(g1[nt].y & 0xffff0000u)};
                const f32x4 a0 = {__uint_as_float(g0[nt].x << 16), __uint_as_float(g0[nt].x & 0xffff0000u), __uint_as_float(g0[nt].y << 16), __uint_as_float(g0[nt].y & 0xffff0000u)};
                const f32x4 o = (Y[nt] - mean) * rs * a1 + a0;
                if (F8OUT(l)) *(unsigned*)((unsigned char*)y + ((size_t)b * SEQ + c * 64 + m) * D + h * 64 + 16 * nt + q4) = pk4_fp8(o[0] * F8_Y, o[1] * F8_Y, o[2] * F8_Y, o[3] * F8_Y);
                else { u32x2 ow; ow.x = pk2(o[0], o[1]); ow.y = pk2(o[2], o[3]); *(u32x2*)(yo + 16 * nt + q4) = ow; } }
            rf[0] = rfn[0]; rf[1] = rfn[1];
#pragma unroll
            for (int nt = 0; nt < 4; ++nt) { y0[nt] = y0n[nt]; g1[nt] = g1n[nt]; g0[nt] = g0n[nt]; }
        }
#undef R2_LDY
    }
    RW_BAR();
}
}
struct MoeOrder {
    const LAS int* pref; int G, c, npn, mode;
    const char* A; const char* B; const int* lists; const float* wl; int esz;
    __device__ __forceinline__ bool next(int i, pg8::Unit& u) const {
        const int total = __builtin_amdgcn_readfirstlane(pref[32]) * npn;
        const long L = (long)i * G + c; if (L >= total) return false;
        int wgid = (int)L; { const int q = total / 8, r = total % 8, xcd = wgid % 8, off = wgid / 8; wgid = (xcd < r ? xcd * (q + 1) : r * (q + 1) + (xcd - r) * q) + off; }
        const int panel = wgid / npn, pn = wgid % npn;
        int e = 0;
        for (int k = 1; k < 32; ++k) { const int pk = __builtin_amdgcn_readfirstlane(pref[k]); if (pk <= panel) e = k; }
        const int tl = panel - __builtin_amdgcn_readfirstlane(pref[e]);
        u.pm = panel; u.pn = pn;
        if (mode == 0) { u.a = A; u.b = B + ((size_t)e * 512 + (size_t)pn * 256) * 2048 * esz; u.rows = lists + e * LCAP + tl * 256; const int rem = __builtin_amdgcn_readfirstlane(pref[40 + e]) - tl * 256; u.nvalid = rem < 256 ? rem : 256; u.wrow = wl + e * LCAP + tl * 256; }
        else { u.a = A + (size_t)panel * 256 * 256 * 2; u.b = B + ((size_t)e * 2048 + (size_t)pn * 256) * 256 * 2; u.rows = nullptr; u.nvalid = 256; u.wrow = nullptr; }
        return true;
    }
};

#define IN(k) (lo <= (k) && (k) < hi)
#define SEAM(k) do { if (IN(k) && IN((k) + 1)) xcd_barrier(bar); } while (0)
#ifndef DUP_PHASE
#define DUP_PHASE -1
#endif
template <int l> __device__ __forceinline__ void ph_n1(Frame& F, const Args& args) {
    using namespace cfg; float* xo = args.out; const float* xin = (l == 0) ? args.in[0] : xo;
    convert_phase(F, args, l);
    if (l == 0) norm_phase<false, false, false, F8IN(l)>(F, args, xin, nullptr, args.in[3] + l * D, l, l);
    else { build_pref(F, l - 1); norm_phase<true, false, false, F8IN(l), true>(F, args, xin, xo, args.in[3] + l * D, l, l); }
}
template <int l> __device__ __forceinline__ void ph_g1(Frame& F, const Args& args) {
    using namespace cfg;
    constexpr int ESZ = F8IN(l) ? 1 : 2;
    pg8::StaticOrder S; S.init(F.ws + wsm::XN, F.ws + wsm::W_IN, M, INC, D, F.G, (int)blockIdx.x, ESZ);
    pg8::EpiBf16 E{(bf16*)(F.ws + wsm::P), INC, ESZ == 1 ? pg8::F8_INV : 1.f};
    pg8::gemm_phase<pg8::EpiBf16, pg8::StaticOrder, false, ESZ>(F.lds, D, S, E);
}
template <int l> __device__ __forceinline__ void ph_m1(Frame& F, const Args& args, unsigned long long& racc) {
    { int hcur = -1; rw::R1Raw raw;
      auto unit_of = [&](int i) { return (F.G == 256) ? ((F.vcu >> 2) << 6) + ((F.vcu & 3) << 4) + i : F.vcu + i * F.G; };
      if (unit_of(0) < 4096) rw::r1_load(F, unit_of(0), raw, F.tid);
      for (int i = 0; unit_of(i) < 4096 && i * F.G < 4096; ++i) { const int u = unit_of(i); const int un = ((i + 1) * F.G < 4096 && unit_of(i + 1) < 4096) ? unit_of(i + 1) : u; rw::r1_unit(F, args, l, u, un, raw, racc, hcur); } }

    for (int u = F.vcu; u < 1024; u += F.G) { const int b = u >> 7, hh = (u >> 4) & 7, qb = ((u & 15) + (u >> 8) * 4) & 15; att::attn_unit<0>(F, args, l, b, hh, qb); }
    if (DUP_PHASE == 21 + 100 * l) { for (int u = F.vcu; u < 1024; u += F.G) { const int b = u >> 7, hh = (u >> 4) & 7, qb = ((u & 15) + (u >> 8) * 4) & 15; att::attn_unit<0>(F, args, l, b, hh, qb); } }
    att::conv_items(F, args, l, F.vcu * 512 + F.tid, F.G * 512);
    if (DUP_PHASE == 22 + 100 * l) att::conv_items(F, args, l, F.vcu * 512 + F.tid, F.G * 512);
}
template <int l> __device__ __forceinline__ void ph_m2(Frame& F, const Args& args) {
    for (;;) { const int it = grab(F, l); if (it >= 64 + 512) break;
        if (it < 64) rw::r2_unit(F, args, l, it);
        else { const int j = it - 64, qb = 15 - (j >> 5), b = (j & 31) >> 2, hh = j & 3; att::attn_unit<1>(F, args, l, b, hh, qb); } }
    if (DUP_PHASE == 8 * l + 3) { __syncthreads();
    for (;;) { const int it = grab(F, l + 2); if (it >= 64 + 512) break;
        if (it < 64) rw::r2_unit(F, args, l, it);
        else { const int j = it - 64, qb = 15 - (j >> 5), b = (j & 31) >> 2, hh = j & 3; att::attn_unit<1>(F, args, l, b, hh, qb); } } }
    if (DUP_PHASE == 30 + 100 * l) { if (F.vcu < 64) rw::r2_unit(F, args, l, F.vcu); }
    if (DUP_PHASE == 31 + 100 * l) { for (int u = F.vcu; u < 512; u += F.G) { const int b = u >> 6, hh = (u >> 4) & 3, qb = (u < 256) ? (u & 15) : 15 - (u & 15); att::attn_unit<1>(F, args, l, b, hh, qb); } }
}
template <int l> __device__ __forceinline__ void ph_g2(Frame& F, const Args& args) {
    using namespace cfg;
    constexpr int ESZ = F8OUT(l) ? 1 : 2;
    pg8::StaticOrder S; S.init(F.ws + wsm::Y, F.ws + wsm::W_OUT, M, D, D, F.G, (int)blockIdx.x, ESZ);
    const void* xin = (l == 0) ? (const void*)args.in[0] : (const void*)args.out;
    bf16* xo = (l == 0) ? (bf16*)args.out : (bf16*)(F.ws + wsm::XB2);
    pg8::EpiRes<l != 0> E{xin, xo, D, ESZ == 1 ? 1.f / (F8_Y * pg8::F8_WGT) : 1.f};
    pg8::gemm_phase<pg8::EpiRes<l != 0>, pg8::StaticOrder, false, ESZ>(F.lds, D, S, E);
}
template <int l> __device__ __forceinline__ void ph_n2(Frame& F, const Args& args) { using namespace cfg;
    const float* xs = (l == 0) ? (const float*)args.out : (const float*)(F.ws + wsm::XB2);
    norm_phase<false, true, false, ((F8_MOE_MASK >> l) & 1) != 0, true>(F, args, xs, nullptr, args.in[4] + l * D, l, l); }
template <int l> __device__ __forceinline__ void ph_e1(Frame& F, const Args& args) {
    using namespace cfg;
    build_pref(F, l);
    constexpr int ESZ = ((F8_MOE_MASK >> l) & 1) ? 1 : 2;
    MoeOrder S{(const LAS int*)(F.lds + TAB_OFF), F.G, (int)blockIdx.x, 2, 0, (const char*)(F.ws + wsm::XN), (const char*)(F.ws + wsm::W_GU), (const int*)(F.ws + wsm::LISTS), (const float*)(F.ws + wsm::WLIST), ESZ};
    pg8::EpiSilu E{(bf16*)(F.ws + wsm::HB), ESZ == 1 ? pg8::F8_INV : 1.f};
    pg8::gemm_phase<pg8::EpiSilu, MoeOrder, true, ESZ>(F.lds, D, S, E);
}
template <int l> __device__ __forceinline__ void ph_e2(Frame& F, const Args& args) {
    using namespace cfg;
    build_pref(F, l);
    MoeOrder S{(const LAS int*)(F.lds + TAB_OFF), F.G, (int)blockIdx.x, 8, 1, (const char*)(F.ws + wsm::HB), (const char*)(F.ws + wsm::W_D), nullptr, nullptr, 2};
    pg8::EpiF8 E{F.ws + wsm::OB, D, F8_OB};
    pg8::gemm_phase<pg8::EpiF8, MoeOrder, false>(F.lds, EH, S, E);
}
#ifndef PROBE_T
#define PROBE_T -1
#endif
#define RUNPH(k, call) do { if (PROBE_T == (k)) pt0 = __builtin_amdgcn_s_memrealtime(); RUNPH_(k, call); if (PROBE_T == (k)) pt1 = __builtin_amdgcn_s_memrealtime(); } while (0)
#define RUNPH_(k, call) do { if (IN(k)) { call; if (DUP_PHASE == (k) && ((k) & 7) != 3 && ((k) & 7) != 5) { __syncthreads(); call; } } SEAM(k); } while (0)
template <int l>
__device__ __forceinline__ void layer_phases(Frame& F, const Args& args, const XcdBarrier& bar, const int lo, const int hi, unsigned long long& pt0, unsigned long long& pt1) {
    constexpr int pb = 8 * l;
    RUNPH(pb + 0, ph_n1<l>(F, args));
    RUNPH(pb + 1, ph_g1<l>(F, args));
    { unsigned long long racc = 0; RUNPH(pb + 2, ph_m1<l>(F, args, racc)); if (PROBE_R1 >= 0 && l == 0) { pt0 = 0; pt1 = racc; } }
    RUNPH(pb + 3, ph_m2<l>(F, args));
    RUNPH(pb + 4, ph_g2<l>(F, args));
    RUNPH(pb + 5, ph_n2<l>(F, args));
    RUNPH(pb + 6, ph_e1<l>(F, args));
    RUNPH(pb + 7, ph_e2<l>(F, args));
}
__global__ void __launch_bounds__(512, 2) mk_fwd(Args args) {
    extern __shared__ __attribute__((aligned(16))) unsigned char lds_raw[];
    using namespace cfg;
    Frame F;
    F.lds = (LAS unsigned char*)lds_raw; F.ws = args.ws; F.ctl = (unsigned*)(args.ws + wsm::CTL);
    F.tid = threadIdx.x; F.lane = F.tid & 63; F.wave = __builtin_amdgcn_readfirstlane(F.tid >> 6);
    F.pacc = 0ull;
    F.G = gridDim.x; { const int bx = blockIdx.x; F.vcu = (F.G % 8 == 0) ? (bx % 8) * (F.G / 8) + bx / 8 : bx; }
    volatile LAS unsigned* MISC = (volatile LAS unsigned*)(F.lds + MISC_OFF);
    for (int u = F.tid; u < (LDS_BYTES - RING_BYTES) / 4; u += 512) ((LAS unsigned*)(F.lds + RING_BYTES))[u] = 0u;
    __syncthreads();
    const int lo = args.ph_lo, hi = args.ph_hi;
    XcdBarrier bar; bar.bar = F.ctl + wsm::CW_BAR; bar.x = 0; bar.st = nullptr;
    if (hi - lo > 1) bar = xcd_barrier_post(F.ctl + wsm::CW_BAR, MISC + 8);
    float* xo = args.out;
    unsigned long long pt0 = 0, pt1 = 0;
    layer_phases<0>(F, args, bar, lo, hi, pt0, pt1);
    layer_phases<1>(F, args, bar, lo, hi, pt0, pt1);
    if (PROBE_T == 16) pt0 = __builtin_amdgcn_s_memrealtime();
    if (IN(16)) {
        build_pref(F, NL - 1); norm_phase<true, false, true, false, true>(F, args, (const float*)(F.ws + wsm::XB2), xo, args.in[5], 0, 0);
    }
    if (PROBE_T == 16) pt1 = __builtin_amdgcn_s_memrealtime();
    if (PROBE_ATT >= 0 && blockIdx.x == 0 && F.tid == 448) { const unsigned long long te = __builtin_amdgcn_s_memrealtime(); while (__builtin_amdgcn_s_memrealtime() - te < 4ull * F.pacc) __builtin_amdgcn_s_sleep(8); }
    if ((PROBE_T >= 0 || PROBE_R1 >= 0) && blockIdx.x == 0 && F.tid == 0) { const unsigned long long te = __builtin_amdgcn_s_memrealtime(); while (__builtin_amdgcn_s_memrealtime() - te < 4ull * (pt1 - pt0)) __builtin_amdgcn_s_sleep(8); }
#undef IN
#undef SEAM
}
extern "C" void kernel_launch(void* const* d_in, const int* in_sizes, int n_in, void* d_out, int out_size, void* d_ws, size_t ws_size, hipStream_t stream) {
    using namespace cfg;
    static int grid = 0;
    if (grid == 0) {
        if (n_in != 32 || ws_size < wsm::END || out_size != M * D) { fprintf(stderr, "kernel_launch: bad args n_in=%d ws=%zu out=%d\n", n_in, ws_size, out_size); grid = -1; return; }
        int dev = 0, cus = 0;
        if (hipGetDevice(&dev) != hipSuccess || hipDeviceGetAttribute(&cus, hipDeviceAttributeMultiprocessorCount, dev) != hipSuccess) { grid = -1; return; }
        if (hipFuncSetAttribute((const void*)mk_fwd, hipFuncAttributeMaxDynamicSharedMemorySize, LDS_BYTES) != hipSuccess) { fprintf(stderr, "hipFuncSetAttribute failed\n"); grid = -1; return; }
        int per_cu = 0;
        if (hipOccupancyMaxActiveBlocksPerMultiprocessor(&per_cu, (const void*)mk_fwd, 512, LDS_BYTES) != hipSuccess || per_cu < 1) fprintf(stderr, "kernel_launch: occupancy query says %d\n", per_cu);
        (void)hipGetLastError();
        grid = cus;
    }
    if (grid < 0) return;
    unsigned char* w = (unsigned char*)d_ws;
    if (hipMemsetAsync(w + wsm::CTL, 0, wsm::CTL_ZERO_BYTES, stream) != hipSuccess) return;
    Args a{};
    for (int i = 0; i < 32; ++i) a.in[i] = (const float*)d_in[i];
    a.out = (float*)d_out; a.ws = w; a.flags = 7; a.ph_lo = 0; a.ph_hi = 17;
    hipLaunchKernelGGL(mk_fwd, dim3(grid), dim3(512), LDS_BYTES, stream, a);
}
```

```cpp
#define DUP_PHASE -1
#include <hip/hip_runtime.h>
#include <cstdint>
#include <cstdio>
#include <cmath>

typedef unsigned short bf16;
__host__ __device__ __forceinline__ unsigned f2bf(float f) { unsigned u = __builtin_bit_cast(unsigned, f); return (u + 0x7fffu + ((u >> 16) & 1u)) >> 16; }
__host__ __device__ __forceinline__ float bf2f(bf16 b) { return __builtin_bit_cast(float, ((unsigned)b) << 16); }

namespace cfg {
constexpr int D = 2048, BATCH = 8, SEQ = 4096, M = BATCH * SEQ, NL = 2;
constexpr int INC = 6400;
constexpr int OFF_BQ = 1792, OFF_BK = 2304, OFF_BV = 2816, OFF_CQ = 3328, OFF_CK = 3840, OFF_CV = 4352, OFF_D = 4864;
constexpr int NEXP = 32, EH = 256;
}
#define GAS __attribute__((address_space(1)))
#define LAS __attribute__((address_space(3)))
typedef float f32x4 __attribute__((ext_vector_type(4)));
typedef float f32x2 __attribute__((ext_vector_type(2)));
typedef short bf16x8 __attribute__((ext_vector_type(8)));
typedef unsigned u32x4 __attribute__((ext_vector_type(4)));
typedef unsigned u32x2 __attribute__((ext_vector_type(2)));
#define RLX_AGENT __ATOMIC_RELAXED, __HIP_MEMORY_SCOPE_AGENT
#define LDS_WAIT() asm volatile("s_waitcnt lgkmcnt(0)" ::: "memory")
#define VM_WAIT() asm volatile("s_waitcnt vmcnt(0)" ::: "memory")

namespace wsm {
constexpr size_t MiB = 1u << 20;
constexpr size_t CTL = 0, CTL_ZERO_BYTES = 1 * MiB;
constexpr size_t LISTS = 2 * MiB;
constexpr size_t WLIST = 6 * MiB;
constexpr size_t TOKINFO = 10 * MiB;
constexpr size_t ROUTE = 11 * MiB;
constexpr size_t WRT = 12 * MiB;
constexpr size_t W_IN = 16 * MiB;
constexpr size_t W_OUT = 41 * MiB;
constexpr size_t W_GU = 49 * MiB;
constexpr size_t W_D = 113 * MiB;
constexpr size_t XN = 146 * MiB;
constexpr size_t P = 274 * MiB;
constexpr size_t HB = P;
constexpr size_t OB = P + 40 * MiB;
constexpr size_t XB2 = P + 200 * MiB;
constexpr size_t Y = 674 * MiB;
constexpr size_t RW = 802 * MiB;
constexpr size_t END = 1010 * MiB;
constexpr int CW_BAR = 4096;
constexpr int CW_CNT = 16384;
constexpr int CW_Q = 32768;
}
constexpr int LCAP = 32768;
constexpr int RING_BYTES = 139264;
constexpr int MISC_OFF = RING_BYTES + 320;
constexpr int TAB_OFF = RING_BYTES + 1024;
constexpr int LDS_BYTES = 147456;
constexpr float C2F = 0.125f * 1.4426950408889634f;
constexpr float LOG2E = 1.4426950408889634f;

typedef __bf16 bf16x2_hw __attribute__((ext_vector_type(2)));
__device__ __forceinline__ unsigned pk2(float lo, float hi) { const f32x2 v = {lo, hi}; const bf16x2_hw b = __builtin_convertvector(v, bf16x2_hw); return __builtin_bit_cast(unsigned, b); }
__device__ __forceinline__ bf16 cvt1(float x) { return (bf16)(pk2(x, x) & 0xffffu); }
__device__ __forceinline__ float f8clamp(float x) { return __builtin_amdgcn_fmed3f(x, -448.f, 448.f); }
__device__ __forceinline__ unsigned pk2_fp8(float a, float b) { int w = 0; w = __builtin_amdgcn_cvt_pk_fp8_f32(f8clamp(a), f8clamp(b), w, false); return (unsigned)w & 0xffffu; }
__device__ __forceinline__ unsigned pk4_fp8(float a, float b, float c, float d) { int w = 0; w = __builtin_amdgcn_cvt_pk_fp8_f32(f8clamp(a), f8clamp(b), w, false); w = __builtin_amdgcn_cvt_pk_fp8_f32(f8clamp(c), f8clamp(d), w, true); return (unsigned)w; }
constexpr int F8_IN_MASK = 2, F8_OUT_MASK = 2;
#define F8IN(l) (((F8_IN_MASK >> (l)) & 1) != 0)
#define F8OUT(l) (((F8_OUT_MASK >> (l)) & 1) != 0)
constexpr float F8_Y = 16.f, F8_OB = 8.f, F8_H = 8.f;
constexpr bool F8_DOWN = true;
constexpr int F8_MOE_MASK = 3;
__device__ __forceinline__ float wave_sum(float v) {
#pragma unroll
    for (int o = 1; o < 64; o <<= 1) v += __shfl_xor(v, o);
    return v;
}

struct Args {
    const float* in[32]; float* out; unsigned char* ws;
    int ph_lo, ph_hi, flags, pad;
};
#define XB_TMO      128
#define XB_XCNT(j)  (256  + 64 * (j))
#define XB_XSUB(j)  (1280 + 64 * (j))
#define XB_XGEN(j)  (2304 + 64 * (j))
#define XB_TOP      3328
#define XB_TOPGEN   3392
#define XCD_BAR_WORDS 3456
#define XB_SPIN_CAP (1u << 22)

__device__ __forceinline__ unsigned xb_ld(unsigned* p)              { return __hip_atomic_load(p, __ATOMIC_RELAXED, __HIP_MEMORY_SCOPE_AGENT); }
__device__ __forceinline__ unsigned xb_add(unsigned* p, unsigned v) { return __hip_atomic_fetch_add(p, v, __ATOMIC_RELAXED, __HIP_MEMORY_SCOPE_AGENT); }
__device__ __forceinline__ unsigned xb_xcc_id() { return (unsigned)__builtin_amdgcn_s_getreg((3 << 11) | 20) & 0xFu; }
#define XB_SPIN(cond, bar) do { unsigned _sp = 0; while (cond) { __builtin_amdgcn_s_sleep(1); \
    if ((++_sp & 255u) == 0u) { if (xb_ld(&(bar)[XB_TMO])) break; if (_sp > XB_SPIN_CAP) { atomicAdd(&(bar)[XB_TMO], 1u); break; } } } } while (0)

struct XcdBarrier {
    unsigned* bar; unsigned x;
    volatile LAS unsigned* st;
};

__device__ __forceinline__ XcdBarrier xcd_barrier_post(unsigned* bar, volatile LAS unsigned* st) {
    XcdBarrier b; b.bar = bar; b.x = xb_xcc_id(); b.st = st;
    if (threadIdx.x == 0) (void)xb_add(&bar[XB_XCNT(b.x)], 1u);
    return b;
}
__device__ __forceinline__ void xcd_barrier_complete(unsigned* bar, unsigned x, unsigned& nloc, unsigned& nx) {
    const unsigned G = gridDim.x * gridDim.y * gridDim.z;
    unsigned sum, cnt, mine, sp = 0u;
    for (;;) {
        sum = 0u; cnt = 0u; mine = 0u;
#pragma unroll
        for (unsigned j = 0; j < 16; ++j) { const unsigned c = xb_ld(&bar[XB_XCNT(j)]); sum += c; cnt += (c > 0u) ? 1u : 0u; mine = (j == x) ? c : mine; }
        if (sum == G) break;
        __builtin_amdgcn_s_sleep(1);
        if ((++sp & 255u) == 0u) { if (xb_ld(&bar[XB_TMO])) break; if (sp > XB_SPIN_CAP) { atomicAdd(&bar[XB_TMO], 1u); break; } }
    }
    nloc = mine > 0u ? mine : 1u; nx = cnt > 0u ? cnt : 1u;
}

__device__ __forceinline__ void xcd_barrier(const XcdBarrier& b) {
    asm volatile("s_waitcnt vmcnt(0)" ::: "memory");
    __syncthreads();
    if (threadIdx.x == 0) {
        unsigned* bar = b.bar;
        __builtin_amdgcn_s_waitcnt(0);
        unsigned nloc = b.st[0], nx = b.st[1];
        if (nloc == 0u) { xcd_barrier_complete(bar, b.x, nloc, nx); b.st[0] = nloc; b.st[1] = nx; }
        const unsigned old = xb_add(&bar[XB_XSUB(b.x)], 1u);
        const unsigned gen = old / nloc;
        if (old + 1u == (gen + 1u) * nloc) {
            __builtin_amdgcn_fence(__ATOMIC_RELEASE, "agent");
            asm volatile("s_waitcnt vmcnt(0)" ::: "memory");
            const unsigned og = xb_add(&bar[XB_TOP], 1u);
            const unsigned tg = og / nx;
            if (og + 1u == (tg + 1u) * nx) xb_add(&bar[XB_TOPGEN], 1u);
            else XB_SPIN(xb_ld(&bar[XB_TOPGEN]) == tg, bar);
            __builtin_amdgcn_fence(__ATOMIC_ACQUIRE, "agent");
            xb_add(&bar[XB_XGEN(b.x)], 1u);
            asm volatile("s_waitcnt vmcnt(0)" ::: "memory");
        } else {
            XB_SPIN(xb_ld(&bar[XB_XGEN(b.x)]) == gen, bar);
            __builtin_amdgcn_fence(__ATOMIC_ACQUIRE, "agent");
            asm volatile("s_waitcnt vmcnt(0)" ::: "memory");
        }
    }
    __syncthreads();
}
namespace pg8 {
#define PG8_LAS __attribute__((address_space(3)))
typedef unsigned short bf16_t;
typedef short bf16x8 __attribute__((ext_vector_type(8)));
typedef float f32x4 __attribute__((ext_vector_type(4)));
typedef unsigned u32x4 __attribute__((ext_vector_type(4)));
typedef unsigned u32x2 __attribute__((ext_vector_type(2)));
typedef int i32x4_t __attribute__((ext_vector_type(4)));
typedef int i32x8_t __attribute__((ext_vector_type(8)));
constexpr float F8_ACT = 16.f, F8_WGT = 512.f, F8_INV = 1.f / (16.f * 512.f);
constexpr int BM = 256, BK = 64, HALF = 128, HTB = HALF * BK * 2, STAGE_BYTES = 8 * HTB, NXCD = 8, WGM = 8;

__host__ __device__ __forceinline__ int lds_byte(int r, int c) { const int st = (r >> 4) * 2 + (c >> 5), rr = r & 15, cc = c & 31, ob = rr * 64 + cc * 2; return st * 1024 + (ob ^ (((ob >> 9) & 1) << 5)); }
__host__ __device__ __forceinline__ void stage_rc(int b, int& R, int& C) { const int st = b / 1024, sb = b % 1024, swz = sb ^ (((sb >> 9) & 1) << 5); R = (st >> 1) * 16 + swz / 64; C = (st & 1) * 32 + (swz % 64) / 2; }
__host__ __device__ __forceinline__ int perm32(int rho) { const int n = rho >> 4, i = rho & 15; return 8 * (i >> 2) + 4 * n + (i & 3); }

struct Unit { int pm, pn; const char* a; const char* b; const int* rows; const float* wrow; int nvalid; int pad_; };

struct StaticOrder {
    int nM, nN, nwg, G, c; const char* A; const char* Bt; size_t tstep;
    __device__ void init(const void* A_, const void* Bt_, int M, int N, int K, int G_, int c_, int esz = 2) { nM = M / BM; nN = N / BM; nwg = nM * nN; G = G_; c = c_; A = (const char*)A_; Bt = (const char*)Bt_; tstep = (size_t)BM * K * esz; }
    __device__ bool next(int i, Unit& u) const {
        const long L = (long)i * G + c; if (L >= nwg) return false;
        int wgid = (int)L; { const int q = nwg / NXCD, r = nwg % NXCD, xcd = wgid % NXCD, off = wgid / NXCD; wgid = (xcd < r ? xcd * (q + 1) : r * (q + 1) + (xcd - r) * q) + off; }
        const int nig = WGM * nN, gid = wgid / nig, fm = gid * WGM, gsz = (nM - fm) < WGM ? (nM - fm) : WGM;
        u.pm = fm + ((wgid % nig) % gsz); u.pn = (wgid % nig) / gsz; u.a = A + (size_t)u.pm * tstep; u.b = Bt + (size_t)u.pn * tstep; u.rows = nullptr; u.wrow = nullptr; u.nvalid = 256; return true;
    }
};

__device__ __forceinline__ unsigned cvt_pk_bf16(float lo, float hi) { unsigned r; asm volatile("v_cvt_pk_bf16_f32 %0, %1, %2" : "=v"(r) : "v"(lo), "v"(hi)); return r; }

struct EpiBf16 {
    static constexpr bool PERM = true;
    bf16_t* O; int ldc; float mul;
    __device__ __forceinline__ void operator()(const f32x4 (&acc)[2][2][4][2], const Unit& u, int wr, int wc, int fr, int fq) const {
        const int row0 = u.pm * BM + wr * 64 + fr; const int col0 = u.pn * BM + wc * 32 + 8 * fq;
#pragma unroll
        for (int ai = 0; ai < 2; ++ai)
#pragma unroll
            for (int m = 0; m < 4; ++m) { bf16_t* rowp = O + (size_t)(row0 + ai * HALF + m * 16) * ldc + col0;
#pragma unroll
                for (int bj = 0; bj < 2; ++bj) { const f32x4 v0 = acc[ai][bj][m][0] * mul, v1 = acc[ai][bj][m][1] * mul;
                    u32x4 w; w.x = cvt_pk_bf16(v0[0], v0[1]); w.y = cvt_pk_bf16(v0[2], v0[3]); w.z = cvt_pk_bf16(v1[0], v1[1]); w.w = cvt_pk_bf16(v1[2], v1[3]);
                    *(u32x4*)(rowp + bj * HALF) = w; } }
    }
};
struct EpiF8 {
    static constexpr bool PERM = true;
    unsigned char* O; int ldc; float mul;
    __device__ __forceinline__ void operator()(const f32x4 (&acc)[2][2][4][2], const Unit& u, int wr, int wc, int fr, int fq) const {
        const int row0 = u.pm * BM + wr * 64 + fr; const int col0 = u.pn * BM + wc * 32 + 8 * fq;
#pragma unroll
        for (int ai = 0; ai < 2; ++ai)
#pragma unroll
            for (int m = 0; m < 4; ++m) { unsigned char* rowp = O + (size_t)(row0 + ai * HALF + m * 16) * ldc + col0;
#pragma unroll
                for (int bj = 0; bj < 2; ++bj) { const f32x4 v0 = acc[ai][bj][m][0] * mul, v1 = acc[ai][bj][m][1] * mul;
                    u32x2 w; w.x = ::pk4_fp8(v0[0], v0[1], v0[2], v0[3]); w.y = ::pk4_fp8(v1[0], v1[1], v1[2], v1[3]);
                    *(u32x2*)(rowp + bj * HALF) = w; } }
    }
};
template <bool BASE_BF16>
struct EpiRes {
    static constexpr bool PERM = false;
    const void* base; bf16_t* C; int ldc; float mul;
    __device__ __forceinline__ void operator()(const f32x4 (&acc)[2][2][4][2], const Unit& u, int wr, int wc, int fr, int fq) const {
        const int row0 = u.pm * BM + wr * 64 + fr, col0 = u.pn * BM + wc * 32 + 4 * fq;
#pragma unroll
        for (int ai = 0; ai < 2; ++ai)
#pragma unroll
            for (int m = 0; m < 4; ++m) { const size_t off = (size_t)(row0 + ai * HALF + m * 16) * ldc + col0;
#pragma unroll
                for (int bj = 0; bj < 2; ++bj)
#pragma unroll
                    for (int n = 0; n < 2; ++n) { const size_t o2 = off + bj * HALF + n * 16; f32x4 bs;
                        if constexpr (BASE_BF16) { const u32x2 w = *(const u32x2*)((const bf16_t*)base + o2); bs = (f32x4){__uint_as_float(w.x << 16), __uint_as_float(w.x & 0xffff0000u), __uint_as_float(w.y << 16), __uint_as_float(w.y & 0xffff0000u)}; }
                        else bs = *(const f32x4*)((const float*)base + o2);
                        const f32x4 r = bs + acc[ai][bj][m][n] * mul;
                        u32x2 ow; ow.x = ::pk2(r[0], r[1]); ow.y = ::pk2(r[2], r[3]); *(u32x2*)(C + o2) = ow; }
                asm volatile("" ::: "memory"); }
    }
};
struct EpiSilu {
    static constexpr bool PERM = true;
    bf16_t* H; float mul; float h8;
    __device__ __forceinline__ void operator()(const f32x4 (&acc)[2][2][4][2], const Unit& u, int wr, int wc, int fr, int fq) const {
        const int row0 = u.pm * BM + wr * 64 + fr; const int col0 = u.pn * HALF + wc * 32 + 8 * fq;
#pragma unroll
        for (int ai = 0; ai < 2; ++ai)
#pragma unroll
            for (int m = 0; m < 4; ++m) { const int row = row0 + ai * HALF + m * 16; const float w = u.wrow[wr * 64 + fr + ai * HALF + m * 16];
                float o[8];
#pragma unroll
                for (int n = 0; n < 2; ++n)
#pragma unroll
                    for (int j = 0; j < 4; ++j) { const float g = acc[ai][0][m][n][j] * mul, up = acc[ai][1][m][n][j] * mul; o[n * 4 + j] = g * __builtin_amdgcn_rcpf(1.f + __expf(-g)) * up * w; }
                if (h8 > 0.f) { u32x2 w8; w8.x = ::pk4_fp8(o[0] * h8, o[1] * h8, o[2] * h8, o[3] * h8); w8.y = ::pk4_fp8(o[4] * h8, o[5] * h8, o[6] * h8, o[7] * h8); *(u32x2*)((unsigned char*)H + (size_t)row * 256 + col0) = w8; }
                else { u32x4 wv; wv.x = cvt_pk_bf16(o[0], o[1]); wv.y = cvt_pk_bf16(o[2], o[3]); wv.z = cvt_pk_bf16(o[4], o[5]); wv.w = cvt_pk_bf16(o[6], o[7]);
                    *(u32x4*)(H + (size_t)row * 256 + col0) = wv; } }
    }
};

template <class Epi, class Sched, bool GATHER, int ESZ = 2>
__device__ __forceinline__ void gemm_phase(PG8_LAS unsigned char* lds, const int K, const Sched& S, const Epi& E) {
    const int tid = threadIdx.x, wid = __builtin_amdgcn_readfirstlane(tid >> 6), lane = tid & 63, wr = wid >> 2, wc = wid & 3, fr = lane & 15, fq = lane >> 4;
    const int KB = K * ESZ;
    const int nt = KB / (BK * 2);
    const size_t kstep = (size_t)(BK * 2);
    const unsigned hstep = (unsigned)HALF * KB;
    int sR[2], sC[2];
    unsigned voffB[2], vc[2][2], vn[2][2];
#pragma unroll
    for (int i = 0; i < 2; ++i) { int R, C; stage_rc(tid * 16 + i * 8192, R, C); sR[i] = R; sC[i] = C; const int Rb = Epi::PERM ? ((R & ~31) + perm32(R & 31)) : R;
        voffB[i] = (unsigned)(Rb * KB + C * 2); vc[0][i] = (unsigned)(R * KB + C * 2); vc[1][i] = vc[0][i] + hstep; vn[0][i] = vc[0][i]; vn[1][i] = vc[1][i]; }
    const unsigned ldsw = (unsigned)wid * 1024u;
    const int aoff = lds_byte(wr * 64 + fr, fq * 8), boff = lds_byte(wc * 32 + fr, fq * 8);
#define PG8_SA(b, h) (((b) * 2 + (h)) * HTB)
#define PG8_SB(b, h) ((4 + (b) * 2 + (h)) * HTB)
#define PG8_STAGE(bufoff, gbase, voff) do { _Pragma("unroll") for (int _i = 0; _i < 2; ++_i) \
        __builtin_amdgcn_global_load_lds((const unsigned*)((const char*)(gbase) + (voff)[_i]), (PG8_LAS unsigned*)(lds + (bufoff) + ldsw + _i * 8192), 16, 0, 0); } while (0)
#define PG8_LD32(addr) __builtin_shufflevector(*(const PG8_LAS i32x4_t*)(addr), *(const PG8_LAS i32x4_t*)((addr) + 1024), 0, 1, 2, 3, 4, 5, 6, 7)
#define PG8_LDA(dst, b, h) do { if constexpr (ESZ == 2) { _Pragma("unroll") for (int m = 0; m < 4; ++m) _Pragma("unroll") for (int k = 0; k < 2; ++k) dst[m][k] = *(const PG8_LAS bf16x8*)(lds + PG8_SA(b, h) + aoff + m * 2048 + k * 1024); } \
        else { _Pragma("unroll") for (int m = 0; m < 4; ++m) dst##8[m] = PG8_LD32(lds + PG8_SA(b, h) + aoff + m * 2048); } } while (0)
#define PG8_LDB(dst, b, h) do { if constexpr (ESZ == 2) { _Pragma("unroll") for (int n = 0; n < 2; ++n) _Pragma("unroll") for (int k = 0; k < 2; ++k) dst[n][k] = *(const PG8_LAS bf16x8*)(lds + PG8_SB(b, h) + boff + n * 2048 + k * 1024); } \
        else { _Pragma("unroll") for (int n = 0; n < 2; ++n) dst##8[n] = PG8_LD32(lds + PG8_SB(b, h) + boff + n * 2048); } } while (0)
#define PG8_F8(x) __builtin_shufflevector(__builtin_bit_cast(i32x4_t, x[0]), __builtin_bit_cast(i32x4_t, x[1]), 0, 1, 2, 3, 4, 5, 6, 7)
#define PG8_MMA(ai, bj, At, Bt) do { __builtin_amdgcn_s_setprio(1); _Pragma("unroll") for (int m = 0; m < 4; ++m) _Pragma("unroll") for (int n = 0; n < 2; ++n) { \
        if constexpr (ESZ == 2) { _Pragma("unroll") for (int k = 0; k < 2; ++k) acc[ai][bj][m][n] = __builtin_amdgcn_mfma_f32_16x16x32_bf16(Bt[n][k], At[m][k], acc[ai][bj][m][n], 0, 0, 0); } \
        else asm volatile("s_nop 1\n\tv_mfma_f32_16x16x128_f8f6f4 %0, %1, %2, %0" : "+v"(acc[ai][bj][m][n]) : "v"(Bt##8[n]), "v"(At##8[m])); } __builtin_amdgcn_s_setprio(0); } while (0)
#define PG8_WAIT_V(n) asm volatile("s_waitcnt vmcnt(" #n ")" ::: "memory")
#define PG8_WAIT_L(n) asm volatile("s_waitcnt lgkmcnt(" #n ")" ::: "memory")
#define PG8_BAR __builtin_amdgcn_s_barrier()
#define PG8_SCHED __builtin_amdgcn_sched_barrier(0)
#define PG8_GV(dst, u) do { if constexpr (GATHER) { _Pragma("unroll") for (int _h = 0; _h < 2; ++_h) _Pragma("unroll") for (int _i = 0; _i < 2; ++_i) { const int _idx = _h * HALF + sR[_i]; \
        const int _tok = (u).rows[_idx < (u).nvalid ? _idx : 0]; dst[_h][_i] = (unsigned)_tok * (unsigned)KB + (unsigned)sC[_i] * 2u; } } } while (0)
    Unit cur, nxt; int ui = 0;
    if (!S.next(0, cur)) return;
    f32x4 acc[2][2][4][2];
#pragma unroll
    for (int a = 0; a < 2; ++a)
#pragma unroll
        for (int b = 0; b < 2; ++b)
#pragma unroll
            for (int m = 0; m < 4; ++m)
#pragma unroll
                for (int n = 0; n < 2; ++n) acc[a][b][m][n] = (f32x4){0.f, 0.f, 0.f, 0.f};
    bf16x8 At[4][2], B0[2][2], B1[2][2];
    i32x8_t At8[4], B08[2], B18[2];
    const char* cA = cur.a; const char* cB = cur.b;
    PG8_GV(vc, cur);
    PG8_STAGE(PG8_SB(0, 0), cB, voffB); PG8_STAGE(PG8_SB(0, 1), cB + hstep, voffB); PG8_STAGE(PG8_SA(0, 0), cA, vc[0]); PG8_STAGE(PG8_SA(0, 1), cA, vc[1]);
    if (wr == 1) PG8_BAR;
    PG8_WAIT_V(2); PG8_BAR;
    PG8_STAGE(PG8_SB(1, 0), cB + kstep, voffB); PG8_STAGE(PG8_SA(1, 0), cA + kstep, vc[0]); PG8_STAGE(PG8_SB(1, 1), cB + hstep + kstep, voffB);
    PG8_WAIT_V(6); PG8_BAR;
    for (;;) {
        const bool has_next = S.next(ui + 1, nxt);
        const char* nA = has_next ? nxt.a : cA; const char* nB = has_next ? nxt.b : cB;
        if constexpr (GATHER) { if (has_next) { PG8_GV(vn, nxt); } else {
#pragma unroll
            for (int h = 0; h < 2; ++h)
#pragma unroll
                for (int i = 0; i < 2; ++i) vn[h][i] = vc[h][i]; } }
#pragma unroll 1
        for (int t = 0; t < nt; t += 2) {
            const bool last = (t == nt - 2);
            const char* a1 = cA + (size_t)(t + 1) * kstep;
            const char* a2 = last ? nA : cA + (size_t)(t + 2) * kstep; const char* b2 = last ? nB : cB + (size_t)(t + 2) * kstep;
            const char* a3 = a2 + kstep; const char* b3 = b2 + kstep;
            unsigned v2[2][2];
#pragma unroll
            for (int h = 0; h < 2; ++h)
#pragma unroll
                for (int i = 0; i < 2; ++i) v2[h][i] = (GATHER && last) ? vn[h][i] : vc[h][i];
            PG8_LDB(B0, 0, 0); PG8_LDB(B1, 0, 1); PG8_SCHED; PG8_LDA(At, 0, 0); PG8_STAGE(PG8_SA(1, 1), a1, vc[1]);
            PG8_WAIT_V(8); PG8_WAIT_L(0); PG8_BAR; PG8_MMA(0, 0, At, B0); PG8_MMA(0, 1, At, B1); PG8_BAR; PG8_SCHED;
            PG8_LDA(At, 0, 1); PG8_STAGE(PG8_SB(0, 0), b2, voffB); PG8_STAGE(PG8_SB(0, 1), b2 + hstep, voffB); PG8_STAGE(PG8_SA(0, 0), a2, v2[0]);
            PG8_WAIT_V(8); PG8_WAIT_L(0); PG8_BAR; PG8_MMA(1, 0, At, B0); PG8_MMA(1, 1, At, B1); PG8_BAR; PG8_SCHED;
            PG8_LDB(B0, 1, 0); PG8_LDB(B1, 1, 1); PG8_SCHED; PG8_LDA(At, 1, 0); PG8_STAGE(PG8_SA(0, 1), a2, v2[1]);
            PG8_WAIT_V(8); PG8_WAIT_L(0); PG8_BAR; PG8_MMA(0, 0, At, B0); PG8_MMA(0, 1, At, B1); PG8_BAR; PG8_SCHED;
            PG8_LDA(At, 1, 1); PG8_STAGE(PG8_SB(1, 0), b3, voffB); PG8_STAGE(PG8_SB(1, 1), b3 + hstep, voffB); PG8_STAGE(PG8_SA(1, 0), a3, v2[0]);
            PG8_WAIT_V(8); PG8_WAIT_L(0); PG8_BAR; PG8_MMA(1, 0, At, B0); PG8_MMA(1, 1, At, B1); PG8_BAR; PG8_SCHED;
        }
        if (wr == 0) PG8_BAR;
        if constexpr (ESZ == 1) asm volatile("s_nop 15\n\ts_nop 7" ::: "memory");
        E(acc, cur, wr, wc, fr, fq);
        if (!has_next) break;
#pragma unroll
        for (int a = 0; a < 2; ++a)
#pragma unroll
            for (int b = 0; b < 2; ++b)
#pragma unroll
                for (int m = 0; m < 4; ++m)
#pragma unroll
                    for (int n = 0; n < 2; ++n) acc[a][b][m][n] = (f32x4){0.f, 0.f, 0.f, 0.f};
        cur = nxt; cA = nA; cB = nB; ++ui;
        if constexpr (GATHER) {
#pragma unroll
            for (int h = 0; h < 2; ++h)
#pragma unroll
                for (int i = 0; i < 2; ++i) vc[h][i] = vn[h][i]; }
        if (wr == 1) PG8_BAR;
    }
    PG8_WAIT_V(0);
    PG8_BAR;
#undef PG8_SA
#undef PG8_SB
#undef PG8_STAGE
#undef PG8_LDA
#undef PG8_LD32
#undef PG8_LDB
#undef PG8_MMA
#undef PG8_F8
#undef PG8_WAIT_V
#undef PG8_WAIT_L
#undef PG8_BAR
#undef PG8_SCHED
#undef PG8_GV
}
}
struct Frame {
    LAS unsigned char* lds; unsigned char* ws; unsigned* ctl;
    int tid, lane, wave, G, vcu;
    unsigned long long pacc;
};

__device__ __forceinline__ void cvt_tile(const float* W, int N, int K, int k0, int n0, bf16* dst, int drow0, float scale, LAS float* scr, int lane) {
#pragma unroll 8
    for (int i = 0; i < 32; ++i) { const int kk = 2 * i + (lane >> 5); scr[kk * 33 + (lane & 31)] = W[(size_t)(k0 + kk) * N + n0 + (lane & 31)]; }
    LDS_WAIT(); asm volatile("" ::: "memory");
    const int c = lane & 7;
#pragma unroll
    for (int j = 0; j < 4; ++j) { const int n = (lane >> 3) + 8 * j; const LAS float* s = scr + (8 * c) * 33 + n;
        u32x4 o; o.x = pk2(s[0 * 33] * scale, s[1 * 33] * scale); o.y = pk2(s[2 * 33] * scale, s[3 * 33] * scale); o.z = pk2(s[4 * 33] * scale, s[5 * 33] * scale); o.w = pk2(s[6 * 33] * scale, s[7 * 33] * scale);
        *(u32x4*)(dst + (size_t)(drow0 + n) * K + k0 + 8 * c) = o; }
    LDS_WAIT(); asm volatile("" ::: "memory");
}
__device__ __forceinline__ void cvt_tile8(const float* W, int N, int K, int k0, int n0, unsigned char* dst, int drow0, float scale, LAS float* scr, int lane) {
#pragma unroll 8
    for (int i = 0; i < 32; ++i) { const int kk = 2 * i + (lane >> 5); scr[kk * 33 + (lane & 31)] = W[(size_t)(k0 + kk) * N + n0 + (lane & 31)]; }
    LDS_WAIT(); asm volatile("" ::: "memory");
    const int c = lane & 7;
#pragma unroll
    for (int j = 0; j < 4; ++j) { const int n = (lane >> 3) + 8 * j; const LAS float* s = scr + (8 * c) * 33 + n;
        u32x2 o; o.x = pk4_fp8(s[0 * 33] * scale, s[1 * 33] * scale, s[2 * 33] * scale, s[3 * 33] * scale); o.y = pk4_fp8(s[4 * 33] * scale, s[5 * 33] * scale, s[6 * 33] * scale, s[7 * 33] * scale);
        *(u32x2*)(dst + (size_t)(drow0 + n) * K + k0 + 8 * c) = o; }
    LDS_WAIT(); asm volatile("" ::: "memory");
}
__device__ __forceinline__ void convert_phase(Frame& F, const Args& a, int l) {
    using namespace cfg;
    LAS float* scr = (LAS float*)(F.lds + F.wave * 16384);
    const int gw = F.vcu * 8 + F.wave, NGW = F.G * 8;
    const float* w_in = a.in[1] + (size_t)l * D * INC; const float* w_out = a.in[2] + (size_t)l * D * D;
    const size_t es = (size_t)NEXP * D * EH;
    const float* wg = a.in[29] + l * es; const float* wu = a.in[30] + l * es; const float* wd = a.in[31] + l * es;
    bf16* Wi = (bf16*)(F.ws + wsm::W_IN); bf16* Wo = (bf16*)(F.ws + wsm::W_OUT); bf16* Wgu = (bf16*)(F.ws + wsm::W_GU); bf16* Wd = (bf16*)(F.ws + wsm::W_D);
    constexpr int I_IN = 32 * 200, I_OUT = 32 * 64, I_G = 32 * 256, I_D = 32 * 256;
    constexpr int NITEMS = I_IN + I_OUT + 2 * I_G + I_D;
    for (int it = gw; it < NITEMS; it += NGW) {
        int r = it;
        if (r < I_IN) { const int kb = r / 200, nb = r % 200, n0 = nb * 32; const bool isq = (n0 >= OFF_BQ && n0 < OFF_BK) || (n0 >= OFF_CQ && n0 < OFF_CK);
            if (F8IN(l)) cvt_tile8(w_in, INC, D, kb * 64, n0, (unsigned char*)Wi, n0, (isq ? C2F : 1.f) * pg8::F8_WGT, scr, F.lane); else cvt_tile(w_in, INC, D, kb * 64, n0, Wi, n0, isq ? C2F : 1.f, scr, F.lane); continue; } r -= I_IN;
        if (r < I_OUT) { const int kb = r / 64, nb = r % 64; if (F8OUT(l)) cvt_tile8(w_out, D, D, kb * 64, nb * 32, (unsigned char*)Wo, nb * 32, pg8::F8_WGT, scr, F.lane); else cvt_tile(w_out, D, D, kb * 64, nb * 32, Wo, nb * 32, 1.f, scr, F.lane); continue; } r -= I_OUT;
        if (r < 2 * I_G) { const int up = r >= I_G; if (up) r -= I_G; const int e = r >> 8, q = r & 255, kb = q >> 3, nb = q & 7, n0 = nb * 32;
            if ((F8_MOE_MASK >> l) & 1) cvt_tile8((up ? wu : wg) + (size_t)e * D * EH, EH, D, kb * 64, n0, (unsigned char*)Wgu, e * 512 + 256 * (n0 >> 7) + (n0 & 127) + (up ? 128 : 0), pg8::F8_WGT, scr, F.lane);
            else cvt_tile((up ? wu : wg) + (size_t)e * D * EH, EH, D, kb * 64, n0, Wgu, e * 512 + 256 * (n0 >> 7) + (n0 & 127) + (up ? 128 : 0), 1.f, scr, F.lane); continue; } r -= 2 * I_G;
        { const int e = r >> 8, q = r & 255, kb = q >> 6, nb = q & 63;
          if (F8_DOWN) cvt_tile8(wd + (size_t)e * EH * D, D, EH, kb * 64, nb * 32, (unsigned char*)Wd + (size_t)e * D * EH, nb * 32, pg8::F8_WGT, scr, F.lane);
          else cvt_tile(wd + (size_t)e * EH * D, D, EH, kb * 64, nb * 32, Wd + (size_t)e * D * EH, nb * 32, 1.f, scr, F.lane); }
    }
    bf16* Wr = (bf16*)(F.ws + wsm::WRT); const float* rg = a.in[25] + (size_t)l * D * 4; const float* re = a.in[27] + (size_t)l * D * 32;
    for (int idx = (F.vcu * 512 + F.tid); idx < 48 * 2048; idx += F.G * 512) { const int n = idx >> 11, k = idx & 2047;
        const float v = n < 4 ? rg[k * 4 + n] : (n < 36 ? re[k * 32 + n - 4] : 0.f); Wr[idx] = cvt1(v); }
    bf16* w2t = (bf16*)(F.ws + wsm::WRT + 262144); bf16* a2t = w2t + 512 * 64; bf16* g2t = a2t + 512 * 64;
    const float* w2 = a.in[8] + (size_t)l * 64 * 512; const float* a2 = a.in[10] + (size_t)l * 64 * 512; const float* g2 = a.in[11] + (size_t)l * 128 * 512;
    for (int idx = (F.vcu * 512 + F.tid); idx < 512 * 256; idx += F.G * 512) { const int ch = idx & 511, j = idx >> 9;
        if (j < 64) w2t[ch * 64 + j] = cvt1(w2[j * 512 + ch]); else if (j < 128) a2t[ch * 64 + (j - 64)] = cvt1(a2[(j - 64) * 512 + ch]); else g2t[ch * 128 + (j - 128)] = cvt1(g2[(j - 128) * 512 + ch]); }
}

__device__ __forceinline__ int grab(Frame& F, int q) {
    volatile LAS int* slot = (volatile LAS int*)(F.lds + MISC_OFF + 64);
    if (F.tid == 0) *slot = (int)__hip_atomic_fetch_add(F.ctl + wsm::CW_Q + q * 64, 1u, RLX_AGENT);
    __syncthreads();
    const int v = *slot;
    __syncthreads();
    return __builtin_amdgcn_readfirstlane(v);
}
__device__ __forceinline__ void build_pref(Frame& F, int l) {
    LAS int* pref = (LAS int*)(F.lds + TAB_OFF);
    if (F.tid == 0) { int s = 0; for (int e = 0; e < 32; ++e) { pref[e] = s; const unsigned c = __hip_atomic_load(F.ctl + wsm::CW_CNT + (l * 32 + e) * 64, RLX_AGENT); pref[40 + e] = (int)c; s += (int)((c + 255u) >> 8); } pref[32] = s; }
    __syncthreads();
}

template <bool COMBINE, bool ROUTER, bool FINAL, bool F8 = false, bool XBF = false>
__device__ __forceinline__ void norm_phase(Frame& F, const Args& a, const float* xsrc, float* xout, const float* gain, int l, int lc) {
    using namespace cfg;
    constexpr int PITCHB = 4112;
    LAS unsigned char* tile = F.lds;
    LAS float* part = (LAS float*)(F.lds + 67584);
    LAS int* pref = (LAS int*)(F.lds + TAB_OFF);
    bf16* xn = (bf16*)(F.ws + wsm::XN);
    const bf16* OB = (const bf16*)(F.ws + wsm::OB);
    const int4* tokinfo = (const int4*)(F.ws + wsm::TOKINFO);
    const int lane = F.lane, w = F.wave;
    f32x4 g4[8];
#pragma unroll
    for (int j = 0; j < 8; ++j) g4[j] = *(const f32x4*)(gain + 4 * lane + 256 * j);
    for (int pass = F.vcu; pass < M / 16; pass += F.G) {
#pragma unroll
        for (int rr = 0; rr < 2; ++rr) {
            const int rt = 2 * w + rr, row = pass * 16 + rt;
            f32x4 v[8];
            if constexpr (XBF) { const bf16* xr = (const bf16*)xsrc + (size_t)row * D + 4 * lane;
#pragma unroll
                for (int j = 0; j < 8; ++j) { const u32x2 w = *(const u32x2*)(xr + 256 * j); v[j] = (f32x4){__uint_as_float(w.x << 16), __uint_as_float(w.x & 0xffff0000u), __uint_as_float(w.y << 16), __uint_as_float(w.y & 0xffff0000u)}; }
            } else { const float* xr = xsrc + (size_t)row * D + 4 * lane;
#pragma unroll
                for (int j = 0; j < 8; ++j) v[j] = *(const f32x4*)(xr + 256 * j); }
            if constexpr (COMBINE) {
                const int4 ti = tokinfo[row];
                const unsigned char* o0 = (const unsigned char*)OB + ((size_t)pref[ti.x] * 256 + ti.y) * D + 4 * lane; const unsigned char* o1 = (const unsigned char*)OB + ((size_t)pref[ti.z] * 256 + ti.w) * D + 4 * lane;
#pragma unroll
                for (int j = 0; j < 8; ++j) { const int p0 = *(const int*)(o0 + 256 * j), p1 = *(const int*)(o1 + 256 * j);
                    const f32x2 a0 = __builtin_amdgcn_cvt_pk_f32_fp8(p0, false), a1 = __builtin_amdgcn_cvt_pk_f32_fp8(p0, true), b0 = __builtin_amdgcn_cvt_pk_f32_fp8(p1, false), b1 = __builtin_amdgcn_cvt_pk_f32_fp8(p1, true);
                    v[j].x += (a0.x + b0.x) * (1.f / F8_OB); v[j].y += (a0.y + b0.y) * (1.f / F8_OB); v[j].z += (a1.x + b1.x) * (1.f / F8_OB); v[j].w += (a1.y + b1.y) * (1.f / F8_OB); }
                if constexpr (!FINAL) {
#pragma unroll
                    for (int j = 0; j < 8; ++j) { if constexpr (XBF) { u32x2 w; w.x = pk2(v[j].x, v[j].y); w.y = pk2(v[j].z, v[j].w); *(u32x2*)((bf16*)xout + (size_t)row * D + 4 * lane + 256 * j) = w; }
                        else *(f32x4*)(xout + (size_t)row * D + 4 * lane + 256 * j) = v[j]; }
                }
            }
            float s = 0.f;
#pragma unroll
            for (int j = 0; j < 8; ++j) s += (v[j].x * v[j].x + v[j].y * v[j].y) + (v[j].z * v[j].z + v[j].w * v[j].w);
            const float rstd = rsqrtf(wave_sum(s) * (1.f / D) + 1e-6f);
#pragma unroll
            for (int j = 0; j < 8; ++j) { const f32x4 o = v[j] * rstd * g4[j];
                if constexpr (FINAL) *(f32x4*)(xout + (size_t)row * D + 4 * lane + 256 * j) = o;
                else if constexpr (F8) { *(unsigned*)((unsigned char*)xn + (size_t)row * D + 4 * lane + 256 * j) = pk4_fp8(o.x * pg8::F8_ACT, o.y * pg8::F8_ACT, o.z * pg8::F8_ACT, o.w * pg8::F8_ACT);
                    if constexpr (ROUTER) { u32x2 pk; pk.x = pk2(o.x, o.y); pk.y = pk2(o.z, o.w); *(LAS u32x2*)(tile + rt * PITCHB + (4 * lane + 256 * j) * 2) = pk; } }
                else { u32x2 pk; pk.x = pk2(o.x, o.y); pk.y = pk2(o.z, o.w);
                    *(u32x2*)(xn + (size_t)row * D + 4 * lane + 256 * j) = pk;
                    if constexpr (ROUTER) *(LAS u32x2*)(tile + rt * PITCHB + (4 * lane + 256 * j) * 2) = pk; } }
        }
        if constexpr (ROUTER) {
            __syncthreads();
            const bf16* Wr = (const bf16*)(F.ws + wsm::WRT);
            f32x4 acc[3] = {(f32x4){0.f, 0.f, 0.f, 0.f}, (f32x4){0.f, 0.f, 0.f, 0.f}, (f32x4){0.f, 0.f, 0.f, 0.f}};
#pragma unroll
            for (int s8 = 0; s8 < 8; ++s8) { const int k = 256 * w + 32 * s8 + 8 * (lane >> 4);
                const bf16x8 af = *(const LAS bf16x8*)(tile + (lane & 15) * PITCHB + k * 2);
#pragma unroll
                for (int nt = 0; nt < 3; ++nt) { const bf16x8 bfr = *(const bf16x8*)(Wr + (size_t)(16 * nt + (lane & 15)) * D + k);
                    acc[nt] = __builtin_amdgcn_mfma_f32_16x16x32_bf16(af, bfr, acc[nt], 0, 0, 0); } }
#pragma unroll
            for (int nt = 0; nt < 3; ++nt)
#pragma unroll
                for (int i = 0; i < 4; ++i) part[(w * 16 + (lane >> 4) * 4 + i) * 48 + 16 * nt + (lane & 15)] = acc[nt][i];
            __syncthreads();
            if (F.tid < 16) {
                const int m = F.tid, tok = pass * 16 + m;
                const float* bg = a.in[26] + l * 4; const float* be = a.in[28] + l * 32;
                float lg[4];
#pragma unroll
                for (int o = 0; o < 4; ++o) { float sacc = bg[o];
#pragma unroll
                    for (int ww = 0; ww < 8; ++ww) sacc += part[(ww * 16 + m) * 48 + o]; lg[o] = sacc; }
                int gi = 0; float gm = lg[0];
#pragma unroll
                for (int o = 1; o < 4; ++o) if (lg[o] > gm) { gm = lg[o]; gi = o; }
                float gs = 0.f;
#pragma unroll
                for (int o = 0; o < 4; ++o) gs += __expf(lg[o] - gm);
                const float gw = 1.f / gs;
                float el[8];
#pragma unroll
                for (int o = 0; o < 8; ++o) { float sacc = be[gi * 8 + o];
#pragma unroll
                    for (int ww = 0; ww < 8; ++ww) sacc += part[(ww * 16 + m) * 48 + 4 + gi * 8 + o]; el[o] = sacc; }
                int i1 = 0; float m1 = el[0];
#pragma unroll
                for (int o = 1; o < 8; ++o) if (el[o] > m1) { m1 = el[o]; i1 = o; }
                int i2 = 0; float m2 = -3e38f;
#pragma unroll
                for (int o = 0; o < 8; ++o) if (o != i1 && el[o] > m2) { m2 = el[o]; i2 = o; }
                const float e2x = __expf(m2 - m1); const float w1 = gw / (1.f + e2x), w2 = gw * e2x / (1.f + e2x);
                const int e1 = gi * 8 + i1, e2 = gi * 8 + i2;
                const int p1 = (int)__hip_atomic_fetch_add(F.ctl + wsm::CW_CNT + (lc * 32 + e1) * 64, 1u, RLX_AGENT);
                const int p2 = (int)__hip_atomic_fetch_add(F.ctl + wsm::CW_CNT + (lc * 32 + e2) * 64, 1u, RLX_AGENT);
                int* lists = (int*)(F.ws + wsm::LISTS); float* wl = (float*)(F.ws + wsm::WLIST);
                lists[e1 * LCAP + p1] = tok; lists[e2 * LCAP + p2] = tok; wl[e1 * LCAP + p1] = w1; wl[e2 * LCAP + p2] = w2;
                ((int4*)(F.ws + wsm::TOKINFO))[tok] = make_int4(e1, p1, e2, p2);
                ((int4*)(F.ws + wsm::ROUTE))[tok] = make_int4(e1, e2, __float_as_int(w1), __float_as_int(w2));
            }
            __syncthreads();
        }
    }
}
namespace att {
typedef float f32x16 __attribute__((ext_vector_type(16)));
typedef short s16x4 __attribute__((ext_vector_type(4)));
constexpr int L_K = 0, L_V = 16384, L_WSF = 135168, L_TAB = 137216;
__device__ __forceinline__ int crow(int r, int hi) { return (r & 3) + 8 * (r >> 2) + 4 * hi; }
__device__ __forceinline__ int t5_bucket(int rel) {
    const int ret = rel > 0 ? 16 : 0; const int n = rel < 0 ? -rel : rel; int bk;
    if (n < 8) bk = n; else if (n < 12) bk = 8; else if (n < 16) bk = 9; else if (n < 23) bk = 10; else if (n < 32) bk = 11;
    else if (n < 46) bk = 12; else if (n < 64) bk = 13; else if (n < 91) bk = 14; else bk = 15;
    return ret + bk;
}
__device__ __forceinline__ unsigned cvtpk(float lo, float hi) { return pk2(lo, hi); }
__device__ __forceinline__ void qkt(f32x16& p0, f32x16& p1, const LAS unsigned char* Kslot, const bf16x8* qr, const f32x16& c0, const f32x16& c1, int r32, int hi) {
    const LAS unsigned char* kb = Kslot + hi * 1024 + r32 * 16;
#pragma unroll
    for (int d0 = 0; d0 < 4; ++d0) {
        const bf16x8 b0 = *(const LAS bf16x8*)(kb + d0 * 2048);
        const bf16x8 b1 = *(const LAS bf16x8*)(kb + d0 * 2048 + 512);
        if (d0 == 0) { p0 = __builtin_amdgcn_mfma_f32_32x32x16_bf16(b0, qr[0], c0, 0, 0, 0); p1 = __builtin_amdgcn_mfma_f32_32x32x16_bf16(b1, qr[0], c1, 0, 0, 0); }
        else { p0 = __builtin_amdgcn_mfma_f32_32x32x16_bf16(b0, qr[d0], p0, 0, 0, 0); p1 = __builtin_amdgcn_mfma_f32_32x32x16_bf16(b1, qr[d0], p1, 0, 0, 0); } }
}
__device__ __forceinline__ float rowmax(const f32x16& p0, const f32x16& p1) {
    float a = fmaxf(fmaxf(p0[0], p0[1]), p1[0]), b = fmaxf(fmaxf(p0[2], p0[3]), p1[1]); a = fmaxf(fmaxf(a, p1[2]), p1[3]);
#pragma unroll
    for (int r = 4; r < 16; r += 4) { a = fmaxf(fmaxf(a, p0[r]), p0[r + 1]); b = fmaxf(fmaxf(b, p0[r + 2]), p0[r + 3]); a = fmaxf(fmaxf(a, p1[r]), p1[r + 1]); b = fmaxf(fmaxf(b, p1[r + 2]), p1[r + 3]); }
    const float m = fmaxf(a, b);
    auto rr = __builtin_amdgcn_permlane32_swap(__float_as_uint(m), __float_as_uint(m), false, false);
    return fmaxf(__uint_as_float(rr[0]), __uint_as_float(rr[1]));
}
template <int ND>
__device__ __forceinline__ void pv(f32x16* o, int vb, bf16x8 pa0, bf16x8 pa1, bf16x8 pa2, bf16x8 pa3) {
#pragma unroll
    for (int d0 = 0; d0 < ND; ++d0) { s16x4 lo[4], hi[4];
#pragma unroll
        for (int ks = 0; ks < 4; ++ks) {
            asm volatile("ds_read_b64_tr_b16 %0,%1 offset:%c2" : "=&v"(lo[ks]) : "v"(vb), "i"(d0 * 4096 + ks * 1024) : "memory");
            asm volatile("ds_read_b64_tr_b16 %0,%1 offset:%c2" : "=&v"(hi[ks]) : "v"(vb), "i"(d0 * 4096 + ks * 1024 + 512) : "memory"); }
        asm volatile("s_waitcnt lgkmcnt(0)" ::: "memory"); __builtin_amdgcn_sched_barrier(0);
#define ATT_PK(k) (bf16x8){lo[k][0], lo[k][1], lo[k][2], lo[k][3], hi[k][0], hi[k][1], hi[k][2], hi[k][3]}
        o[d0] = __builtin_amdgcn_mfma_f32_32x32x16_bf16(pa0, ATT_PK(0), o[d0], 0, 0, 0);
        o[d0] = __builtin_amdgcn_mfma_f32_32x32x16_bf16(pa1, ATT_PK(1), o[d0], 0, 0, 0);
        o[d0] = __builtin_amdgcn_mfma_f32_32x32x16_bf16(pa2, ATT_PK(2), o[d0], 0, 0, 0);
        o[d0] = __builtin_amdgcn_mfma_f32_32x32x16_bf16(pa3, ATT_PK(3), o[d0], 0, 0, 0);
#undef ATT_PK
    }
}
#define ATT_WAIT_BAR(N) asm volatile("s_waitcnt vmcnt(" #N ") lgkmcnt(0)\n\ts_barrier" ::: "memory")
#ifndef PROBE_ATT
#define PROBE_ATT -1
#endif
#define ATT_NOW() __builtin_amdgcn_s_memrealtime()
#define ATT_SBAR() __builtin_amdgcn_sched_barrier(0)
#define ATT_PIN(x) asm volatile("" : "+v"(x))
#define ATT_MFMA(a, b, c) __builtin_amdgcn_mfma_f32_32x32x16_bf16(a, b, c, 0, 0, 0)
typedef const LAS char* lds_cptr;
typedef short v4i16_t __attribute__((ext_vector_type(4)));
__device__ __forceinline__ void glds16(const void* g, unsigned lds_base) {
    unsigned sv; asm volatile("s_mov_b32 %0, m0\n\ts_mov_b32 m0, %2\n\ts_nop 0\n\tglobal_load_lds_dwordx4 %1, off\n\ts_mov_b32 m0, %0" : "=&s"(sv) : "v"(g), "s"(lds_base) : "memory"); }
__device__ __forceinline__ void kload2(bf16x8* kf, lds_cptr kp, int d0) { kf[2 * d0] = *(const LAS bf16x8*)(kp + d0 * 2048); kf[2 * d0 + 1] = *(const LAS bf16x8*)(kp + d0 * 2048 + 512); }
__device__ __forceinline__ s16x4 vtr(lds_cptr q) { return __builtin_bit_cast(s16x4, __builtin_amdgcn_ds_read_tr16_b64_v4i16((LAS v4i16_t*)q)); }

template <int MODE>
__device__ __forceinline__ void attn_unit(Frame& F, const Args& a, const int l, const int b, const int hh, const int qb) {
    using namespace cfg;
    constexpr int ND = MODE ? 4 : 2, VSLOT = ND * 4096, NV = MODE ? 2 : 1, EPG = 8 / ND, KRD0 = MODE ? 8 : 2, VLEAD = 5;
    constexpr int NS = 4, LK = 0, LV = NS * 8192, LQ = 98304;
    constexpr float THR = 8.f;
    unsigned long long pu0_ = 0; if (PROBE_ATT == 3) pu0_ = ATT_NOW();
    const int lane = F.lane, r32 = lane & 31, hi = lane >> 5, wid = F.wave;
    const bf16* p = (const bf16*)(F.ws + wsm::P);
    bf16* y = (bf16*)(F.ws + wsm::Y);
    float* O1s = (float*)(F.ws + wsm::XN);
    LAS unsigned char* lds = F.lds;
    LAS float* wsf = (LAS float*)(lds + L_WSF) + wid * 64;
    LAS float* tab = (LAS float*)(lds + L_TAB);
    const size_t rowbase = (size_t)b * SEQ;
    if (F.tid < 320) { const int i = F.tid; float v;
        if (MODE == 0) { int d = i - 64; d = d < -128 ? -128 : (d > 128 ? 128 : d); v = a.in[17][(size_t)(l * 8 + hh) * 257 + d + 128]; }
        else v = a.in[18][t5_bucket(-(i - 64)) * 4 + hh];
        tab[i] = v * LOG2E; }
    const int t0 = MODE == 0 ? (4 * qb - 8 > 0 ? 4 * qb - 8 : 0) : 0, t1 = 4 * qb + 3;
    const int cw = 4 * qb + (wid >> 1);
    const int va = MODE == 0 ? (cw - 8 > 0 ? cw - 8 : 0) : 0, vb = cw;
    const int q0w = qb * 256 + 32 * wid, myq = q0w + r32;
    const unsigned lds0 = (unsigned)(uintptr_t)lds;
    const lds_cptr kp0 = (lds_cptr)lds + LK + hi * 1024 + r32 * 16;
    const lds_cptr vp0 = (lds_cptr)lds + LV + ((lane >> 4) & 1) * 32 + (lane & 3) * 8 + (4 * hi + ((lane & 15) >> 2)) * 64;
#pragma unroll 1
    for (int sub = 0; sub < (MODE ? 2 : 1); ++sub) {
        const int qcol = MODE ? OFF_CQ + (hh * 2 + sub) * 64 : OFF_BQ + hh * 64;
        const int kcol = MODE ? OFF_CK + (hh * 2 + sub) * 64 : OFF_BK + hh * 64;
        const int vcol = MODE ? OFF_CV + hh * 128 : OFF_BV + hh * 64;
        const bf16* Kh = p + rowbase * INC + kcol; const bf16* Vh = p + rowbase * INC + vcol;
        const bf16* ksrc = Kh + (size_t)lane * INC + wid * 8;
        const bf16* vsrc0 = Vh + (size_t)(16 * (wid & 3) + (lane >> 2)) * INC + (wid >> 2) * 32 + (lane & 3) * 8;
        const unsigned kdst = lds0 + LK + wid * 1024, vdst = lds0 + LV + wid * 1024;
#define ATT_DMA_K(t, s) glds16(ksrc + (size_t)(t) * 64 * INC, (unsigned)__builtin_amdgcn_readfirstlane(kdst + (s) * 8192))
#define ATT_DMA_V(t, s) do { glds16(vsrc0 + (size_t)(t) * 64 * INC, (unsigned)__builtin_amdgcn_readfirstlane(vdst + (s) * VSLOT)); \
        if (MODE) glds16(vsrc0 + (size_t)(t) * 64 * INC + 64, (unsigned)__builtin_amdgcn_readfirstlane(vdst + (s) * VSLOT + 8192)); } while (0)
        { const bf16* Qw = p + (rowbase + q0w) * INC + qcol + (size_t)r32 * INC + hi * 8;
#pragma unroll
          for (int d0 = 0; d0 < 4; ++d0) glds16(Qw + d0 * 16, (unsigned)__builtin_amdgcn_readfirstlane(lds0 + LQ + wid * 4096 + d0 * 1024)); }
        ATT_DMA_K(t0, 0); ATT_DMA_V(t0, 0); ATT_DMA_K(t0 + 1, 1); ATT_DMA_K(t0 + 2, 2); ATT_DMA_K(t0 + 3, 3); ATT_DMA_V(t0 + 1, 1);
        float mhat = 0.f, l_reg = 0.f;
        f32x16 o[ND];
#pragma unroll
        for (int d0 = 0; d0 < ND; ++d0)
#pragma unroll
            for (int r = 0; r < 16; ++r) o[d0][r] = 0.f;
        { LAS unsigned char* z = lds + LV + 3 * VSLOT + F.tid * (VSLOT / 512);
#pragma unroll
          for (int i = 0; i < VSLOT / 512 / 16; ++i) *(LAS u32x4*)(z + 16 * i) = (u32x4){0u, 0u, 0u, 0u}; }
        if (MODE) { ATT_WAIT_BAR(4); } else { ATT_WAIT_BAR(3); }
        const float cf = tab[300];
        bf16x8 qr[4];
#pragma unroll
        for (int d0 = 0; d0 < 4; ++d0) qr[d0] = *(const LAS bf16x8*)(lds + LQ + wid * 4096 + d0 * 1024 + lane * 16);
        bf16x8 kf[8];
#pragma unroll
        for (int d0 = 0; d0 < 4; ++d0) kload2(kf, kp0, d0);
        asm volatile("s_waitcnt lgkmcnt(0)\n\ts_barrier" ::: "memory");
        f32x16 C0, C1; u32x4 pw[4];
#pragma unroll
        for (int r = 0; r < 16; ++r) { C0[r] = 0.f; C1[r] = 0.f; }
#pragma unroll
        for (int g = 0; g < 4; ++g) pw[g] = (u32x4){0u, 0u, 0u, 0u};
#define ATT_CE(e) (((e) < 16) ? C0[(e) & 15] : C1[(e) & 15])
#define ATT_CEXP(e) do { if ((e) < 16) C0[(e) & 15] = __builtin_amdgcn_exp2f(C0[(e) & 15]); else C1[(e) & 15] = __builtin_amdgcn_exp2f(C1[(e) & 15]); } while (0)
#define ATT_VRD(ks, d0) do { vlo[(ks) * ND + (d0)] = vtr(vpp + (d0) * 4096 + (ks) * 1024); vhi[(ks) * ND + (d0)] = vtr(vpp + (d0) * 4096 + (ks) * 1024 + 512); } while (0)
#define ATT_VRDF(f) ATT_VRD((f) / ND, (f) % ND)
#define ATT_VFR(i) (bf16x8){vlo[i][0], vlo[i][1], vlo[i][2], vlo[i][3], vhi[i][0], vhi[i][1], vhi[i][2], vhi[i][3]}
#define ATT_PAF(g) __builtin_bit_cast(bf16x8, pw[g])
        unsigned long long pl0_ = 0; if (PROBE_ATT == 2) pl0_ = ATT_NOW(); if (PROBE_ATT == 4) pl0_ = __builtin_amdgcn_s_memtime();
#pragma unroll 1
        for (int t = t0; t <= t1; ++t) {
            const bool gk = (t + 4 <= t1), gv = (t + 2 <= t1);
            const int s_cur = (t - t0) & 3, s_prev = (t - t0 - 1) & 3, s_next = (t - t0 + 1) & 3, s_nn = (t - t0 + 2) & 3;
            const lds_cptr vpp = vp0 + s_prev * VSLOT;
            const lds_cptr kpn = kp0 + s_next * 8192;
            bool resc = false;
            ATT_SBAR();
            {
                s16x4 vlo[4 * ND], vhi[4 * ND];
                const bool msk = (t > vb) || (t < va);
                const bool nearb = !msk && (q0w - (t * 64 + 63)) < 128;
                if (nearb) {
                    const LAS float* tb = tab + (myq - t * 64 - 4 * hi + 64 - 27 - 32);
#pragma unroll
                    for (int r = 0; r < 16; ++r) { C1[r] = tb[27 - ((r & 3) + 8 * (r >> 2))] - mhat; C0[r] = tb[32 + 27 - ((r & 3) + 8 * (r >> 2))] - mhat; }
                    ATT_SBAR();
                    C0 = ATT_MFMA(kf[0], qr[0], C0); ATT_SBAR(); C1 = ATT_MFMA(kf[1], qr[0], C1); ATT_SBAR();
                } else {
                    f32x16 cfm; const float cfv = msk ? -1e30f : cf - mhat;
#pragma unroll
                    for (int r = 0; r < 16; ++r) cfm[r] = cfv;
                    ATT_SBAR();
                    C0 = ATT_MFMA(kf[0], qr[0], cfm); ATT_SBAR(); C1 = ATT_MFMA(kf[1], qr[0], cfm); ATT_SBAR();
                }
#pragma unroll
                for (int i = 2; i < 8; ++i) {
                    if (i >= 8 - VLEAD) { ATT_VRDF(i - (8 - VLEAD)); ATT_SBAR(); }
                    if (i & 1) C1 = ATT_MFMA(kf[i], qr[i >> 1], C1); else C0 = ATT_MFMA(kf[i], qr[i >> 1], C0);
                    ATT_SBAR();
                }
                if (gk) ATT_DMA_K(t + 4, s_cur);
                if (gv) ATT_DMA_V(t + 2, s_nn);
                const float rm = rowmax(C0, C1);
                const bool firstv = (t == va);
                if (__builtin_expect(firstv || __any(rm > THR), 0)) {
                    const float dl = firstv ? rm : fmaxf(rm, 0.f); mhat += dl;
#pragma unroll
                    for (int r = 0; r < 16; ++r) { C0[r] -= dl; C1[r] -= dl; }
                    const float f = firstv ? 1.f : __builtin_amdgcn_exp2f(-dl); l_reg *= f; if (hi == 0) wsf[r32] = f; resc = !firstv;
                }
                ATT_SBAR();
                float sa = 0.f, sb = 0.f;
#pragma unroll
                for (int m = 0; m < 4 * ND; ++m) {
                    const int g = m / ND, d0 = m % ND;
                    if (m + VLEAD < 4 * ND) { ATT_VRDF(m + VLEAD); ATT_SBAR(); }
                    if (m >= KRD0 && m < KRD0 + 4) { kload2(kf, kpn, m - KRD0); ATT_SBAR(); }
                    o[d0] = ATT_MFMA(ATT_PAF(g), ATT_VFR(g * ND + d0), o[d0]);
#pragma unroll
                    for (int jj = 0; jj < EPG; ++jj) ATT_CEXP(8 * g + EPG * d0 + jj);
                    if (g >= 1) {
#pragma unroll
                        for (int jj = 0; jj < EPG; jj += 2) { const int e = 8 * (g - 1) + EPG * d0 + jj; sa += ATT_CE(e); sb += ATT_CE(e + 1); pw[g - 1][(EPG * d0 + jj) >> 1] = pk2(ATT_CE(e), ATT_CE(e + 1)); }
                        ATT_PIN(pw[g - 1]); ATT_PIN(sa); ATT_PIN(sb);
                    }
                    if (g < 2) ATT_PIN(C0); else ATT_PIN(C1);
                    ATT_SBAR();
                }
#pragma unroll
                for (int jj = 0; jj < 8; jj += 2) { const int e = 24 + jj; sa += ATT_CE(e); sb += ATT_CE(e + 1); pw[3][jj >> 1] = pk2(ATT_CE(e), ATT_CE(e + 1)); }
                l_reg += sa + sb;
            }
            ATT_SBAR();
            unsigned long long pw0_ = 0; if (PROBE_ATT == 0) pw0_ = ATT_NOW();
            { const int dleft = t1 - t;
              if (dleft >= 4) { if (MODE) { ATT_WAIT_BAR(6); } else { ATT_WAIT_BAR(4); } }
              else if (dleft == 3) { if (MODE) { ATT_WAIT_BAR(5); } else { ATT_WAIT_BAR(3); } }
              else if (dleft == 2) { if (MODE) { ATT_WAIT_BAR(4); } else { ATT_WAIT_BAR(2); } }
              else if (dleft == 1) { if (MODE) { ATT_WAIT_BAR(2); } else { ATT_WAIT_BAR(1); } }
              else { ATT_WAIT_BAR(0); } }
            if (PROBE_ATT == 0) F.pacc += ATT_NOW() - pw0_;
            if (resc) {
#pragma unroll
                for (int r = 0; r < 16; ++r) { const float fr = wsf[crow(r, hi)];
#pragma unroll
                    for (int d0 = 0; d0 < ND; ++d0) o[d0][r] *= fr; }
            }
        }
        if (PROBE_ATT == 2) F.pacc += ATT_NOW() - pl0_; if (PROBE_ATT == 4) F.pacc += (__builtin_amdgcn_s_memtime() - pl0_) / 100;
        {
            const lds_cptr vpp = vp0 + ((t1 - t0) & 3) * VSLOT;
            s16x4 vlo[4 * ND], vhi[4 * ND];
#pragma unroll
            for (int ks = 0; ks < 4; ++ks) {
#pragma unroll
                for (int d0 = 0; d0 < ND; ++d0) ATT_VRD(ks, d0);
#pragma unroll
                for (int d0 = 0; d0 < ND; ++d0) o[d0] = ATT_MFMA(ATT_PAF(ks), ATT_VFR(ks * ND + d0), o[d0]);
            }
            asm volatile("s_waitcnt lgkmcnt(0)\n\ts_barrier" ::: "memory");
        }
#undef ATT_DMA_K
#undef ATT_DMA_V
#undef ATT_CE
#undef ATT_CEXP
#undef ATT_VRD
#undef ATT_VFR
#undef ATT_VRDF
#undef ATT_PAF
        float lh = l_reg;
        int ln = lane; asm volatile("" : "+v"(ln));
        const int e32 = ln & 31, ehi = ln >> 5;
        { auto rr = __builtin_amdgcn_permlane32_swap(__float_as_uint(lh), __float_as_uint(lh), false, false); lh = __uint_as_float(rr[0]) + __uint_as_float(rr[1]); }
        if (ehi == 0) wsf[32 + e32] = lh;
        LDS_WAIT();
        constexpr int SP = ND * 128 + 16;
        LAS unsigned char* stg = lds + wid * (32 * SP);
#pragma unroll
        for (int r = 0; r < 16; ++r) { const float rl = __builtin_amdgcn_rcpf(wsf[32 + crow(r, ehi)]);
#pragma unroll
            for (int d0 = 0; d0 < ND; ++d0) *(LAS float*)(stg + crow(r, ehi) * SP + (d0 * 32 + e32) * 4) = o[d0][r] * rl; }
        LDS_WAIT();
        const size_t tok0 = rowbase + (size_t)(qb * 256 + 32 * wid);
        if (MODE == 0) {
#pragma unroll 4
            for (int row = 0; row < 32; ++row) { const float v = *(const LAS float*)(stg + row * SP + ln * 4);
                if (F8OUT(l)) ((unsigned char*)y)[(tok0 + row) * D + 512 + hh * 64 + ln] = (unsigned char)(pk2_fp8(v * F8_Y, 0.f) & 0xffu); else y[(tok0 + row) * D + 512 + hh * 64 + ln] = cvt1(v); }
        } else if (sub == 0) {
#pragma unroll 4
            for (int row = 0; row < 32; ++row) { const f32x2 v = *(const LAS f32x2*)(stg + row * SP + ln * 8); *(f32x2*)(O1s + ((tok0 + row) * 4 + hh) * 128 + 2 * ln) = v; }
        } else {
            const float lam_init = l == 0 ? 0.2f : (float)(0.8 - 0.6 * 0.7408182206817179);
            const float lam = __expf(wave_sum(a.in[19][l * 64 + ln] * a.in[20][l * 64 + ln])) - __expf(wave_sum(a.in[21][l * 64 + ln] * a.in[22][l * 64 + ln])) + lam_init;
            const float* sw = a.in[23] + l * 128;
            const float sw0 = sw[2 * ln] * (1.f - lam_init), sw1 = sw[2 * ln + 1] * (1.f - lam_init);
#pragma unroll 2
            for (int row = 0; row < 32; ++row) { const f32x2 v2 = *(const LAS f32x2*)(stg + row * SP + ln * 8); const f32x2 o1 = *(const f32x2*)(O1s + ((tok0 + row) * 4 + hh) * 128 + 2 * ln);
                const float v0 = o1.x - lam * v2.x, v1 = o1.y - lam * v2.y;
                const float ms = wave_sum(v0 * v0 + v1 * v1);
                const float rs = rsqrtf(ms * (1.f / 128.f) + 1e-5f);
                if (F8OUT(l)) *(unsigned short*)((unsigned char*)y + (tok0 + row) * D + 1024 + hh * 128 + 2 * ln) = (unsigned short)pk2_fp8(v0 * rs * sw0 * F8_Y, v1 * rs * sw1 * F8_Y);
                else *(unsigned*)(y + (tok0 + row) * D + 1024 + hh * 128 + 2 * ln) = pk2(v0 * rs * sw0, v1 * rs * sw1); }
        }
        asm volatile("s_waitcnt vmcnt(0) lgkmcnt(0)\n\ts_barrier" ::: "memory");
    }
    if (PROBE_ATT == 3) F.pacc += ATT_NOW() - pu0_;
}

__device__ __forceinline__ void conv_items(Frame& F, const Args& a, const int l, const int start, const int stride) {
    using namespace cfg;
    const bf16* p = (const bf16*)(F.ws + wsm::P); bf16* y = (bf16*)(F.ws + wsm::Y);
    const float* cw = a.in[24] + l * 3 * 512;
    for (int it = start; it < M * 64; it += stride) {
        const int tok = it >> 6, cg = (it & 63) * 8, t = tok & (SEQ - 1);
        const bf16* r0 = p + (size_t)tok * INC + OFF_D + cg;
        const u32x4 bg = *(const u32x4*)r0;
        u32x4 c0 = *(const u32x4*)(r0 + 512), h0 = *(const u32x4*)(r0 + 1024);
        u32x4 c1 = (u32x4){0, 0, 0, 0}, h1 = c1, c2 = c1, h2 = c1;
        if (t >= 1) { c1 = *(const u32x4*)(r0 - INC + 512); h1 = *(const u32x4*)(r0 - INC + 1024); }
        if (t >= 2) { c2 = *(const u32x4*)(r0 - 2 * INC + 512); h2 = *(const u32x4*)(r0 - 2 * INC + 1024); }
        unsigned ow[4];
#pragma unroll
        for (int j = 0; j < 4; ++j) {
            float res[2];
#pragma unroll
            for (int e = 0; e < 2; ++e) {
                const int ch = cg + 2 * j + e;
#define ATT_UP(w) (e ? __uint_as_float((w) & 0xffff0000u) : __uint_as_float((w) << 16))
                const float u0 = ATT_UP(c0[j]) * ATT_UP(h0[j]), u1 = ATT_UP(c1[j]) * ATT_UP(h1[j]), u2 = ATT_UP(c2[j]) * ATT_UP(h2[j]);
                res[e] = ATT_UP(bg[j]) * (cw[ch] * u2 + cw[512 + ch] * u1 + cw[1024 + ch] * u0);
#undef ATT_UP
            }
            ow[j] = (F8OUT(l)) ? pk2_fp8(res[0] * F8_Y, res[1] * F8_Y) : pk2(res[0], res[1]);
        }
        if (F8OUT(l)) *(u32x2*)((unsigned char*)y + (size_t)tok * D + 1536 + cg) = (u32x2){ow[0] | (ow[1] << 16), ow[2] | (ow[3] << 16)};
        else *(u32x4*)(y + (size_t)tok * D + 1536 + cg) = (u32x4){ow[0], ow[1], ow[2], ow[3]};
    }
}
}
namespace rw {
constexpr int PB = 144, PB2 = 272;
constexpr int SLOT = 9216;
constexpr int R0 = 0, R1B = 49152;
constexpr int O_P0 = 0, O_P0T = 9216, O_AAK = 18432, O_ARB = 27648, O_ARK = 36864;
constexpr int O_SEG = R1B + 9 * SLOT, O_BON = O_SEG + 2048;
constexpr size_t UNIT_BYTES = 49152;
constexpr size_t WL_OFF = (size_t)4096 * UNIT_BYTES;
#define RW_S(i) (R1B + (i) * SLOT)

__device__ __forceinline__ bf16x8 ldfrag(const LAS unsigned char* base, int pitch, int row0, int lane, int s) {
    return *(const LAS bf16x8*)(base + (row0 + (lane & 15)) * pitch + (32 * s + 8 * (lane >> 4)) * 2);
}
template <int KS>
__device__ __forceinline__ f32x4 tile_mm(f32x4 acc, const LAS unsigned char* X, int px, int m0, const LAS unsigned char* Y, int py, int n0, int lane) {
#pragma unroll
    for (int s = 0; s < KS; ++s) acc = __builtin_amdgcn_mfma_f32_16x16x32_bf16(ldfrag(Y, py, n0, lane, s), ldfrag(X, px, m0, lane, s), acc, 0, 0, 0);
    return acc;
}
__device__ __forceinline__ void st_rm(LAS unsigned char* base, int pitch, int m, int n0, f32x4 v) {
    u32x2 w; w.x = pk2(v[0], v[1]); w.y = pk2(v[2], v[3]); *(LAS u32x2*)(base + m * pitch + n0 * 2) = w;
}
__device__ __forceinline__ void st_tr(LAS unsigned char* base, int pitch, int m, int n0, f32x4 v) {
    const unsigned p01 = pk2(v[0], v[1]), p23 = pk2(v[2], v[3]);
    *(LAS bf16*)(base + (n0 + 0) * pitch + m * 2) = (bf16)(p01 & 0xffffu); *(LAS bf16*)(base + (n0 + 1) * pitch + m * 2) = (bf16)(p01 >> 16);
    *(LAS bf16*)(base + (n0 + 2) * pitch + m * 2) = (bf16)(p23 & 0xffffu); *(LAS bf16*)(base + (n0 + 3) * pitch + m * 2) = (bf16)(p23 >> 16);
}
__device__ __forceinline__ f32x4 ld_rm(const LAS unsigned char* base, int pitch, int m, int n0) {
    const u32x2 w = *(const LAS u32x2*)(base + m * pitch + n0 * 2);
    return (f32x4){__uint_as_float(w.x << 16), __uint_as_float(w.x & 0xffff0000u), __uint_as_float(w.y << 16), __uint_as_float(w.y & 0xffff0000u)};
}
__device__ __forceinline__ void unpack8(const u32x4 w, float* f) {
#pragma unroll
    for (int j = 0; j < 4; ++j) { f[2 * j] = __uint_as_float(w[j] << 16); f[2 * j + 1] = __uint_as_float(w[j] & 0xffff0000u); }
}
__device__ __forceinline__ u32x4 pack8(const float* f) { return (u32x4){pk2(f[0], f[1]), pk2(f[2], f[3]), pk2(f[4], f[5]), pk2(f[6], f[7])}; }
__device__ __forceinline__ float sigm(float x) { return __builtin_amdgcn_rcpf(1.f + __expf(-x)); }
#define RW_BAR() do { asm volatile("s_waitcnt lgkmcnt(0)" ::: "memory"); __builtin_amdgcn_s_barrier(); asm volatile("" ::: "memory"); } while (0)

#ifndef PROBE_R1
#define PROBE_R1 -1
#endif
#define R1_STAMP(k) do { if (PROBE_R1 >= 0) { const unsigned long long now_ = __builtin_amdgcn_s_memrealtime(); if (PROBE_R1 == (k)) racc += now_ - rlast; rlast = now_; } } while (0)
struct R1Raw { u32x4 c[7], p[7]; };
__device__ __forceinline__ void r1_load(Frame& F, const int u, R1Raw& raw, const int tid) {
    using namespace cfg;
    const int c = u & 63, h = (u >> 6) & 7, b = u >> 9, t = tid >> 3, j0 = (tid & 7) * 8;
    const bf16* cur = (const bf16*)(F.ws + wsm::P) + ((size_t)b * SEQ + c * 64 + t) * INC + j0; const bf16* prv = cur - INC;
#pragma unroll
    for (int i = 0; i < 7; ++i) { const int col = i < 4 ? 1536 + 64 * i : (i - 4) * 512 + h * 64; raw.c[i] = *(const u32x4*)(cur + col); raw.p[i] = *(const u32x4*)(prv + col); }
}
__device__ __forceinline__ void r1_unit(Frame& F, const Args& a, const int l, const int u, const int unext, R1Raw& raw, unsigned long long& racc, int& hcur) {
    using namespace cfg;
    unsigned long long rlast = PROBE_R1 >= 0 ? __builtin_amdgcn_s_memrealtime() : 0ull;
    int tid_ = F.tid; asm volatile("" : "+v"(tid_));
    const int tid = tid_, lane = tid & 63, w = F.wave;
    const int c = u & 63, h = (u >> 6) & 7, b = u >> 9;
    unsigned lbase_ = (unsigned)(uintptr_t)F.lds; asm volatile("" : "+s"(lbase_));
    LAS unsigned char* lds = (LAS unsigned char*)(uintptr_t)lbase_;
    const bf16* p = (const bf16*)(F.ws + wsm::P);
    const bf16* w2t = (const bf16*)(F.ws + wsm::WRT + 262144);
    const bf16* a2t = w2t + 512 * 64; const bf16* g2t = a2t + 512 * 64;
    unsigned char* gout = F.ws + wsm::RW + (size_t)u * UNIT_BYTES;
    float* wl_out = (float*)(F.ws + wsm::RW + WL_OFF) + (size_t)u * 64;
    const float* mu = a.in[6] + l * 1792;
    const size_t tok0 = (size_t)b * SEQ + c * 64;
    const int t = tid >> 3, j0 = (tid & 7) * 8;
    const bool hasprev = (c > 0) || (t > 0);
    const bf16* cur = p + (tok0 + t) * INC; const bf16* prv = cur - INC;
    LAS float* WPRE = (LAS float*)(lds + 0); LAS float* APRE = (LAS float*)(lds + 16384); LAS float* GG = (LAS float*)(lds + 32768);
    LAS float* PAR = (LAS float*)(lds + 134400);
    const int mtA = w >> 1;
    bf16x8 fw[2][2], fa[2][2], fg[2][4];
    if (h != hcur) {
        RW_BAR();
        if (w < 7) { const int pidx = w == 0 ? 7 : (w == 1 ? 9 : 10 + w); PAR[w * 64 + lane] = a.in[pidx][l * 512 + h * 64 + lane]; }
        if (tid < 448) { const int col = tid < 192 ? (tid >> 6) * 512 + h * 64 + (tid & 63) : 1536 + (tid - 192); PAR[448 + tid] = mu[col]; }
        hcur = h;
        RW_BAR();
    }
    float r[8], k[8], v[8];
    {
        auto mix8 = [&](int i, int mo, float* o) { float cv[8], pv[8], m8[8]; unpack8(raw.c[i], cv);
            if (hasprev) unpack8(raw.p[i], pv); else {
#pragma unroll
                for (int j = 0; j < 8; ++j) pv[j] = 0.f; }
            *(f32x4*)m8 = *(const LAS f32x4*)(PAR + 448 + mo); *(f32x4*)(m8 + 4) = *(const LAS f32x4*)(PAR + 448 + mo + 4);
#pragma unroll
            for (int j = 0; j < 8; ++j) o[j] = cv[j] + (pv[j] - cv[j]) * m8[j]; };
        float x[8];
        mix8(0, 192 + j0, x);
#pragma unroll
        for (int j = 0; j < 8; ++j) { const float e2 = __expf(2.f * x[j]); x[j] = 1.f - 2.f * __builtin_amdgcn_rcpf(e2 + 1.f); }
        *(LAS u32x4*)(lds + RW_S(0) + t * PB + j0 * 2) = pack8(x);
        mix8(1, 256 + j0, x);
        *(LAS u32x4*)(lds + RW_S(1) + t * PB + j0 * 2) = pack8(x);
        asm volatile("" ::: "memory");
        mix8(2, 320 + j0, x);
#pragma unroll
        for (int j = 0; j < 8; ++j) x[j] = sigm(x[j]);
        *(LAS u32x4*)(lds + RW_S(2) + t * PB2 + j0 * 2) = pack8(x);
        mix8(3, 384 + j0, x);
#pragma unroll
        for (int j = 0; j < 8; ++j) x[j] = sigm(x[j]);
        *(LAS u32x4*)(lds + RW_S(2) + t * PB2 + (64 + j0) * 2) = pack8(x);
        asm volatile("" ::: "memory");
#pragma unroll
        for (int q = 0; q < 2; ++q) { const int ch = h * 64 + 16 * (2 * (w & 1) + q) + (lane & 15);
#pragma unroll
            for (int s2 = 0; s2 < 2; ++s2) { const int kq = 32 * s2 + 8 * (lane >> 4); fw[q][s2] = *(const bf16x8*)(w2t + ch * 64 + kq); fa[q][s2] = *(const bf16x8*)(a2t + ch * 64 + kq); }
#pragma unroll
            for (int s2 = 0; s2 < 4; ++s2) fg[q][s2] = *(const bf16x8*)(g2t + ch * 128 + 32 * s2 + 8 * (lane >> 4)); }
        mix8(4, j0, r); mix8(5, 64 + j0, k); mix8(6, 128 + j0, v);
        r1_load(F, unext, raw, tid);
    }
    RW_BAR(); R1_STAMP(0);
    {
#pragma unroll
        for (int q = 0; q < 2; ++q) { const int nt = 2 * (w & 1) + q;
            f32x4 aw = {0.f, 0.f, 0.f, 0.f}, aa = aw, ag = aw;
#pragma unroll
            for (int s2 = 0; s2 < 2; ++s2) {
                aw = __builtin_amdgcn_mfma_f32_16x16x32_bf16(fw[q][s2], ldfrag(lds + RW_S(0), PB, 16 * mtA, lane, s2), aw, 0, 0, 0);
                aa = __builtin_amdgcn_mfma_f32_16x16x32_bf16(fa[q][s2], ldfrag(lds + RW_S(1), PB, 16 * mtA, lane, s2), aa, 0, 0, 0); }
#pragma unroll
            for (int s2 = 0; s2 < 4; ++s2) ag = __builtin_amdgcn_mfma_f32_16x16x32_bf16(fg[q][s2], ldfrag(lds + RW_S(2), PB2, 16 * mtA, lane, s2), ag, 0, 0, 0);
            const int m = 16 * mtA + (lane & 15), n0 = 16 * nt + 4 * (lane >> 4);
            const f32x4 w04 = *(const LAS f32x4*)(PAR + n0), a04 = *(const LAS f32x4*)(PAR + 64 + n0);
#pragma unroll
            for (int i = 0; i < 4; ++i) { const float nx = -(w04[i] + aw[i]); const float sp = nx > 20.f ? nx : __logf(1.f + __expf(nx)); aw[i] = -__expf(-sp - 0.5f); aa[i] = sigm(a04[i] + aa[i]); }
            *(LAS f32x4*)(WPRE + m * 64 + n0) = aw; *(LAS f32x4*)(APRE + m * 64 + n0) = aa; *(LAS f32x4*)(GG + m * 64 + n0) = ag; }
    }
    RW_BAR(); R1_STAMP(1); R1_STAMP(2);
    {
        LAS float* SEG = (LAS float*)(lds + O_SEG);
        const int ch = tid & 63, seg = tid >> 6;
        float pf[8]; float run = 0.f;
#pragma unroll
        for (int i = 0; i < 8; ++i) { run += WPRE[(8 * seg + i) * 64 + ch]; pf[i] = run; }
        SEG[seg * 64 + ch] = run;
        RW_BAR();
        float off = 0.f;
        for (int s2 = 0; s2 < seg; ++s2) off += SEG[s2 * 64 + ch];
#pragma unroll
        for (int i = 0; i < 8; ++i) WPRE[(8 * seg + i) * 64 + ch] = off + pf[i];
    }
    RW_BAR(); R1_STAMP(3);
    {
        float kk[8], k2[8], aic[8]; float ss = 0.f, bon = 0.f;
        { float pkk[8], pka[8], prk[8];
#define R1_LD8(dst, src) do { *(f32x4*)(dst) = *(const LAS f32x4*)(src); *(f32x4*)((dst) + 4) = *(const LAS f32x4*)((src) + 4); } while (0)
          R1_LD8(aic, APRE + t * 64 + j0); R1_LD8(pkk, PAR + 128 + j0); R1_LD8(pka, PAR + 192 + j0); R1_LD8(prk, PAR + 256 + j0);
#undef R1_LD8
#pragma unroll
          for (int j = 0; j < 8; ++j) { kk[j] = k[j] * pkk[j]; ss += kk[j] * kk[j]; k2[j] = k[j] * (1.f + (aic[j] - 1.f) * pka[j]); bon += r[j] * k2[j] * prk[j]; } }
        ss += __shfl_xor(ss, 1); ss += __shfl_xor(ss, 2); ss += __shfl_xor(ss, 4);
        bon += __shfl_xor(bon, 1); bon += __shfl_xor(bon, 2); bon += __shfl_xor(bon, 4);
        const float inv = 1.f / fmaxf(sqrtf(ss), 1e-12f);
        unsigned g1w[4], g0w[4];
#pragma unroll
        for (int jp = 0; jp < 8; jp += 2) {
            const f32x2 cum = *(const LAS f32x2*)(WPRE + t * 64 + j0 + jp), tot = *(const LAS f32x2*)(WPRE + 63 * 64 + j0 + jp), gg = *(const LAS f32x2*)(GG + t * 64 + j0 + jp);
            f32x2 cpv = {0.f, 0.f}; if (t > 0) cpv = *(const LAS f32x2*)(WPRE + (t - 1) * 64 + j0 + jp);
            const f32x2 pgw = *(const LAS f32x2*)(PAR + 320 + j0 + jp), pgb = *(const LAS f32x2*)(PAR + 384 + j0 + jp);
            float xa[2], xr[2], xb[2], xk[2], xbh[2], xkh[2], g1[2], g0[2];
#pragma unroll
            for (int e = 0; e < 2; ++e) { const int j = jp + e; const float kn = kk[j] * inv, bv = kn * aic[j];
                const float e_ex = __expf(cpv[e]), e_in = __expf(cum[e]), e_ng = __expf(-cum[e]), e_tt = __expf(tot[e] - cum[e]);
                xa[e] = -kn * e_ex; xr[e] = r[j] * e_in; xb[e] = bv * e_ng; xk[e] = k2[j] * e_ng; xbh[e] = bv * e_tt; xkh[e] = k2[j] * e_tt;
                g1[e] = pgw[e] * gg[e]; g0[e] = (pgb[e] + bon * v[j]) * gg[e];
                if (t == 63) wl_out[j0 + j] = __expf(tot[e]); }
            const unsigned pa = pk2(xa[0], xa[1]), pr = pk2(xr[0], xr[1]), pb = pk2(xb[0], xb[1]), pkn = pk2(xk[0], xk[1]), pv2 = pk2(v[jp], v[jp + 1]), pbh = pk2(xbh[0], xbh[1]), pkh = pk2(xkh[0], xkh[1]);
            *(LAS unsigned*)(lds + RW_S(0) + t * PB + (j0 + jp) * 2) = pa; *(LAS unsigned*)(lds + RW_S(1) + t * PB + (j0 + jp) * 2) = pr;
            *(LAS unsigned*)(lds + RW_S(2) + t * PB + (j0 + jp) * 2) = pb; *(LAS unsigned*)(lds + RW_S(3) + t * PB + (j0 + jp) * 2) = pkn;
            *(LAS bf16*)(lds + RW_S(4) + (j0 + jp) * PB + t * 2) = (bf16)(pa & 0xffffu); *(LAS bf16*)(lds + RW_S(4) + (j0 + jp + 1) * PB + t * 2) = (bf16)(pa >> 16);
            *(LAS bf16*)(lds + RW_S(5) + (j0 + jp) * PB + t * 2) = (bf16)(pv2 & 0xffffu); *(LAS bf16*)(lds + RW_S(5) + (j0 + jp + 1) * PB + t * 2) = (bf16)(pv2 >> 16);
            *(LAS bf16*)(lds + RW_S(6) + (j0 + jp) * PB + t * 2) = (bf16)(pbh & 0xffffu); *(LAS bf16*)(lds + RW_S(6) + (j0 + jp + 1) * PB + t * 2) = (bf16)(pbh >> 16);
            *(LAS bf16*)(lds + RW_S(7) + (j0 + jp) * PB + t * 2) = (bf16)(pkh & 0xffffu); *(LAS bf16*)(lds + RW_S(7) + (j0 + jp + 1) * PB + t * 2) = (bf16)(pkh >> 16);
            g1w[jp >> 1] = pk2(g1[0], g1[1]); g0w[jp >> 1] = pk2(g0[0], g0[1]);
        }
        *(u32x4*)(gout + 32768 + (t * 64 + j0) * 2) = (u32x4){g1w[0], g1w[1], g1w[2], g1w[3]};
        *(u32x4*)(gout + 40960 + (t * 64 + j0) * 2) = (u32x4){g0w[0], g0w[1], g0w[2], g0w[3]};
    }
    RW_BAR(); R1_STAMP(4);
    {
        const int mi = w >> 1;
        const LAS unsigned char* X = lds + RW_S(mi < 2 ? 0 : 1); const LAS unsigned char* Y = lds + RW_S((mi & 1) ? 3 : 2);
        LAS unsigned char* dst = lds + (mi == 0 ? O_P0 : mi == 1 ? O_AAK : mi == 2 ? O_ARB : O_ARK);
        const bool incl = mi >= 2;
#pragma unroll
        for (int q = 0; q < 2; ++q) { const int mt = 2 * (w & 1) + q; const int m = 16 * mt + (lane & 15);
#pragma unroll
            for (int nt = 0; nt < 4; ++nt) { f32x4 acc = {0.f, 0.f, 0.f, 0.f};
                if (nt <= mt) acc = tile_mm<2>(acc, X, PB, 16 * mt, Y, PB, 16 * nt, lane);
                const int n0 = 16 * nt + 4 * (lane >> 4);
#pragma unroll
                for (int i = 0; i < 4; ++i) { const int n = n0 + i; if (!(incl ? n <= m : n < m)) acc[i] = 0.f; }
                st_rm(dst, PB, m, n0, acc);
                if (mi == 0) st_tr(lds + O_P0T, PB, m, n0, acc); } }
    }
    RW_BAR(); R1_STAMP(5);
    {
        f32x4 T[4];
        const int wr = w & 3, m = 16 * wr + (lane & 15);
        LAS unsigned char* Trm = lds + RW_S(8);
        if (w < 4) {
#pragma unroll
            for (int nt = 0; nt < 4; ++nt) { const int n0 = 16 * nt + 4 * (lane >> 4); T[nt] = ld_rm(lds + O_P0, PB, m, n0);
#pragma unroll
                for (int i = 0; i < 4; ++i) if (n0 + i == m) T[nt][i] += 1.f;
                st_rm(Trm, PB, m, n0, T[nt]); }
#pragma unroll
            for (int nt = 0; nt < 4; ++nt) { f32x4 acc = {0.f, 0.f, 0.f, 0.f}; acc = tile_mm<2>(acc, lds + RW_S(5), PB, 16 * wr, lds + O_AAK, PB, 16 * nt, lane); st_rm(lds + RW_S(0), PB, m, 16 * nt + 4 * (lane >> 4), acc); }
        } else {
#pragma unroll
            for (int nt = 0; nt < 4; ++nt) { f32x4 acc = {0.f, 0.f, 0.f, 0.f}; acc = tile_mm<2>(acc, lds + O_P0, PB, 16 * wr, lds + O_P0T, PB, 16 * nt, lane);
                const int n0 = 16 * nt + 4 * (lane >> 4); st_rm(lds + RW_S(2), PB, m, n0, acc); st_tr(lds + RW_S(3), PB, m, n0, acc); }
        }
        RW_BAR();
#pragma unroll 1
        for (int s = 1; s <= 5; ++s) {
            const int cb = s & 1;
            const LAS unsigned char* Pc = lds + (cb ? RW_S(2) : O_P0); const LAS unsigned char* PcT = lds + (cb ? RW_S(3) : O_P0T);
            LAS unsigned char* Pn = lds + (cb ? O_P0 : RW_S(2)); LAS unsigned char* PnT = lds + (cb ? O_P0T : RW_S(3));
            if (w < 4) {
                f32x4 d[4];
#pragma unroll
                for (int nt = 0; nt < 4; ++nt) { d[nt] = (f32x4){0.f, 0.f, 0.f, 0.f}; d[nt] = tile_mm<2>(d[nt], Trm, PB, 16 * wr, PcT, PB, 16 * nt, lane); }
                LDS_WAIT();
#pragma unroll
                for (int nt = 0; nt < 4; ++nt) { T[nt] += d[nt]; st_rm(Trm, PB, m, 16 * nt + 4 * (lane >> 4), T[nt]); }
            } else if (s < 5) {
#pragma unroll
                for (int nt = 0; nt < 4; ++nt) { f32x4 acc = {0.f, 0.f, 0.f, 0.f}; acc = tile_mm<2>(acc, Pc, PB, 16 * wr, PcT, PB, 16 * nt, lane);
                    const int n0 = 16 * nt + 4 * (lane >> 4); st_rm(Pn, PB, m, n0, acc); st_tr(PnT, PB, m, n0, acc); }
            }
            RW_BAR();
        }
    }
    R1_STAMP(6);
    {
        const LAS unsigned char* Z = lds + (w < 4 ? RW_S(4) : RW_S(0)); const int zr0 = 16 * (w & 3);
        f32x4 acc[4];
#pragma unroll
        for (int nt = 0; nt < 4; ++nt) { acc[nt] = (f32x4){0.f, 0.f, 0.f, 0.f}; acc[nt] = tile_mm<2>(acc[nt], Z, PB, zr0, lds + RW_S(8), PB, 16 * nt, lane); }
#pragma unroll
        for (int nt = 0; nt < 4; ++nt) st_rm(lds + RW_S(2), PB, 16 * w + (lane & 15), 16 * nt + 4 * (lane >> 4), acc[nt]);
    }
    RW_BAR(); R1_STAMP(7);
    {
        const int job = w >> 1;
        const LAS unsigned char* XTt = lds + RW_S(2); const LAS unsigned char* XTb = lds + RW_S(2) + 64 * PB;
#pragma unroll
        for (int q = 0; q < 2; ++q) { const int mt = 2 * (w & 1) + q; const int m = 16 * mt + (lane & 15);
#pragma unroll
            for (int nt = 0; nt < 4; ++nt) { f32x4 acc = {0.f, 0.f, 0.f, 0.f}; const int n0 = 16 * nt + 4 * (lane >> 4);
                if (job == 0) { acc = ld_rm(lds + RW_S(1), PB, m, n0); acc = tile_mm<2>(acc, lds + O_ARB, PB, 16 * mt, XTt, PB, 16 * nt, lane); }
                else if (job == 1) { acc = tile_mm<2>(acc, lds + O_ARB, PB, 16 * mt, XTb, PB, 16 * nt, lane); acc = tile_mm<2>(acc, lds + O_ARK, PB, 16 * mt, lds + RW_S(5), PB, 16 * nt, lane); }
                else if (job == 2) { acc = tile_mm<2>(acc, lds + RW_S(6), PB, 16 * mt, XTt, PB, 16 * nt, lane); }
                else { acc = tile_mm<2>(acc, XTb, PB, 16 * mt, lds + RW_S(6), PB, 16 * nt, lane); acc = tile_mm<2>(acc, lds + RW_S(5), PB, 16 * mt, lds + RW_S(7), PB, 16 * nt, lane); }
                u32x2 o; o.x = pk2(acc[0], acc[1]); o.y = pk2(acc[2], acc[3]);
                *(u32x2*)(gout + job * 8192 + (m * 64 + n0) * 2) = o; } }
    }
    RW_BAR(); R1_STAMP(8);
}

__device__ __forceinline__ void r2_unit(Frame& F, const Args& a, const int l, const int bh) {
    using namespace cfg;
    const int lane = F.lane, w = F.wave, wr = w & 3;
    LAS unsigned char* lds = F.lds;
    bf16* y = (bf16*)(F.ws + wsm::Y);
    const unsigned char* gin = F.ws + wsm::RW + (size_t)bh * 64 * UNIT_BYTES;
    const float* wlp = (const float*)(F.ws + wsm::RW + WL_OFF) + (size_t)bh * 64 * 64;
    const int b = bh >> 3, h = bh & 7;
    const int m = 16 * wr + (lane & 15), q4 = 4 * (lane >> 4);
    if (w < 4) {
        f32x4 S[4];
#pragma unroll
        for (int nt = 0; nt < 4; ++nt) { S[nt] = (f32x4){0.f, 0.f, 0.f, 0.f}; st_rm(lds, PB, m, 16 * nt + q4, S[nt]); }
        bf16x8 mtf[4][2], mtn[4][2]; u32x2 cf[4], cfn[4]; f32x4 wl[4], wln[4];
#define R2_LDS(c_, M_, C_, W_) do { const unsigned char* g_ = gin + (size_t)(c_) * UNIT_BYTES; _Pragma("unroll") for (int nt = 0; nt < 4; ++nt) { \
            _Pragma("unroll") for (int s_ = 0; s_ < 2; ++s_) M_[nt][s_] = *(const bf16x8*)(g_ + 16384 + ((16 * nt + (lane & 15)) * 64 + 32 * s_ + 8 * (lane >> 4)) * 2); \
            C_[nt] = *(const u32x2*)(g_ + 24576 + (m * 64 + 16 * nt + q4) * 2); W_[nt] = *(const f32x4*)(wlp + (c_) * 64 + 16 * nt + q4); } } while (0)
        R2_LDS(0, mtf, cf, wl);
#pragma unroll 1
        for (int c = 0; c < 64; ++c) {
            LAS unsigned char* Scur = lds + (c & 1) * SLOT; LAS unsigned char* Snxt = lds + ((c + 1) & 1) * SLOT;
            const int cn = c < 63 ? c + 1 : 63;
            R2_LDS(cn, mtn, cfn, wln);
            RW_BAR();
            bf16x8 sf[2];
#pragma unroll
            for (int s = 0; s < 2; ++s) sf[s] = ldfrag(Scur, PB, 16 * wr, lane, s);
#pragma unroll
            for (int nt = 0; nt < 4; ++nt) {
                f32x4 acc = S[nt] * wl[nt];
                acc[0] += __uint_as_float(cf[nt].x << 16); acc[1] += __uint_as_float(cf[nt].x & 0xffff0000u); acc[2] += __uint_as_float(cf[nt].y << 16); acc[3] += __uint_as_float(cf[nt].y & 0xffff0000u);
#pragma unroll
                for (int s = 0; s < 2; ++s) acc = __builtin_amdgcn_mfma_f32_16x16x32_bf16(mtf[nt][s], sf[s], acc, 0, 0, 0);
                S[nt] = acc; st_rm(Snxt, PB, m, 16 * nt + q4, acc); }
#pragma unroll
            for (int nt = 0; nt < 4; ++nt) { mtf[nt][0] = mtn[nt][0]; mtf[nt][1] = mtn[nt][1]; cf[nt] = cfn[nt]; wl[nt] = wln[nt]; }
        }
#undef R2_LDS
    } else {
        bf16x8 rf[2], rfn[2]; u32x2 y0[4], g1[4], g0[4], y0n[4], g1n[4], g0n[4];
#define R2_LDY(c_, R_, Y_, G1_, G0_) do { const unsigned char* g_ = gin + (size_t)(c_) * UNIT_BYTES; \
            _Pragma("unroll") for (int s_ = 0; s_ < 2; ++s_) R_[s_] = *(const bf16x8*)(g_ + (m * 64 + 32 * s_ + 8 * (lane >> 4)) * 2); \
            _Pragma("unroll") for (int nt = 0; nt < 4; ++nt) { const int o_ = (m * 64 + 16 * nt + q4) * 2; Y_[nt] = *(const u32x2*)(g_ + 8192 + o_); G1_[nt] = *(const u32x2*)(g_ + 32768 + o_); G0_[nt] = *(const u32x2*)(g_ + 40960 + o_); } } while (0)
        R2_LDY(0, rf, y0, g1, g0);
#pragma unroll 1
        for (int c = 0; c < 64; ++c) {
            LAS unsigned char* Scur = lds + (c & 1) * SLOT;
            const int cn = c < 63 ? c + 1 : 63;
            R2_LDY(cn, rfn, y0n, g1n, g0n);
            RW_BAR();
            f32x4 Y[4]; float sum = 0.f;
#pragma unroll
            for (int nt = 0; nt < 4; ++nt) {
                f32x4 acc = {__uint_as_float(y0[nt].x << 16), __uint_as_float(y0[nt].x & 0xffff0000u), __uint_as_float(y0[nt].y << 16), __uint_as_float(y0[nt].y & 0xffff0000u)};
#pragma unroll
                for (int s = 0; s < 2; ++s) acc = __builtin_amdgcn_mfma_f32_16x16x32_bf16(ldfrag(Scur, PB, 16 * nt, lane, s), rf[s], acc, 0, 0, 0);
                Y[nt] = acc; sum += (acc[0] + acc[1]) + (acc[2] + acc[3]); }
            sum += __shfl_xor(sum, 16); sum += __shfl_xor(sum, 32);
            const float mean = sum * (1.f / 64.f); float var = 0.f;
#pragma unroll
            for (int nt = 0; nt < 4; ++nt)
#pragma unroll
                for (int i = 0; i < 4; ++i) { const float d = Y[nt][i] - mean; var += d * d; }
            var += __shfl_xor(var, 16); var += __shfl_xor(var, 32);
            const float rs = rsqrtf(var * (1.f / 64.f) + 64e-5f);
            bf16* yo = y + ((size_t)b * SEQ + c * 64 + m) * D + h * 64;
#pragma unroll
            for (int nt = 0; nt < 4; ++nt) {
                const f32x4 a1 = {__uint_as_float(g1[nt].x << 16), __uint_as_float(g1[nt].x & 0xffff0000u), __uint_as_float(g1[nt].y << 16), __uint_as_float(g1[nt].y & 0xffff0000u)};
                const f32x4 a0 = {__uint_as_float(g0[nt].x << 16), __uint_as_float(g0[nt].x & 0xffff0000u), __uint_as_float(g0[nt].y << 16), __uint_as_float(g0[nt].y & 0xffff0000u)};
                const f32x4 o = (Y[nt] - mean) * rs * a1 + a0;
                if (F8OUT(l)) *(unsigned*)((unsigned char*)y + ((size_t)b * SEQ + c * 64 + m) * D + h * 64 + 16 * nt + q4) = pk4_fp8(o[0] * F8_Y, o[1] * F8_Y, o[2] * F8_Y, o[3] * F8_Y);
                else { u32x2 ow; ow.x = pk2(o[0], o[1]); ow.y = pk2(o[2], o[3]); *(u32x2*)(yo + 16 * nt + q4) = ow; } }
            rf[0] = rfn[0]; rf[1] = rfn[1];
#pragma unroll
            for (int nt = 0; nt < 4; ++nt) { y0[nt] = y0n[nt]; g1[nt] = g1n[nt]; g0[nt] = g0n[nt]; }
        }
#undef R2_LDY
    }
    RW_BAR();
}
}
struct MoeOrder {
    const LAS int* pref; int G, c, npn, mode;
    const char* A; const char* B; const int* lists; const float* wl; int esz;
    __device__ __forceinline__ bool next(int i, pg8::Unit& u) const {
        const int total = __builtin_amdgcn_readfirstlane(pref[32]) * npn;
        const long L = (long)i * G + c; if (L >= total) return false;
        int wgid = (int)L; { const int q = total / 8, r = total % 8, xcd = wgid % 8, off = wgid / 8; wgid = (xcd < r ? xcd * (q + 1) : r * (q + 1) + (xcd - r) * q) + off; }
        const int panel = wgid / npn, pn = wgid % npn;
        int e = 0;
        for (int k = 1; k < 32; ++k) { const int pk = __builtin_amdgcn_readfirstlane(pref[k]); if (pk <= panel) e = k; }
        const int tl = panel - __builtin_amdgcn_readfirstlane(pref[e]);
        u.pm = panel; u.pn = pn;
        if (mode == 0) { u.a = A; u.b = B + ((size_t)e * 512 + (size_t)pn * 256) * 2048 * esz; u.rows = lists + e * LCAP + tl * 256; const int rem = __builtin_amdgcn_readfirstlane(pref[40 + e]) - tl * 256; u.nvalid = rem < 256 ? rem : 256; u.wrow = wl + e * LCAP + tl * 256; }
        else { u.a = A + (size_t)panel * 256 * 256 * esz; u.b = B + ((size_t)e * 2048 + (size_t)pn * 256) * 256 * esz; u.rows = nullptr; u.nvalid = 256; u.wrow = nullptr; }
        return true;
    }
};

#define IN(k) (lo <= (k) && (k) < hi)
#define SEAM(k) do { if (IN(k) && IN((k) + 1)) xcd_barrier(bar); } while (0)
#ifndef DUP_PHASE
#define DUP_PHASE -1
#endif
template <int l> __device__ __forceinline__ void ph_n1(Frame& F, const Args& args) {
    using namespace cfg; float* xo = args.out; const float* xin = (l == 0) ? args.in[0] : xo;
    convert_phase(F, args, l);
    if (l == 0) norm_phase<false, false, false, F8IN(l)>(F, args, xin, nullptr, args.in[3] + l * D, l, l);
    else { build_pref(F, l - 1); norm_phase<true, false, false, F8IN(l), true>(F, args, xin, xo, args.in[3] + l * D, l, l); }
}
template <int l> __device__ __forceinline__ void ph_g1(Frame& F, const Args& args) {
    using namespace cfg;
    constexpr int ESZ = F8IN(l) ? 1 : 2;
    pg8::StaticOrder S; S.init(F.ws + wsm::XN, F.ws + wsm::W_IN, M, INC, D, F.G, (int)blockIdx.x, ESZ);
    pg8::EpiBf16 E{(bf16*)(F.ws + wsm::P), INC, ESZ == 1 ? pg8::F8_INV : 1.f};
    pg8::gemm_phase<pg8::EpiBf16, pg8::StaticOrder, false, ESZ>(F.lds, D, S, E);
}
template <int l> __device__ __forceinline__ void ph_m1(Frame& F, const Args& args, unsigned long long& racc) {
    { int hcur = -1; rw::R1Raw raw;
      auto unit_of = [&](int i) { return (F.G == 256) ? ((F.vcu >> 2) << 6) + ((F.vcu & 3) << 4) + i : F.vcu + i * F.G; };
      if (unit_of(0) < 4096) rw::r1_load(F, unit_of(0), raw, F.tid);
      for (int i = 0; unit_of(i) < 4096 && i * F.G < 4096; ++i) { const int u = unit_of(i); const int un = ((i + 1) * F.G < 4096 && unit_of(i + 1) < 4096) ? unit_of(i + 1) : u; rw::r1_unit(F, args, l, u, un, raw, racc, hcur); } }

    for (int u = F.vcu; u < 1024; u += F.G) { const int b = u >> 7, hh = (u >> 4) & 7, qb = ((u & 15) + (u >> 8) * 4) & 15; att::attn_unit<0>(F, args, l, b, hh, qb); }
    if (DUP_PHASE == 21 + 100 * l) { for (int u = F.vcu; u < 1024; u += F.G) { const int b = u >> 7, hh = (u >> 4) & 7, qb = ((u & 15) + (u >> 8) * 4) & 15; att::attn_unit<0>(F, args, l, b, hh, qb); } }
    att::conv_items(F, args, l, F.vcu * 512 + F.tid, F.G * 512);
    if (DUP_PHASE == 22 + 100 * l) att::conv_items(F, args, l, F.vcu * 512 + F.tid, F.G * 512);
}
template <int l> __device__ __forceinline__ void ph_m2(Frame& F, const Args& args) {
    for (;;) { const int it = grab(F, l); if (it >= 64 + 512) break;
        if (it < 64) rw::r2_unit(F, args, l, it);
        else { const int j = it - 64, qb = 15 - (j >> 5), b = (j & 31) >> 2, hh = j & 3; att::attn_unit<1>(F, args, l, b, hh, qb); } }
    if (DUP_PHASE == 8 * l + 3) { __syncthreads();
    for (;;) { const int it = grab(F, l + 2); if (it >= 64 + 512) break;
        if (it < 64) rw::r2_unit(F, args, l, it);
        else { const int j = it - 64, qb = 15 - (j >> 5), b = (j & 31) >> 2, hh = j & 3; att::attn_unit<1>(F, args, l, b, hh, qb); } } }
    if (DUP_PHASE == 30 + 100 * l) { if (F.vcu < 64) rw::r2_unit(F, args, l, F.vcu); }
    if (DUP_PHASE == 31 + 100 * l) { for (int u = F.vcu; u < 512; u += F.G) { const int b = u >> 6, hh = (u >> 4) & 3, qb = (u < 256) ? (u & 15) : 15 - (u & 15); att::attn_unit<1>(F, args, l, b, hh, qb); } }
}
template <int l> __device__ __forceinline__ void ph_g2(Frame& F, const Args& args) {
    using namespace cfg;
    constexpr int ESZ = F8OUT(l) ? 1 : 2;
    pg8::StaticOrder S; S.init(F.ws + wsm::Y, F.ws + wsm::W_OUT, M, D, D, F.G, (int)blockIdx.x, ESZ);
    const void* xin = (l == 0) ? (const void*)args.in[0] : (const void*)args.out;
    bf16* xo = (l == 0) ? (bf16*)args.out : (bf16*)(F.ws + wsm::XB2);
    pg8::EpiRes<l != 0> E{xin, xo, D, ESZ == 1 ? 1.f / (F8_Y * pg8::F8_WGT) : 1.f};
    pg8::gemm_phase<pg8::EpiRes<l != 0>, pg8::StaticOrder, false, ESZ>(F.lds, D, S, E);
}
template <int l> __device__ __forceinline__ void ph_n2(Frame& F, const Args& args) { using namespace cfg;
    const float* xs = (l == 0) ? (const float*)args.out : (const float*)(F.ws + wsm::XB2);
    norm_phase<false, true, false, ((F8_MOE_MASK >> l) & 1) != 0, true>(F, args, xs, nullptr, args.in[4] + l * D, l, l); }
template <int l> __device__ __forceinline__ void ph_e1(Frame& F, const Args& args) {
    using namespace cfg;
    build_pref(F, l);
    constexpr int ESZ = ((F8_MOE_MASK >> l) & 1) ? 1 : 2;
    MoeOrder S{(const LAS int*)(F.lds + TAB_OFF), F.G, (int)blockIdx.x, 2, 0, (const char*)(F.ws + wsm::XN), (const char*)(F.ws + wsm::W_GU), (const int*)(F.ws + wsm::LISTS), (const float*)(F.ws + wsm::WLIST), ESZ};
    pg8::EpiSilu E{(bf16*)(F.ws + wsm::HB), ESZ == 1 ? pg8::F8_INV : 1.f, F8_DOWN ? F8_H : 0.f};
    pg8::gemm_phase<pg8::EpiSilu, MoeOrder, true, ESZ>(F.lds, D, S, E);
}
template <int l> __device__ __forceinline__ void ph_e2(Frame& F, const Args& args) {
    using namespace cfg;
    build_pref(F, l);
    constexpr int ESZ = F8_DOWN ? 1 : 2;
    MoeOrder S{(const LAS int*)(F.lds + TAB_OFF), F.G, (int)blockIdx.x, 8, 1, (const char*)(F.ws + wsm::HB), (const char*)(F.ws + wsm::W_D), nullptr, nullptr, ESZ};
    pg8::EpiF8 E{F.ws + wsm::OB, D, F8_DOWN ? F8_OB / (F8_H * pg8::F8_WGT) : F8_OB};
    pg8::gemm_phase<pg8::EpiF8, MoeOrder, false, ESZ>(F.lds, EH, S, E);
}
#ifndef PROBE_T
#define PROBE_T -1
#endif
#define RUNPH(k, call) do { if (PROBE_T == (k)) pt0 = __builtin_amdgcn_s_memrealtime(); RUNPH_(k, call); if (PROBE_T == (k)) pt1 = __builtin_amdgcn_s_memrealtime(); } while (0)
#define RUNPH_(k, call) do { if (IN(k)) { call; if (DUP_PHASE == (k) && ((k) & 7) != 3 && ((k) & 7) != 5) { __syncthreads(); call; } } SEAM(k); } while (0)
template <int l>
__device__ __forceinline__ void layer_phases(Frame& F, const Args& args, const XcdBarrier& bar, const int lo, const int hi, unsigned long long& pt0, unsigned long long& pt1) {
    constexpr int pb = 8 * l;
    RUNPH(pb + 0, ph_n1<l>(F, args));
    RUNPH(pb + 1, ph_g1<l>(F, args));
    { unsigned long long racc = 0; RUNPH(pb + 2, ph_m1<l>(F, args, racc)); if (PROBE_R1 >= 0 && l == 0) { pt0 = 0; pt1 = racc; } }
    RUNPH(pb + 3, ph_m2<l>(F, args));
    RUNPH(pb + 4, ph_g2<l>(F, args));
    RUNPH(pb + 5, ph_n2<l>(F, args));
    RUNPH(pb + 6, ph_e1<l>(F, args));
    RUNPH(pb + 7, ph_e2<l>(F, args));
}
__global__ void __launch_bounds__(512, 2) mk_fwd(Args args) {
    extern __shared__ __attribute__((aligned(16))) unsigned char lds_raw[];
    using namespace cfg;
    Frame F;
    F.lds = (LAS unsigned char*)lds_raw; F.ws = args.ws; F.ctl = (unsigned*)(args.ws + wsm::CTL);
    F.tid = threadIdx.x; F.lane = F.tid & 63; F.wave = __builtin_amdgcn_readfirstlane(F.tid >> 6);
    F.pacc = 0ull;
    F.G = gridDim.x; { const int bx = blockIdx.x; F.vcu = (F.G % 8 == 0) ? (bx % 8) * (F.G / 8) + bx / 8 : bx; }
    volatile LAS unsigned* MISC = (volatile LAS unsigned*)(F.lds + MISC_OFF);
    for (int u = F.tid; u < (LDS_BYTES - RING_BYTES) / 4; u += 512) ((LAS unsigned*)(F.lds + RING_BYTES))[u] = 0u;
    __syncthreads();
    const int lo = args.ph_lo, hi = args.ph_hi;
    XcdBarrier bar; bar.bar = F.ctl + wsm::CW_BAR; bar.x = 0; bar.st = nullptr;
    if (hi - lo > 1) bar = xcd_barrier_post(F.ctl + wsm::CW_BAR, MISC + 8);
    float* xo = args.out;
    unsigned long long pt0 = 0, pt1 = 0;
    layer_phases<0>(F, args, bar, lo, hi, pt0, pt1);
    layer_phases<1>(F, args, bar, lo, hi, pt0, pt1);
    if (PROBE_T == 16) pt0 = __builtin_amdgcn_s_memrealtime();
    if (IN(16)) {
        build_pref(F, NL - 1); norm_phase<true, false, true, false, true>(F, args, (const float*)(F.ws + wsm::XB2), xo, args.in[5], 0, 0);
    }
    if (PROBE_T == 16) pt1 = __builtin_amdgcn_s_memrealtime();
    if (PROBE_ATT >= 0 && blockIdx.x == 0 && F.tid == 448) { const unsigned long long te = __builtin_amdgcn_s_memrealtime(); while (__builtin_amdgcn_s_memrealtime() - te < 4ull * F.pacc) __builtin_amdgcn_s_sleep(8); }
    if ((PROBE_T >= 0 || PROBE_R1 >= 0) && blockIdx.x == 0 && F.tid == 0) { const unsigned long long te = __builtin_amdgcn_s_memrealtime(); while (__builtin_amdgcn_s_memrealtime() - te < 4ull * (pt1 - pt0)) __builtin_amdgcn_s_sleep(8); }
#undef IN
#undef SEAM
}
extern "C" void kernel_launch(void* const* d_in, const int* in_sizes, int n_in, void* d_out, int out_size, void* d_ws, size_t ws_size, hipStream_t stream) {
    using namespace cfg;
    static int grid = 0;
    if (grid == 0) {
        if (n_in != 32 || ws_size < wsm::END || out_size != M * D) { fprintf(stderr, "kernel_launch: bad args n_in=%d ws=%zu out=%d\n", n_in, ws_size, out_size); grid = -1; return; }
        int dev = 0, cus = 0;
        if (hipGetDevice(&dev) != hipSuccess || hipDeviceGetAttribute(&cus, hipDeviceAttributeMultiprocessorCount, dev) != hipSuccess) { grid = -1; return; }
        if (hipFuncSetAttribute((const void*)mk_fwd, hipFuncAttributeMaxDynamicSharedMemorySize, LDS_BYTES) != hipSuccess) { fprintf(stderr, "hipFuncSetAttribute failed\n"); grid = -1; return; }
        int per_cu = 0;
        if (hipOccupancyMaxActiveBlocksPerMultiprocessor(&per_cu, (const void*)mk_fwd, 512, LDS_BYTES) != hipSuccess || per_cu < 1) fprintf(stderr, "kernel_launch: occupancy query says %d\n", per_cu);
        (void)hipGetLastError();
        grid = cus;
    }
    if (grid < 0) return;
    unsigned char* w = (unsigned char*)d_ws;
    if (hipMemsetAsync(w + wsm::CTL, 0, wsm::CTL_ZERO_BYTES, stream) != hipSuccess) return;
    Args a{};
    for (int i = 0; i < 32; ++i) a.in[i] = (const float*)d_in[i];
    a.out = (float*)d_out; a.ws = w; a.flags = 7; a.ph_lo = 0; a.ph_hi = 17;
    hipLaunchKernelGGL(mk_fwd, dim3(grid), dim3(512), LDS_BYTES, stream, a);
}
```

```cpp
#define DUP_PHASE -1
#include <hip/hip_runtime.h>
#include <cstdint>
#include <cstdio>
#include <cmath>

typedef unsigned short bf16;
__host__ __device__ __forceinline__ unsigned f2bf(float f) { unsigned u = __builtin_bit_cast(unsigned, f); return (u + 0x7fffu + ((u >> 16) & 1u)) >> 16; }
__host__ __device__ __forceinline__ float bf2f(bf16 b) { return __builtin_bit_cast(float, ((unsigned)b) << 16); }

namespace cfg {
constexpr int D = 2048, BATCH = 8, SEQ = 4096, M = BATCH * SEQ, NL = 2;
constexpr int INC = 6400;
constexpr int OFF_BQ = 1792, OFF_BK = 2304, OFF_BV = 2816, OFF_CQ = 3328, OFF_CK = 3840, OFF_CV = 4352, OFF_D = 4864;
constexpr int NEXP = 32, EH = 256;
}
#define GAS __attribute__((address_space(1)))
#define LAS __attribute__((address_space(3)))
typedef float f32x4 __attribute__((ext_vector_type(4)));
typedef float f32x2 __attribute__((ext_vector_type(2)));
typedef short bf16x8 __attribute__((ext_vector_type(8)));
typedef unsigned u32x4 __attribute__((ext_vector_type(4)));
typedef unsigned u32x2 __attribute__((ext_vector_type(2)));
#define RLX_AGENT __ATOMIC_RELAXED, __HIP_MEMORY_SCOPE_AGENT
#define LDS_WAIT() asm volatile("s_waitcnt lgkmcnt(0)" ::: "memory")
#define VM_WAIT() asm volatile("s_waitcnt vmcnt(0)" ::: "memory")

namespace wsm {
constexpr size_t MiB = 1u << 20;
constexpr size_t CTL = 0, CTL_ZERO_BYTES = 1 * MiB;
constexpr size_t LISTS = 2 * MiB;
constexpr size_t WLIST = 6 * MiB;
constexpr size_t TOKINFO = 10 * MiB;
constexpr size_t ROUTE = 11 * MiB;
constexpr size_t WRT = 12 * MiB;
constexpr size_t W_IN = 16 * MiB;
constexpr size_t W_OUT = 41 * MiB;
constexpr size_t W_GU = 49 * MiB;
constexpr size_t W_D = 113 * MiB;
constexpr size_t XN = 146 * MiB;
constexpr size_t LORA = XN + 64 * MiB;
constexpr size_t P = 274 * MiB;
constexpr size_t HB = P;
constexpr size_t OB = P + 40 * MiB;
constexpr size_t XB2 = P + 200 * MiB;
constexpr size_t Y = 674 * MiB;
constexpr size_t RW = 802 * MiB;
constexpr size_t END = 1010 * MiB;
constexpr int CW_BAR = 4096;
constexpr int CW_CNT = 16384;
constexpr int CW_Q = 32768;
}
constexpr int LCAP = 32768;
constexpr int RING_BYTES = 139264;
constexpr int MISC_OFF = RING_BYTES + 320;
constexpr int TAB_OFF = RING_BYTES + 1024;
constexpr int LDS_BYTES = 147456;
constexpr float C2F = 0.125f * 1.4426950408889634f;
constexpr float LOG2E = 1.4426950408889634f;

typedef __bf16 bf16x2_hw __attribute__((ext_vector_type(2)));
__device__ __forceinline__ unsigned pk2(float lo, float hi) { const f32x2 v = {lo, hi}; const bf16x2_hw b = __builtin_convertvector(v, bf16x2_hw); return __builtin_bit_cast(unsigned, b); }
__device__ __forceinline__ bf16 cvt1(float x) { return (bf16)(pk2(x, x) & 0xffffu); }
__device__ __forceinline__ float f8clamp(float x) { return __builtin_amdgcn_fmed3f(x, -448.f, 448.f); }
__device__ __forceinline__ unsigned pk2_fp8(float a, float b) { int w = 0; w = __builtin_amdgcn_cvt_pk_fp8_f32(f8clamp(a), f8clamp(b), w, false); return (unsigned)w & 0xffffu; }
__device__ __forceinline__ unsigned pk4_fp8(float a, float b, float c, float d) { int w = 0; w = __builtin_amdgcn_cvt_pk_fp8_f32(f8clamp(a), f8clamp(b), w, false); w = __builtin_amdgcn_cvt_pk_fp8_f32(f8clamp(c), f8clamp(d), w, true); return (unsigned)w; }
constexpr int F8_IN_MASK = 2, F8_OUT_MASK = 2;
#define F8IN(l) (((F8_IN_MASK >> (l)) & 1) != 0)
#define F8OUT(l) (((F8_OUT_MASK >> (l)) & 1) != 0)
constexpr float F8_Y = 16.f, F8_OB = 8.f, F8_H = 8.f;
constexpr bool F8_DOWN = true;
constexpr int F8_MOE_MASK = 3;
__device__ __forceinline__ float wave_sum(float v) {
#pragma unroll
    for (int o = 1; o < 64; o <<= 1) v += __shfl_xor(v, o);
    return v;
}

struct Args {
    const float* in[32]; float* out; unsigned char* ws;
    int ph_lo, ph_hi, flags, pad;
};
#define XB_TMO      128
#define XB_XCNT(j)  (256  + 64 * (j))
#define XB_XSUB(j)  (1280 + 64 * (j))
#define XB_XGEN(j)  (2304 + 64 * (j))
#define XB_TOP      3328
#define XB_TOPGEN   3392
#define XCD_BAR_WORDS 3456
#define XB_SPIN_CAP (1u << 22)

__device__ __forceinline__ unsigned xb_ld(unsigned* p)              { return __hip_atomic_load(p, __ATOMIC_RELAXED, __HIP_MEMORY_SCOPE_AGENT); }
__device__ __forceinline__ unsigned xb_add(unsigned* p, unsigned v) { return __hip_atomic_fetch_add(p, v, __ATOMIC_RELAXED, __HIP_MEMORY_SCOPE_AGENT); }
__device__ __forceinline__ unsigned xb_xcc_id() { return (unsigned)__builtin_amdgcn_s_getreg((3 << 11) | 20) & 0xFu; }
#define XB_SPIN(cond, bar) do { unsigned _sp = 0; while (cond) { __builtin_amdgcn_s_sleep(1); \
    if ((++_sp & 255u) == 0u) { if (xb_ld(&(bar)[XB_TMO])) break; if (_sp > XB_SPIN_CAP) { atomicAdd(&(bar)[XB_TMO], 1u); break; } } } } while (0)

struct XcdBarrier {
    unsigned* bar; unsigned x;
    volatile LAS unsigned* st;
};

__device__ __forceinline__ XcdBarrier xcd_barrier_post(unsigned* bar, volatile LAS unsigned* st) {
    XcdBarrier b; b.bar = bar; b.x = xb_xcc_id(); b.st = st;
    if (threadIdx.x == 0) (void)xb_add(&bar[XB_XCNT(b.x)], 1u);
    return b;
}
__device__ __forceinline__ void xcd_barrier_complete(unsigned* bar, unsigned x, unsigned& nloc, unsigned& nx) {
    const unsigned G = gridDim.x * gridDim.y * gridDim.z;
    unsigned sum, cnt, mine, sp = 0u;
    for (;;) {
        sum = 0u; cnt = 0u; mine = 0u;
#pragma unroll
        for (unsigned j = 0; j < 16; ++j) { const unsigned c = xb_ld(&bar[XB_XCNT(j)]); sum += c; cnt += (c > 0u) ? 1u : 0u; mine = (j == x) ? c : mine; }
        if (sum == G) break;
        __builtin_amdgcn_s_sleep(1);
        if ((++sp & 255u) == 0u) { if (xb_ld(&bar[XB_TMO])) break; if (sp > XB_SPIN_CAP) { atomicAdd(&bar[XB_TMO], 1u); break; } }
    }
    nloc = mine > 0u ? mine : 1u; nx = cnt > 0u ? cnt : 1u;
}

__device__ __forceinline__ void xcd_barrier(const XcdBarrier& b) {
    asm volatile("s_waitcnt vmcnt(0)" ::: "memory");
    __syncthreads();
    if (threadIdx.x == 0) {
        unsigned* bar = b.bar;
        __builtin_amdgcn_s_waitcnt(0);
        unsigned nloc = b.st[0], nx = b.st[1];
        if (nloc == 0u) { xcd_barrier_complete(bar, b.x, nloc, nx); b.st[0] = nloc; b.st[1] = nx; }
        const unsigned old = xb_add(&bar[XB_XSUB(b.x)], 1u);
        const unsigned gen = old / nloc;
        if (old + 1u == (gen + 1u) * nloc) {
            __builtin_amdgcn_fence(__ATOMIC_RELEASE, "agent");
            asm volatile("s_waitcnt vmcnt(0)" ::: "memory");
            const unsigned og = xb_add(&bar[XB_TOP], 1u);
            const unsigned tg = og / nx;
            if (og + 1u == (tg + 1u) * nx) xb_add(&bar[XB_TOPGEN], 1u);
            else XB_SPIN(xb_ld(&bar[XB_TOPGEN]) == tg, bar);
            __builtin_amdgcn_fence(__ATOMIC_ACQUIRE, "agent");
            xb_add(&bar[XB_XGEN(b.x)], 1u);
            asm volatile("s_waitcnt vmcnt(0)" ::: "memory");
        } else {
            XB_SPIN(xb_ld(&bar[XB_XGEN(b.x)]) == gen, bar);
            __builtin_amdgcn_fence(__ATOMIC_ACQUIRE, "agent");
            asm volatile("s_waitcnt vmcnt(0)" ::: "memory");
        }
    }
    __syncthreads();
}
namespace pg8 {
#define PG8_LAS __attribute__((address_space(3)))
typedef unsigned short bf16_t;
typedef short bf16x8 __attribute__((ext_vector_type(8)));
typedef float f32x4 __attribute__((ext_vector_type(4)));
typedef unsigned u32x4 __attribute__((ext_vector_type(4)));
typedef unsigned u32x2 __attribute__((ext_vector_type(2)));
typedef int i32x4_t __attribute__((ext_vector_type(4)));
typedef int i32x8_t __attribute__((ext_vector_type(8)));
constexpr float F8_ACT = 16.f, F8_WGT = 512.f, F8_INV = 1.f / (16.f * 512.f);
constexpr int BM = 256, BK = 64, HALF = 128, HTB = HALF * BK * 2, STAGE_BYTES = 8 * HTB, NXCD = 8, WGM = 8;

__host__ __device__ __forceinline__ int lds_byte(int r, int c) { const int st = (r >> 4) * 2 + (c >> 5), rr = r & 15, cc = c & 31, ob = rr * 64 + cc * 2; return st * 1024 + (ob ^ (((ob >> 9) & 1) << 5)); }
__host__ __device__ __forceinline__ void stage_rc(int b, int& R, int& C) { const int st = b / 1024, sb = b % 1024, swz = sb ^ (((sb >> 9) & 1) << 5); R = (st >> 1) * 16 + swz / 64; C = (st & 1) * 32 + (swz % 64) / 2; }
__host__ __device__ __forceinline__ int perm32(int rho) { const int n = rho >> 4, i = rho & 15; return 8 * (i >> 2) + 4 * n + (i & 3); }

struct Unit { int pm, pn; const char* a; const char* b; const int* rows; const float* wrow; int nvalid; int pad_; };

struct StaticOrder {
    int nM, nN, nwg, G, c; const char* A; const char* Bt; size_t tstep;
    __device__ void init(const void* A_, const void* Bt_, int M, int N, int K, int G_, int c_, int esz = 2) { nM = M / BM; nN = N / BM; nwg = nM * nN; G = G_; c = c_; A = (const char*)A_; Bt = (const char*)Bt_; tstep = (size_t)BM * K * esz; }
    __device__ bool next(int i, Unit& u) const {
        const long L = (long)i * G + c; if (L >= nwg) return false;
        int wgid = (int)L; { const int q = nwg / NXCD, r = nwg % NXCD, xcd = wgid % NXCD, off = wgid / NXCD; wgid = (xcd < r ? xcd * (q + 1) : r * (q + 1) + (xcd - r) * q) + off; }
        const int nig = WGM * nN, gid = wgid / nig, fm = gid * WGM, gsz = (nM - fm) < WGM ? (nM - fm) : WGM;
        u.pm = fm + ((wgid % nig) % gsz); u.pn = (wgid % nig) / gsz; u.a = A + (size_t)u.pm * tstep; u.b = Bt + (size_t)u.pn * tstep; u.rows = nullptr; u.wrow = nullptr; u.nvalid = 256; return true;
    }
};

__device__ __forceinline__ unsigned cvt_pk_bf16(float lo, float hi) { unsigned r; asm volatile("v_cvt_pk_bf16_f32 %0, %1, %2" : "=v"(r) : "v"(lo), "v"(hi)); return r; }

struct EpiBf16 {
    static constexpr bool PERM = true;
    bf16_t* O; int ldc; float mul;
    __device__ __forceinline__ void operator()(const f32x4 (&acc)[2][2][4][2], const Unit& u, int wr, int wc, int fr, int fq) const {
        const int row0 = u.pm * BM + wr * 64 + fr; const int col0 = u.pn * BM + wc * 32 + 8 * fq;
#pragma unroll
        for (int ai = 0; ai < 2; ++ai)
#pragma unroll
            for (int m = 0; m < 4; ++m) { bf16_t* rowp = O + (size_t)(row0 + ai * HALF + m * 16) * ldc + col0;
#pragma unroll
                for (int bj = 0; bj < 2; ++bj) { const f32x4 v0 = acc[ai][bj][m][0] * mul, v1 = acc[ai][bj][m][1] * mul;
                    u32x4 w; w.x = cvt_pk_bf16(v0[0], v0[1]); w.y = cvt_pk_bf16(v0[2], v0[3]); w.z = cvt_pk_bf16(v1[0], v1[1]); w.w = cvt_pk_bf16(v1[2], v1[3]);
                    *(u32x4*)(rowp + bj * HALF) = w; } }
    }
};
struct EpiF8 {
    static constexpr bool PERM = true;
    unsigned char* O; int ldc; float mul;
    __device__ __forceinline__ void operator()(const f32x4 (&acc)[2][2][4][2], const Unit& u, int wr, int wc, int fr, int fq) const {
        const int row0 = u.pm * BM + wr * 64 + fr; const int col0 = u.pn * BM + wc * 32 + 8 * fq;
#pragma unroll
        for (int ai = 0; ai < 2; ++ai)
#pragma unroll
            for (int m = 0; m < 4; ++m) { unsigned char* rowp = O + (size_t)(row0 + ai * HALF + m * 16) * ldc + col0;
#pragma unroll
                for (int bj = 0; bj < 2; ++bj) { const f32x4 v0 = acc[ai][bj][m][0] * mul, v1 = acc[ai][bj][m][1] * mul;
                    u32x2 w; w.x = ::pk4_fp8(v0[0], v0[1], v0[2], v0[3]); w.y = ::pk4_fp8(v1[0], v1[1], v1[2], v1[3]);
                    *(u32x2*)(rowp + bj * HALF) = w; } }
    }
};
template <bool BASE_BF16>
struct EpiRes {
    static constexpr bool PERM = false;
    const void* base; bf16_t* C; int ldc; float mul;
    __device__ __forceinline__ void operator()(const f32x4 (&acc)[2][2][4][2], const Unit& u, int wr, int wc, int fr, int fq) const {
        const int row0 = u.pm * BM + wr * 64 + fr, col0 = u.pn * BM + wc * 32 + 4 * fq;
#pragma unroll
        for (int ai = 0; ai < 2; ++ai)
#pragma unroll
            for (int m = 0; m < 4; ++m) { const size_t off = (size_t)(row0 + ai * HALF + m * 16) * ldc + col0;
#pragma unroll
                for (int bj = 0; bj < 2; ++bj)
#pragma unroll
                    for (int n = 0; n < 2; ++n) { const size_t o2 = off + bj * HALF + n * 16; f32x4 bs;
                        if constexpr (BASE_BF16) { const u32x2 w = *(const u32x2*)((const bf16_t*)base + o2); bs = (f32x4){__uint_as_float(w.x << 16), __uint_as_float(w.x & 0xffff0000u), __uint_as_float(w.y << 16), __uint_as_float(w.y & 0xffff0000u)}; }
                        else bs = *(const f32x4*)((const float*)base + o2);
                        const f32x4 r = bs + acc[ai][bj][m][n] * mul;
                        u32x2 ow; ow.x = ::pk2(r[0], r[1]); ow.y = ::pk2(r[2], r[3]); *(u32x2*)(C + o2) = ow; }
                asm volatile("" ::: "memory"); }
    }
};
struct EpiSilu {
    static constexpr bool PERM = true;
    bf16_t* H; float mul; float h8;
    __device__ __forceinline__ void operator()(const f32x4 (&acc)[2][2][4][2], const Unit& u, int wr, int wc, int fr, int fq) const {
        const int row0 = u.pm * BM + wr * 64 + fr; const int col0 = u.pn * HALF + wc * 32 + 8 * fq;
#pragma unroll
        for (int ai = 0; ai < 2; ++ai)
#pragma unroll
            for (int m = 0; m < 4; ++m) { const int row = row0 + ai * HALF + m * 16; const float w = u.wrow[wr * 64 + fr + ai * HALF + m * 16];
                float o[8];
#pragma unroll
                for (int n = 0; n < 2; ++n)
#pragma unroll
                    for (int j = 0; j < 4; ++j) { const float g = acc[ai][0][m][n][j] * mul, up = acc[ai][1][m][n][j] * mul; o[n * 4 + j] = g * __builtin_amdgcn_rcpf(1.f + __expf(-g)) * up * w; }
                if (h8 > 0.f) { u32x2 w8; w8.x = ::pk4_fp8(o[0] * h8, o[1] * h8, o[2] * h8, o[3] * h8); w8.y = ::pk4_fp8(o[4] * h8, o[5] * h8, o[6] * h8, o[7] * h8); *(u32x2*)((unsigned char*)H + (size_t)row * 256 + col0) = w8; }
                else { u32x4 wv; wv.x = cvt_pk_bf16(o[0], o[1]); wv.y = cvt_pk_bf16(o[2], o[3]); wv.z = cvt_pk_bf16(o[4], o[5]); wv.w = cvt_pk_bf16(o[6], o[7]);
                    *(u32x4*)(H + (size_t)row * 256 + col0) = wv; } }
    }
};

template <class Epi, class Sched, bool GATHER, int ESZ = 2>
__device__ __forceinline__ void gemm_phase(PG8_LAS unsigned char* lds, const int K, const Sched& S, const Epi& E) {
    const int tid = threadIdx.x, wid = __builtin_amdgcn_readfirstlane(tid >> 6), lane = tid & 63, wr = wid >> 2, wc = wid & 3, fr = lane & 15, fq = lane >> 4;
    const int KB = K * ESZ;
    const int nt = KB / (BK * 2);
    const size_t kstep = (size_t)(BK * 2);
    const unsigned hstep = (unsigned)HALF * KB;
    int sR[2], sC[2];
    unsigned voffB[2], vc[2][2], vn[2][2];
#pragma unroll
    for (int i = 0; i < 2; ++i) { int R, C; stage_rc(tid * 16 + i * 8192, R, C); sR[i] = R; sC[i] = C; const int Rb = Epi::PERM ? ((R & ~31) + perm32(R & 31)) : R;
        voffB[i] = (unsigned)(Rb * KB + C * 2); vc[0][i] = (unsigned)(R * KB + C * 2); vc[1][i] = vc[0][i] + hstep; vn[0][i] = vc[0][i]; vn[1][i] = vc[1][i]; }
    const unsigned ldsw = (unsigned)wid * 1024u;
    const int aoff = lds_byte(wr * 64 + fr, fq * 8), boff = lds_byte(wc * 32 + fr, fq * 8);
#define PG8_SA(b, h) (((b) * 2 + (h)) * HTB)
#define PG8_SB(b, h) ((4 + (b) * 2 + (h)) * HTB)
#define PG8_STAGE(bufoff, gbase, voff) do { _Pragma("unroll") for (int _i = 0; _i < 2; ++_i) \
        __builtin_amdgcn_global_load_lds((const unsigned*)((const char*)(gbase) + (voff)[_i]), (PG8_LAS unsigned*)(lds + (bufoff) + ldsw + _i * 8192), 16, 0, 0); } while (0)
#define PG8_LD32(addr) __builtin_shufflevector(*(const PG8_LAS i32x4_t*)(addr), *(const PG8_LAS i32x4_t*)((addr) + 1024), 0, 1, 2, 3, 4, 5, 6, 7)
#define PG8_LDA(dst, b, h) do { if constexpr (ESZ == 2) { _Pragma("unroll") for (int m = 0; m < 4; ++m) _Pragma("unroll") for (int k = 0; k < 2; ++k) dst[m][k] = *(const PG8_LAS bf16x8*)(lds + PG8_SA(b, h) + aoff + m * 2048 + k * 1024); } \
        else { _Pragma("unroll") for (int m = 0; m < 4; ++m) dst##8[m] = PG8_LD32(lds + PG8_SA(b, h) + aoff + m * 2048); } } while (0)
#define PG8_LDB(dst, b, h) do { if constexpr (ESZ == 2) { _Pragma("unroll") for (int n = 0; n < 2; ++n) _Pragma("unroll") for (int k = 0; k < 2; ++k) dst[n][k] = *(const PG8_LAS bf16x8*)(lds + PG8_SB(b, h) + boff + n * 2048 + k * 1024); } \
        else { _Pragma("unroll") for (int n = 0; n < 2; ++n) dst##8[n] = PG8_LD32(lds + PG8_SB(b, h) + boff + n * 2048); } } while (0)
#define PG8_F8(x) __builtin_shufflevector(__builtin_bit_cast(i32x4_t, x[0]), __builtin_bit_cast(i32x4_t, x[1]), 0, 1, 2, 3, 4, 5, 6, 7)
#define PG8_MMA(ai, bj, At, Bt) do { __builtin_amdgcn_s_setprio(1); _Pragma("unroll") for (int m = 0; m < 4; ++m) _Pragma("unroll") for (int n = 0; n < 2; ++n) { \
        if constexpr (ESZ == 2) { _Pragma("unroll") for (int k = 0; k < 2; ++k) acc[ai][bj][m][n] = __builtin_amdgcn_mfma_f32_16x16x32_bf16(Bt[n][k], At[m][k], acc[ai][bj][m][n], 0, 0, 0); } \
        else asm volatile("s_nop 1\n\tv_mfma_f32_16x16x128_f8f6f4 %0, %1, %2, %0" : "+v"(acc[ai][bj][m][n]) : "v"(Bt##8[n]), "v"(At##8[m])); } __builtin_amdgcn_s_setprio(0); } while (0)
#define PG8_WAIT_V(n) asm volatile("s_waitcnt vmcnt(" #n ")" ::: "memory")
#define PG8_WAIT_L(n) asm volatile("s_waitcnt lgkmcnt(" #n ")" ::: "memory")
#define PG8_BAR __builtin_amdgcn_s_barrier()
#define PG8_SCHED __builtin_amdgcn_sched_barrier(0)
#define PG8_GV(dst, u) do { if constexpr (GATHER) { _Pragma("unroll") for (int _h = 0; _h < 2; ++_h) _Pragma("unroll") for (int _i = 0; _i < 2; ++_i) { const int _idx = _h * HALF + sR[_i]; \
        const int _tok = (u).rows[_idx < (u).nvalid ? _idx : 0]; dst[_h][_i] = (unsigned)_tok * (unsigned)KB + (unsigned)sC[_i] * 2u; } } } while (0)
    Unit cur, nxt; int ui = 0;
    if (!S.next(0, cur)) return;
    f32x4 acc[2][2][4][2];
#pragma unroll
    for (int a = 0; a < 2; ++a)
#pragma unroll
        for (int b = 0; b < 2; ++b)
#pragma unroll
            for (int m = 0; m < 4; ++m)
#pragma unroll
                for (int n = 0; n < 2; ++n) acc[a][b][m][n] = (f32x4){0.f, 0.f, 0.f, 0.f};
    bf16x8 At[4][2], B0[2][2], B1[2][2];
    i32x8_t At8[4], B08[2], B18[2];
    const char* cA = cur.a; const char* cB = cur.b;
    PG8_GV(vc, cur);
    PG8_STAGE(PG8_SB(0, 0), cB, voffB); PG8_STAGE(PG8_SB(0, 1), cB + hstep, voffB); PG8_STAGE(PG8_SA(0, 0), cA, vc[0]); PG8_STAGE(PG8_SA(0, 1), cA, vc[1]);
    if (wr == 1) PG8_BAR;
    PG8_WAIT_V(2); PG8_BAR;
    PG8_STAGE(PG8_SB(1, 0), cB + kstep, voffB); PG8_STAGE(PG8_SA(1, 0), cA + kstep, vc[0]); PG8_STAGE(PG8_SB(1, 1), cB + hstep + kstep, voffB);
    PG8_WAIT_V(6); PG8_BAR;
    for (;;) {
        const bool has_next = S.next(ui + 1, nxt);
        const char* nA = has_next ? nxt.a : cA; const char* nB = has_next ? nxt.b : cB;
        if constexpr (GATHER) { if (has_next) { PG8_GV(vn, nxt); } else {
#pragma unroll
            for (int h = 0; h < 2; ++h)
#pragma unroll
                for (int i = 0; i < 2; ++i) vn[h][i] = vc[h][i]; } }
#pragma unroll 1
        for (int t = 0; t < nt; t += 2) {
            const bool last = (t == nt - 2);
            const char* a1 = cA + (size_t)(t + 1) * kstep;
            const char* a2 = last ? nA : cA + (size_t)(t + 2) * kstep; const char* b2 = last ? nB : cB + (size_t)(t + 2) * kstep;
            const char* a3 = a2 + kstep; const char* b3 = b2 + kstep;
            unsigned v2[2][2];
#pragma unroll
            for (int h = 0; h < 2; ++h)
#pragma unroll
                for (int i = 0; i < 2; ++i) v2[h][i] = (GATHER && last) ? vn[h][i] : vc[h][i];
            PG8_LDB(B0, 0, 0); PG8_LDB(B1, 0, 1); PG8_SCHED; PG8_LDA(At, 0, 0); PG8_STAGE(PG8_SA(1, 1), a1, vc[1]);
            PG8_WAIT_V(8); PG8_WAIT_L(0); PG8_BAR; PG8_MMA(0, 0, At, B0); PG8_MMA(0, 1, At, B1); PG8_BAR; PG8_SCHED;
            PG8_LDA(At, 0, 1); PG8_STAGE(PG8_SB(0, 0), b2, voffB); PG8_STAGE(PG8_SB(0, 1), b2 + hstep, voffB); PG8_STAGE(PG8_SA(0, 0), a2, v2[0]);
            PG8_WAIT_V(8); PG8_WAIT_L(0); PG8_BAR; PG8_MMA(1, 0, At, B0); PG8_MMA(1, 1, At, B1); PG8_BAR; PG8_SCHED;
            PG8_LDB(B0, 1, 0); PG8_LDB(B1, 1, 1); PG8_SCHED; PG8_LDA(At, 1, 0); PG8_STAGE(PG8_SA(0, 1), a2, v2[1]);
            PG8_WAIT_V(8); PG8_WAIT_L(0); PG8_BAR; PG8_MMA(0, 0, At, B0); PG8_MMA(0, 1, At, B1); PG8_BAR; PG8_SCHED;
            PG8_LDA(At, 1, 1); PG8_STAGE(PG8_SB(1, 0), b3, voffB); PG8_STAGE(PG8_SB(1, 1), b3 + hstep, voffB); PG8_STAGE(PG8_SA(1, 0), a3, v2[0]);
            PG8_WAIT_V(8); PG8_WAIT_L(0); PG8_BAR; PG8_MMA(1, 0, At, B0); PG8_MMA(1, 1, At, B1); PG8_BAR; PG8_SCHED;
        }
        if (wr == 0) PG8_BAR;
        if constexpr (ESZ == 1) asm volatile("s_nop 15\n\ts_nop 7" ::: "memory");
        E(acc, cur, wr, wc, fr, fq);
        if (!has_next) break;
#pragma unroll
        for (int a = 0; a < 2; ++a)
#pragma unroll
            for (int b = 0; b < 2; ++b)
#pragma unroll
                for (int m = 0; m < 4; ++m)
#pragma unroll
                    for (int n = 0; n < 2; ++n) acc[a][b][m][n] = (f32x4){0.f, 0.f, 0.f, 0.f};
        cur = nxt; cA = nA; cB = nB; ++ui;
        if constexpr (GATHER) {
#pragma unroll
            for (int h = 0; h < 2; ++h)
#pragma unroll
                for (int i = 0; i < 2; ++i) vc[h][i] = vn[h][i]; }
        if (wr == 1) PG8_BAR;
    }
    PG8_WAIT_V(0);
    PG8_BAR;
#undef PG8_SA
#undef PG8_SB
#undef PG8_STAGE
#undef PG8_LDA
#undef PG8_LD32
#undef PG8_LDB
#undef PG8_MMA
#undef PG8_F8
#undef PG8_WAIT_V
#undef PG8_WAIT_L
#undef PG8_BAR
#undef PG8_SCHED
#undef PG8_GV
}
}
struct Frame {
    LAS unsigned char* lds; unsigned char* ws; unsigned* ctl;
    int tid, lane, wave, G, vcu;
    unsigned long long pacc;
};

__device__ __forceinline__ void cvt_tile(const float* W, int N, int K, int k0, int n0, bf16* dst, int drow0, float scale, LAS float* scr, int lane) {
#pragma unroll 8
    for (int i = 0; i < 32; ++i) { const int kk = 2 * i + (lane >> 5); scr[kk * 33 + (lane & 31)] = W[(size_t)(k0 + kk) * N + n0 + (lane & 31)]; }
    LDS_WAIT(); asm volatile("" ::: "memory");
    const int c = lane & 7;
#pragma unroll
    for (int j = 0; j < 4; ++j) { const int n = (lane >> 3) + 8 * j; const LAS float* s = scr + (8 * c) * 33 + n;
        u32x4 o; o.x = pk2(s[0 * 33] * scale, s[1 * 33] * scale); o.y = pk2(s[2 * 33] * scale, s[3 * 33] * scale); o.z = pk2(s[4 * 33] * scale, s[5 * 33] * scale); o.w = pk2(s[6 * 33] * scale, s[7 * 33] * scale);
        *(u32x4*)(dst + (size_t)(drow0 + n) * K + k0 + 8 * c) = o; }
    LDS_WAIT(); asm volatile("" ::: "memory");
}
__device__ __forceinline__ void cvt_tile8(const float* W, int N, int K, int k0, int n0, unsigned char* dst, int drow0, float scale, LAS float* scr, int lane) {
#pragma unroll 8
    for (int i = 0; i < 32; ++i) { const int kk = 2 * i + (lane >> 5); scr[kk * 33 + (lane & 31)] = W[(size_t)(k0 + kk) * N + n0 + (lane & 31)]; }
    LDS_WAIT(); asm volatile("" ::: "memory");
    const int c = lane & 7;
#pragma unroll
    for (int j = 0; j < 4; ++j) { const int n = (lane >> 3) + 8 * j; const LAS float* s = scr + (8 * c) * 33 + n;
        u32x2 o; o.x = pk4_fp8(s[0 * 33] * scale, s[1 * 33] * scale, s[2 * 33] * scale, s[3 * 33] * scale); o.y = pk4_fp8(s[4 * 33] * scale, s[5 * 33] * scale, s[6 * 33] * scale, s[7 * 33] * scale);
        *(u32x2*)(dst + (size_t)(drow0 + n) * K + k0 + 8 * c) = o; }
    LDS_WAIT(); asm volatile("" ::: "memory");
}
__device__ __forceinline__ void convert_phase(Frame& F, const Args& a, int l) {
    using namespace cfg;
    LAS float* scr = (LAS float*)(F.lds + F.wave * 16384);
    const int gw = F.vcu * 8 + F.wave, NGW = F.G * 8;
    const float* w_in = a.in[1] + (size_t)l * D * INC; const float* w_out = a.in[2] + (size_t)l * D * D;
    const size_t es = (size_t)NEXP * D * EH;
    const float* wg = a.in[29] + l * es; const float* wu = a.in[30] + l * es; const float* wd = a.in[31] + l * es;
    bf16* Wi = (bf16*)(F.ws + wsm::W_IN); bf16* Wo = (bf16*)(F.ws + wsm::W_OUT); bf16* Wgu = (bf16*)(F.ws + wsm::W_GU); bf16* Wd = (bf16*)(F.ws + wsm::W_D);
    constexpr int I_IN = 32 * 200, I_OUT = 32 * 64, I_G = 32 * 256, I_D = 32 * 256;
    constexpr int NITEMS = I_IN + I_OUT + 2 * I_G + I_D;
    for (int it = gw; it < NITEMS; it += NGW) {
        int r = it;
        if (r < I_IN) { const int kb = r / 200, nb = r % 200, n0 = nb * 32; const bool isq = (n0 >= OFF_BQ && n0 < OFF_BK) || (n0 >= OFF_CQ && n0 < OFF_CK);
            if (F8IN(l)) cvt_tile8(w_in, INC, D, kb * 64, n0, (unsigned char*)Wi, n0, (isq ? C2F : 1.f) * pg8::F8_WGT, scr, F.lane); else cvt_tile(w_in, INC, D, kb * 64, n0, Wi, n0, isq ? C2F : 1.f, scr, F.lane); continue; } r -= I_IN;
        if (r < I_OUT) { const int kb = r / 64, nb = r % 64; if (F8OUT(l)) cvt_tile8(w_out, D, D, kb * 64, nb * 32, (unsigned char*)Wo, nb * 32, pg8::F8_WGT, scr, F.lane); else cvt_tile(w_out, D, D, kb * 64, nb * 32, Wo, nb * 32, 1.f, scr, F.lane); continue; } r -= I_OUT;
        if (r < 2 * I_G) { const int up = r >= I_G; if (up) r -= I_G; const int e = r >> 8, q = r & 255, kb = q >> 3, nb = q & 7, n0 = nb * 32;
            if ((F8_MOE_MASK >> l) & 1) cvt_tile8((up ? wu : wg) + (size_t)e * D * EH, EH, D, kb * 64, n0, (unsigned char*)Wgu, e * 512 + 256 * (n0 >> 7) + (n0 & 127) + (up ? 128 : 0), pg8::F8_WGT, scr, F.lane);
            else cvt_tile((up ? wu : wg) + (size_t)e * D * EH, EH, D, kb * 64, n0, Wgu, e * 512 + 256 * (n0 >> 7) + (n0 & 127) + (up ? 128 : 0), 1.f, scr, F.lane); continue; } r -= 2 * I_G;
        { const int e = r >> 8, q = r & 255, kb = q >> 6, nb = q & 63;
          if (F8_DOWN) cvt_tile8(wd + (size_t)e * EH * D, D, EH, kb * 64, nb * 32, (unsigned char*)Wd + (size_t)e * D * EH, nb * 32, pg8::F8_WGT, scr, F.lane);
          else cvt_tile(wd + (size_t)e * EH * D, D, EH, kb * 64, nb * 32, Wd + (size_t)e * D * EH, nb * 32, 1.f, scr, F.lane); }
    }
    bf16* Wr = (bf16*)(F.ws + wsm::WRT); const float* rg = a.in[25] + (size_t)l * D * 4; const float* re = a.in[27] + (size_t)l * D * 32;
    for (int idx = (F.vcu * 512 + F.tid); idx < 48 * 2048; idx += F.G * 512) { const int n = idx >> 11, k = idx & 2047;
        const float v = n < 4 ? rg[k * 4 + n] : (n < 36 ? re[k * 32 + n - 4] : 0.f); Wr[idx] = cvt1(v); }
    bf16* w2t = (bf16*)(F.ws + wsm::WRT + 262144); bf16* a2t = w2t + 512 * 64; bf16* g2t = a2t + 512 * 64;
    const float* w2 = a.in[8] + (size_t)l * 64 * 512; const float* a2 = a.in[10] + (size_t)l * 64 * 512; const float* g2 = a.in[11] + (size_t)l * 128 * 512;
    for (int idx = (F.vcu * 512 + F.tid); idx < 512 * 256; idx += F.G * 512) { const int ch = idx & 511, j = idx >> 9;
        if (j < 64) w2t[ch * 64 + j] = cvt1(w2[j * 512 + ch]); else if (j < 128) a2t[ch * 64 + (j - 64)] = cvt1(a2[(j - 64) * 512 + ch]); else g2t[ch * 128 + (j - 128)] = cvt1(g2[(j - 128) * 512 + ch]); }
}

__device__ __forceinline__ int grab(Frame& F, int q) {
    volatile LAS int* slot = (volatile LAS int*)(F.lds + MISC_OFF + 64);
    if (F.tid == 0) *slot = (int)__hip_atomic_fetch_add(F.ctl + wsm::CW_Q + q * 64, 1u, RLX_AGENT);
    __syncthreads();
    const int v = *slot;
    __syncthreads();
    return __builtin_amdgcn_readfirstlane(v);
}
__device__ __forceinline__ void build_pref(Frame& F, int l) {
    LAS int* pref = (LAS int*)(F.lds + TAB_OFF);
    if (F.tid == 0) { int s = 0; for (int e = 0; e < 32; ++e) { pref[e] = s; const unsigned c = __hip_atomic_load(F.ctl + wsm::CW_CNT + (l * 32 + e) * 64, RLX_AGENT); pref[40 + e] = (int)c; s += (int)((c + 255u) >> 8); } pref[32] = s; }
    __syncthreads();
}

template <bool COMBINE, bool ROUTER, bool FINAL, bool F8 = false, bool XBF = false>
__device__ __forceinline__ void norm_phase(Frame& F, const Args& a, const float* xsrc, float* xout, const float* gain, int l, int lc) {
    using namespace cfg;
    constexpr int PITCHB = 4112;
    LAS unsigned char* tile = F.lds;
    LAS float* part = (LAS float*)(F.lds + 67584);
    LAS int* pref = (LAS int*)(F.lds + TAB_OFF);
    bf16* xn = (bf16*)(F.ws + wsm::XN);
    const bf16* OB = (const bf16*)(F.ws + wsm::OB);
    const int4* tokinfo = (const int4*)(F.ws + wsm::TOKINFO);
    const int lane = F.lane, w = F.wave;
    f32x4 g4[8];
#pragma unroll
    for (int j = 0; j < 8; ++j) g4[j] = *(const f32x4*)(gain + 4 * lane + 256 * j);
    for (int pass = F.vcu; pass < M / 16; pass += F.G) {
#pragma unroll
        for (int rr = 0; rr < 2; ++rr) {
            const int rt = 2 * w + rr, row = pass * 16 + rt;
            f32x4 v[8];
            if constexpr (XBF) { const bf16* xr = (const bf16*)xsrc + (size_t)row * D + 4 * lane;
#pragma unroll
                for (int j = 0; j < 8; ++j) { const u32x2 w = *(const u32x2*)(xr + 256 * j); v[j] = (f32x4){__uint_as_float(w.x << 16), __uint_as_float(w.x & 0xffff0000u), __uint_as_float(w.y << 16), __uint_as_float(w.y & 0xffff0000u)}; }
            } else { const float* xr = xsrc + (size_t)row * D + 4 * lane;
#pragma unroll
                for (int j = 0; j < 8; ++j) v[j] = *(const f32x4*)(xr + 256 * j); }
            if constexpr (COMBINE) {
                const int4 ti = tokinfo[row];
                const unsigned char* o0 = (const unsigned char*)OB + ((size_t)pref[ti.x] * 256 + ti.y) * D + 4 * lane; const unsigned char* o1 = (const unsigned char*)OB + ((size_t)pref[ti.z] * 256 + ti.w) * D + 4 * lane;
#pragma unroll
                for (int j = 0; j < 8; ++j) { const int p0 = *(const int*)(o0 + 256 * j), p1 = *(const int*)(o1 + 256 * j);
                    const f32x2 a0 = __builtin_amdgcn_cvt_pk_f32_fp8(p0, false), a1 = __builtin_amdgcn_cvt_pk_f32_fp8(p0, true), b0 = __builtin_amdgcn_cvt_pk_f32_fp8(p1, false), b1 = __builtin_amdgcn_cvt_pk_f32_fp8(p1, true);
                    v[j].x += (a0.x + b0.x) * (1.f / F8_OB); v[j].y += (a0.y + b0.y) * (1.f / F8_OB); v[j].z += (a1.x + b1.x) * (1.f / F8_OB); v[j].w += (a1.y + b1.y) * (1.f / F8_OB); }
                if constexpr (!FINAL) {
#pragma unroll
                    for (int j = 0; j < 8; ++j) { if constexpr (XBF) { u32x2 w; w.x = pk2(v[j].x, v[j].y); w.y = pk2(v[j].z, v[j].w); *(u32x2*)((bf16*)xout + (size_t)row * D + 4 * lane + 256 * j) = w; }
                        else *(f32x4*)(xout + (size_t)row * D + 4 * lane + 256 * j) = v[j]; }
                }
            }
            float s = 0.f;
#pragma unroll
            for (int j = 0; j < 8; ++j) s += (v[j].x * v[j].x + v[j].y * v[j].y) + (v[j].z * v[j].z + v[j].w * v[j].w);
            const float rstd = rsqrtf(wave_sum(s) * (1.f / D) + 1e-6f);
#pragma unroll
            for (int j = 0; j < 8; ++j) { const f32x4 o = v[j] * rstd * g4[j];
                if constexpr (FINAL) *(f32x4*)(xout + (size_t)row * D + 4 * lane + 256 * j) = o;
                else if constexpr (F8) { *(unsigned*)((unsigned char*)xn + (size_t)row * D + 4 * lane + 256 * j) = pk4_fp8(o.x * pg8::F8_ACT, o.y * pg8::F8_ACT, o.z * pg8::F8_ACT, o.w * pg8::F8_ACT);
                    if constexpr (ROUTER) { u32x2 pk; pk.x = pk2(o.x, o.y); pk.y = pk2(o.z, o.w); *(LAS u32x2*)(tile + rt * PITCHB + (4 * lane + 256 * j) * 2) = pk; } }
                else { u32x2 pk; pk.x = pk2(o.x, o.y); pk.y = pk2(o.z, o.w);
                    *(u32x2*)(xn + (size_t)row * D + 4 * lane + 256 * j) = pk;
                    if constexpr (ROUTER) *(LAS u32x2*)(tile + rt * PITCHB + (4 * lane + 256 * j) * 2) = pk; } }
        }
        if constexpr (ROUTER) {
            __syncthreads();
            const bf16* Wr = (const bf16*)(F.ws + wsm::WRT);
            f32x4 acc[3] = {(f32x4){0.f, 0.f, 0.f, 0.f}, (f32x4){0.f, 0.f, 0.f, 0.f}, (f32x4){0.f, 0.f, 0.f, 0.f}};
#pragma unroll
            for (int s8 = 0; s8 < 8; ++s8) { const int k = 256 * w + 32 * s8 + 8 * (lane >> 4);
                const bf16x8 af = *(const LAS bf16x8*)(tile + (lane & 15) * PITCHB + k * 2);
#pragma unroll
                for (int nt = 0; nt < 3; ++nt) { const bf16x8 bfr = *(const bf16x8*)(Wr + (size_t)(16 * nt + (lane & 15)) * D + k);
                    acc[nt] = __builtin_amdgcn_mfma_f32_16x16x32_bf16(af, bfr, acc[nt], 0, 0, 0); } }
#pragma unroll
            for (int nt = 0; nt < 3; ++nt)
#pragma unroll
                for (int i = 0; i < 4; ++i) part[(w * 16 + (lane >> 4) * 4 + i) * 48 + 16 * nt + (lane & 15)] = acc[nt][i];
            __syncthreads();
            if (F.tid < 16) {
                const int m = F.tid, tok = pass * 16 + m;
                const float* bg = a.in[26] + l * 4; const float* be = a.in[28] + l * 32;
                float lg[4];
#pragma unroll
                for (int o = 0; o < 4; ++o) { float sacc = bg[o];
#pragma unroll
                    for (int ww = 0; ww < 8; ++ww) sacc += part[(ww * 16 + m) * 48 + o]; lg[o] = sacc; }
                int gi = 0; float gm = lg[0];
#pragma unroll
                for (int o = 1; o < 4; ++o) if (lg[o] > gm) { gm = lg[o]; gi = o; }
                float gs = 0.f;
#pragma unroll
                for (int o = 0; o < 4; ++o) gs += __expf(lg[o] - gm);
                const float gw = 1.f / gs;
                float el[8];
#pragma unroll
                for (int o = 0; o < 8; ++o) { float sacc = be[gi * 8 + o];
#pragma unroll
                    for (int ww = 0; ww < 8; ++ww) sacc += part[(ww * 16 + m) * 48 + 4 + gi * 8 + o]; el[o] = sacc; }
                int i1 = 0; float m1 = el[0];
#pragma unroll
                for (int o = 1; o < 8; ++o) if (el[o] > m1) { m1 = el[o]; i1 = o; }
                int i2 = 0; float m2 = -3e38f;
#pragma unroll
                for (int o = 0; o < 8; ++o) if (o != i1 && el[o] > m2) { m2 = el[o]; i2 = o; }
                const float e2x = __expf(m2 - m1); const float w1 = gw / (1.f + e2x), w2 = gw * e2x / (1.f + e2x);
                const int e1 = gi * 8 + i1, e2 = gi * 8 + i2;
                const int p1 = (int)__hip_atomic_fetch_add(F.ctl + wsm::CW_CNT + (lc * 32 + e1) * 64, 1u, RLX_AGENT);
                const int p2 = (int)__hip_atomic_fetch_add(F.ctl + wsm::CW_CNT + (lc * 32 + e2) * 64, 1u, RLX_AGENT);
                int* lists = (int*)(F.ws + wsm::LISTS); float* wl = (float*)(F.ws + wsm::WLIST);
                lists[e1 * LCAP + p1] = tok; lists[e2 * LCAP + p2] = tok; wl[e1 * LCAP + p1] = w1; wl[e2 * LCAP + p2] = w2;
                ((int4*)(F.ws + wsm::TOKINFO))[tok] = make_int4(e1, p1, e2, p2);
                ((int4*)(F.ws + wsm::ROUTE))[tok] = make_int4(e1, e2, __float_as_int(w1), __float_as_int(w2));
            }
            __syncthreads();
        }
    }
}
namespace att {
typedef float f32x16 __attribute__((ext_vector_type(16)));
typedef short s16x4 __attribute__((ext_vector_type(4)));
constexpr int L_K = 0, L_V = 16384, L_WSF = 135168, L_TAB = 137216;
__device__ __forceinline__ int crow(int r, int hi) { return (r & 3) + 8 * (r >> 2) + 4 * hi; }
__device__ __forceinline__ int t5_bucket(int rel) {
    const int ret = rel > 0 ? 16 : 0; const int n = rel < 0 ? -rel : rel; int bk;
    if (n < 8) bk = n; else if (n < 12) bk = 8; else if (n < 16) bk = 9; else if (n < 23) bk = 10; else if (n < 32) bk = 11;
    else if (n < 46) bk = 12; else if (n < 64) bk = 13; else if (n < 91) bk = 14; else bk = 15;
    return ret + bk;
}
__device__ __forceinline__ unsigned cvtpk(float lo, float hi) { return pk2(lo, hi); }
__device__ __forceinline__ void qkt(f32x16& p0, f32x16& p1, const LAS unsigned char* Kslot, const bf16x8* qr, const f32x16& c0, const f32x16& c1, int r32, int hi) {
    const LAS unsigned char* kb = Kslot + hi * 1024 + r32 * 16;
#pragma unroll
    for (int d0 = 0; d0 < 4; ++d0) {
        const bf16x8 b0 = *(const LAS bf16x8*)(kb + d0 * 2048);
        const bf16x8 b1 = *(const LAS bf16x8*)(kb + d0 * 2048 + 512);
        if (d0 == 0) { p0 = __builtin_amdgcn_mfma_f32_32x32x16_bf16(b0, qr[0], c0, 0, 0, 0); p1 = __builtin_amdgcn_mfma_f32_32x32x16_bf16(b1, qr[0], c1, 0, 0, 0); }
        else { p0 = __builtin_amdgcn_mfma_f32_32x32x16_bf16(b0, qr[d0], p0, 0, 0, 0); p1 = __builtin_amdgcn_mfma_f32_32x32x16_bf16(b1, qr[d0], p1, 0, 0, 0); } }
}
__device__ __forceinline__ float rowmax(const f32x16& p0, const f32x16& p1) {
    float a = fmaxf(fmaxf(p0[0], p0[1]), p1[0]), b = fmaxf(fmaxf(p0[2], p0[3]), p1[1]); a = fmaxf(fmaxf(a, p1[2]), p1[3]);
#pragma unroll
    for (int r = 4; r < 16; r += 4) { a = fmaxf(fmaxf(a, p0[r]), p0[r + 1]); b = fmaxf(fmaxf(b, p0[r + 2]), p0[r + 3]); a = fmaxf(fmaxf(a, p1[r]), p1[r + 1]); b = fmaxf(fmaxf(b, p1[r + 2]), p1[r + 3]); }
    const float m = fmaxf(a, b);
    auto rr = __builtin_amdgcn_permlane32_swap(__float_as_uint(m), __float_as_uint(m), false, false);
    return fmaxf(__uint_as_float(rr[0]), __uint_as_float(rr[1]));
}
template <int ND>
__device__ __forceinline__ void pv(f32x16* o, int vb, bf16x8 pa0, bf16x8 pa1, bf16x8 pa2, bf16x8 pa3) {
#pragma unroll
    for (int d0 = 0; d0 < ND; ++d0) { s16x4 lo[4], hi[4];
#pragma unroll
        for (int ks = 0; ks < 4; ++ks) {
            asm volatile("ds_read_b64_tr_b16 %0,%1 offset:%c2" : "=&v"(lo[ks]) : "v"(vb), "i"(d0 * 4096 + ks * 1024) : "memory");
            asm volatile("ds_read_b64_tr_b16 %0,%1 offset:%c2" : "=&v"(hi[ks]) : "v"(vb), "i"(d0 * 4096 + ks * 1024 + 512) : "memory"); }
        asm volatile("s_waitcnt lgkmcnt(0)" ::: "memory"); __builtin_amdgcn_sched_barrier(0);
#define ATT_PK(k) (bf16x8){lo[k][0], lo[k][1], lo[k][2], lo[k][3], hi[k][0], hi[k][1], hi[k][2], hi[k][3]}
        o[d0] = __builtin_amdgcn_mfma_f32_32x32x16_bf16(pa0, ATT_PK(0), o[d0], 0, 0, 0);
        o[d0] = __builtin_amdgcn_mfma_f32_32x32x16_bf16(pa1, ATT_PK(1), o[d0], 0, 0, 0);
        o[d0] = __builtin_amdgcn_mfma_f32_32x32x16_bf16(pa2, ATT_PK(2), o[d0], 0, 0, 0);
        o[d0] = __builtin_amdgcn_mfma_f32_32x32x16_bf16(pa3, ATT_PK(3), o[d0], 0, 0, 0);
#undef ATT_PK
    }
}
#define ATT_WAIT_BAR(N) asm volatile("s_waitcnt vmcnt(" #N ") lgkmcnt(0)\n\ts_barrier" ::: "memory")
#ifndef PROBE_ATT
#define PROBE_ATT -1
#endif
#define ATT_NOW() __builtin_amdgcn_s_memrealtime()
#define ATT_SBAR() __builtin_amdgcn_sched_barrier(0)
#define ATT_PIN(x) asm volatile("" : "+v"(x))
#define ATT_MFMA(a, b, c) __builtin_amdgcn_mfma_f32_32x32x16_bf16(a, b, c, 0, 0, 0)
typedef const LAS char* lds_cptr;
typedef short v4i16_t __attribute__((ext_vector_type(4)));
__device__ __forceinline__ void glds16(const void* g, unsigned lds_base) {
    unsigned sv; asm volatile("s_mov_b32 %0, m0\n\ts_mov_b32 m0, %2\n\ts_nop 0\n\tglobal_load_lds_dwordx4 %1, off\n\ts_mov_b32 m0, %0" : "=&s"(sv) : "v"(g), "s"(lds_base) : "memory"); }
__device__ __forceinline__ void kload2(bf16x8* kf, lds_cptr kp, int d0) { kf[2 * d0] = *(const LAS bf16x8*)(kp + d0 * 2048); kf[2 * d0 + 1] = *(const LAS bf16x8*)(kp + d0 * 2048 + 512); }
__device__ __forceinline__ s16x4 vtr(lds_cptr q) { return __builtin_bit_cast(s16x4, __builtin_amdgcn_ds_read_tr16_b64_v4i16((LAS v4i16_t*)q)); }

template <int MODE>
__device__ __forceinline__ void attn_unit(Frame& F, const Args& a, const int l, const int b, const int hh, const int qb) {
    using namespace cfg;
    constexpr int ND = MODE ? 4 : 2, VSLOT = ND * 4096, NV = MODE ? 2 : 1, EPG = 8 / ND, KRD0 = MODE ? 8 : 2, VLEAD = 5;
    constexpr int NS = 4, LK = 0, LV = NS * 8192, LQ = 98304;
    constexpr float THR = 8.f;
    unsigned long long pu0_ = 0; if (PROBE_ATT == 3) pu0_ = ATT_NOW();
    const int lane = F.lane, r32 = lane & 31, hi = lane >> 5, wid = F.wave;
    const bf16* p = (const bf16*)(F.ws + wsm::P);
    bf16* y = (bf16*)(F.ws + wsm::Y);
    float* O1s = (float*)(F.ws + wsm::XN);
    LAS unsigned char* lds = F.lds;
    LAS float* wsf = (LAS float*)(lds + L_WSF) + wid * 64;
    LAS float* tab = (LAS float*)(lds + L_TAB);
    const size_t rowbase = (size_t)b * SEQ;
    if (F.tid < 320) { const int i = F.tid; float v;
        if (MODE == 0) { int d = i - 64; d = d < -128 ? -128 : (d > 128 ? 128 : d); v = a.in[17][(size_t)(l * 8 + hh) * 257 + d + 128]; }
        else v = a.in[18][t5_bucket(-(i - 64)) * 4 + hh];
        tab[i] = v * LOG2E; }
    const int t0 = MODE == 0 ? (4 * qb - 8 > 0 ? 4 * qb - 8 : 0) : 0, t1 = 4 * qb + 3;
    const int cw = 4 * qb + (wid >> 1);
    const int va = MODE == 0 ? (cw - 8 > 0 ? cw - 8 : 0) : 0, vb = cw;
    const int q0w = qb * 256 + 32 * wid, myq = q0w + r32;
    const unsigned lds0 = (unsigned)(uintptr_t)lds;
    const lds_cptr kp0 = (lds_cptr)lds + LK + hi * 1024 + r32 * 16;
    const lds_cptr vp0 = (lds_cptr)lds + LV + ((lane >> 4) & 1) * 32 + (lane & 3) * 8 + (4 * hi + ((lane & 15) >> 2)) * 64;
#pragma unroll 1
    for (int sub = 0; sub < (MODE ? 2 : 1); ++sub) {
        const int qcol = MODE ? OFF_CQ + (hh * 2 + sub) * 64 : OFF_BQ + hh * 64;
        const int kcol = MODE ? OFF_CK + (hh * 2 + sub) * 64 : OFF_BK + hh * 64;
        const int vcol = MODE ? OFF_CV + hh * 128 : OFF_BV + hh * 64;
        const bf16* Kh = p + rowbase * INC + kcol; const bf16* Vh = p + rowbase * INC + vcol;
        const bf16* ksrc = Kh + (size_t)lane * INC + wid * 8;
        const bf16* vsrc0 = Vh + (size_t)(16 * (wid & 3) + (lane >> 2)) * INC + (wid >> 2) * 32 + (lane & 3) * 8;
        const unsigned kdst = lds0 + LK + wid * 1024, vdst = lds0 + LV + wid * 1024;
#define ATT_DMA_K(t, s) glds16(ksrc + (size_t)(t) * 64 * INC, (unsigned)__builtin_amdgcn_readfirstlane(kdst + (s) * 8192))
#define ATT_DMA_V(t, s) do { glds16(vsrc0 + (size_t)(t) * 64 * INC, (unsigned)__builtin_amdgcn_readfirstlane(vdst + (s) * VSLOT)); \
        if (MODE) glds16(vsrc0 + (size_t)(t) * 64 * INC + 64, (unsigned)__builtin_amdgcn_readfirstlane(vdst + (s) * VSLOT + 8192)); } while (0)
        { const bf16* Qw = p + (rowbase + q0w) * INC + qcol + (size_t)r32 * INC + hi * 8;
#pragma unroll
          for (int d0 = 0; d0 < 4; ++d0) glds16(Qw + d0 * 16, (unsigned)__builtin_amdgcn_readfirstlane(lds0 + LQ + wid * 4096 + d0 * 1024)); }
        ATT_DMA_K(t0, 0); ATT_DMA_V(t0, 0); ATT_DMA_K(t0 + 1, 1); ATT_DMA_K(t0 + 2, 2); ATT_DMA_K(t0 + 3, 3); ATT_DMA_V(t0 + 1, 1);
        float mhat = 0.f, l_reg = 0.f;
        f32x16 o[ND];
#pragma unroll
        for (int d0 = 0; d0 < ND; ++d0)
#pragma unroll
            for (int r = 0; r < 16; ++r) o[d0][r] = 0.f;
        { LAS unsigned char* z = lds + LV + 3 * VSLOT + F.tid * (VSLOT / 512);
#pragma unroll
          for (int i = 0; i < VSLOT / 512 / 16; ++i) *(LAS u32x4*)(z + 16 * i) = (u32x4){0u, 0u, 0u, 0u}; }
        if (MODE) { ATT_WAIT_BAR(4); } else { ATT_WAIT_BAR(3); }
        const float cf = tab[300];
        bf16x8 qr[4];
#pragma unroll
        for (int d0 = 0; d0 < 4; ++d0) qr[d0] = *(const LAS bf16x8*)(lds + LQ + wid * 4096 + d0 * 1024 + lane * 16);
        bf16x8 kf[8];
#pragma unroll
        for (int d0 = 0; d0 < 4; ++d0) kload2(kf, kp0, d0);
        asm volatile("s_waitcnt lgkmcnt(0)\n\ts_barrier" ::: "memory");
        f32x16 C0, C1; u32x4 pw[4];
#pragma unroll
        for (int r = 0; r < 16; ++r) { C0[r] = 0.f; C1[r] = 0.f; }
#pragma unroll
        for (int g = 0; g < 4; ++g) pw[g] = (u32x4){0u, 0u, 0u, 0u};
#define ATT_CE(e) (((e) < 16) ? C0[(e) & 15] : C1[(e) & 15])
#define ATT_CEXP(e) do { if ((e) < 16) C0[(e) & 15] = __builtin_amdgcn_exp2f(C0[(e) & 15]); else C1[(e) & 15] = __builtin_amdgcn_exp2f(C1[(e) & 15]); } while (0)
#define ATT_VRD(ks, d0) do { vlo[(ks) * ND + (d0)] = vtr(vpp + (d0) * 4096 + (ks) * 1024); vhi[(ks) * ND + (d0)] = vtr(vpp + (d0) * 4096 + (ks) * 1024 + 512); } while (0)
#define ATT_VRDF(f) ATT_VRD((f) / ND, (f) % ND)
#define ATT_VFR(i) (bf16x8){vlo[i][0], vlo[i][1], vlo[i][2], vlo[i][3], vhi[i][0], vhi[i][1], vhi[i][2], vhi[i][3]}
#define ATT_PAF(g) __builtin_bit_cast(bf16x8, pw[g])
        unsigned long long pl0_ = 0; if (PROBE_ATT == 2) pl0_ = ATT_NOW(); if (PROBE_ATT == 4) pl0_ = __builtin_amdgcn_s_memtime();
#pragma unroll 1
        for (int t = t0; t <= t1; ++t) {
            const bool gk = (t + 4 <= t1), gv = (t + 2 <= t1);
            const int s_cur = (t - t0) & 3, s_prev = (t - t0 - 1) & 3, s_next = (t - t0 + 1) & 3, s_nn = (t - t0 + 2) & 3;
            const lds_cptr vpp = vp0 + s_prev * VSLOT;
            const lds_cptr kpn = kp0 + s_next * 8192;
            bool resc = false;
            ATT_SBAR();
            {
                s16x4 vlo[4 * ND], vhi[4 * ND];
                const bool msk = (t > vb) || (t < va);
                const bool nearb = !msk && (q0w - (t * 64 + 63)) < 128;
                if (nearb) {
                    const LAS float* tb = tab + (myq - t * 64 - 4 * hi + 64 - 27 - 32);
#pragma unroll
                    for (int r = 0; r < 16; ++r) { C1[r] = tb[27 - ((r & 3) + 8 * (r >> 2))] - mhat; C0[r] = tb[32 + 27 - ((r & 3) + 8 * (r >> 2))] - mhat; }
                    ATT_SBAR();
                    C0 = ATT_MFMA(kf[0], qr[0], C0); ATT_SBAR(); C1 = ATT_MFMA(kf[1], qr[0], C1); ATT_SBAR();
                } else {
                    f32x16 cfm; const float cfv = msk ? -1e30f : cf - mhat;
#pragma unroll
                    for (int r = 0; r < 16; ++r) cfm[r] = cfv;
                    ATT_SBAR();
                    C0 = ATT_MFMA(kf[0], qr[0], cfm); ATT_SBAR(); C1 = ATT_MFMA(kf[1], qr[0], cfm); ATT_SBAR();
                }
#pragma unroll
                for (int i = 2; i < 8; ++i) {
                    if (i >= 8 - VLEAD) { ATT_VRDF(i - (8 - VLEAD)); ATT_SBAR(); }
                    if (i & 1) C1 = ATT_MFMA(kf[i], qr[i >> 1], C1); else C0 = ATT_MFMA(kf[i], qr[i >> 1], C0);
                    ATT_SBAR();
                }
                if (gk) ATT_DMA_K(t + 4, s_cur);
                if (gv) ATT_DMA_V(t + 2, s_nn);
                const float rm = rowmax(C0, C1);
                const bool firstv = (t == va);
                if (__builtin_expect(firstv || __any(rm > THR), 0)) {
                    const float dl = firstv ? rm : fmaxf(rm, 0.f); mhat += dl;
#pragma unroll
                    for (int r = 0; r < 16; ++r) { C0[r] -= dl; C1[r] -= dl; }
                    const float f = firstv ? 1.f : __builtin_amdgcn_exp2f(-dl); l_reg *= f; if (hi == 0) wsf[r32] = f; resc = !firstv;
                }
                ATT_SBAR();
                float sa = 0.f, sb = 0.f;
#pragma unroll
                for (int m = 0; m < 4 * ND; ++m) {
                    const int g = m / ND, d0 = m % ND;
                    if (m + VLEAD < 4 * ND) { ATT_VRDF(m + VLEAD); ATT_SBAR(); }
                    if (m >= KRD0 && m < KRD0 + 4) { kload2(kf, kpn, m - KRD0); ATT_SBAR(); }
                    o[d0] = ATT_MFMA(ATT_PAF(g), ATT_VFR(g * ND + d0), o[d0]);
#pragma unroll
                    for (int jj = 0; jj < EPG; ++jj) ATT_CEXP(8 * g + EPG * d0 + jj);
                    if (g >= 1) {
#pragma unroll
                        for (int jj = 0; jj < EPG; jj += 2) { const int e = 8 * (g - 1) + EPG * d0 + jj; sa += ATT_CE(e); sb += ATT_CE(e + 1); pw[g - 1][(EPG * d0 + jj) >> 1] = pk2(ATT_CE(e), ATT_CE(e + 1)); }
                        ATT_PIN(pw[g - 1]); ATT_PIN(sa); ATT_PIN(sb);
                    }
                    if (g < 2) ATT_PIN(C0); else ATT_PIN(C1);
                    ATT_SBAR();
                }
#pragma unroll
                for (int jj = 0; jj < 8; jj += 2) { const int e = 24 + jj; sa += ATT_CE(e); sb += ATT_CE(e + 1); pw[3][jj >> 1] = pk2(ATT_CE(e), ATT_CE(e + 1)); }
                l_reg += sa + sb;
            }
            ATT_SBAR();
            unsigned long long pw0_ = 0; if (PROBE_ATT == 0) pw0_ = ATT_NOW();
            { const int dleft = t1 - t;
              if (dleft >= 4) { if (MODE) { ATT_WAIT_BAR(6); } else { ATT_WAIT_BAR(4); } }
              else if (dleft == 3) { if (MODE) { ATT_WAIT_BAR(5); } else { ATT_WAIT_BAR(3); } }
              else if (dleft == 2) { if (MODE) { ATT_WAIT_BAR(4); } else { ATT_WAIT_BAR(2); } }
              else if (dleft == 1) { if (MODE) { ATT_WAIT_BAR(2); } else { ATT_WAIT_BAR(1); } }
              else { ATT_WAIT_BAR(0); } }
            if (PROBE_ATT == 0) F.pacc += ATT_NOW() - pw0_;
            if (resc) {
#pragma unroll
                for (int r = 0; r < 16; ++r) { const float fr = wsf[crow(r, hi)];
#pragma unroll
                    for (int d0 = 0; d0 < ND; ++d0) o[d0][r] *= fr; }
            }
        }
        if (PROBE_ATT == 2) F.pacc += ATT_NOW() - pl0_; if (PROBE_ATT == 4) F.pacc += (__builtin_amdgcn_s_memtime() - pl0_) / 100;
        {
            const lds_cptr vpp = vp0 + ((t1 - t0) & 3) * VSLOT;
            s16x4 vlo[4 * ND], vhi[4 * ND];
#pragma unroll
            for (int ks = 0; ks < 4; ++ks) {
#pragma unroll
                for (int d0 = 0; d0 < ND; ++d0) ATT_VRD(ks, d0);
#pragma unroll
                for (int d0 = 0; d0 < ND; ++d0) o[d0] = ATT_MFMA(ATT_PAF(ks), ATT_VFR(ks * ND + d0), o[d0]);
            }
            asm volatile("s_waitcnt lgkmcnt(0)\n\ts_barrier" ::: "memory");
        }
#undef ATT_DMA_K
#undef ATT_DMA_V
#undef ATT_CE
#undef ATT_CEXP
#undef ATT_VRD
#undef ATT_VFR
#undef ATT_VRDF
#undef ATT_PAF
        float lh = l_reg;
        int ln = lane; asm volatile("" : "+v"(ln));
        const int e32 = ln & 31, ehi = ln >> 5;
        { auto rr = __builtin_amdgcn_permlane32_swap(__float_as_uint(lh), __float_as_uint(lh), false, false); lh = __uint_as_float(rr[0]) + __uint_as_float(rr[1]); }
        if (ehi == 0) wsf[32 + e32] = lh;
        LDS_WAIT();
        constexpr int SP = ND * 128 + 16;
        LAS unsigned char* stg = lds + wid * (32 * SP);
#pragma unroll
        for (int r = 0; r < 16; ++r) { const float rl = __builtin_amdgcn_rcpf(wsf[32 + crow(r, ehi)]);
#pragma unroll
            for (int d0 = 0; d0 < ND; ++d0) *(LAS float*)(stg + crow(r, ehi) * SP + (d0 * 32 + e32) * 4) = o[d0][r] * rl; }
        LDS_WAIT();
        const size_t tok0 = rowbase + (size_t)(qb * 256 + 32 * wid);
        if (MODE == 0) {
#pragma unroll 4
            for (int row = 0; row < 32; ++row) { const float v = *(const LAS float*)(stg + row * SP + ln * 4);
                if (F8OUT(l)) ((unsigned char*)y)[(tok0 + row) * D + 512 + hh * 64 + ln] = (unsigned char)(pk2_fp8(v * F8_Y, 0.f) & 0xffu); else y[(tok0 + row) * D + 512 + hh * 64 + ln] = cvt1(v); }
        } else if (sub == 0) {
#pragma unroll 4
            for (int row = 0; row < 32; ++row) { const f32x2 v = *(const LAS f32x2*)(stg + row * SP + ln * 8); *(f32x2*)(O1s + ((tok0 + row) * 4 + hh) * 128 + 2 * ln) = v; }
        } else {
            const float lam_init = l == 0 ? 0.2f : (float)(0.8 - 0.6 * 0.7408182206817179);
            const float lam = __expf(wave_sum(a.in[19][l * 64 + ln] * a.in[20][l * 64 + ln])) - __expf(wave_sum(a.in[21][l * 64 + ln] * a.in[22][l * 64 + ln])) + lam_init;
            const float* sw = a.in[23] + l * 128;
            const float sw0 = sw[2 * ln] * (1.f - lam_init), sw1 = sw[2 * ln + 1] * (1.f - lam_init);
#pragma unroll 2
            for (int row = 0; row < 32; ++row) { const f32x2 v2 = *(const LAS f32x2*)(stg + row * SP + ln * 8); const f32x2 o1 = *(const f32x2*)(O1s + ((tok0 + row) * 4 + hh) * 128 + 2 * ln);
                const float v0 = o1.x - lam * v2.x, v1 = o1.y - lam * v2.y;
                const float ms = wave_sum(v0 * v0 + v1 * v1);
                const float rs = rsqrtf(ms * (1.f / 128.f) + 1e-5f);
                if (F8OUT(l)) *(unsigned short*)((unsigned char*)y + (tok0 + row) * D + 1024 + hh * 128 + 2 * ln) = (unsigned short)pk2_fp8(v0 * rs * sw0 * F8_Y, v1 * rs * sw1 * F8_Y);
                else *(unsigned*)(y + (tok0 + row) * D + 1024 + hh * 128 + 2 * ln) = pk2(v0 * rs * sw0, v1 * rs * sw1); }
        }
        asm volatile("s_waitcnt vmcnt(0) lgkmcnt(0)\n\ts_barrier" ::: "memory");
    }
    if (PROBE_ATT == 3) F.pacc += ATT_NOW() - pu0_;
}

__device__ __forceinline__ void conv_items(Frame& F, const Args& a, const int l, const int start, const int stride) {
    using namespace cfg;
    const bf16* p = (const bf16*)(F.ws + wsm::P); bf16* y = (bf16*)(F.ws + wsm::Y);
    const float* cw = a.in[24] + l * 3 * 512;
    for (int it = start; it < M * 64; it += stride) {
        const int tok = it >> 6, cg = (it & 63) * 8, t = tok & (SEQ - 1);
        const bf16* r0 = p + (size_t)tok * INC + OFF_D + cg;
        const u32x4 bg = *(const u32x4*)r0;
        u32x4 c0 = *(const u32x4*)(r0 + 512), h0 = *(const u32x4*)(r0 + 1024);
        u32x4 c1 = (u32x4){0, 0, 0, 0}, h1 = c1, c2 = c1, h2 = c1;
        if (t >= 1) { c1 = *(const u32x4*)(r0 - INC + 512); h1 = *(const u32x4*)(r0 - INC + 1024); }
        if (t >= 2) { c2 = *(const u32x4*)(r0 - 2 * INC + 512); h2 = *(const u32x4*)(r0 - 2 * INC + 1024); }
        unsigned ow[4];
#pragma unroll
        for (int j = 0; j < 4; ++j) {
            float res[2];
#pragma unroll
            for (int e = 0; e < 2; ++e) {
                const int ch = cg + 2 * j + e;
#define ATT_UP(w) (e ? __uint_as_float((w) & 0xffff0000u) : __uint_as_float((w) << 16))
                const float u0 = ATT_UP(c0[j]) * ATT_UP(h0[j]), u1 = ATT_UP(c1[j]) * ATT_UP(h1[j]), u2 = ATT_UP(c2[j]) * ATT_UP(h2[j]);
                res[e] = ATT_UP(bg[j]) * (cw[ch] * u2 + cw[512 + ch] * u1 + cw[1024 + ch] * u0);
#undef ATT_UP
            }
            ow[j] = (F8OUT(l)) ? pk2_fp8(res[0] * F8_Y, res[1] * F8_Y) : pk2(res[0], res[1]);
        }
        if (F8OUT(l)) *(u32x2*)((unsigned char*)y + (size_t)tok * D + 1536 + cg) = (u32x2){ow[0] | (ow[1] << 16), ow[2] | (ow[3] << 16)};
        else *(u32x4*)(y + (size_t)tok * D + 1536 + cg) = (u32x4){ow[0], ow[1], ow[2], ow[3]};
    }
}
}
namespace rw {
constexpr int PB = 144, PB2 = 272;
constexpr int SLOT = 9216;
constexpr int R0 = 0, R1B = 49152;
constexpr int O_P0 = 0, O_P0T = 9216, O_AAK = 18432, O_ARB = 27648, O_ARK = 36864;
constexpr int O_SEG = R1B + 9 * SLOT, O_BON = O_SEG + 2048;
constexpr size_t UNIT_BYTES = 49152;
constexpr size_t WL_OFF = (size_t)4096 * UNIT_BYTES;
#define RW_S(i) (R1B + (i) * SLOT)

__device__ __forceinline__ bf16x8 ldfrag(const LAS unsigned char* base, int pitch, int row0, int lane, int s) {
    return *(const LAS bf16x8*)(base + (row0 + (lane & 15)) * pitch + (32 * s + 8 * (lane >> 4)) * 2);
}
template <int KS>
__device__ __forceinline__ f32x4 tile_mm(f32x4 acc, const LAS unsigned char* X, int px, int m0, const LAS unsigned char* Y, int py, int n0, int lane) {
#pragma unroll
    for (int s = 0; s < KS; ++s) acc = __builtin_amdgcn_mfma_f32_16x16x32_bf16(ldfrag(Y, py, n0, lane, s), ldfrag(X, px, m0, lane, s), acc, 0, 0, 0);
    return acc;
}
__device__ __forceinline__ void st_rm(LAS unsigned char* base, int pitch, int m, int n0, f32x4 v) {
    u32x2 w; w.x = pk2(v[0], v[1]); w.y = pk2(v[2], v[3]); *(LAS u32x2*)(base + m * pitch + n0 * 2) = w;
}
__device__ __forceinline__ void st_tr(LAS unsigned char* base, int pitch, int m, int n0, f32x4 v) {
    const unsigned p01 = pk2(v[0], v[1]), p23 = pk2(v[2], v[3]);
    *(LAS bf16*)(base + (n0 + 0) * pitch + m * 2) = (bf16)(p01 & 0xffffu); *(LAS bf16*)(base + (n0 + 1) * pitch + m * 2) = (bf16)(p01 >> 16);
    *(LAS bf16*)(base + (n0 + 2) * pitch + m * 2) = (bf16)(p23 & 0xffffu); *(LAS bf16*)(base + (n0 + 3) * pitch + m * 2) = (bf16)(p23 >> 16);
}
__device__ __forceinline__ f32x4 ld_rm(const LAS unsigned char* base, int pitch, int m, int n0) {
    const u32x2 w = *(const LAS u32x2*)(base + m * pitch + n0 * 2);
    return (f32x4){__uint_as_float(w.x << 16), __uint_as_float(w.x & 0xffff0000u), __uint_as_float(w.y << 16), __uint_as_float(w.y & 0xffff0000u)};
}
__device__ __forceinline__ void unpack8(const u32x4 w, float* f) {
#pragma unroll
    for (int j = 0; j < 4; ++j) { f[2 * j] = __uint_as_float(w[j] << 16); f[2 * j + 1] = __uint_as_float(w[j] & 0xffff0000u); }
}
__device__ __forceinline__ u32x4 pack8(const float* f) { return (u32x4){pk2(f[0], f[1]), pk2(f[2], f[3]), pk2(f[4], f[5]), pk2(f[6], f[7])}; }
__device__ __forceinline__ float sigm(float x) { return __builtin_amdgcn_rcpf(1.f + __expf(-x)); }
#define RW_BAR() do { asm volatile("s_waitcnt lgkmcnt(0)" ::: "memory"); __builtin_amdgcn_s_barrier(); asm volatile("" ::: "memory"); } while (0)

#ifndef PROBE_R1
#define PROBE_R1 -1
#endif
#define R1_STAMP(k) do { if (PROBE_R1 >= 0) { const unsigned long long now_ = __builtin_amdgcn_s_memrealtime(); if (PROBE_R1 == (k)) racc += now_ - rlast; rlast = now_; } } while (0)
struct R1Raw { u32x4 c[3], p[3]; bf16x8 fl[8]; };
__device__ __forceinline__ void r1_load(Frame& F, const int u, R1Raw& raw, const int tid) {
    using namespace cfg;
    const int c = u & 63, h = (u >> 6) & 7, b = u >> 9, t = tid >> 3, j0 = (tid & 7) * 8, lane = tid & 63;
    const size_t tok0 = (size_t)b * SEQ + c * 64;
    const bf16* cur = (const bf16*)(F.ws + wsm::P) + (tok0 + t) * INC + j0; const bf16* prv = cur - INC;
#pragma unroll
    for (int i = 0; i < 3; ++i) { const int col = i * 512 + h * 64; raw.c[i] = *(const u32x4*)(cur + col); raw.p[i] = *(const u32x4*)(prv + col); }
    const bf16* lr = (const bf16*)(F.ws + wsm::LORA) + (tok0 + 16 * (F.wave >> 1) + (lane & 15)) * 256 + 8 * (lane >> 4);
#pragma unroll
    for (int s2 = 0; s2 < 2; ++s2) { raw.fl[s2] = *(const bf16x8*)(lr + 32 * s2); raw.fl[2 + s2] = *(const bf16x8*)(lr + 64 + 32 * s2); }
#pragma unroll
    for (int s2 = 0; s2 < 4; ++s2) raw.fl[4 + s2] = *(const bf16x8*)(lr + 128 + 32 * s2);
}
struct R1W { bf16x8 fw[2][2], fa[2][2], fg[2][4]; };
__device__ __forceinline__ void lora_prepass(Frame& F, const Args& a, const int l) {
    using namespace cfg;
    const bf16* p = (const bf16*)(F.ws + wsm::P); bf16* lora = (bf16*)(F.ws + wsm::LORA);
    const float* mu = a.in[6] + l * 1792 + 1536;
    for (int it = F.vcu * 512 + F.tid; it < M * 32; it += F.G * 512) {
        const int tok = it >> 5, cg = (it & 31) * 8;
        const bf16* cur = p + (size_t)tok * INC + 1536 + cg;
        float cv[8], pv[8], x[8];
        unpack8(*(const u32x4*)cur, cv);
        if ((tok & (SEQ - 1)) != 0) unpack8(*(const u32x4*)(cur - INC), pv); else {
#pragma unroll
            for (int j = 0; j < 8; ++j) pv[j] = 0.f; }
        const f32x4 m0 = *(const f32x4*)(mu + cg), m1 = *(const f32x4*)(mu + cg + 4);
#pragma unroll
        for (int j = 0; j < 8; ++j) { const float mj = j < 4 ? m0[j] : m1[j - 4]; x[j] = cv[j] + (pv[j] - cv[j]) * mj; }
        if (cg < 64) {
#pragma unroll
            for (int j = 0; j < 8; ++j) { const float e2 = __expf(2.f * x[j]); x[j] = 1.f - 2.f * __builtin_amdgcn_rcpf(e2 + 1.f); }
        } else if (cg >= 128) {
#pragma unroll
            for (int j = 0; j < 8; ++j) x[j] = sigm(x[j]);
        }
        *(u32x4*)(lora + (size_t)tok * 256 + cg) = pack8(x);
    }
}
__device__ __forceinline__ void r1_unit(Frame& F, const Args& a, const int l, const int u, const int unext, R1Raw& raw, R1W& W, unsigned long long& racc, int& hcur) {
    using namespace cfg;
    unsigned long long rlast = PROBE_R1 >= 0 ? __builtin_amdgcn_s_memrealtime() : 0ull;
    int tid_ = F.tid; asm volatile("" : "+v"(tid_));
    const int tid = tid_, lane = tid & 63, w = F.wave;
    const int c = u & 63, h = (u >> 6) & 7, b = u >> 9;
    unsigned lbase_ = (unsigned)(uintptr_t)F.lds; asm volatile("" : "+s"(lbase_));
    LAS unsigned char* lds = (LAS unsigned char*)(uintptr_t)lbase_;
    const bf16* p = (const bf16*)(F.ws + wsm::P);
    const bf16* w2t = (const bf16*)(F.ws + wsm::WRT + 262144);
    const bf16* a2t = w2t + 512 * 64; const bf16* g2t = a2t + 512 * 64;
    unsigned char* gout = F.ws + wsm::RW + (size_t)u * UNIT_BYTES;
    float* wl_out = (float*)(F.ws + wsm::RW + WL_OFF) + (size_t)u * 64;
    const float* mu = a.in[6] + l * 1792;
    const size_t tok0 = (size_t)b * SEQ + c * 64;
    const int t = tid >> 3, j0 = (tid & 7) * 8;
    const bool hasprev = (c > 0) || (t > 0);
    const bf16* cur = p + (tok0 + t) * INC; const bf16* prv = cur - INC;
    LAS float* WPRE = (LAS float*)(lds + 0); LAS float* APRE = (LAS float*)(lds + 16384); LAS float* GG = (LAS float*)(lds + 32768);
    LAS float* PAR = (LAS float*)(lds + 134400);
    const int mtA = w >> 1;
    if (h != hcur) {
        RW_BAR();
        if (w < 7) { const int pidx = w == 0 ? 7 : (w == 1 ? 9 : 10 + w); PAR[w * 64 + lane] = a.in[pidx][l * 512 + h * 64 + lane]; }
        if (tid < 448) { const int col = tid < 192 ? (tid >> 6) * 512 + h * 64 + (tid & 63) : 1536 + (tid - 192); PAR[448 + tid] = mu[col]; }
        hcur = h;
#pragma unroll
        for (int q = 0; q < 2; ++q) { const int ch = h * 64 + 16 * (2 * (w & 1) + q) + (lane & 15);
#pragma unroll
            for (int s2 = 0; s2 < 2; ++s2) { const int kq = 32 * s2 + 8 * (lane >> 4); W.fw[q][s2] = *(const bf16x8*)(w2t + ch * 64 + kq); W.fa[q][s2] = *(const bf16x8*)(a2t + ch * 64 + kq); }
#pragma unroll
            for (int s2 = 0; s2 < 4; ++s2) W.fg[q][s2] = *(const bf16x8*)(g2t + ch * 128 + 32 * s2 + 8 * (lane >> 4)); }
        RW_BAR();
    }
    float r[8], k[8], v[8];
    {
        auto mix8 = [&](int i, int mo, float* o) { float cv[8], pv[8], m8[8]; unpack8(raw.c[i], cv);
            if (hasprev) unpack8(raw.p[i], pv); else {
#pragma unroll
                for (int j = 0; j < 8; ++j) pv[j] = 0.f; }
            *(f32x4*)m8 = *(const LAS f32x4*)(PAR + 448 + mo); *(f32x4*)(m8 + 4) = *(const LAS f32x4*)(PAR + 448 + mo + 4);
#pragma unroll
            for (int j = 0; j < 8; ++j) o[j] = cv[j] + (pv[j] - cv[j]) * m8[j]; };
        mix8(0, j0, r); mix8(1, 64 + j0, k); mix8(2, 128 + j0, v);
    }
    R1_STAMP(0);
    {
#pragma unroll
        for (int q = 0; q < 2; ++q) { const int nt = 2 * (w & 1) + q;
            f32x4 aw = {0.f, 0.f, 0.f, 0.f}, aa = aw, ag = aw;
#pragma unroll
            for (int s2 = 0; s2 < 2; ++s2) {
                aw = __builtin_amdgcn_mfma_f32_16x16x32_bf16(W.fw[q][s2], raw.fl[s2], aw, 0, 0, 0);
                aa = __builtin_amdgcn_mfma_f32_16x16x32_bf16(W.fa[q][s2], raw.fl[2 + s2], aa, 0, 0, 0); }
#pragma unroll
            for (int s2 = 0; s2 < 4; ++s2) ag = __builtin_amdgcn_mfma_f32_16x16x32_bf16(W.fg[q][s2], raw.fl[4 + s2], ag, 0, 0, 0);
            const int m = 16 * mtA + (lane & 15), n0 = 16 * nt + 4 * (lane >> 4);
            const f32x4 w04 = *(const LAS f32x4*)(PAR + n0), a04 = *(const LAS f32x4*)(PAR + 64 + n0);
#pragma unroll
            for (int i = 0; i < 4; ++i) { const float nx = -(w04[i] + aw[i]); const float sp = nx > 20.f ? nx : __logf(1.f + __expf(nx)); aw[i] = -__expf(-sp - 0.5f); aa[i] = sigm(a04[i] + aa[i]); }
            *(LAS f32x4*)(WPRE + m * 64 + n0) = aw; *(LAS f32x4*)(APRE + m * 64 + n0) = aa; *(LAS f32x4*)(GG + m * 64 + n0) = ag; }
    }
    r1_load(F, unext, raw, tid);
    RW_BAR(); R1_STAMP(1); R1_STAMP(2);
    {
        LAS float* SEG = (LAS float*)(lds + O_SEG);
        const int ch = tid & 63, seg = tid >> 6;
        float pf[8]; float run = 0.f;
#pragma unroll
        for (int i = 0; i < 8; ++i) { run += WPRE[(8 * seg + i) * 64 + ch]; pf[i] = run; }
        SEG[seg * 64 + ch] = run;
        RW_BAR();
        float off = 0.f;
        for (int s2 = 0; s2 < seg; ++s2) off += SEG[s2 * 64 + ch];
#pragma unroll
        for (int i = 0; i < 8; ++i) WPRE[(8 * seg + i) * 64 + ch] = off + pf[i];
    }
    RW_BAR(); R1_STAMP(3);
    {
        float kk[8], k2[8], aic[8]; float ss = 0.f, bon = 0.f;
        { float pkk[8], pka[8], prk[8];
#define R1_LD8(dst, src) do { *(f32x4*)(dst) = *(const LAS f32x4*)(src); *(f32x4*)((dst) + 4) = *(const LAS f32x4*)((src) + 4); } while (0)
          R1_LD8(aic, APRE + t * 64 + j0); R1_LD8(pkk, PAR + 128 + j0); R1_LD8(pka, PAR + 192 + j0); R1_LD8(prk, PAR + 256 + j0);
#undef R1_LD8
#pragma unroll
          for (int j = 0; j < 8; ++j) { kk[j] = k[j] * pkk[j]; ss += kk[j] * kk[j]; k2[j] = k[j] * (1.f + (aic[j] - 1.f) * pka[j]); bon += r[j] * k2[j] * prk[j]; } }
        ss += __shfl_xor(ss, 1); ss += __shfl_xor(ss, 2); ss += __shfl_xor(ss, 4);
        bon += __shfl_xor(bon, 1); bon += __shfl_xor(bon, 2); bon += __shfl_xor(bon, 4);
        const float inv = 1.f / fmaxf(sqrtf(ss), 1e-12f);
        unsigned g1w[4], g0w[4];
#pragma unroll
        for (int jp = 0; jp < 8; jp += 2) {
            const f32x2 cum = *(const LAS f32x2*)(WPRE + t * 64 + j0 + jp), tot = *(const LAS f32x2*)(WPRE + 63 * 64 + j0 + jp), gg = *(const LAS f32x2*)(GG + t * 64 + j0 + jp);
            f32x2 cpv = {0.f, 0.f}; if (t > 0) cpv = *(const LAS f32x2*)(WPRE + (t - 1) * 64 + j0 + jp);
            const f32x2 pgw = *(const LAS f32x2*)(PAR + 320 + j0 + jp), pgb = *(const LAS f32x2*)(PAR + 384 + j0 + jp);
            float xa[2], xr[2], xb[2], xk[2], xbh[2], xkh[2], g1[2], g0[2];
#pragma unroll
            for (int e = 0; e < 2; ++e) { const int j = jp + e; const float kn = kk[j] * inv, bv = kn * aic[j];
                const float e_ex = __expf(cpv[e]), e_in = __expf(cum[e]), e_ng = __expf(-cum[e]), e_tt = __expf(tot[e] - cum[e]);
                xa[e] = -kn * e_ex; xr[e] = r[j] * e_in; xb[e] = bv * e_ng; xk[e] = k2[j] * e_ng; xbh[e] = bv * e_tt; xkh[e] = k2[j] * e_tt;
                g1[e] = pgw[e] * gg[e]; g0[e] = (pgb[e] + bon * v[j]) * gg[e];
                if (t == 63) wl_out[j0 + j] = __expf(tot[e]); }
            const unsigned pa = pk2(xa[0], xa[1]), pr = pk2(xr[0], xr[1]), pb = pk2(xb[0], xb[1]), pkn = pk2(xk[0], xk[1]), pv2 = pk2(v[jp], v[jp + 1]), pbh = pk2(xbh[0], xbh[1]), pkh = pk2(xkh[0], xkh[1]);
            *(LAS unsigned*)(lds + RW_S(0) + t * PB + (j0 + jp) * 2) = pa; *(LAS unsigned*)(lds + RW_S(1) + t * PB + (j0 + jp) * 2) = pr;
            *(LAS unsigned*)(lds + RW_S(2) + t * PB + (j0 + jp) * 2) = pb; *(LAS unsigned*)(lds + RW_S(3) + t * PB + (j0 + jp) * 2) = pkn;
            *(LAS bf16*)(lds + RW_S(4) + (j0 + jp) * PB + t * 2) = (bf16)(pa & 0xffffu); *(LAS bf16*)(lds + RW_S(4) + (j0 + jp + 1) * PB + t * 2) = (bf16)(pa >> 16);
            *(LAS bf16*)(lds + RW_S(5) + (j0 + jp) * PB + t * 2) = (bf16)(pv2 & 0xffffu); *(LAS bf16*)(lds + RW_S(5) + (j0 + jp + 1) * PB + t * 2) = (bf16)(pv2 >> 16);
            *(LAS bf16*)(lds + RW_S(6) + (j0 + jp) * PB + t * 2) = (bf16)(pbh & 0xffffu); *(LAS bf16*)(lds + RW_S(6) + (j0 + jp + 1) * PB + t * 2) = (bf16)(pbh >> 16);
            *(LAS bf16*)(lds + RW_S(7) + (j0 + jp) * PB + t * 2) = (bf16)(pkh & 0xffffu); *(LAS bf16*)(lds + RW_S(7) + (j0 + jp + 1) * PB + t * 2) = (bf16)(pkh >> 16);
            g1w[jp >> 1] = pk2(g1[0], g1[1]); g0w[jp >> 1] = pk2(g0[0], g0[1]);
        }
        *(u32x4*)(gout + 32768 + (t * 64 + j0) * 2) = (u32x4){g1w[0], g1w[1], g1w[2], g1w[3]};
        *(u32x4*)(gout + 40960 + (t * 64 + j0) * 2) = (u32x4){g0w[0], g0w[1], g0w[2], g0w[3]};
    }
    RW_BAR(); R1_STAMP(4);
    {
        const int mi = w >> 1;
        const LAS unsigned char* X = lds + RW_S(mi < 2 ? 0 : 1); const LAS unsigned char* Y = lds + RW_S((mi & 1) ? 3 : 2);
        LAS unsigned char* dst = lds + (mi == 0 ? O_P0 : mi == 1 ? O_AAK : mi == 2 ? O_ARB : O_ARK);
        const bool incl = mi >= 2;
#pragma unroll
        for (int q = 0; q < 2; ++q) { const int mt = 2 * (w & 1) + q; const int m = 16 * mt + (lane & 15);
#pragma unroll
            for (int nt = 0; nt < 4; ++nt) { f32x4 acc = {0.f, 0.f, 0.f, 0.f};
                if (nt <= mt) acc = tile_mm<2>(acc, X, PB, 16 * mt, Y, PB, 16 * nt, lane);
                const int n0 = 16 * nt + 4 * (lane >> 4);
#pragma unroll
                for (int i = 0; i < 4; ++i) { const int n = n0 + i; if (!(incl ? n <= m : n < m)) acc[i] = 0.f; }
                st_rm(dst, PB, m, n0, acc);
                if (mi == 0) st_tr(lds + O_P0T, PB, m, n0, acc); } }
    }
    RW_BAR(); R1_STAMP(5);
    {
        f32x4 T[4];
        const int wr = w & 3, m = 16 * wr + (lane & 15);
        LAS unsigned char* Trm = lds + RW_S(8);
        if (w < 4) {
#pragma unroll
            for (int nt = 0; nt < 4; ++nt) { const int n0 = 16 * nt + 4 * (lane >> 4); T[nt] = ld_rm(lds + O_P0, PB, m, n0);
#pragma unroll
                for (int i = 0; i < 4; ++i) if (n0 + i == m) T[nt][i] += 1.f;
                st_rm(Trm, PB, m, n0, T[nt]); }
#pragma unroll
            for (int nt = 0; nt < 4; ++nt) { f32x4 acc = {0.f, 0.f, 0.f, 0.f}; acc = tile_mm<2>(acc, lds + RW_S(5), PB, 16 * wr, lds + O_AAK, PB, 16 * nt, lane); st_rm(lds + RW_S(0), PB, m, 16 * nt + 4 * (lane >> 4), acc); }
        } else {
#pragma unroll
            for (int nt = 0; nt < 4; ++nt) { f32x4 acc = {0.f, 0.f, 0.f, 0.f}; acc = tile_mm<2>(acc, lds + O_P0, PB, 16 * wr, lds + O_P0T, PB, 16 * nt, lane);
                const int n0 = 16 * nt + 4 * (lane >> 4); st_rm(lds + RW_S(2), PB, m, n0, acc); st_tr(lds + RW_S(3), PB, m, n0, acc); }
        }
        RW_BAR();
#pragma unroll 1
        for (int s = 1; s <= 5; ++s) {
            const int cb = s & 1;
            const LAS unsigned char* Pc = lds + (cb ? RW_S(2) : O_P0); const LAS unsigned char* PcT = lds + (cb ? RW_S(3) : O_P0T);
            LAS unsigned char* Pn = lds + (cb ? O_P0 : RW_S(2)); LAS unsigned char* PnT = lds + (cb ? O_P0T : RW_S(3));
            if (w < 4) {
                f32x4 d[4];
#pragma unroll
                for (int nt = 0; nt < 4; ++nt) { d[nt] = (f32x4){0.f, 0.f, 0.f, 0.f}; d[nt] = tile_mm<2>(d[nt], Trm, PB, 16 * wr, PcT, PB, 16 * nt, lane); }
                LDS_WAIT();
#pragma unroll
                for (int nt = 0; nt < 4; ++nt) { T[nt] += d[nt]; st_rm(Trm, PB, m, 16 * nt + 4 * (lane >> 4), T[nt]); }
            } else if (s < 5) {
#pragma unroll
                for (int nt = 0; nt < 4; ++nt) { f32x4 acc = {0.f, 0.f, 0.f, 0.f}; acc = tile_mm<2>(acc, Pc, PB, 16 * wr, PcT, PB, 16 * nt, lane);
                    const int n0 = 16 * nt + 4 * (lane >> 4); st_rm(Pn, PB, m, n0, acc); st_tr(PnT, PB, m, n0, acc); }
            }
            RW_BAR();
        }
    }
    R1_STAMP(6);
    {
        const LAS unsigned char* Z = lds + (w < 4 ? RW_S(4) : RW_S(0)); const int zr0 = 16 * (w & 3);
        f32x4 acc[4];
#pragma unroll
        for (int nt = 0; nt < 4; ++nt) { acc[nt] = (f32x4){0.f, 0.f, 0.f, 0.f}; acc[nt] = tile_mm<2>(acc[nt], Z, PB, zr0, lds + RW_S(8), PB, 16 * nt, lane); }
#pragma unroll
        for (int nt = 0; nt < 4; ++nt) st_rm(lds + RW_S(2), PB, 16 * w + (lane & 15), 16 * nt + 4 * (lane >> 4), acc[nt]);
    }
    RW_BAR(); R1_STAMP(7);
    {
        const int job = w >> 1;
        const LAS unsigned char* XTt = lds + RW_S(2); const LAS unsigned char* XTb = lds + RW_S(2) + 64 * PB;
#pragma unroll
        for (int q = 0; q < 2; ++q) { const int mt = 2 * (w & 1) + q; const int m = 16 * mt + (lane & 15);
#pragma unroll
            for (int nt = 0; nt < 4; ++nt) { f32x4 acc = {0.f, 0.f, 0.f, 0.f}; const int n0 = 16 * nt + 4 * (lane >> 4);
                if (job == 0) { acc = ld_rm(lds + RW_S(1), PB, m, n0); acc = tile_mm<2>(acc, lds + O_ARB, PB, 16 * mt, XTt, PB, 16 * nt, lane); }
                else if (job == 1) { acc = tile_mm<2>(acc, lds + O_ARB, PB, 16 * mt, XTb, PB, 16 * nt, lane); acc = tile_mm<2>(acc, lds + O_ARK, PB, 16 * mt, lds + RW_S(5), PB, 16 * nt, lane); }
                else if (job == 2) { acc = tile_mm<2>(acc, lds + RW_S(6), PB, 16 * mt, XTt, PB, 16 * nt, lane); }
                else { acc = tile_mm<2>(acc, XTb, PB, 16 * mt, lds + RW_S(6), PB, 16 * nt, lane); acc = tile_mm<2>(acc, lds + RW_S(5), PB, 16 * mt, lds + RW_S(7), PB, 16 * nt, lane); }
                u32x2 o; o.x = pk2(acc[0], acc[1]); o.y = pk2(acc[2], acc[3]);
                *(u32x2*)(gout + job * 8192 + (m * 64 + n0) * 2) = o; } }
    }
    RW_BAR(); R1_STAMP(8);
}

__device__ __forceinline__ void r2_unit(Frame& F, const Args& a, const int l, const int bh) {
    using namespace cfg;
    const int lane = F.lane, w = F.wave, wr = w & 3;
    LAS unsigned char* lds = F.lds;
    bf16* y = (bf16*)(F.ws + wsm::Y);
    const unsigned char* gin = F.ws + wsm::RW + (size_t)bh * 64 * UNIT_BYTES;
    const float* wlp = (const float*)(F.ws + wsm::RW + WL_OFF) + (size_t)bh * 64 * 64;
    const int b = bh >> 3, h = bh & 7;
    const int m = 16 * wr + (lane & 15), q4 = 4 * (lane >> 4);
    if (w < 4) {
        f32x4 S[4];
#pragma unroll
        for (int nt = 0; nt < 4; ++nt) { S[nt] = (f32x4){0.f, 0.f, 0.f, 0.f}; st_rm(lds, PB, m, 16 * nt + q4, S[nt]); }
        bf16x8 mtf[4][2], mtn[4][2]; u32x2 cf[4], cfn[4]; f32x4 wl[4], wln[4];
#define R2_LDS(c_, M_, C_, W_) do { const unsigned char* g_ = gin + (size_t)(c_) * UNIT_BYTES; _Pragma("unroll") for (int nt = 0; nt < 4; ++nt) { \
            _Pragma("unroll") for (int s_ = 0; s_ < 2; ++s_) M_[nt][s_] = *(const bf16x8*)(g_ + 16384 + ((16 * nt + (lane & 15)) * 64 + 32 * s_ + 8 * (lane >> 4)) * 2); \
            C_[nt] = *(const u32x2*)(g_ + 24576 + (m * 64 + 16 * nt + q4) * 2); W_[nt] = *(const f32x4*)(wlp + (c_) * 64 + 16 * nt + q4); } } while (0)
        R2_LDS(0, mtf, cf, wl);
#pragma unroll 1
        for (int c = 0; c < 64; ++c) {
            LAS unsigned char* Scur = lds + (c & 1) * SLOT; LAS unsigned char* Snxt = lds + ((c + 1) & 1) * SLOT;
            const int cn = c < 63 ? c + 1 : 63;
            R2_LDS(cn, mtn, cfn, wln);
            RW_BAR();
            bf16x8 sf[2];
#pragma unroll
            for (int s = 0; s < 2; ++s) sf[s] = ldfrag(Scur, PB, 16 * wr, lane, s);
#pragma unroll
            for (int nt = 0; nt < 4; ++nt) {
                f32x4 acc = S[nt] * wl[nt];
                acc[0] += __uint_as_float(cf[nt].x << 16); acc[1] += __uint_as_float(cf[nt].x & 0xffff0000u); acc[2] += __uint_as_float(cf[nt].y << 16); acc[3] += __uint_as_float(cf[nt].y & 0xffff0000u);
#pragma unroll
                for (int s = 0; s < 2; ++s) acc = __builtin_amdgcn_mfma_f32_16x16x32_bf16(mtf[nt][s], sf[s], acc, 0, 0, 0);
                S[nt] = acc; st_rm(Snxt, PB, m, 16 * nt + q4, acc); }
#pragma unroll
            for (int nt = 0; nt < 4; ++nt) { mtf[nt][0] = mtn[nt][0]; mtf[nt][1] = mtn[nt][1]; cf[nt] = cfn[nt]; wl[nt] = wln[nt]; }
        }
#undef R2_LDS
    } else {
        bf16x8 rf[2], rfn[2]; u32x2 y0[4], g1[4], g0[4], y0n[4], g1n[4], g0n[4];
#define R2_LDY(c_, R_, Y_, G1_, G0_) do { const unsigned char* g_ = gin + (size_t)(c_) * UNIT_BYTES; \
            _Pragma("unroll") for (int s_ = 0; s_ < 2; ++s_) R_[s_] = *(const bf16x8*)(g_ + (m * 64 + 32 * s_ + 8 * (lane >> 4)) * 2); \
            _Pragma("unroll") for (int nt = 0; nt < 4; ++nt) { const int o_ = (m * 64 + 16 * nt + q4) * 2; Y_[nt] = *(const u32x2*)(g_ + 8192 + o_); G1_[nt] = *(const u32x2*)(g_ + 32768 + o_); G0_[nt] = *(const u32x2*)(g_ + 40960 + o_); } } while (0)
        R2_LDY(0, rf, y0, g1, g0);
#pragma unroll 1
        for (int c = 0; c < 64; ++c) {
            LAS unsigned char* Scur = lds + (c & 1) * SLOT;
            const int cn = c < 63 ? c + 1 : 63;
            R2_LDY(cn, rfn, y0n, g1n, g0n);
            RW_BAR();
            f32x4 Y[4]; float sum = 0.f;
#pragma unroll
            for (int nt = 0; nt < 4; ++nt) {
                f32x4 acc = {__uint_as_float(y0[nt].x << 16), __uint_as_float(y0[nt].x & 0xffff0000u), __uint_as_float(y0[nt].y << 16), __uint_as_float(y0[nt].y & 0xffff0000u)};
#pragma unroll
                for (int s = 0; s < 2; ++s) acc = __builtin_amdgcn_mfma_f32_16x16x32_bf16(ldfrag(Scur, PB, 16 * nt, lane, s), rf[s], acc, 0, 0, 0);
                Y[nt] = acc; sum += (acc[0] + acc[1]) + (acc[2] + acc[3]); }
            sum += __shfl_xor(sum, 16); sum += __shfl_xor(sum, 32);
            const float mean = sum * (1.f / 64.f); float var = 0.f;
#pragma unroll
            for (int nt = 0; nt < 4; ++nt)
#pragma unroll
                for (int i = 0; i < 4; ++i) { const float d = Y[nt][i] - mean; var += d * d; }
            var += __shfl_xor(var, 16); var += __shfl_xor(var, 32);
            const float rs = rsqrtf(var * (1.f / 64.f) + 64e-5f);
            bf16* yo = y + ((size_t)b * SEQ + c * 64 + m) * D + h * 64;
#pragma unroll
            for (int nt = 0; nt < 4; ++nt) {
                const f32x4 a1 = {__uint_as_float(g1[nt].x << 16), __uint_as_float(g1[nt].x & 0xffff0000u), __uint_as_float(g1[nt].y << 16), __uint_as_float(g1[nt].y & 0xffff0000u)};
                const f32x4 a0 = {__uint_as_float(g0[nt].x << 16), __uint_as_float(g0[nt].x & 0xffff0000u), __uint_as_float(g0[nt].y << 16), __uint_as_float(g0[nt].y & 0xffff0000u)};
                const f32x4 o = (Y[nt] - mean) * rs * a1 + a0;
                if (F8OUT(l)) *(unsigned*)((unsigned char*)y + ((size_t)b * SEQ + c * 64 + m) * D + h * 64 + 16 * nt + q4) = pk4_fp8(o[0] * F8_Y, o[1] * F8_Y, o[2] * F8_Y, o[3] * F8_Y);
                else { u32x2 ow; ow.x = pk2(o[0], o[1]); ow.y = pk2(o[2], o[3]); *(u32x2*)(yo + 16 * nt + q4) = ow; } }
            rf[0] = rfn[0]; rf[1] = rfn[1];
#pragma unroll
            for (int nt = 0; nt < 4; ++nt) { y0[nt] = y0n[nt]; g1[nt] = g1n[nt]; g0[nt] = g0n[nt]; }
        }
#undef R2_LDY
    }
    RW_BAR();
}
}
struct MoeOrder {
    const LAS int* pref; int G, c, npn, mode;
    const char* A; const char* B; const int* lists; const float* wl; int esz;
    __device__ __forceinline__ bool next(int i, pg8::Unit& u) const {
        const int total = __builtin_amdgcn_readfirstlane(pref[32]) * npn;
        const long L = (long)i * G + c; if (L >= total) return false;
        int wgid = (int)L; { const int q = total / 8, r = total % 8, xcd = wgid % 8, off = wgid / 8; wgid = (xcd < r ? xcd * (q + 1) : r * (q + 1) + (xcd - r) * q) + off; }
        const int panel = wgid / npn, pn = wgid % npn;
        int e = 0;
        for (int k = 1; k < 32; ++k) { const int pk = __builtin_amdgcn_readfirstlane(pref[k]); if (pk <= panel) e = k; }
        const int tl = panel - __builtin_amdgcn_readfirstlane(pref[e]);
        u.pm = panel; u.pn = pn;
        if (mode == 0) { u.a = A; u.b = B + ((size_t)e * 512 + (size_t)pn * 256) * 2048 * esz; u.rows = lists + e * LCAP + tl * 256; const int rem = __builtin_amdgcn_readfirstlane(pref[40 + e]) - tl * 256; u.nvalid = rem < 256 ? rem : 256; u.wrow = wl + e * LCAP + tl * 256; }
        else { u.a = A + (size_t)panel * 256 * 256 * esz; u.b = B + ((size_t)e * 2048 + (size_t)pn * 256) * 256 * esz; u.rows = nullptr; u.nvalid = 256; u.wrow = nullptr; }
        return true;
    }
};

#define IN(k) (lo <= (k) && (k) < hi)
#define SEAM(k) do { if (IN(k) && IN((k) + 1)) xcd_barrier(bar); } while (0)
#ifndef DUP_PHASE
#define DUP_PHASE -1
#endif
template <int l> __device__ __forceinline__ void ph_n1(Frame& F, const Args& args) {
    using namespace cfg; float* xo = args.out; const float* xin = (l == 0) ? args.in[0] : xo;
    convert_phase(F, args, l);
    if (l == 0) norm_phase<false, false, false, F8IN(l)>(F, args, xin, nullptr, args.in[3] + l * D, l, l);
    else { build_pref(F, l - 1); norm_phase<true, false, false, F8IN(l), true>(F, args, xin, xo, args.in[3] + l * D, l, l); }
}
template <int l> __device__ __forceinline__ void ph_g1(Frame& F, const Args& args) {
    using namespace cfg;
    constexpr int ESZ = F8IN(l) ? 1 : 2;
    pg8::StaticOrder S; S.init(F.ws + wsm::XN, F.ws + wsm::W_IN, M, INC, D, F.G, (int)blockIdx.x, ESZ);
    pg8::EpiBf16 E{(bf16*)(F.ws + wsm::P), INC, ESZ == 1 ? pg8::F8_INV : 1.f};
    pg8::gemm_phase<pg8::EpiBf16, pg8::StaticOrder, false, ESZ>(F.lds, D, S, E);
}
template <int l> __device__ __forceinline__ void ph_m1(Frame& F, const Args& args, const XcdBarrier& bar, unsigned long long& racc) {
    rw::lora_prepass(F, args, l);
    xcd_barrier(bar);
    { int hcur = -1; rw::R1Raw raw; rw::R1W W;
      auto unit_of = [&](int i) { return (F.G == 256) ? ((F.vcu >> 2) << 6) + ((F.vcu & 3) << 4) + i : F.vcu + i * F.G; };
      if (unit_of(0) < 4096) rw::r1_load(F, unit_of(0), raw, F.tid);
      for (int i = 0; unit_of(i) < 4096 && i * F.G < 4096; ++i) { const int u = unit_of(i); const int un = ((i + 1) * F.G < 4096 && unit_of(i + 1) < 4096) ? unit_of(i + 1) : u; rw::r1_unit(F, args, l, u, un, raw, W, racc, hcur); } }

    for (int u = F.vcu; u < 1024; u += F.G) { const int b = u >> 7, hh = (u >> 4) & 7, qb = ((u & 15) + (u >> 8) * 4) & 15; att::attn_unit<0>(F, args, l, b, hh, qb); }
    if (DUP_PHASE == 21 + 100 * l) { for (int u = F.vcu; u < 1024; u += F.G) { const int b = u >> 7, hh = (u >> 4) & 7, qb = ((u & 15) + (u >> 8) * 4) & 15; att::attn_unit<0>(F, args, l, b, hh, qb); } }
    att::conv_items(F, args, l, F.vcu * 512 + F.tid, F.G * 512);
    if (DUP_PHASE == 22 + 100 * l) att::conv_items(F, args, l, F.vcu * 512 + F.tid, F.G * 512);
}
template <int l> __device__ __forceinline__ void ph_m2(Frame& F, const Args& args) {
    for (;;) { const int it = grab(F, l); if (it >= 64 + 512) break;
        if (it < 64) rw::r2_unit(F, args, l, it);
        else { const int j = it - 64, qb = 15 - (j >> 5), b = (j & 31) >> 2, hh = j & 3; att::attn_unit<1>(F, args, l, b, hh, qb); } }
    if (DUP_PHASE == 8 * l + 3) { __syncthreads();
    for (;;) { const int it = grab(F, l + 2); if (it >= 64 + 512) break;
        if (it < 64) rw::r2_unit(F, args, l, it);
        else { const int j = it - 64, qb = 15 - (j >> 5), b = (j & 31) >> 2, hh = j & 3; att::attn_unit<1>(F, args, l, b, hh, qb); } } }
    if (DUP_PHASE == 30 + 100 * l) { if (F.vcu < 64) rw::r2_unit(F, args, l, F.vcu); }
    if (DUP_PHASE == 31 + 100 * l) { for (int u = F.vcu; u < 512; u += F.G) { const int b = u >> 6, hh = (u >> 4) & 3, qb = (u < 256) ? (u & 15) : 15 - (u & 15); att::attn_unit<1>(F, args, l, b, hh, qb); } }
}
template <int l> __device__ __forceinline__ void ph_g2(Frame& F, const Args& args) {
    using namespace cfg;
    constexpr int ESZ = F8OUT(l) ? 1 : 2;
    pg8::StaticOrder S; S.init(F.ws + wsm::Y, F.ws + wsm::W_OUT, M, D, D, F.G, (int)blockIdx.x, ESZ);
    const void* xin = (l == 0) ? (const void*)args.in[0] : (const void*)args.out;
    bf16* xo = (l == 0) ? (bf16*)args.out : (bf16*)(F.ws + wsm::XB2);
    pg8::EpiRes<l != 0> E{xin, xo, D, ESZ == 1 ? 1.f / (F8_Y * pg8::F8_WGT) : 1.f};
    pg8::gemm_phase<pg8::EpiRes<l != 0>, pg8::StaticOrder, false, ESZ>(F.lds, D, S, E);
}
template <int l> __device__ __forceinline__ void ph_n2(Frame& F, const Args& args) { using namespace cfg;
    const float* xs = (l == 0) ? (const float*)args.out : (const float*)(F.ws + wsm::XB2);
    norm_phase<false, true, false, ((F8_MOE_MASK >> l) & 1) != 0, true>(F, args, xs, nullptr, args.in[4] + l * D, l, l); }
template <int l> __device__ __forceinline__ void ph_e1(Frame& F, const Args& args) {
    using namespace cfg;
    build_pref(F, l);
    constexpr int ESZ = ((F8_MOE_MASK >> l) & 1) ? 1 : 2;
    MoeOrder S{(const LAS int*)(F.lds + TAB_OFF), F.G, (int)blockIdx.x, 2, 0, (const char*)(F.ws + wsm::XN), (const char*)(F.ws + wsm::W_GU), (const int*)(F.ws + wsm::LISTS), (const float*)(F.ws + wsm::WLIST), ESZ};
    pg8::EpiSilu E{(bf16*)(F.ws + wsm::HB), ESZ == 1 ? pg8::F8_INV : 1.f, F8_DOWN ? F8_H : 0.f};
    pg8::gemm_phase<pg8::EpiSilu, MoeOrder, true, ESZ>(F.lds, D, S, E);
}
template <int l> __device__ __forceinline__ void ph_e2(Frame& F, const Args& args) {
    using namespace cfg;
    build_pref(F, l);
    constexpr int ESZ = F8_DOWN ? 1 : 2;
    MoeOrder S{(const LAS int*)(F.lds + TAB_OFF), F.G, (int)blockIdx.x, 8, 1, (const char*)(F.ws + wsm::HB), (const char*)(F.ws + wsm::W_D), nullptr, nullptr, ESZ};
    pg8::EpiF8 E{F.ws + wsm::OB, D, F8_DOWN ? F8_OB / (F8_H * pg8::F8_WGT) : F8_OB};
    pg8::gemm_phase<pg8::EpiF8, MoeOrder, false, ESZ>(F.lds, EH, S, E);
}
#ifndef PROBE_T
#define PROBE_T -1
#endif
#define RUNPH(k, call) do { if (PROBE_T == (k)) pt0 = __builtin_amdgcn_s_memrealtime(); RUNPH_(k, call); if (PROBE_T == (k)) pt1 = __builtin_amdgcn_s_memrealtime(); } while (0)
#define RUNPH_(k, call) do { if (IN(k)) { call; if (DUP_PHASE == (k) && ((k) & 7) != 3 && ((k) & 7) != 5) { __syncthreads(); call; } } SEAM(k); } while (0)
template <int l>
__device__ __forceinline__ void layer_phases(Frame& F, const Args& args, const XcdBarrier& bar, const int lo, const int hi, unsigned long long& pt0, unsigned long long& pt1) {
    constexpr int pb = 8 * l;
    RUNPH(pb + 0, ph_n1<l>(F, args));
    RUNPH(pb + 1, ph_g1<l>(F, args));
    { unsigned long long racc = 0; RUNPH(pb + 2, ph_m1<l>(F, args, bar, racc)); if (PROBE_R1 >= 0 && l == 0) { pt0 = 0; pt1 = racc; } }
    RUNPH(pb + 3, ph_m2<l>(F, args));
    RUNPH(pb + 4, ph_g2<l>(F, args));
    RUNPH(pb + 5, ph_n2<l>(F, args));
    RUNPH(pb + 6, ph_e1<l>(F, args));
    RUNPH(pb + 7, ph_e2<l>(F, args));
}
__global__ void __launch_bounds__(512, 2) mk_fwd(Args args) {
    extern __shared__ __attribute__((aligned(16))) unsigned char lds_raw[];
    using namespace cfg;
    Frame F;
    F.lds = (LAS unsigned char*)lds_raw; F.ws = args.ws; F.ctl = (unsigned*)(args.ws + wsm::CTL);
    F.tid = threadIdx.x; F.lane = F.tid & 63; F.wave = __builtin_amdgcn_readfirstlane(F.tid >> 6);
    F.pacc = 0ull;
    F.G = gridDim.x; { const int bx = blockIdx.x; F.vcu = (F.G % 8 == 0) ? (bx % 8) * (F.G / 8) + bx / 8 : bx; }
    volatile LAS unsigned* MISC = (volatile LAS unsigned*)(F.lds + MISC_OFF);
    for (int u = F.tid; u < (LDS_BYTES - RING_BYTES) / 4; u += 512) ((LAS unsigned*)(F.lds + RING_BYTES))[u] = 0u;
    __syncthreads();
    const int lo = args.ph_lo, hi = args.ph_hi;
    XcdBarrier bar; bar.bar = F.ctl + wsm::CW_BAR; bar.x = 0; bar.st = nullptr;
    if (hi - lo > 1) bar = xcd_barrier_post(F.ctl + wsm::CW_BAR, MISC + 8);
    float* xo = args.out;
    unsigned long long pt0 = 0, pt1 = 0;
    layer_phases<0>(F, args, bar, lo, hi, pt0, pt1);
    layer_phases<1>(F, args, bar, lo, hi, pt0, pt1);
    if (PROBE_T == 16) pt0 = __builtin_amdgcn_s_memrealtime();
    if (IN(16)) {
        build_pref(F, NL - 1); norm_phase<true, false, true, false, true>(F, args, (const float*)(F.ws + wsm::XB2), xo, args.in[5], 0, 0);
    }
    if (PROBE_T == 16) pt1 = __builtin_amdgcn_s_memrealtime();
    if (PROBE_ATT >= 0 && blockIdx.x == 0 && F.tid == 448) { const unsigned long long te = __builtin_amdgcn_s_memrealtime(); while (__builtin_amdgcn_s_memrealtime() - te < 4ull * F.pacc) __builtin_amdgcn_s_sleep(8); }
    if ((PROBE_T >= 0 || PROBE_R1 >= 0) && blockIdx.x == 0 && F.tid == 0) { const unsigned long long te = __builtin_amdgcn_s_memrealtime(); while (__builtin_amdgcn_s_memrealtime() - te < 4ull * (pt1 - pt0)) __builtin_amdgcn_s_sleep(8); }
#undef IN
#undef SEAM
}
extern "C" void kernel_launch(void* const* d_in, const int* in_sizes, int n_in, void* d_out, int out_size, void* d_ws, size_t ws_size, hipStream_t stream) {
    using namespace cfg;
    static int grid = 0;
    if (grid == 0) {
        if (n_in != 32 || ws_size < wsm::END || out_size != M * D) { fprintf(stderr, "kernel_launch: bad args n_in=%d ws=%zu out=%d\n", n_in, ws_size, out_size); grid = -1; return; }
        int dev = 0, cus = 0;
        if (hipGetDevice(&dev) != hipSuccess || hipDeviceGetAttribute(&cus, hipDeviceAttributeMultiprocessorCount, dev) != hipSuccess) { grid = -1; return; }
        if (hipFuncSetAttribute((const void*)mk_fwd, hipFuncAttributeMaxDynamicSharedMemorySize, LDS_BYTES) != hipSuccess) { fprintf(stderr, "hipFuncSetAttribute failed\n"); grid = -1; return; }
        int per_cu = 0;
        if (hipOccupancyMaxActiveBlocksPerMultiprocessor(&per_cu, (const void*)mk_fwd, 512, LDS_BYTES) != hipSuccess || per_cu < 1) fprintf(stderr, "kernel_launch: occupancy query says %d\n", per_cu);
        (void)hipGetLastError();
        grid = cus;
    }
    if (grid < 0) return;
    unsigned char* w = (unsigned char*)d_ws;
    if (hipMemsetAsync(w + wsm::CTL, 0, wsm::CTL_ZERO_BYTES, stream) != hipSuccess) return;
    Args a{};
    for (int i = 0; i < 32; ++i) a.in[i] = (const float*)d_in[i];
    a.out = (float*)d_out; a.ws = w; a.flags = 7; a.ph_lo = 0; a.ph_hi = 17;
    hipLaunchKernelGGL(mk_fwd, dim3(grid), dim3(512), LDS_BYTES, stream, a);
}
```

```cpp
#define DUP_PHASE -1
#include <hip/hip_runtime.h>
#include <cstdint>
#include <cstdio>
#include <cmath>

typedef unsigned short bf16;
__host__ __device__ __forceinline__ unsigned f2bf(float f) { unsigned u = __builtin_bit_cast(unsigned, f); return (u + 0x7fffu + ((u >> 16) & 1u)) >> 16; }
__host__ __device__ __forceinline__ float bf2f(bf16 b) { return __builtin_bit_cast(float, ((unsigned)b) << 16); }

namespace cfg {
constexpr int D = 2048, BATCH = 8, SEQ = 4096, M = BATCH * SEQ, NL = 2;
constexpr int INC = 6400;
constexpr int OFF_BQ = 1792, OFF_BK = 2304, OFF_BV = 2816, OFF_CQ = 3328, OFF_CK = 3840, OFF_CV = 4352, OFF_D = 4864;
constexpr int NEXP = 32, EH = 256;
}
#define GAS __attribute__((address_space(1)))
#define LAS __attribute__((address_space(3)))
typedef float f32x4 __attribute__((ext_vector_type(4)));
typedef float f32x2 __attribute__((ext_vector_type(2)));
typedef short bf16x8 __attribute__((ext_vector_type(8)));
typedef unsigned u32x4 __attribute__((ext_vector_type(4)));
typedef unsigned u32x2 __attribute__((ext_vector_type(2)));
#define RLX_AGENT __ATOMIC_RELAXED, __HIP_MEMORY_SCOPE_AGENT
#define LDS_WAIT() asm volatile("s_waitcnt lgkmcnt(0)" ::: "memory")
#define VM_WAIT() asm volatile("s_waitcnt vmcnt(0)" ::: "memory")

namespace wsm {
constexpr size_t MiB = 1u << 20;
constexpr size_t CTL = 0, CTL_ZERO_BYTES = 1 * MiB;
constexpr size_t LISTS = 2 * MiB;
constexpr size_t WLIST = 6 * MiB;
constexpr size_t TOKINFO = 10 * MiB;
constexpr size_t ROUTE = 11 * MiB;
constexpr size_t WRT = 12 * MiB;
constexpr size_t TABS = WRT + 1 * MiB;
constexpr size_t W_IN = 16 * MiB;
constexpr size_t W_OUT = 41 * MiB;
constexpr size_t W_GU = 49 * MiB;
constexpr size_t W_D = 113 * MiB;
constexpr size_t XN = 146 * MiB;
constexpr size_t LORA = XN + 64 * MiB;
constexpr size_t P = 274 * MiB;
constexpr size_t HB = P;
constexpr size_t OB = P + 40 * MiB;
constexpr size_t XB2 = P + 200 * MiB;
constexpr size_t Y = 674 * MiB;
constexpr size_t RW = 802 * MiB;
constexpr size_t END = 1010 * MiB;
constexpr int CW_BAR = 4096;
constexpr int CW_CNT = 16384;
constexpr int CW_Q = 32768;
}
constexpr int LCAP = 32768;
constexpr int RING_BYTES = 139264;
constexpr int MISC_OFF = RING_BYTES + 320;
constexpr int TAB_OFF = RING_BYTES + 1024;
constexpr int LDS_BYTES = 147456;
constexpr float C2F = 0.125f * 1.4426950408889634f;
constexpr float LOG2E = 1.4426950408889634f;

typedef __bf16 bf16x2_hw __attribute__((ext_vector_type(2)));
__device__ __forceinline__ unsigned pk2(float lo, float hi) { const f32x2 v = {lo, hi}; const bf16x2_hw b = __builtin_convertvector(v, bf16x2_hw); return __builtin_bit_cast(unsigned, b); }
__device__ __forceinline__ bf16 cvt1(float x) { return (bf16)(pk2(x, x) & 0xffffu); }
__device__ __forceinline__ float f8clamp(float x) { return __builtin_amdgcn_fmed3f(x, -448.f, 448.f); }
__device__ __forceinline__ unsigned pk2_fp8(float a, float b) { int w = 0; w = __builtin_amdgcn_cvt_pk_fp8_f32(f8clamp(a), f8clamp(b), w, false); return (unsigned)w & 0xffffu; }
__device__ __forceinline__ unsigned pk4_fp8(float a, float b, float c, float d) { int w = 0; w = __builtin_amdgcn_cvt_pk_fp8_f32(f8clamp(a), f8clamp(b), w, false); w = __builtin_amdgcn_cvt_pk_fp8_f32(f8clamp(c), f8clamp(d), w, true); return (unsigned)w; }
constexpr int F8_IN_MASK = 2, F8_OUT_MASK = 2;
#define F8IN(l) (((F8_IN_MASK >> (l)) & 1) != 0)
#define F8OUT(l) (((F8_OUT_MASK >> (l)) & 1) != 0)
constexpr float F8_Y = 16.f, F8_OB = 8.f, F8_H = 8.f;
constexpr bool F8_DOWN = true;
constexpr int F8_MOE_MASK = 3;
__device__ __forceinline__ float wave_sum(float v) {
#pragma unroll
    for (int o = 1; o < 64; o <<= 1) v += __shfl_xor(v, o);
    return v;
}

struct Args {
    const float* in[32]; float* out; unsigned char* ws;
    int ph_lo, ph_hi, flags, pad;
};
#define XB_TMO      128
#define XB_XCNT(j)  (256  + 64 * (j))
#define XB_XSUB(j)  (1280 + 64 * (j))
#define XB_XGEN(j)  (2304 + 64 * (j))
#define XB_TOP      3328
#define XB_TOPGEN   3392
#define XCD_BAR_WORDS 3456
#define XB_SPIN_CAP (1u << 22)

__device__ __forceinline__ unsigned xb_ld(unsigned* p)              { return __hip_atomic_load(p, __ATOMIC_RELAXED, __HIP_MEMORY_SCOPE_AGENT); }
__device__ __forceinline__ unsigned xb_add(unsigned* p, unsigned v) { return __hip_atomic_fetch_add(p, v, __ATOMIC_RELAXED, __HIP_MEMORY_SCOPE_AGENT); }
__device__ __forceinline__ unsigned xb_xcc_id() { return (unsigned)__builtin_amdgcn_s_getreg((3 << 11) | 20) & 0xFu; }
#define XB_SPIN(cond, bar) do { unsigned _sp = 0; while (cond) { __builtin_amdgcn_s_sleep(1); \
    if ((++_sp & 255u) == 0u) { if (xb_ld(&(bar)[XB_TMO])) break; if (_sp > XB_SPIN_CAP) { atomicAdd(&(bar)[XB_TMO], 1u); break; } } } } while (0)

struct XcdBarrier {
    unsigned* bar; unsigned x;
    volatile LAS unsigned* st;
};

__device__ __forceinline__ XcdBarrier xcd_barrier_post(unsigned* bar, volatile LAS unsigned* st) {
    XcdBarrier b; b.bar = bar; b.x = xb_xcc_id(); b.st = st;
    if (threadIdx.x == 0) (void)xb_add(&bar[XB_XCNT(b.x)], 1u);
    return b;
}
__device__ __forceinline__ void xcd_barrier_complete(unsigned* bar, unsigned x, unsigned& nloc, unsigned& nx) {
    const unsigned G = gridDim.x * gridDim.y * gridDim.z;
    unsigned sum, cnt, mine, sp = 0u;
    for (;;) {
        sum = 0u; cnt = 0u; mine = 0u;
#pragma unroll
        for (unsigned j = 0; j < 16; ++j) { const unsigned c = xb_ld(&bar[XB_XCNT(j)]); sum += c; cnt += (c > 0u) ? 1u : 0u; mine = (j == x) ? c : mine; }
        if (sum == G) break;
        __builtin_amdgcn_s_sleep(1);
        if ((++sp & 255u) == 0u) { if (xb_ld(&bar[XB_TMO])) break; if (sp > XB_SPIN_CAP) { atomicAdd(&bar[XB_TMO], 1u); break; } }
    }
    nloc = mine > 0u ? mine : 1u; nx = cnt > 0u ? cnt : 1u;
}

__device__ __forceinline__ void xcd_barrier(const XcdBarrier& b) {
    asm volatile("s_waitcnt vmcnt(0)" ::: "memory");
    __syncthreads();
    if (threadIdx.x == 0) {
        unsigned* bar = b.bar;
        __builtin_amdgcn_s_waitcnt(0);
        unsigned nloc = b.st[0], nx = b.st[1];
        if (nloc == 0u) { xcd_barrier_complete(bar, b.x, nloc, nx); b.st[0] = nloc; b.st[1] = nx; }
        const unsigned old = xb_add(&bar[XB_XSUB(b.x)], 1u);
        const unsigned gen = old / nloc;
        if (old + 1u == (gen + 1u) * nloc) {
            __builtin_amdgcn_fence(__ATOMIC_RELEASE, "agent");
            asm volatile("s_waitcnt vmcnt(0)" ::: "memory");
            const unsigned og = xb_add(&bar[XB_TOP], 1u);
            const unsigned tg = og / nx;
            if (og + 1u == (tg + 1u) * nx) xb_add(&bar[XB_TOPGEN], 1u);
            else XB_SPIN(xb_ld(&bar[XB_TOPGEN]) == tg, bar);
            __builtin_amdgcn_fence(__ATOMIC_ACQUIRE, "agent");
            xb_add(&bar[XB_XGEN(b.x)], 1u);
            asm volatile("s_waitcnt vmcnt(0)" ::: "memory");
        } else {
            XB_SPIN(xb_ld(&bar[XB_XGEN(b.x)]) == gen, bar);
            __builtin_amdgcn_fence(__ATOMIC_ACQUIRE, "agent");
            asm volatile("s_waitcnt vmcnt(0)" ::: "memory");
        }
    }
    __syncthreads();
}
namespace pg8 {
#define PG8_LAS __attribute__((address_space(3)))
typedef unsigned short bf16_t;
typedef short bf16x8 __attribute__((ext_vector_type(8)));
typedef float f32x4 __attribute__((ext_vector_type(4)));
typedef unsigned u32x4 __attribute__((ext_vector_type(4)));
typedef unsigned u32x2 __attribute__((ext_vector_type(2)));
typedef int i32x4_t __attribute__((ext_vector_type(4)));
typedef int i32x8_t __attribute__((ext_vector_type(8)));
constexpr float F8_ACT = 16.f, F8_WGT = 512.f, F8_INV = 1.f / (16.f * 512.f);
constexpr int BM = 256, BK = 64, HALF = 128, HTB = HALF * BK * 2, STAGE_BYTES = 8 * HTB, NXCD = 8, WGM = 8;

__host__ __device__ __forceinline__ int lds_byte(int r, int c) { const int st = (r >> 4) * 2 + (c >> 5), rr = r & 15, cc = c & 31, ob = rr * 64 + cc * 2; return st * 1024 + (ob ^ (((ob >> 9) & 1) << 5)); }
__host__ __device__ __forceinline__ void stage_rc(int b, int& R, int& C) { const int st = b / 1024, sb = b % 1024, swz = sb ^ (((sb >> 9) & 1) << 5); R = (st >> 1) * 16 + swz / 64; C = (st & 1) * 32 + (swz % 64) / 2; }
__host__ __device__ __forceinline__ int perm32(int rho) { const int n = rho >> 4, i = rho & 15; return 8 * (i >> 2) + 4 * n + (i & 3); }

struct Unit { int pm, pn; const char* a; const char* b; const int* rows; const float* wrow; int nvalid; int pad_; };

struct StaticOrder {
    int nM, nN, nwg, G, c; const char* A; const char* Bt; size_t tstep;
    __device__ void init(const void* A_, const void* Bt_, int M, int N, int K, int G_, int c_, int esz = 2) { nM = M / BM; nN = N / BM; nwg = nM * nN; G = G_; c = c_; A = (const char*)A_; Bt = (const char*)Bt_; tstep = (size_t)BM * K * esz; }
    __device__ bool next(int i, Unit& u) const {
        const long L = (long)i * G + c; if (L >= nwg) return false;
        int wgid = (int)L; { const int q = nwg / NXCD, r = nwg % NXCD, xcd = wgid % NXCD, off = wgid / NXCD; wgid = (xcd < r ? xcd * (q + 1) : r * (q + 1) + (xcd - r) * q) + off; }
        const int nig = WGM * nN, gid = wgid / nig, fm = gid * WGM, gsz = (nM - fm) < WGM ? (nM - fm) : WGM;
        u.pm = fm + ((wgid % nig) % gsz); u.pn = (wgid % nig) / gsz; u.a = A + (size_t)u.pm * tstep; u.b = Bt + (size_t)u.pn * tstep; u.rows = nullptr; u.wrow = nullptr; u.nvalid = 256; return true;
    }
};

__device__ __forceinline__ unsigned cvt_pk_bf16(float lo, float hi) { unsigned r; asm volatile("v_cvt_pk_bf16_f32 %0, %1, %2" : "=v"(r) : "v"(lo), "v"(hi)); return r; }

struct EpiBf16 {
    static constexpr bool PERM = true;
    bf16_t* O; int ldc; float mul;
    __device__ __forceinline__ void operator()(const f32x4 (&acc)[2][2][4][2], const Unit& u, int wr, int wc, int fr, int fq) const {
        const int row0 = u.pm * BM + wr * 64 + fr; const int col0 = u.pn * BM + wc * 32 + 8 * fq;
#pragma unroll
        for (int ai = 0; ai < 2; ++ai)
#pragma unroll
            for (int m = 0; m < 4; ++m) { bf16_t* rowp = O + (size_t)(row0 + ai * HALF + m * 16) * ldc + col0;
#pragma unroll
                for (int bj = 0; bj < 2; ++bj) { const f32x4 v0 = acc[ai][bj][m][0] * mul, v1 = acc[ai][bj][m][1] * mul;
                    u32x4 w; w.x = cvt_pk_bf16(v0[0], v0[1]); w.y = cvt_pk_bf16(v0[2], v0[3]); w.z = cvt_pk_bf16(v1[0], v1[1]); w.w = cvt_pk_bf16(v1[2], v1[3]);
                    *(u32x4*)(rowp + bj * HALF) = w; } }
    }
};
struct EpiF8 {
    static constexpr bool PERM = true;
    unsigned char* O; int ldc; float mul;
    __device__ __forceinline__ void operator()(const f32x4 (&acc)[2][2][4][2], const Unit& u, int wr, int wc, int fr, int fq) const {
        const int row0 = u.pm * BM + wr * 64 + fr; const int col0 = u.pn * BM + wc * 32 + 8 * fq;
#pragma unroll
        for (int ai = 0; ai < 2; ++ai)
#pragma unroll
            for (int m = 0; m < 4; ++m) { unsigned char* rowp = O + (size_t)(row0 + ai * HALF + m * 16) * ldc + col0;
#pragma unroll
                for (int bj = 0; bj < 2; ++bj) { const f32x4 v0 = acc[ai][bj][m][0] * mul, v1 = acc[ai][bj][m][1] * mul;
                    u32x2 w; w.x = ::pk4_fp8(v0[0], v0[1], v0[2], v0[3]); w.y = ::pk4_fp8(v1[0], v1[1], v1[2], v1[3]);
                    *(u32x2*)(rowp + bj * HALF) = w; } }
    }
};
template <bool BASE_BF16>
struct EpiRes {
    static constexpr bool PERM = true;
    const void* base; bf16_t* C; int ldc; float mul;
    __device__ __forceinline__ void operator()(const f32x4 (&acc)[2][2][4][2], const Unit& u, int wr, int wc, int fr, int fq) const {
        const int row0 = u.pm * BM + wr * 64 + fr, col0 = u.pn * BM + wc * 32 + 8 * fq;
#pragma unroll
        for (int ai = 0; ai < 2; ++ai)
#pragma unroll
            for (int m = 0; m < 4; ++m) { const size_t off = (size_t)(row0 + ai * HALF + m * 16) * ldc + col0;
#pragma unroll
                for (int bj = 0; bj < 2; ++bj) { const size_t o2 = off + bj * HALF; f32x4 b0, b1;
                    if constexpr (BASE_BF16) { const u32x4 w = *(const u32x4*)((const bf16_t*)base + o2);
                        b0 = (f32x4){__uint_as_float(w.x << 16), __uint_as_float(w.x & 0xffff0000u), __uint_as_float(w.y << 16), __uint_as_float(w.y & 0xffff0000u)};
                        b1 = (f32x4){__uint_as_float(w.z << 16), __uint_as_float(w.z & 0xffff0000u), __uint_as_float(w.w << 16), __uint_as_float(w.w & 0xffff0000u)}; }
                    else { b0 = *(const f32x4*)((const float*)base + o2); b1 = *(const f32x4*)((const float*)base + o2 + 4); }
                    const f32x4 r0 = b0 + acc[ai][bj][m][0] * mul, r1 = b1 + acc[ai][bj][m][1] * mul;
                    u32x4 ow; ow.x = ::pk2(r0[0], r0[1]); ow.y = ::pk2(r0[2], r0[3]); ow.z = ::pk2(r1[0], r1[1]); ow.w = ::pk2(r1[2], r1[3]);
                    *(u32x4*)(C + o2) = ow; }
                asm volatile("" ::: "memory"); }
    }
};
struct EpiSilu {
    static constexpr bool PERM = true;
    bf16_t* H; float mul; float h8;
    __device__ __forceinline__ void operator()(const f32x4 (&acc)[2][2][4][2], const Unit& u, int wr, int wc, int fr, int fq) const {
        const int row0 = u.pm * BM + wr * 64 + fr; const int col0 = u.pn * HALF + wc * 32 + 8 * fq;
#pragma unroll
        for (int ai = 0; ai < 2; ++ai)
#pragma unroll
            for (int m = 0; m < 4; ++m) { const int row = row0 + ai * HALF + m * 16; const float w = u.wrow[wr * 64 + fr + ai * HALF + m * 16];
                float o[8];
#pragma unroll
                for (int n = 0; n < 2; ++n)
#pragma unroll
                    for (int j = 0; j < 4; ++j) { const float g = acc[ai][0][m][n][j] * mul, up = acc[ai][1][m][n][j] * mul; o[n * 4 + j] = g * __builtin_amdgcn_rcpf(1.f + __expf(-g)) * up * w; }
                if (h8 > 0.f) { u32x2 w8; w8.x = ::pk4_fp8(o[0] * h8, o[1] * h8, o[2] * h8, o[3] * h8); w8.y = ::pk4_fp8(o[4] * h8, o[5] * h8, o[6] * h8, o[7] * h8); *(u32x2*)((unsigned char*)H + (size_t)row * 256 + col0) = w8; }
                else { u32x4 wv; wv.x = cvt_pk_bf16(o[0], o[1]); wv.y = cvt_pk_bf16(o[2], o[3]); wv.z = cvt_pk_bf16(o[4], o[5]); wv.w = cvt_pk_bf16(o[6], o[7]);
                    *(u32x4*)(H + (size_t)row * 256 + col0) = wv; } }
    }
};

template <class Epi, class Sched, bool GATHER, int ESZ = 2>
__device__ __forceinline__ void gemm_phase(PG8_LAS unsigned char* lds, const int K, const Sched& S, const Epi& E) {
    const int tid = threadIdx.x, wid = __builtin_amdgcn_readfirstlane(tid >> 6), lane = tid & 63, wr = wid >> 2, wc = wid & 3, fr = lane & 15, fq = lane >> 4;
    const int KB = K * ESZ;
    const int nt = KB / (BK * 2);
    const size_t kstep = (size_t)(BK * 2);
    const unsigned hstep = (unsigned)HALF * KB;
    int sR[2], sC[2];
    unsigned voffB[2], vc[2][2], vn[2][2];
#pragma unroll
    for (int i = 0; i < 2; ++i) { int R, C; stage_rc(tid * 16 + i * 8192, R, C); sR[i] = R; sC[i] = C; const int Rb = Epi::PERM ? ((R & ~31) + perm32(R & 31)) : R;
        voffB[i] = (unsigned)(Rb * KB + C * 2); vc[0][i] = (unsigned)(R * KB + C * 2); vc[1][i] = vc[0][i] + hstep; vn[0][i] = vc[0][i]; vn[1][i] = vc[1][i]; }
    const unsigned ldsw = (unsigned)wid * 1024u;
    const int aoff = lds_byte(wr * 64 + fr, fq * 8), boff = lds_byte(wc * 32 + fr, fq * 8);
#define PG8_SA(b, h) (((b) * 2 + (h)) * HTB)
#define PG8_SB(b, h) ((4 + (b) * 2 + (h)) * HTB)
#define PG8_STAGE(bufoff, gbase, voff) do { _Pragma("unroll") for (int _i = 0; _i < 2; ++_i) \
        __builtin_amdgcn_global_load_lds((const unsigned*)((const char*)(gbase) + (voff)[_i]), (PG8_LAS unsigned*)(lds + (bufoff) + ldsw + _i * 8192), 16, 0, 0); } while (0)
#define PG8_LD32(addr) __builtin_shufflevector(*(const PG8_LAS i32x4_t*)(addr), *(const PG8_LAS i32x4_t*)((addr) + 1024), 0, 1, 2, 3, 4, 5, 6, 7)
#define PG8_LDA(dst, b, h) do { if constexpr (ESZ == 2) { _Pragma("unroll") for (int m = 0; m < 4; ++m) _Pragma("unroll") for (int k = 0; k < 2; ++k) dst[m][k] = *(const PG8_LAS bf16x8*)(lds + PG8_SA(b, h) + aoff + m * 2048 + k * 1024); } \
        else { _Pragma("unroll") for (int m = 0; m < 4; ++m) dst##8[m] = PG8_LD32(lds + PG8_SA(b, h) + aoff + m * 2048); } } while (0)
#define PG8_LDB(dst, b, h) do { if constexpr (ESZ == 2) { _Pragma("unroll") for (int n = 0; n < 2; ++n) _Pragma("unroll") for (int k = 0; k < 2; ++k) dst[n][k] = *(const PG8_LAS bf16x8*)(lds + PG8_SB(b, h) + boff + n * 2048 + k * 1024); } \
        else { _Pragma("unroll") for (int n = 0; n < 2; ++n) dst##8[n] = PG8_LD32(lds + PG8_SB(b, h) + boff + n * 2048); } } while (0)
#define PG8_F8(x) __builtin_shufflevector(__builtin_bit_cast(i32x4_t, x[0]), __builtin_bit_cast(i32x4_t, x[1]), 0, 1, 2, 3, 4, 5, 6, 7)
#define PG8_MMA(ai, bj, At, Bt) do { __builtin_amdgcn_s_setprio(1); _Pragma("unroll") for (int m = 0; m < 4; ++m) _Pragma("unroll") for (int n = 0; n < 2; ++n) { \
        if constexpr (ESZ == 2) { _Pragma("unroll") for (int k = 0; k < 2; ++k) acc[ai][bj][m][n] = __builtin_amdgcn_mfma_f32_16x16x32_bf16(Bt[n][k], At[m][k], acc[ai][bj][m][n], 0, 0, 0); } \
        else asm volatile("s_nop 1\n\tv_mfma_f32_16x16x128_f8f6f4 %0, %1, %2, %0" : "+v"(acc[ai][bj][m][n]) : "v"(Bt##8[n]), "v"(At##8[m])); } __builtin_amdgcn_s_setprio(0); } while (0)
#define PG8_WAIT_V(n) asm volatile("s_waitcnt vmcnt(" #n ")" ::: "memory")
#define PG8_WAIT_L(n) asm volatile("s_waitcnt lgkmcnt(" #n ")" ::: "memory")
#define PG8_BAR __builtin_amdgcn_s_barrier()
#define PG8_SCHED __builtin_amdgcn_sched_barrier(0)
#define PG8_GV(dst, u) do { if constexpr (GATHER) { _Pragma("unroll") for (int _h = 0; _h < 2; ++_h) _Pragma("unroll") for (int _i = 0; _i < 2; ++_i) { const int _idx = _h * HALF + sR[_i]; \
        const int _tok = (u).rows[_idx < (u).nvalid ? _idx : 0]; dst[_h][_i] = (unsigned)_tok * (unsigned)KB + (unsigned)sC[_i] * 2u; } } } while (0)
    Unit cur, nxt; int ui = 0;
    if (!S.next(0, cur)) return;
    f32x4 acc[2][2][4][2];
#pragma unroll
    for (int a = 0; a < 2; ++a)
#pragma unroll
        for (int b = 0; b < 2; ++b)
#pragma unroll
            for (int m = 0; m < 4; ++m)
#pragma unroll
                for (int n = 0; n < 2; ++n) acc[a][b][m][n] = (f32x4){0.f, 0.f, 0.f, 0.f};
    bf16x8 At[4][2], B0[2][2], B1[2][2];
    i32x8_t At8[4], B08[2], B18[2];
    const char* cA = cur.a; const char* cB = cur.b;
    PG8_GV(vc, cur);
    PG8_STAGE(PG8_SB(0, 0), cB, voffB); PG8_STAGE(PG8_SB(0, 1), cB + hstep, voffB); PG8_STAGE(PG8_SA(0, 0), cA, vc[0]); PG8_STAGE(PG8_SA(0, 1), cA, vc[1]);
    if (wr == 1) PG8_BAR;
    PG8_WAIT_V(2); PG8_BAR;
    PG8_STAGE(PG8_SB(1, 0), cB + kstep, voffB); PG8_STAGE(PG8_SA(1, 0), cA + kstep, vc[0]); PG8_STAGE(PG8_SB(1, 1), cB + hstep + kstep, voffB);
    PG8_WAIT_V(6); PG8_BAR;
    for (;;) {
        const bool has_next = S.next(ui + 1, nxt);
        const char* nA = has_next ? nxt.a : cA; const char* nB = has_next ? nxt.b : cB;
        if constexpr (GATHER) { if (has_next) { PG8_GV(vn, nxt); } else {
#pragma unroll
            for (int h = 0; h < 2; ++h)
#pragma unroll
                for (int i = 0; i < 2; ++i) vn[h][i] = vc[h][i]; } }
#pragma unroll 1
        for (int t = 0; t < nt; t += 2) {
            const bool last = (t == nt - 2);
            const char* a1 = cA + (size_t)(t + 1) * kstep;
            const char* a2 = last ? nA : cA + (size_t)(t + 2) * kstep; const char* b2 = last ? nB : cB + (size_t)(t + 2) * kstep;
            const char* a3 = a2 + kstep; const char* b3 = b2 + kstep;
            unsigned v2[2][2];
#pragma unroll
            for (int h = 0; h < 2; ++h)
#pragma unroll
                for (int i = 0; i < 2; ++i) v2[h][i] = (GATHER && last) ? vn[h][i] : vc[h][i];
            PG8_LDB(B0, 0, 0); PG8_LDB(B1, 0, 1); PG8_SCHED; PG8_LDA(At, 0, 0); PG8_STAGE(PG8_SA(1, 1), a1, vc[1]);
            PG8_WAIT_V(8); PG8_WAIT_L(0); PG8_BAR; PG8_MMA(0, 0, At, B0); PG8_MMA(0, 1, At, B1); PG8_BAR; PG8_SCHED;
            PG8_LDA(At, 0, 1); PG8_STAGE(PG8_SB(0, 0), b2, voffB); PG8_STAGE(PG8_SB(0, 1), b2 + hstep, voffB); PG8_STAGE(PG8_SA(0, 0), a2, v2[0]);
            PG8_WAIT_V(8); PG8_WAIT_L(0); PG8_BAR; PG8_MMA(1, 0, At, B0); PG8_MMA(1, 1, At, B1); PG8_BAR; PG8_SCHED;
            PG8_LDB(B0, 1, 0); PG8_LDB(B1, 1, 1); PG8_SCHED; PG8_LDA(At, 1, 0); PG8_STAGE(PG8_SA(0, 1), a2, v2[1]);
            PG8_WAIT_V(8); PG8_WAIT_L(0); PG8_BAR; PG8_MMA(0, 0, At, B0); PG8_MMA(0, 1, At, B1); PG8_BAR; PG8_SCHED;
            PG8_LDA(At, 1, 1); PG8_STAGE(PG8_SB(1, 0), b3, voffB); PG8_STAGE(PG8_SB(1, 1), b3 + hstep, voffB); PG8_STAGE(PG8_SA(1, 0), a3, v2[0]);
            PG8_WAIT_V(8); PG8_WAIT_L(0); PG8_BAR; PG8_MMA(1, 0, At, B0); PG8_MMA(1, 1, At, B1); PG8_BAR; PG8_SCHED;
        }
        if (wr == 0) PG8_BAR;
        if constexpr (ESZ == 1) asm volatile("s_nop 15\n\ts_nop 7" ::: "memory");
        E(acc, cur, wr, wc, fr, fq);
        if (!has_next) break;
#pragma unroll
        for (int a = 0; a < 2; ++a)
#pragma unroll
            for (int b = 0; b < 2; ++b)
#pragma unroll
                for (int m = 0; m < 4; ++m)
#pragma unroll
                    for (int n = 0; n < 2; ++n) acc[a][b][m][n] = (f32x4){0.f, 0.f, 0.f, 0.f};
        cur = nxt; cA = nA; cB = nB; ++ui;
        if constexpr (GATHER) {
#pragma unroll
            for (int h = 0; h < 2; ++h)
#pragma unroll
                for (int i = 0; i < 2; ++i) vc[h][i] = vn[h][i]; }
        if (wr == 1) PG8_BAR;
    }
    PG8_WAIT_V(0);
    PG8_BAR;
#undef PG8_SA
#undef PG8_SB
#undef PG8_STAGE
#undef PG8_LDA
#undef PG8_LD32
#undef PG8_LDB
#undef PG8_MMA
#undef PG8_F8
#undef PG8_WAIT_V
#undef PG8_WAIT_L
#undef PG8_BAR
#undef PG8_SCHED
#undef PG8_GV
}
}
struct Frame {
    LAS unsigned char* lds; unsigned char* ws; unsigned* ctl;
    int tid, lane, wave, G, vcu;
    unsigned long long pacc;
};

__device__ __forceinline__ void cvt_tile(const float* W, int N, int K, int k0, int n0, bf16* dst, int drow0, float scale, LAS float* scr, int lane) {
#pragma unroll 8
    for (int i = 0; i < 32; ++i) { const int kk = 2 * i + (lane >> 5); scr[kk * 33 + (lane & 31)] = W[(size_t)(k0 + kk) * N + n0 + (lane & 31)]; }
    LDS_WAIT(); asm volatile("" ::: "memory");
    const int c = lane & 7;
#pragma unroll
    for (int j = 0; j < 4; ++j) { const int n = (lane >> 3) + 8 * j; const LAS float* s = scr + (8 * c) * 33 + n;
        u32x4 o; o.x = pk2(s[0 * 33] * scale, s[1 * 33] * scale); o.y = pk2(s[2 * 33] * scale, s[3 * 33] * scale); o.z = pk2(s[4 * 33] * scale, s[5 * 33] * scale); o.w = pk2(s[6 * 33] * scale, s[7 * 33] * scale);
        *(u32x4*)(dst + (size_t)(drow0 + n) * K + k0 + 8 * c) = o; }
    LDS_WAIT(); asm volatile("" ::: "memory");
}
__device__ __forceinline__ void cvt_tile8(const float* W, int N, int K, int k0, int n0, unsigned char* dst, int drow0, float scale, LAS float* scr, int lane) {
#pragma unroll 8
    for (int i = 0; i < 32; ++i) { const int kk = 2 * i + (lane >> 5); scr[kk * 33 + (lane & 31)] = W[(size_t)(k0 + kk) * N + n0 + (lane & 31)]; }
    LDS_WAIT(); asm volatile("" ::: "memory");
    const int c = lane & 7;
#pragma unroll
    for (int j = 0; j < 4; ++j) { const int n = (lane >> 3) + 8 * j; const LAS float* s = scr + (8 * c) * 33 + n;
        u32x2 o; o.x = pk4_fp8(s[0 * 33] * scale, s[1 * 33] * scale, s[2 * 33] * scale, s[3 * 33] * scale); o.y = pk4_fp8(s[4 * 33] * scale, s[5 * 33] * scale, s[6 * 33] * scale, s[7 * 33] * scale);
        *(u32x2*)(dst + (size_t)(drow0 + n) * K + k0 + 8 * c) = o; }
    LDS_WAIT(); asm volatile("" ::: "memory");
}
__device__ __forceinline__ void convert_phase(Frame& F, const Args& a, int l) {
    using namespace cfg;
    LAS float* scr = (LAS float*)(F.lds + F.wave * 16384);
    const int gw = F.vcu * 8 + F.wave, NGW = F.G * 8;
    const float* w_in = a.in[1] + (size_t)l * D * INC; const float* w_out = a.in[2] + (size_t)l * D * D;
    const size_t es = (size_t)NEXP * D * EH;
    const float* wg = a.in[29] + l * es; const float* wu = a.in[30] + l * es; const float* wd = a.in[31] + l * es;
    bf16* Wi = (bf16*)(F.ws + wsm::W_IN); bf16* Wo = (bf16*)(F.ws + wsm::W_OUT); bf16* Wgu = (bf16*)(F.ws + wsm::W_GU); bf16* Wd = (bf16*)(F.ws + wsm::W_D);
    constexpr int I_IN = 32 * 200, I_OUT = 32 * 64, I_G = 32 * 256, I_D = 32 * 256;
    constexpr int NITEMS = I_IN + I_OUT + 2 * I_G + I_D;
    for (int it = gw; it < NITEMS; it += NGW) {
        int r = it;
        if (r < I_IN) { const int kb = r / 200, nb = r % 200, n0 = nb * 32; const bool isq = (n0 >= OFF_BQ && n0 < OFF_BK) || (n0 >= OFF_CQ && n0 < OFF_CK);
            if (F8IN(l)) cvt_tile8(w_in, INC, D, kb * 64, n0, (unsigned char*)Wi, n0, (isq ? C2F : 1.f) * pg8::F8_WGT, scr, F.lane); else cvt_tile(w_in, INC, D, kb * 64, n0, Wi, n0, isq ? C2F : 1.f, scr, F.lane); continue; } r -= I_IN;
        if (r < I_OUT) { const int kb = r / 64, nb = r % 64; if (F8OUT(l)) cvt_tile8(w_out, D, D, kb * 64, nb * 32, (unsigned char*)Wo, nb * 32, pg8::F8_WGT, scr, F.lane); else cvt_tile(w_out, D, D, kb * 64, nb * 32, Wo, nb * 32, 1.f, scr, F.lane); continue; } r -= I_OUT;
        if (r < 2 * I_G) { const int up = r >= I_G; if (up) r -= I_G; const int e = r >> 8, q = r & 255, kb = q >> 3, nb = q & 7, n0 = nb * 32;
            if ((F8_MOE_MASK >> l) & 1) cvt_tile8((up ? wu : wg) + (size_t)e * D * EH, EH, D, kb * 64, n0, (unsigned char*)Wgu, e * 512 + 256 * (n0 >> 7) + (n0 & 127) + (up ? 128 : 0), pg8::F8_WGT, scr, F.lane);
            else cvt_tile((up ? wu : wg) + (size_t)e * D * EH, EH, D, kb * 64, n0, Wgu, e * 512 + 256 * (n0 >> 7) + (n0 & 127) + (up ? 128 : 0), 1.f, scr, F.lane); continue; } r -= 2 * I_G;
        { const int e = r >> 8, q = r & 255, kb = q >> 6, nb = q & 63;
          if (F8_DOWN) cvt_tile8(wd + (size_t)e * EH * D, D, EH, kb * 64, nb * 32, (unsigned char*)Wd + (size_t)e * D * EH, nb * 32, pg8::F8_WGT, scr, F.lane);
          else cvt_tile(wd + (size_t)e * EH * D, D, EH, kb * 64, nb * 32, Wd + (size_t)e * D * EH, nb * 32, 1.f, scr, F.lane); }
    }
    bf16* Wr = (bf16*)(F.ws + wsm::WRT); const float* rg = a.in[25] + (size_t)l * D * 4; const float* re = a.in[27] + (size_t)l * D * 32;
    for (int idx = (F.vcu * 512 + F.tid); idx < 48 * 2048; idx += F.G * 512) { const int n = idx >> 11, k = idx & 2047;
        const float v = n < 4 ? rg[k * 4 + n] : (n < 36 ? re[k * 32 + n - 4] : 0.f); Wr[idx] = cvt1(v); }
    bf16* w2t = (bf16*)(F.ws + wsm::WRT + 262144); bf16* a2t = w2t + 512 * 64; bf16* g2t = a2t + 512 * 64;
    const float* w2 = a.in[8] + (size_t)l * 64 * 512; const float* a2 = a.in[10] + (size_t)l * 64 * 512; const float* g2 = a.in[11] + (size_t)l * 128 * 512;
    for (int idx = (F.vcu * 512 + F.tid); idx < 512 * 256; idx += F.G * 512) { const int ch = idx & 511, j = idx >> 9;
        if (j < 64) w2t[ch * 64 + j] = cvt1(w2[j * 512 + ch]); else if (j < 128) a2t[ch * 64 + (j - 64)] = cvt1(a2[(j - 64) * 512 + ch]); else g2t[ch * 128 + (j - 128)] = cvt1(g2[(j - 128) * 512 + ch]); }
}

__device__ __forceinline__ int grab(Frame& F, int q) {
    volatile LAS int* slot = (volatile LAS int*)(F.lds + MISC_OFF + 64);
    if (F.tid == 0) *slot = (int)__hip_atomic_fetch_add(F.ctl + wsm::CW_Q + q * 64, 1u, RLX_AGENT);
    __syncthreads();
    const int v = *slot;
    __syncthreads();
    return __builtin_amdgcn_readfirstlane(v);
}
__device__ __forceinline__ void build_pref(Frame& F, int l) {
    LAS int* pref = (LAS int*)(F.lds + TAB_OFF);
    if (F.tid < 64) { const int e = F.tid & 31;
        const unsigned c = __hip_atomic_load(F.ctl + wsm::CW_CNT + (l * 32 + e) * 64, RLX_AGENT);
        const int np = (int)((c + 255u) >> 8); int inc = np;
#pragma unroll
        for (int o = 1; o < 32; o <<= 1) { const int nb = __shfl_up(inc, o); if (e >= o) inc += nb; }
        if (F.tid < 32) { pref[e] = inc - np; pref[40 + e] = (int)c; if (e == 31) pref[32] = inc; } }
    __syncthreads();
}

template <bool COMBINE, bool ROUTER, bool FINAL, bool F8 = false, bool XBF = false>
__device__ __forceinline__ void norm_phase(Frame& F, const Args& a, const float* xsrc, float* xout, const float* gain, int l, int lc) {
    using namespace cfg;
    constexpr int PITCHB = 4112;
    LAS unsigned char* tile = F.lds;
    LAS float* part = (LAS float*)(F.lds + 67584);
    LAS int* pref = (LAS int*)(F.lds + TAB_OFF);
    bf16* xn = (bf16*)(F.ws + wsm::XN);
    const bf16* OB = (const bf16*)(F.ws + wsm::OB);
    const int4* tokinfo = (const int4*)(F.ws + wsm::TOKINFO);
    const int lane = F.lane, w = F.wave;
    f32x4 g4[8];
#pragma unroll
    for (int j = 0; j < 8; ++j) g4[j] = *(const f32x4*)(gain + 4 * lane + 256 * j);
    LAS float* rb = (LAS float*)(F.lds + TAB_OFF + 1024);
    if constexpr (ROUTER) { if (F.tid < 36) rb[F.tid] = F.tid < 4 ? a.in[26][l * 4 + F.tid] : a.in[28][l * 32 + F.tid - 4]; __syncthreads(); }
    bf16x8 wrf[ROUTER ? 8 : 1][3];
    if constexpr (ROUTER) { const bf16* Wr = (const bf16*)(F.ws + wsm::WRT);
#pragma unroll
        for (int s8 = 0; s8 < 8; ++s8)
#pragma unroll
            for (int nt = 0; nt < 3; ++nt) wrf[s8][nt] = *(const bf16x8*)(Wr + (size_t)(16 * nt + (lane & 15)) * D + 256 * w + 32 * s8 + 8 * (lane >> 4)); }
    for (int pass = F.vcu; pass < M / 16; pass += F.G) {
#pragma unroll
        for (int rr = 0; rr < 2; ++rr) {
            const int rt = 2 * w + rr, row = pass * 16 + rt;
            f32x4 v[8];
            if constexpr (XBF) { const bf16* xr = (const bf16*)xsrc + (size_t)row * D + 4 * lane;
#pragma unroll
                for (int j = 0; j < 8; ++j) { const u32x2 w = *(const u32x2*)(xr + 256 * j); v[j] = (f32x4){__uint_as_float(w.x << 16), __uint_as_float(w.x & 0xffff0000u), __uint_as_float(w.y << 16), __uint_as_float(w.y & 0xffff0000u)}; }
            } else { const float* xr = xsrc + (size_t)row * D + 4 * lane;
#pragma unroll
                for (int j = 0; j < 8; ++j) v[j] = *(const f32x4*)(xr + 256 * j); }
            if constexpr (COMBINE) {
                const int4 ti = tokinfo[row];
                const unsigned char* o0 = (const unsigned char*)OB + ((size_t)pref[ti.x] * 256 + ti.y) * D + 4 * lane; const unsigned char* o1 = (const unsigned char*)OB + ((size_t)pref[ti.z] * 256 + ti.w) * D + 4 * lane;
#pragma unroll
                for (int j = 0; j < 8; ++j) { const int p0 = *(const int*)(o0 + 256 * j), p1 = *(const int*)(o1 + 256 * j);
                    const f32x2 a0 = __builtin_amdgcn_cvt_pk_f32_fp8(p0, false), a1 = __builtin_amdgcn_cvt_pk_f32_fp8(p0, true), b0 = __builtin_amdgcn_cvt_pk_f32_fp8(p1, false), b1 = __builtin_amdgcn_cvt_pk_f32_fp8(p1, true);
                    v[j].x += (a0.x + b0.x) * (1.f / F8_OB); v[j].y += (a0.y + b0.y) * (1.f / F8_OB); v[j].z += (a1.x + b1.x) * (1.f / F8_OB); v[j].w += (a1.y + b1.y) * (1.f / F8_OB); }
                if constexpr (!FINAL) {
#pragma unroll
                    for (int j = 0; j < 8; ++j) { if constexpr (XBF) { u32x2 w; w.x = pk2(v[j].x, v[j].y); w.y = pk2(v[j].z, v[j].w); *(u32x2*)((bf16*)xout + (size_t)row * D + 4 * lane + 256 * j) = w; }
                        else *(f32x4*)(xout + (size_t)row * D + 4 * lane + 256 * j) = v[j]; }
                }
            }
            float s = 0.f;
#pragma unroll
            for (int j = 0; j < 8; ++j) s += (v[j].x * v[j].x + v[j].y * v[j].y) + (v[j].z * v[j].z + v[j].w * v[j].w);
            const float rstd = rsqrtf(wave_sum(s) * (1.f / D) + 1e-6f);
#pragma unroll
            for (int j = 0; j < 8; ++j) { const f32x4 o = v[j] * rstd * g4[j];
                if constexpr (FINAL) *(f32x4*)(xout + (size_t)row * D + 4 * lane + 256 * j) = o;
                else if constexpr (F8) { *(unsigned*)((unsigned char*)xn + (size_t)row * D + 4 * lane + 256 * j) = pk4_fp8(o.x * pg8::F8_ACT, o.y * pg8::F8_ACT, o.z * pg8::F8_ACT, o.w * pg8::F8_ACT);
                    if constexpr (ROUTER) { u32x2 pk; pk.x = pk2(o.x, o.y); pk.y = pk2(o.z, o.w); *(LAS u32x2*)(tile + rt * PITCHB + (4 * lane + 256 * j) * 2) = pk; } }
                else { u32x2 pk; pk.x = pk2(o.x, o.y); pk.y = pk2(o.z, o.w);
                    *(u32x2*)(xn + (size_t)row * D + 4 * lane + 256 * j) = pk;
                    if constexpr (ROUTER) *(LAS u32x2*)(tile + rt * PITCHB + (4 * lane + 256 * j) * 2) = pk; } }
        }
        if constexpr (ROUTER) {
            __syncthreads();
            f32x4 acc[3] = {(f32x4){0.f, 0.f, 0.f, 0.f}, (f32x4){0.f, 0.f, 0.f, 0.f}, (f32x4){0.f, 0.f, 0.f, 0.f}};
#pragma unroll
            for (int s8 = 0; s8 < 8; ++s8) { const int k = 256 * w + 32 * s8 + 8 * (lane >> 4);
                const bf16x8 af = *(const LAS bf16x8*)(tile + (lane & 15) * PITCHB + k * 2);
#pragma unroll
                for (int nt = 0; nt < 3; ++nt) acc[nt] = __builtin_amdgcn_mfma_f32_16x16x32_bf16(af, wrf[s8][nt], acc[nt], 0, 0, 0); }
#pragma unroll
            for (int nt = 0; nt < 3; ++nt)
#pragma unroll
                for (int i = 0; i < 4; ++i) part[(w * 16 + (lane >> 4) * 4 + i) * 48 + 16 * nt + (lane & 15)] = acc[nt][i];
            __syncthreads();
            if (F.tid < 16) {
                const int m = F.tid, tok = pass * 16 + m;
                const LAS float* bg = rb; const LAS float* be = rb + 4;
                float lg[4];
#pragma unroll
                for (int o = 0; o < 4; ++o) { float sacc = bg[o];
#pragma unroll
                    for (int ww = 0; ww < 8; ++ww) sacc += part[(ww * 16 + m) * 48 + o]; lg[o] = sacc; }
                int gi = 0; float gm = lg[0];
#pragma unroll
                for (int o = 1; o < 4; ++o) if (lg[o] > gm) { gm = lg[o]; gi = o; }
                float gs = 0.f;
#pragma unroll
                for (int o = 0; o < 4; ++o) gs += __expf(lg[o] - gm);
                const float gw = 1.f / gs;
                float el[8];
#pragma unroll
                for (int o = 0; o < 8; ++o) { float sacc = be[gi * 8 + o];
#pragma unroll
                    for (int ww = 0; ww < 8; ++ww) sacc += part[(ww * 16 + m) * 48 + 4 + gi * 8 + o]; el[o] = sacc; }
                int i1 = 0; float m1 = el[0];
#pragma unroll
                for (int o = 1; o < 8; ++o) if (el[o] > m1) { m1 = el[o]; i1 = o; }
                int i2 = 0; float m2 = -3e38f;
#pragma unroll
                for (int o = 0; o < 8; ++o) if (o != i1 && el[o] > m2) { m2 = el[o]; i2 = o; }
                const float e2x = __expf(m2 - m1); const float w1 = gw / (1.f + e2x), w2 = gw * e2x / (1.f + e2x);
                const int e1 = gi * 8 + i1, e2 = gi * 8 + i2;
                const int p1 = (int)__hip_atomic_fetch_add(F.ctl + wsm::CW_CNT + (lc * 32 + e1) * 64, 1u, RLX_AGENT);
                const int p2 = (int)__hip_atomic_fetch_add(F.ctl + wsm::CW_CNT + (lc * 32 + e2) * 64, 1u, RLX_AGENT);
                int* lists = (int*)(F.ws + wsm::LISTS); float* wl = (float*)(F.ws + wsm::WLIST);
                lists[e1 * LCAP + p1] = tok; lists[e2 * LCAP + p2] = tok; wl[e1 * LCAP + p1] = w1; wl[e2 * LCAP + p2] = w2;
                ((int4*)(F.ws + wsm::TOKINFO))[tok] = make_int4(e1, p1, e2, p2);
                ((int4*)(F.ws + wsm::ROUTE))[tok] = make_int4(e1, e2, __float_as_int(w1), __float_as_int(w2));
            }
            __syncthreads();
        }
    }
}
namespace att {
typedef float f32x16 __attribute__((ext_vector_type(16)));
typedef short s16x4 __attribute__((ext_vector_type(4)));
constexpr int L_K = 0, L_V = 16384, L_WSF = 135168, L_TAB = 137216;
__device__ __forceinline__ int crow(int r, int hi) { return (r & 3) + 8 * (r >> 2) + 4 * hi; }
__device__ __forceinline__ int t5_bucket(int rel) {
    const int ret = rel > 0 ? 16 : 0; const int n = rel < 0 ? -rel : rel; int bk;
    if (n < 8) bk = n; else if (n < 12) bk = 8; else if (n < 16) bk = 9; else if (n < 23) bk = 10; else if (n < 32) bk = 11;
    else if (n < 46) bk = 12; else if (n < 64) bk = 13; else if (n < 91) bk = 14; else bk = 15;
    return ret + bk;
}
__device__ __forceinline__ unsigned cvtpk(float lo, float hi) { return pk2(lo, hi); }
__device__ __forceinline__ void qkt(f32x16& p0, f32x16& p1, const LAS unsigned char* Kslot, const bf16x8* qr, const f32x16& c0, const f32x16& c1, int r32, int hi) {
    const LAS unsigned char* kb = Kslot + hi * 1024 + r32 * 16;
#pragma unroll
    for (int d0 = 0; d0 < 4; ++d0) {
        const bf16x8 b0 = *(const LAS bf16x8*)(kb + d0 * 2048);
        const bf16x8 b1 = *(const LAS bf16x8*)(kb + d0 * 2048 + 512);
        if (d0 == 0) { p0 = __builtin_amdgcn_mfma_f32_32x32x16_bf16(b0, qr[0], c0, 0, 0, 0); p1 = __builtin_amdgcn_mfma_f32_32x32x16_bf16(b1, qr[0], c1, 0, 0, 0); }
        else { p0 = __builtin_amdgcn_mfma_f32_32x32x16_bf16(b0, qr[d0], p0, 0, 0, 0); p1 = __builtin_amdgcn_mfma_f32_32x32x16_bf16(b1, qr[d0], p1, 0, 0, 0); } }
}
__device__ __forceinline__ float rowmax(const f32x16& p0, const f32x16& p1) {
    float a = fmaxf(fmaxf(p0[0], p0[1]), p1[0]), b = fmaxf(fmaxf(p0[2], p0[3]), p1[1]); a = fmaxf(fmaxf(a, p1[2]), p1[3]);
#pragma unroll
    for (int r = 4; r < 16; r += 4) { a = fmaxf(fmaxf(a, p0[r]), p0[r + 1]); b = fmaxf(fmaxf(b, p0[r + 2]), p0[r + 3]); a = fmaxf(fmaxf(a, p1[r]), p1[r + 1]); b = fmaxf(fmaxf(b, p1[r + 2]), p1[r + 3]); }
    const float m = fmaxf(a, b);
    auto rr = __builtin_amdgcn_permlane32_swap(__float_as_uint(m), __float_as_uint(m), false, false);
    return fmaxf(__uint_as_float(rr[0]), __uint_as_float(rr[1]));
}
template <int ND>
__device__ __forceinline__ void pv(f32x16* o, int vb, bf16x8 pa0, bf16x8 pa1, bf16x8 pa2, bf16x8 pa3) {
#pragma unroll
    for (int d0 = 0; d0 < ND; ++d0) { s16x4 lo[4], hi[4];
#pragma unroll
        for (int ks = 0; ks < 4; ++ks) {
            asm volatile("ds_read_b64_tr_b16 %0,%1 offset:%c2" : "=&v"(lo[ks]) : "v"(vb), "i"(d0 * 4096 + ks * 1024) : "memory");
            asm volatile("ds_read_b64_tr_b16 %0,%1 offset:%c2" : "=&v"(hi[ks]) : "v"(vb), "i"(d0 * 4096 + ks * 1024 + 512) : "memory"); }
        asm volatile("s_waitcnt lgkmcnt(0)" ::: "memory"); __builtin_amdgcn_sched_barrier(0);
#define ATT_PK(k) (bf16x8){lo[k][0], lo[k][1], lo[k][2], lo[k][3], hi[k][0], hi[k][1], hi[k][2], hi[k][3]}
        o[d0] = __builtin_amdgcn_mfma_f32_32x32x16_bf16(pa0, ATT_PK(0), o[d0], 0, 0, 0);
        o[d0] = __builtin_amdgcn_mfma_f32_32x32x16_bf16(pa1, ATT_PK(1), o[d0], 0, 0, 0);
        o[d0] = __builtin_amdgcn_mfma_f32_32x32x16_bf16(pa2, ATT_PK(2), o[d0], 0, 0, 0);
        o[d0] = __builtin_amdgcn_mfma_f32_32x32x16_bf16(pa3, ATT_PK(3), o[d0], 0, 0, 0);
#undef ATT_PK
    }
}
#define ATT_WAIT_BAR(N) asm volatile("s_waitcnt vmcnt(" #N ") lgkmcnt(0)\n\ts_barrier" ::: "memory")
#ifndef PROBE_ATT
#define PROBE_ATT -1
#endif
#define ATT_NOW() __builtin_amdgcn_s_memrealtime()
#define ATT_SBAR() __builtin_amdgcn_sched_barrier(0)
#define ATT_PIN(x) asm volatile("" : "+v"(x))
#define ATT_MFMA(a, b, c) __builtin_amdgcn_mfma_f32_32x32x16_bf16(a, b, c, 0, 0, 0)
typedef const LAS char* lds_cptr;
typedef short v4i16_t __attribute__((ext_vector_type(4)));
__device__ __forceinline__ void glds16(const void* g, unsigned lds_base) {
    unsigned sv; asm volatile("s_mov_b32 %0, m0\n\ts_mov_b32 m0, %2\n\ts_nop 0\n\tglobal_load_lds_dwordx4 %1, off\n\ts_mov_b32 m0, %0" : "=&s"(sv) : "v"(g), "s"(lds_base) : "memory"); }
__device__ __forceinline__ void kload2(bf16x8* kf, lds_cptr kp, int d0) { kf[2 * d0] = *(const LAS bf16x8*)(kp + d0 * 2048); kf[2 * d0 + 1] = *(const LAS bf16x8*)(kp + d0 * 2048 + 512); }
__device__ __forceinline__ s16x4 vtr(lds_cptr q) { return __builtin_bit_cast(s16x4, __builtin_amdgcn_ds_read_tr16_b64_v4i16((LAS v4i16_t*)q)); }

template <int MODE>
__device__ __forceinline__ void attn_unit(Frame& F, const Args& a, const int l, const int b, const int hh, const int qb) {
    using namespace cfg;
    constexpr int ND = MODE ? 4 : 2, VSLOT = ND * 4096, NV = MODE ? 2 : 1, EPG = 8 / ND, KRD0 = MODE ? 8 : 2, VLEAD = 5;
    constexpr int NS = 4, LK = 0, LV = NS * 8192, LQ = 98304;
    constexpr float THR = 8.f;
    unsigned long long pu0_ = 0; if (PROBE_ATT == 3) pu0_ = ATT_NOW();
    const int lane = F.lane, r32 = lane & 31, hi = lane >> 5, wid = F.wave;
    const bf16* p = (const bf16*)(F.ws + wsm::P);
    bf16* y = (bf16*)(F.ws + wsm::Y);
    float* O1s = (float*)(F.ws + wsm::XN);
    LAS unsigned char* lds = F.lds;
    LAS float* wsf = (LAS float*)(lds + L_WSF) + wid * 64;
    LAS float* tab = (LAS float*)(lds + L_TAB);
    const size_t rowbase = (size_t)b * SEQ;
    const float* tg = (const float*)(F.ws + wsm::TABS) + (size_t)(F.vcu & 7) * 4096;
    if (F.tid < 320) tab[F.tid] = tg[(MODE ? 2560 : 0) + hh * 320 + F.tid];
    const int t0 = MODE == 0 ? (4 * qb - 8 > 0 ? 4 * qb - 8 : 0) : 0, t1 = 4 * qb + 3;
    const int cw = 4 * qb + (wid >> 1);
    const int va = MODE == 0 ? (cw - 8 > 0 ? cw - 8 : 0) : 0, vb = cw;
    const int q0w = qb * 256 + 32 * wid, myq = q0w + r32;
    const unsigned lds0 = (unsigned)(uintptr_t)lds;
    const lds_cptr kp0 = (lds_cptr)lds + LK + hi * 1024 + r32 * 16;
    const lds_cptr vp0 = (lds_cptr)lds + LV + ((lane >> 4) & 1) * 32 + (lane & 3) * 8 + (4 * hi + ((lane & 15) >> 2)) * 64;
#pragma unroll 1
    for (int sub = 0; sub < (MODE ? 2 : 1); ++sub) {
        const int qcol = MODE ? OFF_CQ + (hh * 2 + sub) * 64 : OFF_BQ + hh * 64;
        const int kcol = MODE ? OFF_CK + (hh * 2 + sub) * 64 : OFF_BK + hh * 64;
        const int vcol = MODE ? OFF_CV + hh * 128 : OFF_BV + hh * 64;
        const bf16* Kh = p + rowbase * INC + kcol; const bf16* Vh = p + rowbase * INC + vcol;
        const bf16* ksrc = Kh + (size_t)lane * INC + wid * 8;
        const bf16* vsrc0 = Vh + (size_t)(16 * (wid & 3) + (lane >> 2)) * INC + (wid >> 2) * 32 + (lane & 3) * 8;
        const unsigned kdst = lds0 + LK + wid * 1024, vdst = lds0 + LV + wid * 1024;
#define ATT_DMA_K(t, s) glds16(ksrc + (size_t)(t) * 64 * INC, (unsigned)__builtin_amdgcn_readfirstlane(kdst + (s) * 8192))
#define ATT_DMA_V(t, s) do { glds16(vsrc0 + (size_t)(t) * 64 * INC, (unsigned)__builtin_amdgcn_readfirstlane(vdst + (s) * VSLOT)); \
        if (MODE) glds16(vsrc0 + (size_t)(t) * 64 * INC + 64, (unsigned)__builtin_amdgcn_readfirstlane(vdst + (s) * VSLOT + 8192)); } while (0)
        { const bf16* Qw = p + (rowbase + q0w) * INC + qcol + (size_t)r32 * INC + hi * 8;
#pragma unroll
          for (int d0 = 0; d0 < 4; ++d0) glds16(Qw + d0 * 16, (unsigned)__builtin_amdgcn_readfirstlane(lds0 + LQ + wid * 4096 + d0 * 1024)); }
        ATT_DMA_K(t0, 0); ATT_DMA_V(t0, 0); ATT_DMA_K(t0 + 1, 1); ATT_DMA_K(t0 + 2, 2); ATT_DMA_K(t0 + 3, 3); ATT_DMA_V(t0 + 1, 1);
        float mhat = 0.f, l_reg = 0.f;
        f32x16 o[ND];
#pragma unroll
        for (int d0 = 0; d0 < ND; ++d0)
#pragma unroll
            for (int r = 0; r < 16; ++r) o[d0][r] = 0.f;
        { LAS unsigned char* z = lds + LV + 3 * VSLOT + F.tid * (VSLOT / 512);
#pragma unroll
          for (int i = 0; i < VSLOT / 512 / 16; ++i) *(LAS u32x4*)(z + 16 * i) = (u32x4){0u, 0u, 0u, 0u}; }
        if (MODE) { ATT_WAIT_BAR(4); } else { ATT_WAIT_BAR(3); }
        const float cf = tab[300];
        bf16x8 qr[4];
#pragma unroll
        for (int d0 = 0; d0 < 4; ++d0) qr[d0] = *(const LAS bf16x8*)(lds + LQ + wid * 4096 + d0 * 1024 + lane * 16);
        bf16x8 kf[8];
#pragma unroll
        for (int d0 = 0; d0 < 4; ++d0) kload2(kf, kp0, d0);
        asm volatile("s_waitcnt lgkmcnt(0)\n\ts_barrier" ::: "memory");
        f32x16 C0, C1; u32x4 pw[4];
#pragma unroll
        for (int r = 0; r < 16; ++r) { C0[r] = 0.f; C1[r] = 0.f; }
#pragma unroll
        for (int g = 0; g < 4; ++g) pw[g] = (u32x4){0u, 0u, 0u, 0u};
#define ATT_CE(e) (((e) < 16) ? C0[(e) & 15] : C1[(e) & 15])
#define ATT_CEXP(e) do { if ((e) < 16) C0[(e) & 15] = __builtin_amdgcn_exp2f(C0[(e) & 15]); else C1[(e) & 15] = __builtin_amdgcn_exp2f(C1[(e) & 15]); } while (0)
#define ATT_VRD(ks, d0) do { vlo[(ks) * ND + (d0)] = vtr(vpp + (d0) * 4096 + (ks) * 1024); vhi[(ks) * ND + (d0)] = vtr(vpp + (d0) * 4096 + (ks) * 1024 + 512); } while (0)
#define ATT_VRDF(f) ATT_VRD((f) / ND, (f) % ND)
#define ATT_VFR(i) (bf16x8){vlo[i][0], vlo[i][1], vlo[i][2], vlo[i][3], vhi[i][0], vhi[i][1], vhi[i][2], vhi[i][3]}
#define ATT_PAF(g) __builtin_bit_cast(bf16x8, pw[g])
        unsigned long long pl0_ = 0; if (PROBE_ATT == 2) pl0_ = ATT_NOW(); if (PROBE_ATT == 4) pl0_ = __builtin_amdgcn_s_memtime();
#pragma unroll 1
        for (int t = t0; t <= t1; ++t) {
            const bool gk = (t + 4 <= t1), gv = (t + 2 <= t1);
            const int s_cur = (t - t0) & 3, s_prev = (t - t0 - 1) & 3, s_next = (t - t0 + 1) & 3, s_nn = (t - t0 + 2) & 3;
            const lds_cptr vpp = vp0 + s_prev * VSLOT;
            const lds_cptr kpn = kp0 + s_next * 8192;
            bool resc = false;
            ATT_SBAR();
            {
                s16x4 vlo[4 * ND], vhi[4 * ND];
                const bool msk = (t > vb) || (t < va);
                const bool nearb = !msk && (q0w - (t * 64 + 63)) < 128;
                if (nearb) {
                    const LAS float* tb = tab + (myq - t * 64 - 4 * hi + 64 - 27 - 32);
#pragma unroll
                    for (int r = 0; r < 16; ++r) { C1[r] = tb[27 - ((r & 3) + 8 * (r >> 2))] - mhat; C0[r] = tb[32 + 27 - ((r & 3) + 8 * (r >> 2))] - mhat; }
                    ATT_SBAR();
                    C0 = ATT_MFMA(kf[0], qr[0], C0); ATT_SBAR(); C1 = ATT_MFMA(kf[1], qr[0], C1); ATT_SBAR();
                } else {
                    f32x16 cfm; const float cfv = msk ? -1e30f : cf - mhat;
#pragma unroll
                    for (int r = 0; r < 16; ++r) cfm[r] = cfv;
                    ATT_SBAR();
                    C0 = ATT_MFMA(kf[0], qr[0], cfm); ATT_SBAR(); C1 = ATT_MFMA(kf[1], qr[0], cfm); ATT_SBAR();
                }
#pragma unroll
                for (int i = 2; i < 8; ++i) {
                    if (i >= 8 - VLEAD) { ATT_VRDF(i - (8 - VLEAD)); ATT_SBAR(); }
                    if (i & 1) C1 = ATT_MFMA(kf[i], qr[i >> 1], C1); else C0 = ATT_MFMA(kf[i], qr[i >> 1], C0);
                    ATT_SBAR();
                }
                if (gk) ATT_DMA_K(t + 4, s_cur);
                if (gv) ATT_DMA_V(t + 2, s_nn);
                const float rm = rowmax(C0, C1);
                const bool firstv = (t == va);
                if (__builtin_expect(firstv || __any(rm > THR), 0)) {
                    const float dl = firstv ? rm : fmaxf(rm, 0.f); mhat += dl;
#pragma unroll
                    for (int r = 0; r < 16; ++r) { C0[r] -= dl; C1[r] -= dl; }
                    const float f = firstv ? 1.f : __builtin_amdgcn_exp2f(-dl); l_reg *= f; if (hi == 0) wsf[r32] = f; resc = !firstv;
                }
                ATT_SBAR();
                float sa = 0.f, sb = 0.f;
#pragma unroll
                for (int m = 0; m < 4 * ND; ++m) {
                    const int g = m / ND, d0 = m % ND;
                    if (m + VLEAD < 4 * ND) { ATT_VRDF(m + VLEAD); ATT_SBAR(); }
                    if (m >= KRD0 && m < KRD0 + 4) { kload2(kf, kpn, m - KRD0); ATT_SBAR(); }
                    o[d0] = ATT_MFMA(ATT_PAF(g), ATT_VFR(g * ND + d0), o[d0]);
#pragma unroll
                    for (int jj = 0; jj < EPG; ++jj) ATT_CEXP(8 * g + EPG * d0 + jj);
                    if (g >= 1) {
#pragma unroll
                        for (int jj = 0; jj < EPG; jj += 2) { const int e = 8 * (g - 1) + EPG * d0 + jj; sa += ATT_CE(e); sb += ATT_CE(e + 1); pw[g - 1][(EPG * d0 + jj) >> 1] = pk2(ATT_CE(e), ATT_CE(e + 1)); }
                        ATT_PIN(pw[g - 1]); ATT_PIN(sa); ATT_PIN(sb);
                    }
                    if (g < 2) ATT_PIN(C0); else ATT_PIN(C1);
                    ATT_SBAR();
                }
#pragma unroll
                for (int jj = 0; jj < 8; jj += 2) { const int e = 24 + jj; sa += ATT_CE(e); sb += ATT_CE(e + 1); pw[3][jj >> 1] = pk2(ATT_CE(e), ATT_CE(e + 1)); }
                l_reg += sa + sb;
            }
            ATT_SBAR();
            unsigned long long pw0_ = 0; if (PROBE_ATT == 0) pw0_ = ATT_NOW();
            { const int dleft = t1 - t;
              if (dleft >= 4) { if (MODE) { ATT_WAIT_BAR(6); } else { ATT_WAIT_BAR(4); } }
              else if (dleft == 3) { if (MODE) { ATT_WAIT_BAR(5); } else { ATT_WAIT_BAR(3); } }
              else if (dleft == 2) { if (MODE) { ATT_WAIT_BAR(4); } else { ATT_WAIT_BAR(2); } }
              else if (dleft == 1) { if (MODE) { ATT_WAIT_BAR(2); } else { ATT_WAIT_BAR(1); } }
              else { ATT_WAIT_BAR(0); } }
            if (PROBE_ATT == 0) F.pacc += ATT_NOW() - pw0_;
            if (resc) {
#pragma unroll
                for (int r = 0; r < 16; ++r) { const float fr = wsf[crow(r, hi)];
#pragma unroll
                    for (int d0 = 0; d0 < ND; ++d0) o[d0][r] *= fr; }
            }
        }
        if (PROBE_ATT == 2) F.pacc += ATT_NOW() - pl0_; if (PROBE_ATT == 4) F.pacc += (__builtin_amdgcn_s_memtime() - pl0_) / 100;
        {
            const lds_cptr vpp = vp0 + ((t1 - t0) & 3) * VSLOT;
            s16x4 vlo[4 * ND], vhi[4 * ND];
#pragma unroll
            for (int ks = 0; ks < 4; ++ks) {
#pragma unroll
                for (int d0 = 0; d0 < ND; ++d0) ATT_VRD(ks, d0);
#pragma unroll
                for (int d0 = 0; d0 < ND; ++d0) o[d0] = ATT_MFMA(ATT_PAF(ks), ATT_VFR(ks * ND + d0), o[d0]);
            }
            asm volatile("s_waitcnt lgkmcnt(0)\n\ts_barrier" ::: "memory");
        }
#undef ATT_DMA_K
#undef ATT_DMA_V
#undef ATT_CE
#undef ATT_CEXP
#undef ATT_VRD
#undef ATT_VFR
#undef ATT_VRDF
#undef ATT_PAF
        float lh = l_reg;
        int ln = lane; asm volatile("" : "+v"(ln));
        const int e32 = ln & 31, ehi = ln >> 5;
        { auto rr = __builtin_amdgcn_permlane32_swap(__float_as_uint(lh), __float_as_uint(lh), false, false); lh = __uint_as_float(rr[0]) + __uint_as_float(rr[1]); }
        if (ehi == 0) wsf[32 + e32] = lh;
        LDS_WAIT();
        constexpr int SP = ND * 128 + 16;
        LAS unsigned char* stg = lds + wid * (32 * SP);
#pragma unroll
        for (int r = 0; r < 16; ++r) { const float rl = __builtin_amdgcn_rcpf(wsf[32 + crow(r, ehi)]);
#pragma unroll
            for (int d0 = 0; d0 < ND; ++d0) *(LAS float*)(stg + crow(r, ehi) * SP + (d0 * 32 + e32) * 4) = o[d0][r] * rl; }
        LDS_WAIT();
        const size_t tok0 = rowbase + (size_t)(qb * 256 + 32 * wid);
        if (MODE == 0) {
#pragma unroll 4
            for (int row = 0; row < 32; ++row) { const float v = *(const LAS float*)(stg + row * SP + ln * 4);
                if (F8OUT(l)) ((unsigned char*)y)[(tok0 + row) * D + 512 + hh * 64 + ln] = (unsigned char)(pk2_fp8(v * F8_Y, 0.f) & 0xffu); else y[(tok0 + row) * D + 512 + hh * 64 + ln] = cvt1(v); }
        } else if (sub == 0) {
#pragma unroll 4
            for (int row = 0; row < 32; ++row) { const f32x2 v = *(const LAS f32x2*)(stg + row * SP + ln * 8); *(f32x2*)(O1s + ((tok0 + row) * 4 + hh) * 128 + 2 * ln) = v; }
        } else {
            const float lam = tg[3840];
            const float sw0 = tg[3848 + 2 * ln], sw1 = tg[3848 + 2 * ln + 1];
#pragma unroll 2
            for (int row = 0; row < 32; ++row) { const f32x2 v2 = *(const LAS f32x2*)(stg + row * SP + ln * 8); const f32x2 o1 = *(const f32x2*)(O1s + ((tok0 + row) * 4 + hh) * 128 + 2 * ln);
                const float v0 = o1.x - lam * v2.x, v1 = o1.y - lam * v2.y;
                const float ms = wave_sum(v0 * v0 + v1 * v1);
                const float rs = rsqrtf(ms * (1.f / 128.f) + 1e-5f);
                if (F8OUT(l)) *(unsigned short*)((unsigned char*)y + (tok0 + row) * D + 1024 + hh * 128 + 2 * ln) = (unsigned short)pk2_fp8(v0 * rs * sw0 * F8_Y, v1 * rs * sw1 * F8_Y);
                else *(unsigned*)(y + (tok0 + row) * D + 1024 + hh * 128 + 2 * ln) = pk2(v0 * rs * sw0, v1 * rs * sw1); }
        }
        asm volatile("s_waitcnt vmcnt(0) lgkmcnt(0)\n\ts_barrier" ::: "memory");
    }
    if (PROBE_ATT == 3) F.pacc += ATT_NOW() - pu0_;
}

__device__ __forceinline__ void conv_items(Frame& F, const Args& a, const int l, const int start, const int stride) {
    using namespace cfg;
    const bf16* p = (const bf16*)(F.ws + wsm::P); bf16* y = (bf16*)(F.ws + wsm::Y);
    const float* cwp = a.in[24] + l * 3 * 512;
    float cw[3][8];
    { const int cg0 = (start & 63) * 8;
#pragma unroll
      for (int q = 0; q < 3; ++q) { const f32x4 w0 = *(const f32x4*)(cwp + q * 512 + cg0), w1 = *(const f32x4*)(cwp + q * 512 + cg0 + 4);
#pragma unroll
          for (int j = 0; j < 4; ++j) { cw[q][j] = w0[j]; cw[q][4 + j] = w1[j]; } } }
    for (int it = start; it < M * 64; it += stride) {
        const int tok = it >> 6, cg = (it & 63) * 8, t = tok & (SEQ - 1);
        const bf16* r0 = p + (size_t)tok * INC + OFF_D + cg;
        const u32x4 bg = *(const u32x4*)r0;
        u32x4 c0 = *(const u32x4*)(r0 + 512), h0 = *(const u32x4*)(r0 + 1024);
        u32x4 c1 = (u32x4){0, 0, 0, 0}, h1 = c1, c2 = c1, h2 = c1;
        if (t >= 1) { c1 = *(const u32x4*)(r0 - INC + 512); h1 = *(const u32x4*)(r0 - INC + 1024); }
        if (t >= 2) { c2 = *(const u32x4*)(r0 - 2 * INC + 512); h2 = *(const u32x4*)(r0 - 2 * INC + 1024); }
        unsigned ow[4];
#pragma unroll
        for (int j = 0; j < 4; ++j) {
            float res[2];
#pragma unroll
            for (int e = 0; e < 2; ++e) {
#define ATT_UP(w) (e ? __uint_as_float((w) & 0xffff0000u) : __uint_as_float((w) << 16))
                const float u0 = ATT_UP(c0[j]) * ATT_UP(h0[j]), u1 = ATT_UP(c1[j]) * ATT_UP(h1[j]), u2 = ATT_UP(c2[j]) * ATT_UP(h2[j]);
                res[e] = ATT_UP(bg[j]) * (cw[0][2 * j + e] * u2 + cw[1][2 * j + e] * u1 + cw[2][2 * j + e] * u0);
#undef ATT_UP
            }
            ow[j] = (F8OUT(l)) ? pk2_fp8(res[0] * F8_Y, res[1] * F8_Y) : pk2(res[0], res[1]);
        }
        if (F8OUT(l)) *(u32x2*)((unsigned char*)y + (size_t)tok * D + 1536 + cg) = (u32x2){ow[0] | (ow[1] << 16), ow[2] | (ow[3] << 16)};
        else *(u32x4*)(y + (size_t)tok * D + 1536 + cg) = (u32x4){ow[0], ow[1], ow[2], ow[3]};
    }
}
}
__device__ __forceinline__ void build_attn_tables(Frame& F, const Args& a, const int l) {
    float* tabs = (float*)(F.ws + wsm::TABS);
    const float lam_init = l == 0 ? 0.2f : (float)(0.8 - 0.6 * 0.7408182206817179);
    for (int idx = F.vcu * 512 + F.tid; idx < 8 * 4096; idx += F.G * 512) {
        const int e = idx & 4095; float v = 0.f;
        if (e < 2560) { const int hh = e / 320, i = e - hh * 320; int d = i - 64; d = d < -128 ? -128 : (d > 128 ? 128 : d); v = a.in[17][(size_t)(l * 8 + hh) * 257 + d + 128] * LOG2E; }
        else if (e < 3840) { const int e2 = e - 2560, hh = e2 / 320, i = e2 - hh * 320; v = a.in[18][att::t5_bucket(-(i - 64)) * 4 + hh] * LOG2E; }
        else if (e == 3840) { float s1 = 0.f, s2 = 0.f;
            for (int j = 0; j < 64; ++j) { s1 += a.in[19][l * 64 + j] * a.in[20][l * 64 + j]; s2 += a.in[21][l * 64 + j] * a.in[22][l * 64 + j]; }
            v = __expf(s1) - __expf(s2) + lam_init; }
        else if (e >= 3848 && e < 3976) v = a.in[23][l * 128 + e - 3848] * (1.f - lam_init);
        tabs[idx] = v;
    }
}
namespace rw {
constexpr int PB = 144, PB2 = 272;
constexpr int SLOT = 9216;
constexpr int R0 = 0, R1B = 49152;
constexpr int O_P0 = 0, O_P0T = 9216, O_AAK = 18432, O_ARB = 27648, O_ARK = 36864;
constexpr int O_SEG = R1B + 9 * SLOT, O_BON = O_SEG + 2048;
constexpr size_t UNIT_BYTES = 49152;
constexpr size_t WL_OFF = (size_t)4096 * UNIT_BYTES;
#define RW_S(i) (R1B + (i) * SLOT)

__device__ __forceinline__ bf16x8 ldfrag(const LAS unsigned char* base, int pitch, int row0, int lane, int s) {
    return *(const LAS bf16x8*)(base + (row0 + (lane & 15)) * pitch + (32 * s + 8 * (lane >> 4)) * 2);
}
template <int KS>
__device__ __forceinline__ f32x4 tile_mm(f32x4 acc, const LAS unsigned char* X, int px, int m0, const LAS unsigned char* Y, int py, int n0, int lane) {
#pragma unroll
    for (int s = 0; s < KS; ++s) acc = __builtin_amdgcn_mfma_f32_16x16x32_bf16(ldfrag(Y, py, n0, lane, s), ldfrag(X, px, m0, lane, s), acc, 0, 0, 0);
    return acc;
}
__device__ __forceinline__ void st_rm(LAS unsigned char* base, int pitch, int m, int n0, f32x4 v) {
    u32x2 w; w.x = pk2(v[0], v[1]); w.y = pk2(v[2], v[3]); *(LAS u32x2*)(base + m * pitch + n0 * 2) = w;
}
__device__ __forceinline__ void st_tr(LAS unsigned char* base, int pitch, int m, int n0, f32x4 v) {
    const unsigned p01 = pk2(v[0], v[1]), p23 = pk2(v[2], v[3]);
    *(LAS bf16*)(base + (n0 + 0) * pitch + m * 2) = (bf16)(p01 & 0xffffu); *(LAS bf16*)(base + (n0 + 1) * pitch + m * 2) = (bf16)(p01 >> 16);
    *(LAS bf16*)(base + (n0 + 2) * pitch + m * 2) = (bf16)(p23 & 0xffffu); *(LAS bf16*)(base + (n0 + 3) * pitch + m * 2) = (bf16)(p23 >> 16);
}
__device__ __forceinline__ f32x4 ld_rm(const LAS unsigned char* base, int pitch, int m, int n0) {
    const u32x2 w = *(const LAS u32x2*)(base + m * pitch + n0 * 2);
    return (f32x4){__uint_as_float(w.x << 16), __uint_as_float(w.x & 0xffff0000u), __uint_as_float(w.y << 16), __uint_as_float(w.y & 0xffff0000u)};
}
__device__ __forceinline__ void unpack8(const u32x4 w, float* f) {
#pragma unroll
    for (int j = 0; j < 4; ++j) { f[2 * j] = __uint_as_float(w[j] << 16); f[2 * j + 1] = __uint_as_float(w[j] & 0xffff0000u); }
}
__device__ __forceinline__ u32x4 pack8(const float* f) { return (u32x4){pk2(f[0], f[1]), pk2(f[2], f[3]), pk2(f[4], f[5]), pk2(f[6], f[7])}; }
__device__ __forceinline__ float sigm(float x) { return __builtin_amdgcn_rcpf(1.f + __expf(-x)); }
#define RW_BAR() do { asm volatile("s_waitcnt lgkmcnt(0)" ::: "memory"); __builtin_amdgcn_s_barrier(); asm volatile("" ::: "memory"); } while (0)

#ifndef PROBE_R1
#define PROBE_R1 -1
#endif
#define R1_STAMP(k) do { if (PROBE_R1 >= 0) { const unsigned long long now_ = __builtin_amdgcn_s_memrealtime(); if (PROBE_R1 == (k)) racc += now_ - rlast; rlast = now_; } } while (0)
__device__ __forceinline__ int xo_frag(int rt, int s, int lane) { return ((rt * 2 + s) * 64 + lane) * 16; }
__device__ __forceinline__ int xo_acc(int rt, int nt, int lane) { return ((rt * 4 + nt) * 64 + lane) * 8; }
__device__ __forceinline__ int xo_frag_from_acc(int rt, int nt, int lane) { const int q = lane >> 4, kc = 2 * nt + (q >> 1); return ((rt * 2 + (kc >> 2)) * 64 + (kc & 3) * 16 + (lane & 15)) * 16 + (q & 1) * 8; }
struct R1Raw { u32x4 c[3], p[3]; bf16x8 fl[8]; };
__device__ __forceinline__ void r1_load(Frame& F, const int u, R1Raw& raw, const int tid) {
    using namespace cfg;
    const int c = u & 63, h = (u >> 6) & 7, b = u >> 9, t = tid >> 3, j0 = (tid & 7) * 8, lane = tid & 63;
    const size_t tok0 = (size_t)b * SEQ + c * 64;
    const bf16* cur = (const bf16*)(F.ws + wsm::P) + (tok0 + t) * INC + j0; const bf16* prv = cur - INC;
#pragma unroll
    for (int i = 0; i < 3; ++i) { const int col = i * 512 + h * 64; raw.c[i] = *(const u32x4*)(cur + col); raw.p[i] = *(const u32x4*)(prv + col); }
    const bf16* lr = (const bf16*)(F.ws + wsm::LORA) + (tok0 + 16 * (F.wave >> 1) + (lane & 15)) * 256 + 8 * (lane >> 4);
#pragma unroll
    for (int s2 = 0; s2 < 2; ++s2) { raw.fl[s2] = *(const bf16x8*)(lr + 32 * s2); raw.fl[2 + s2] = *(const bf16x8*)(lr + 64 + 32 * s2); }
#pragma unroll
    for (int s2 = 0; s2 < 4; ++s2) raw.fl[4 + s2] = *(const bf16x8*)(lr + 128 + 32 * s2);
}
struct R1W { bf16x8 fw[2][2], fa[2][2], fg[2][4]; };
__device__ __forceinline__ void lora_prepass(Frame& F, const Args& a, const int l) {
    using namespace cfg;
    const bf16* p = (const bf16*)(F.ws + wsm::P); bf16* lora = (bf16*)(F.ws + wsm::LORA);
    const float* mu = a.in[6] + l * 1792 + 1536;
    const int cg = (F.tid & 31) * 8;
    const f32x4 m0 = *(const f32x4*)(mu + cg), m1 = *(const f32x4*)(mu + cg + 4);
    for (int it = F.vcu * 512 + F.tid; it < M * 32; it += F.G * 512) {
        const int tok = it >> 5;
        const bf16* cur = p + (size_t)tok * INC + 1536 + cg;
        float cv[8], pv[8], x[8];
        unpack8(*(const u32x4*)cur, cv);
        if ((tok & (SEQ - 1)) != 0) unpack8(*(const u32x4*)(cur - INC), pv); else {
#pragma unroll
            for (int j = 0; j < 8; ++j) pv[j] = 0.f; }
#pragma unroll
        for (int j = 0; j < 8; ++j) { const float mj = j < 4 ? m0[j] : m1[j - 4]; x[j] = cv[j] + (pv[j] - cv[j]) * mj; }
        if (cg < 64) {
#pragma unroll
            for (int j = 0; j < 8; ++j) { const float e2 = __expf(2.f * x[j]); x[j] = 1.f - 2.f * __builtin_amdgcn_rcpf(e2 + 1.f); }
        } else if (cg >= 128) {
#pragma unroll
            for (int j = 0; j < 8; ++j) x[j] = sigm(x[j]);
        }
        *(u32x4*)(lora + (size_t)tok * 256 + cg) = pack8(x);
    }
}
__device__ __forceinline__ void r1_unit(Frame& F, const Args& a, const int l, const int u, const int unext, R1Raw& raw, R1W& W, unsigned long long& racc, int& hcur) {
    using namespace cfg;
    unsigned long long rlast = PROBE_R1 >= 0 ? __builtin_amdgcn_s_memrealtime() : 0ull;
    int tid_ = F.tid; asm volatile("" : "+v"(tid_));
    const int tid = tid_, lane = tid & 63, w = F.wave;
    const int c = u & 63, h = (u >> 6) & 7, b = u >> 9;
    unsigned lbase_ = (unsigned)(uintptr_t)F.lds; asm volatile("" : "+s"(lbase_));
    LAS unsigned char* lds = (LAS unsigned char*)(uintptr_t)lbase_;
    const bf16* p = (const bf16*)(F.ws + wsm::P);
    const bf16* w2t = (const bf16*)(F.ws + wsm::WRT + 262144);
    const bf16* a2t = w2t + 512 * 64; const bf16* g2t = a2t + 512 * 64;
    unsigned char* gout = F.ws + wsm::RW + (size_t)u * UNIT_BYTES;
    float* wl_out = (float*)(F.ws + wsm::RW + WL_OFF) + (size_t)u * 64;
    const float* mu = a.in[6] + l * 1792;
    const size_t tok0 = (size_t)b * SEQ + c * 64;
    const int t = tid >> 3, j0 = (tid & 7) * 8;
    const bool hasprev = (c > 0) || (t > 0);
    const bf16* cur = p + (tok0 + t) * INC; const bf16* prv = cur - INC;
    LAS float* WPRE = (LAS float*)(lds + 0); LAS float* APRE = (LAS float*)(lds + 16384); LAS float* GG = (LAS float*)(lds + 32768);
    LAS float* PAR = (LAS float*)(lds + 134400);
    const int mtA = w >> 1;
    if (h != hcur) {
        RW_BAR();
        if (w < 7) { const int pidx = w == 0 ? 7 : (w == 1 ? 9 : 10 + w); PAR[w * 64 + lane] = a.in[pidx][l * 512 + h * 64 + lane]; }
        if (tid < 448) { const int col = tid < 192 ? (tid >> 6) * 512 + h * 64 + (tid & 63) : 1536 + (tid - 192); PAR[448 + tid] = mu[col]; }
        hcur = h;
#pragma unroll
        for (int q = 0; q < 2; ++q) { const int ch = h * 64 + 16 * (2 * (w & 1) + q) + (lane & 15);
#pragma unroll
            for (int s2 = 0; s2 < 2; ++s2) { const int kq = 32 * s2 + 8 * (lane >> 4); W.fw[q][s2] = *(const bf16x8*)(w2t + ch * 64 + kq); W.fa[q][s2] = *(const bf16x8*)(a2t + ch * 64 + kq); }
#pragma unroll
            for (int s2 = 0; s2 < 4; ++s2) W.fg[q][s2] = *(const bf16x8*)(g2t + ch * 128 + 32 * s2 + 8 * (lane >> 4)); }
        RW_BAR();
    }
    float r[8], k[8], v[8];
    {
        auto mix8 = [&](int i, int mo, float* o) { float cv[8], pv[8], m8[8]; unpack8(raw.c[i], cv);
            if (hasprev) unpack8(raw.p[i], pv); else {
#pragma unroll
                for (int j = 0; j < 8; ++j) pv[j] = 0.f; }
            *(f32x4*)m8 = *(const LAS f32x4*)(PAR + 448 + mo); *(f32x4*)(m8 + 4) = *(const LAS f32x4*)(PAR + 448 + mo + 4);
#pragma unroll
            for (int j = 0; j < 8; ++j) o[j] = cv[j] + (pv[j] - cv[j]) * m8[j]; };
        mix8(0, j0, r); mix8(1, 64 + j0, k); mix8(2, 128 + j0, v);
    }
    R1_STAMP(0);
    {
#pragma unroll
        for (int q = 0; q < 2; ++q) { const int nt = 2 * (w & 1) + q;
            f32x4 aw = {0.f, 0.f, 0.f, 0.f}, aa = aw, ag = aw;
#pragma unroll
            for (int s2 = 0; s2 < 2; ++s2) {
                aw = __builtin_amdgcn_mfma_f32_16x16x32_bf16(W.fw[q][s2], raw.fl[s2], aw, 0, 0, 0);
                aa = __builtin_amdgcn_mfma_f32_16x16x32_bf16(W.fa[q][s2], raw.fl[2 + s2], aa, 0, 0, 0); }
#pragma unroll
            for (int s2 = 0; s2 < 4; ++s2) ag = __builtin_amdgcn_mfma_f32_16x16x32_bf16(W.fg[q][s2], raw.fl[4 + s2], ag, 0, 0, 0);
            const int m = 16 * mtA + (lane & 15), n0 = 16 * nt + 4 * (lane >> 4);
            const f32x4 w04 = *(const LAS f32x4*)(PAR + n0), a04 = *(const LAS f32x4*)(PAR + 64 + n0);
#pragma unroll
            for (int i = 0; i < 4; ++i) { const float nx = -(w04[i] + aw[i]); const float sp = nx > 20.f ? nx : __logf(1.f + __expf(nx)); aw[i] = -__expf(-sp - 0.5f); aa[i] = sigm(a04[i] + aa[i]); }
            *(LAS f32x4*)(WPRE + m * 64 + n0) = aw; *(LAS f32x4*)(APRE + m * 64 + n0) = aa; *(LAS f32x4*)(GG + m * 64 + n0) = ag; }
    }
    r1_load(F, unext, raw, tid);
    RW_BAR(); R1_STAMP(1); R1_STAMP(2);
    {
        LAS float* SEG = (LAS float*)(lds + O_SEG);
        const int ch = tid & 63, seg = tid >> 6;
        float pf[8]; float run = 0.f;
#pragma unroll
        for (int i = 0; i < 8; ++i) { run += WPRE[(8 * seg + i) * 64 + ch]; pf[i] = run; }
        SEG[seg * 64 + ch] = run;
        RW_BAR();
        float off = 0.f;
        for (int s2 = 0; s2 < seg; ++s2) off += SEG[s2 * 64 + ch];
#pragma unroll
        for (int i = 0; i < 8; ++i) WPRE[(8 * seg + i) * 64 + ch] = off + pf[i];
    }
    RW_BAR(); R1_STAMP(3);
    {
        float kk[8], k2[8], aic[8]; float ss = 0.f, bon = 0.f;
        { float pkk[8], pka[8], prk[8];
#define R1_LD8(dst, src) do { *(f32x4*)(dst) = *(const LAS f32x4*)(src); *(f32x4*)((dst) + 4) = *(const LAS f32x4*)((src) + 4); } while (0)
          R1_LD8(aic, APRE + t * 64 + j0); R1_LD8(pkk, PAR + 128 + j0); R1_LD8(pka, PAR + 192 + j0); R1_LD8(prk, PAR + 256 + j0);
#undef R1_LD8
#pragma unroll
          for (int j = 0; j < 8; ++j) { kk[j] = k[j] * pkk[j]; ss += kk[j] * kk[j]; k2[j] = k[j] * (1.f + (aic[j] - 1.f) * pka[j]); bon += r[j] * k2[j] * prk[j]; } }
        ss += __shfl_xor(ss, 1); ss += __shfl_xor(ss, 2); ss += __shfl_xor(ss, 4);
        bon += __shfl_xor(bon, 1); bon += __shfl_xor(bon, 2); bon += __shfl_xor(bon, 4);
        const float inv = 1.f / fmaxf(sqrtf(ss), 1e-12f);
        unsigned g1w[4], g0w[4];
#pragma unroll
        for (int jp = 0; jp < 8; jp += 2) {
            const f32x2 cum = *(const LAS f32x2*)(WPRE + t * 64 + j0 + jp), tot = *(const LAS f32x2*)(WPRE + 63 * 64 + j0 + jp), gg = *(const LAS f32x2*)(GG + t * 64 + j0 + jp);
            f32x2 cpv = {0.f, 0.f}; if (t > 0) cpv = *(const LAS f32x2*)(WPRE + (t - 1) * 64 + j0 + jp);
            const f32x2 pgw = *(const LAS f32x2*)(PAR + 320 + j0 + jp), pgb = *(const LAS f32x2*)(PAR + 384 + j0 + jp);
            float xa[2], xr[2], xb[2], xk[2], xbh[2], xkh[2], g1[2], g0[2];
#pragma unroll
            for (int e = 0; e < 2; ++e) { const int j = jp + e; const float kn = kk[j] * inv, bv = kn * aic[j];
                const float e_ex = __expf(cpv[e]), e_in = __expf(cum[e]), e_ng = __expf(-cum[e]), e_tt = __expf(tot[e] - cum[e]);
                xa[e] = -kn * e_ex; xr[e] = r[j] * e_in; xb[e] = bv * e_ng; xk[e] = k2[j] * e_ng; xbh[e] = bv * e_tt; xkh[e] = k2[j] * e_tt;
                g1[e] = pgw[e] * gg[e]; g0[e] = (pgb[e] + bon * v[j]) * gg[e];
                if (t == 63) wl_out[j0 + j] = __expf(tot[e]); }
            const unsigned pa = pk2(xa[0], xa[1]), pr = pk2(xr[0], xr[1]), pb = pk2(xb[0], xb[1]), pkn = pk2(xk[0], xk[1]), pv2 = pk2(v[jp], v[jp + 1]), pbh = pk2(xbh[0], xbh[1]), pkh = pk2(xkh[0], xkh[1]);
            *(LAS unsigned*)(lds + RW_S(0) + t * PB + (j0 + jp) * 2) = pa; *(LAS unsigned*)(lds + RW_S(1) + t * PB + (j0 + jp) * 2) = pr;
            *(LAS unsigned*)(lds + RW_S(2) + t * PB + (j0 + jp) * 2) = pb; *(LAS unsigned*)(lds + RW_S(3) + t * PB + (j0 + jp) * 2) = pkn;
            *(LAS bf16*)(lds + RW_S(4) + (j0 + jp) * PB + t * 2) = (bf16)(pa & 0xffffu); *(LAS bf16*)(lds + RW_S(4) + (j0 + jp + 1) * PB + t * 2) = (bf16)(pa >> 16);
            *(LAS bf16*)(lds + RW_S(5) + (j0 + jp) * PB + t * 2) = (bf16)(pv2 & 0xffffu); *(LAS bf16*)(lds + RW_S(5) + (j0 + jp + 1) * PB + t * 2) = (bf16)(pv2 >> 16);
            *(LAS bf16*)(lds + RW_S(6) + (j0 + jp) * PB + t * 2) = (bf16)(pbh & 0xffffu); *(LAS bf16*)(lds + RW_S(6) + (j0 + jp + 1) * PB + t * 2) = (bf16)(pbh >> 16);
            *(LAS bf16*)(lds + RW_S(7) + (j0 + jp) * PB + t * 2) = (bf16)(pkh & 0xffffu); *(LAS bf16*)(lds + RW_S(7) + (j0 + jp + 1) * PB + t * 2) = (bf16)(pkh >> 16);
            g1w[jp >> 1] = pk2(g1[0], g1[1]); g0w[jp >> 1] = pk2(g0[0], g0[1]);
        }
        { const int rt = t >> 4, nt_ = j0 >> 4, ql = (((j0 & 15) >> 2) << 4) + (t & 15);
          *(u32x2*)(gout + 32768 + xo_acc(rt, nt_, ql)) = (u32x2){g1w[0], g1w[1]}; *(u32x2*)(gout + 32768 + xo_acc(rt, nt_, ql + 16)) = (u32x2){g1w[2], g1w[3]};
          *(u32x2*)(gout + 40960 + xo_acc(rt, nt_, ql)) = (u32x2){g0w[0], g0w[1]}; *(u32x2*)(gout + 40960 + xo_acc(rt, nt_, ql + 16)) = (u32x2){g0w[2], g0w[3]}; }
    }
    RW_BAR(); R1_STAMP(4);
    {
        const int mi = w >> 1;
        const LAS unsigned char* X = lds + RW_S(mi < 2 ? 0 : 1); const LAS unsigned char* Y = lds + RW_S((mi & 1) ? 3 : 2);
        LAS unsigned char* dst = lds + (mi == 0 ? O_P0 : mi == 1 ? O_AAK : mi == 2 ? O_ARB : O_ARK);
        const bool incl = mi >= 2;
#pragma unroll
        for (int q = 0; q < 2; ++q) { const int mt = 2 * (w & 1) + q; const int m = 16 * mt + (lane & 15);
#pragma unroll
            for (int nt = 0; nt < 4; ++nt) { f32x4 acc = {0.f, 0.f, 0.f, 0.f};
                if (nt <= mt) acc = tile_mm<2>(acc, X, PB, 16 * mt, Y, PB, 16 * nt, lane);
                const int n0 = 16 * nt + 4 * (lane >> 4);
#pragma unroll
                for (int i = 0; i < 4; ++i) { const int n = n0 + i; if (!(incl ? n <= m : n < m)) acc[i] = 0.f; }
                st_rm(dst, PB, m, n0, acc);
                if (mi == 0) st_tr(lds + O_P0T, PB, m, n0, acc); } }
    }
    RW_BAR(); R1_STAMP(5);
    {
        f32x4 T[4];
        const int wr = w & 3, m = 16 * wr + (lane & 15);
        LAS unsigned char* Trm = lds + RW_S(8);
        if (w < 4) {
#pragma unroll
            for (int nt = 0; nt < 4; ++nt) { const int n0 = 16 * nt + 4 * (lane >> 4); T[nt] = ld_rm(lds + O_P0, PB, m, n0);
#pragma unroll
                for (int i = 0; i < 4; ++i) if (n0 + i == m) T[nt][i] += 1.f;
                st_rm(Trm, PB, m, n0, T[nt]); }
#pragma unroll
            for (int nt = 0; nt < 4; ++nt) { f32x4 acc = {0.f, 0.f, 0.f, 0.f}; acc = tile_mm<2>(acc, lds + RW_S(5), PB, 16 * wr, lds + O_AAK, PB, 16 * nt, lane); st_rm(lds + RW_S(0), PB, m, 16 * nt + 4 * (lane >> 4), acc); }
        } else {
#pragma unroll
            for (int nt = 0; nt < 4; ++nt) { f32x4 acc = {0.f, 0.f, 0.f, 0.f}; acc = tile_mm<2>(acc, lds + O_P0, PB, 16 * wr, lds + O_P0T, PB, 16 * nt, lane);
                const int n0 = 16 * nt + 4 * (lane >> 4); st_rm(lds + RW_S(2), PB, m, n0, acc); st_tr(lds + RW_S(3), PB, m, n0, acc); }
        }
        RW_BAR();
#pragma unroll 1
        for (int s = 1; s <= 5; ++s) {
            const int cb = s & 1;
            const LAS unsigned char* Pc = lds + (cb ? RW_S(2) : O_P0); const LAS unsigned char* PcT = lds + (cb ? RW_S(3) : O_P0T);
            LAS unsigned char* Pn = lds + (cb ? O_P0 : RW_S(2)); LAS unsigned char* PnT = lds + (cb ? O_P0T : RW_S(3));
            if (w < 4) {
                f32x4 d[4];
#pragma unroll
                for (int nt = 0; nt < 4; ++nt) { d[nt] = (f32x4){0.f, 0.f, 0.f, 0.f}; d[nt] = tile_mm<2>(d[nt], Trm, PB, 16 * wr, PcT, PB, 16 * nt, lane); }
                LDS_WAIT();
#pragma unroll
                for (int nt = 0; nt < 4; ++nt) { T[nt] += d[nt]; st_rm(Trm, PB, m, 16 * nt + 4 * (lane >> 4), T[nt]); }
            } else if (s < 5) {
#pragma unroll
                for (int nt = 0; nt < 4; ++nt) { f32x4 acc = {0.f, 0.f, 0.f, 0.f}; acc = tile_mm<2>(acc, Pc, PB, 16 * wr, PcT, PB, 16 * nt, lane);
                    const int n0 = 16 * nt + 4 * (lane >> 4); st_rm(Pn, PB, m, n0, acc); st_tr(PnT, PB, m, n0, acc); }
            }
            RW_BAR();
        }
    }
    R1_STAMP(6);
    {
        const LAS unsigned char* Z = lds + (w < 4 ? RW_S(4) : RW_S(0)); const int zr0 = 16 * (w & 3);
        f32x4 acc[4];
#pragma unroll
        for (int nt = 0; nt < 4; ++nt) { acc[nt] = (f32x4){0.f, 0.f, 0.f, 0.f}; acc[nt] = tile_mm<2>(acc[nt], Z, PB, zr0, lds + RW_S(8), PB, 16 * nt, lane); }
#pragma unroll
        for (int nt = 0; nt < 4; ++nt) st_rm(lds + RW_S(2), PB, 16 * w + (lane & 15), 16 * nt + 4 * (lane >> 4), acc[nt]);
    }
    RW_BAR(); R1_STAMP(7);
    {
        const int job = w >> 1;
        const LAS unsigned char* XTt = lds + RW_S(2); const LAS unsigned char* XTb = lds + RW_S(2) + 64 * PB;
#pragma unroll
        for (int q = 0; q < 2; ++q) { const int mt = 2 * (w & 1) + q; const int m = 16 * mt + (lane & 15);
#pragma unroll
            for (int nt = 0; nt < 4; ++nt) { f32x4 acc = {0.f, 0.f, 0.f, 0.f}; const int n0 = 16 * nt + 4 * (lane >> 4);
                if (job == 0) { acc = ld_rm(lds + RW_S(1), PB, m, n0); acc = tile_mm<2>(acc, lds + O_ARB, PB, 16 * mt, XTt, PB, 16 * nt, lane); }
                else if (job == 1) { acc = tile_mm<2>(acc, lds + O_ARB, PB, 16 * mt, XTb, PB, 16 * nt, lane); acc = tile_mm<2>(acc, lds + O_ARK, PB, 16 * mt, lds + RW_S(5), PB, 16 * nt, lane); }
                else if (job == 2) { acc = tile_mm<2>(acc, lds + RW_S(6), PB, 16 * mt, XTt, PB, 16 * nt, lane); }
                else { acc = tile_mm<2>(acc, XTb, PB, 16 * mt, lds + RW_S(6), PB, 16 * nt, lane); acc = tile_mm<2>(acc, lds + RW_S(5), PB, 16 * mt, lds + RW_S(7), PB, 16 * nt, lane); }
                u32x2 o; o.x = pk2(acc[0], acc[1]); o.y = pk2(acc[2], acc[3]);
                *(u32x2*)(gout + job * 8192 + (((job & 1) == 0) ? xo_frag_from_acc(mt, nt, lane) : xo_acc(mt, nt, lane))) = o; } }
    }
    RW_BAR(); R1_STAMP(8);
}

__device__ __forceinline__ void r2_unit(Frame& F, const Args& a, const int l, const int bh) {
    using namespace cfg;
    const int lane = F.lane, w = F.wave, wr = w & 3;
    LAS unsigned char* lds = F.lds;
    bf16* y = (bf16*)(F.ws + wsm::Y);
    const unsigned char* gin = F.ws + wsm::RW + (size_t)bh * 64 * UNIT_BYTES;
    const float* wlp = (const float*)(F.ws + wsm::RW + WL_OFF) + (size_t)bh * 64 * 64;
    const int b = bh >> 3, h = bh & 7;
    const int m = 16 * wr + (lane & 15), q4 = 4 * (lane >> 4);
    if (w < 4) {
        f32x4 S[4];
#pragma unroll
        for (int nt = 0; nt < 4; ++nt) { S[nt] = (f32x4){0.f, 0.f, 0.f, 0.f}; st_rm(lds, PB, m, 16 * nt + q4, S[nt]); }
        bf16x8 mtf[4][2], mtn[4][2]; u32x2 cf[4], cfn[4]; f32x4 wl[4], wln[4];
#define R2_LDS(c_, M_, C_, W_) do { const unsigned char* g_ = gin + (size_t)(c_) * UNIT_BYTES; _Pragma("unroll") for (int nt = 0; nt < 4; ++nt) { \
            _Pragma("unroll") for (int s_ = 0; s_ < 2; ++s_) M_[nt][s_] = *(const bf16x8*)(g_ + 16384 + xo_frag(nt, s_, lane)); \
            C_[nt] = *(const u32x2*)(g_ + 24576 + xo_acc(wr, nt, lane)); W_[nt] = *(const f32x4*)(wlp + (c_) * 64 + 16 * nt + q4); } } while (0)
        R2_LDS(0, mtf, cf, wl);
#pragma unroll 1
        for (int c = 0; c < 64; ++c) {
            LAS unsigned char* Scur = lds + (c & 1) * SLOT; LAS unsigned char* Snxt = lds + ((c + 1) & 1) * SLOT;
            const int cn = c < 63 ? c + 1 : 63;
            R2_LDS(cn, mtn, cfn, wln);
            RW_BAR();
            bf16x8 sf[2];
#pragma unroll
            for (int s = 0; s < 2; ++s) sf[s] = ldfrag(Scur, PB, 16 * wr, lane, s);
#pragma unroll
            for (int nt = 0; nt < 4; ++nt) {
                f32x4 acc = S[nt] * wl[nt];
                acc[0] += __uint_as_float(cf[nt].x << 16); acc[1] += __uint_as_float(cf[nt].x & 0xffff0000u); acc[2] += __uint_as_float(cf[nt].y << 16); acc[3] += __uint_as_float(cf[nt].y & 0xffff0000u);
#pragma unroll
                for (int s = 0; s < 2; ++s) acc = __builtin_amdgcn_mfma_f32_16x16x32_bf16(mtf[nt][s], sf[s], acc, 0, 0, 0);
                S[nt] = acc; st_rm(Snxt, PB, m, 16 * nt + q4, acc); }
#pragma unroll
            for (int nt = 0; nt < 4; ++nt) { mtf[nt][0] = mtn[nt][0]; mtf[nt][1] = mtn[nt][1]; cf[nt] = cfn[nt]; wl[nt] = wln[nt]; }
        }
#undef R2_LDS
    } else {
        bf16x8 rf[2], rfn[2]; u32x2 y0[4], g1[4], g0[4], y0n[4], g1n[4], g0n[4];
#define R2_LDY(c_, R_, Y_, G1_, G0_) do { const unsigned char* g_ = gin + (size_t)(c_) * UNIT_BYTES; \
            _Pragma("unroll") for (int s_ = 0; s_ < 2; ++s_) R_[s_] = *(const bf16x8*)(g_ + xo_frag(wr, s_, lane)); \
            _Pragma("unroll") for (int nt = 0; nt < 4; ++nt) { const int o_ = xo_acc(wr, nt, lane); Y_[nt] = *(const u32x2*)(g_ + 8192 + o_); G1_[nt] = *(const u32x2*)(g_ + 32768 + o_); G0_[nt] = *(const u32x2*)(g_ + 40960 + o_); } } while (0)
        R2_LDY(0, rf, y0, g1, g0);
#pragma unroll 1
        for (int c = 0; c < 64; ++c) {
            LAS unsigned char* Scur = lds + (c & 1) * SLOT;
            const int cn = c < 63 ? c + 1 : 63;
            R2_LDY(cn, rfn, y0n, g1n, g0n);
            RW_BAR();
            f32x4 Y[4]; float sum = 0.f;
#pragma unroll
            for (int nt = 0; nt < 4; ++nt) {
                f32x4 acc = {__uint_as_float(y0[nt].x << 16), __uint_as_float(y0[nt].x & 0xffff0000u), __uint_as_float(y0[nt].y << 16), __uint_as_float(y0[nt].y & 0xffff0000u)};
#pragma unroll
                for (int s = 0; s < 2; ++s) acc = __builtin_amdgcn_mfma_f32_16x16x32_bf16(ldfrag(Scur, PB, 16 * nt, lane, s), rf[s], acc, 0, 0, 0);
                Y[nt] = acc; sum += (acc[0] + acc[1]) + (acc[2] + acc[3]); }
            sum += __shfl_xor(sum, 16); sum += __shfl_xor(sum, 32);
            const float mean = sum * (1.f / 64.f); float var = 0.f;
#pragma unroll
            for (int nt = 0; nt < 4; ++nt)
#pragma unroll
                for (int i = 0; i < 4; ++i) { const float d = Y[nt][i] - mean; var += d * d; }
            var += __shfl_xor(var, 16); var += __shfl_xor(var, 32);
            const float rs = rsqrtf(var * (1.f / 64.f) + 64e-5f);
            bf16* yo = y + ((size_t)b * SEQ + c * 64 + m) * D + h * 64;
#pragma unroll
            for (int nt = 0; nt < 4; ++nt) {
                const f32x4 a1 = {__uint_as_float(g1[nt].x << 16), __uint_as_float(g1[nt].x & 0xffff0000u), __uint_as_float(g1[nt].y << 16), __uint_as_float(g1[nt].y & 0xffff0000u)};
                const f32x4 a0 = {__uint_as_float(g0[nt].x << 16), __uint_as_float(g0[nt].x & 0xffff0000u), __uint_as_float(g0[nt].y << 16), __uint_as_float(g0[nt].y & 0xffff0000u)};
                const f32x4 o = (Y[nt] - mean) * rs * a1 + a0;
                if (F8OUT(l)) *(unsigned*)((unsigned char*)y + ((size_t)b * SEQ + c * 64 + m) * D + h * 64 + 16 * nt + q4) = pk4_fp8(o[0] * F8_Y, o[1] * F8_Y, o[2] * F8_Y, o[3] * F8_Y);
                else { u32x2 ow; ow.x = pk2(o[0], o[1]); ow.y = pk2(o[2], o[3]); *(u32x2*)(yo + 16 * nt + q4) = ow; } }
            rf[0] = rfn[0]; rf[1] = rfn[1];
#pragma unroll
            for (int nt = 0; nt < 4; ++nt) { y0[nt] = y0n[nt]; g1[nt] = g1n[nt]; g0[nt] = g0n[nt]; }
        }
#undef R2_LDY
    }
    RW_BAR();
}
}
struct MoeOrder {
    const LAS int* pref; int G, c, npn, mode;
    const char* A; const char* B; const int* lists; const float* wl; int esz;
    __device__ __forceinline__ bool next(int i, pg8::Unit& u) const {
        const int total = __builtin_amdgcn_readfirstlane(pref[32]) * npn;
        const long L = (long)i * G + c; if (L >= total) return false;
        int wgid = (int)L; { const int q = total / 8, r = total % 8, xcd = wgid % 8, off = wgid / 8; wgid = (xcd < r ? xcd * (q + 1) : r * (q + 1) + (xcd - r) * q) + off; }
        const int panel = wgid / npn, pn = wgid % npn;
        int e = 0;
        for (int k = 1; k < 32; ++k) { const int pk = __builtin_amdgcn_readfirstlane(pref[k]); if (pk <= panel) e = k; }
        const int tl = panel - __builtin_amdgcn_readfirstlane(pref[e]);
        u.pm = panel; u.pn = pn;
        if (mode == 0) { u.a = A; u.b = B + ((size_t)e * 512 + (size_t)pn * 256) * 2048 * esz; u.rows = lists + e * LCAP + tl * 256; const int rem = __builtin_amdgcn_readfirstlane(pref[40 + e]) - tl * 256; u.nvalid = rem < 256 ? rem : 256; u.wrow = wl + e * LCAP + tl * 256; }
        else { u.a = A + (size_t)panel * 256 * 256 * esz; u.b = B + ((size_t)e * 2048 + (size_t)pn * 256) * 256 * esz; u.rows = nullptr; u.nvalid = 256; u.wrow = nullptr; }
        return true;
    }
};

#define IN(k) (lo <= (k) && (k) < hi)
#define SEAM(k) do { if (IN(k) && IN((k) + 1)) xcd_barrier(bar); } while (0)
#ifndef DUP_PHASE
#define DUP_PHASE -1
#endif
template <int l> __device__ __forceinline__ void ph_n1(Frame& F, const Args& args) {
    using namespace cfg; float* xo = args.out; const float* xin = (l == 0) ? args.in[0] : xo;
    convert_phase(F, args, l);
    build_attn_tables(F, args, l);
    if (l == 0) norm_phase<false, false, false, F8IN(l)>(F, args, xin, nullptr, args.in[3] + l * D, l, l);
    else { build_pref(F, l - 1); norm_phase<true, false, false, F8IN(l), true>(F, args, xin, xo, args.in[3] + l * D, l, l); }
}
template <int l> __device__ __forceinline__ void ph_g1(Frame& F, const Args& args) {
    using namespace cfg;
    constexpr int ESZ = F8IN(l) ? 1 : 2;
    pg8::StaticOrder S; S.init(F.ws + wsm::XN, F.ws + wsm::W_IN, M, INC, D, F.G, (int)blockIdx.x, ESZ);
    pg8::EpiBf16 E{(bf16*)(F.ws + wsm::P), INC, ESZ == 1 ? pg8::F8_INV : 1.f};
    pg8::gemm_phase<pg8::EpiBf16, pg8::StaticOrder, false, ESZ>(F.lds, D, S, E);
}
template <int l> __device__ __forceinline__ void ph_m1(Frame& F, const Args& args, const XcdBarrier& bar, unsigned long long& racc) {
    rw::lora_prepass(F, args, l);
    xcd_barrier(bar);
    { int hcur = -1; rw::R1Raw raw; rw::R1W W;
      auto unit_of = [&](int i) { return (F.G == 256) ? ((F.vcu >> 2) << 6) + ((F.vcu & 3) << 4) + i : F.vcu + i * F.G; };
      if (unit_of(0) < 4096) rw::r1_load(F, unit_of(0), raw, F.tid);
      for (int i = 0; unit_of(i) < 4096 && i * F.G < 4096; ++i) { const int u = unit_of(i); const int un = ((i + 1) * F.G < 4096 && unit_of(i + 1) < 4096) ? unit_of(i + 1) : u; rw::r1_unit(F, args, l, u, un, raw, W, racc, hcur); } }

    for (int u = F.vcu; u < 1024; u += F.G) { const int b = u >> 7, hh = (u >> 4) & 7, qb = ((u & 15) + (u >> 8) * 4) & 15; att::attn_unit<0>(F, args, l, b, hh, qb); }
    if (DUP_PHASE == 21 + 100 * l) { for (int u = F.vcu; u < 1024; u += F.G) { const int b = u >> 7, hh = (u >> 4) & 7, qb = ((u & 15) + (u >> 8) * 4) & 15; att::attn_unit<0>(F, args, l, b, hh, qb); } }
    att::conv_items(F, args, l, F.vcu * 512 + F.tid, F.G * 512);
    if (DUP_PHASE == 22 + 100 * l) att::conv_items(F, args, l, F.vcu * 512 + F.tid, F.G * 512);
}
template <int l> __device__ __forceinline__ void ph_m2(Frame& F, const Args& args) {
    for (;;) { const int it = grab(F, l); if (it >= 64 + 512) break;
        int t_ = F.tid; asm volatile("" : "+v"(t_)); F.tid = t_; F.lane = t_ & 63;
        if (it < 64) rw::r2_unit(F, args, l, it);
        else { const int j = it - 64, qb = 15 - (j >> 5), b = (j & 31) >> 2, hh = j & 3; att::attn_unit<1>(F, args, l, b, hh, qb); } }
    if (DUP_PHASE == 8 * l + 3) { __syncthreads();
    for (;;) { const int it = grab(F, l + 2); if (it >= 64 + 512) break;
        if (it < 64) rw::r2_unit(F, args, l, it);
        else { const int j = it - 64, qb = 15 - (j >> 5), b = (j & 31) >> 2, hh = j & 3; att::attn_unit<1>(F, args, l, b, hh, qb); } } }
    if (DUP_PHASE == 30 + 100 * l) { if (F.vcu < 64) rw::r2_unit(F, args, l, F.vcu); }
    if (DUP_PHASE == 31 + 100 * l) { for (int u = F.vcu; u < 512; u += F.G) { const int b = u >> 6, hh = (u >> 4) & 3, qb = (u < 256) ? (u & 15) : 15 - (u & 15); att::attn_unit<1>(F, args, l, b, hh, qb); } }
}
template <int l> __device__ __forceinline__ void ph_g2(Frame& F, const Args& args) {
    using namespace cfg;
    constexpr int ESZ = F8OUT(l) ? 1 : 2;
    pg8::StaticOrder S; S.init(F.ws + wsm::Y, F.ws + wsm::W_OUT, M, D, D, F.G, (int)blockIdx.x, ESZ);
    const void* xin = (l == 0) ? (const void*)args.in[0] : (const void*)args.out;
    bf16* xo = (l == 0) ? (bf16*)args.out : (bf16*)(F.ws + wsm::XB2);
    pg8::EpiRes<l != 0> E{xin, xo, D, ESZ == 1 ? 1.f / (F8_Y * pg8::F8_WGT) : 1.f};
    pg8::gemm_phase<pg8::EpiRes<l != 0>, pg8::StaticOrder, false, ESZ>(F.lds, D, S, E);
}
template <int l> __device__ __forceinline__ void ph_n2(Frame& F, const Args& args) { using namespace cfg;
    const float* xs = (l == 0) ? (const float*)args.out : (const float*)(F.ws + wsm::XB2);
    norm_phase<false, true, false, ((F8_MOE_MASK >> l) & 1) != 0, true>(F, args, xs, nullptr, args.in[4] + l * D, l, l); }
template <int l> __device__ __forceinline__ void ph_e1(Frame& F, const Args& args) {
    using namespace cfg;
    build_pref(F, l);
    constexpr int ESZ = ((F8_MOE_MASK >> l) & 1) ? 1 : 2;
    MoeOrder S{(const LAS int*)(F.lds + TAB_OFF), F.G, (int)blockIdx.x, 2, 0, (const char*)(F.ws + wsm::XN), (const char*)(F.ws + wsm::W_GU), (const int*)(F.ws + wsm::LISTS), (const float*)(F.ws + wsm::WLIST), ESZ};
    pg8::EpiSilu E{(bf16*)(F.ws + wsm::HB), ESZ == 1 ? pg8::F8_INV : 1.f, F8_DOWN ? F8_H : 0.f};
    pg8::gemm_phase<pg8::EpiSilu, MoeOrder, true, ESZ>(F.lds, D, S, E);
}
template <int l> __device__ __forceinline__ void ph_e2(Frame& F, const Args& args) {
    using namespace cfg;
    build_pref(F, l);
    constexpr int ESZ = F8_DOWN ? 1 : 2;
    MoeOrder S{(const LAS int*)(F.lds + TAB_OFF), F.G, (int)blockIdx.x, 8, 1, (const char*)(F.ws + wsm::HB), (const char*)(F.ws + wsm::W_D), nullptr, nullptr, ESZ};
    pg8::EpiF8 E{F.ws + wsm::OB, D, F8_DOWN ? F8_OB / (F8_H * pg8::F8_WGT) : F8_OB};
    pg8::gemm_phase<pg8::EpiF8, MoeOrder, false, ESZ>(F.lds, EH, S, E);
}
#ifndef PROBE_T
#define PROBE_T -1
#endif
#define RUNPH(k, call) do { if (PROBE_T == (k)) pt0 = __builtin_amdgcn_s_memrealtime(); RUNPH_(k, call); if (PROBE_T == (k)) pt1 = __builtin_amdgcn_s_memrealtime(); } while (0)
#define RUNPH_(k, call) do { if (IN(k)) { call; if (DUP_PHASE == (k) && ((k) & 7) != 3 && ((k) & 7) != 5) { __syncthreads(); call; } } SEAM(k); } while (0)
template <int l>
__device__ __forceinline__ void layer_phases(Frame& F, const Args& args, const XcdBarrier& bar, const int lo, const int hi, unsigned long long& pt0, unsigned long long& pt1) {
    constexpr int pb = 8 * l;
    RUNPH(pb + 0, ph_n1<l>(F, args));
    RUNPH(pb + 1, ph_g1<l>(F, args));
    { unsigned long long racc = 0; RUNPH(pb + 2, ph_m1<l>(F, args, bar, racc)); if (PROBE_R1 >= 0 && l == 0) { pt0 = 0; pt1 = racc; } }
    RUNPH(pb + 3, ph_m2<l>(F, args));
    RUNPH(pb + 4, ph_g2<l>(F, args));
    RUNPH(pb + 5, ph_n2<l>(F, args));
    RUNPH(pb + 6, ph_e1<l>(F, args));
    RUNPH(pb + 7, ph_e2<l>(F, args));
}
__global__ void __launch_bounds__(512, 2) mk_fwd(Args args) {
    extern __shared__ __attribute__((aligned(16))) unsigned char lds_raw[];
    using namespace cfg;
    Frame F;
    F.lds = (LAS unsigned char*)lds_raw; F.ws = args.ws; F.ctl = (unsigned*)(args.ws + wsm::CTL);
    F.tid = threadIdx.x; F.lane = F.tid & 63; F.wave = __builtin_amdgcn_readfirstlane(F.tid >> 6);
    F.pacc = 0ull;
    F.G = gridDim.x; { const int bx = blockIdx.x; F.vcu = (F.G % 8 == 0) ? (bx % 8) * (F.G / 8) + bx / 8 : bx; }
    volatile LAS unsigned* MISC = (volatile LAS unsigned*)(F.lds + MISC_OFF);
    for (int u = F.tid; u < (LDS_BYTES - RING_BYTES) / 4; u += 512) ((LAS unsigned*)(F.lds + RING_BYTES))[u] = 0u;
    __syncthreads();
    const int lo = args.ph_lo, hi = args.ph_hi;
    XcdBarrier bar; bar.bar = F.ctl + wsm::CW_BAR; bar.x = 0; bar.st = nullptr;
    if (hi - lo > 1) bar = xcd_barrier_post(F.ctl + wsm::CW_BAR, MISC + 8);
    float* xo = args.out;
    unsigned long long pt0 = 0, pt1 = 0;
    layer_phases<0>(F, args, bar, lo, hi, pt0, pt1);
    layer_phases<1>(F, args, bar, lo, hi, pt0, pt1);
    if (PROBE_T == 16) pt0 = __builtin_amdgcn_s_memrealtime();
    if (IN(16)) {
        build_pref(F, NL - 1); norm_phase<true, false, true, false, true>(F, args, (const float*)(F.ws + wsm::XB2), xo, args.in[5], 0, 0);
    }
    if (PROBE_T == 16) pt1 = __builtin_amdgcn_s_memrealtime();
    if (PROBE_ATT >= 0 && blockIdx.x == 0 && F.tid == 448) { const unsigned long long te = __builtin_amdgcn_s_memrealtime(); while (__builtin_amdgcn_s_memrealtime() - te < 4ull * F.pacc) __builtin_amdgcn_s_sleep(8); }
    if ((PROBE_T >= 0 || PROBE_R1 >= 0) && blockIdx.x == 0 && F.tid == 0) { const unsigned long long te = __builtin_amdgcn_s_memrealtime(); while (__builtin_amdgcn_s_memrealtime() - te < 4ull * (pt1 - pt0)) __builtin_amdgcn_s_sleep(8); }
#undef IN
#undef SEAM
}
extern "C" void kernel_launch(void* const* d_in, const int* in_sizes, int n_in, void* d_out, int out_size, void* d_ws, size_t ws_size, hipStream_t stream) {
    using namespace cfg;
    static int grid = 0;
    if (grid == 0) {
        if (n_in != 32 || ws_size < wsm::END || out_size != M * D) { fprintf(stderr, "kernel_launch: bad args n_in=%d ws=%zu out=%d\n", n_in, ws_size, out_size); grid = -1; return; }
        int dev = 0, cus = 0;
        if (hipGetDevice(&dev) != hipSuccess || hipDeviceGetAttribute(&cus, hipDeviceAttributeMultiprocessorCount, dev) != hipSuccess) { grid = -1; return; }
        if (hipFuncSetAttribute((const void*)mk_fwd, hipFuncAttributeMaxDynamicSharedMemorySize, LDS_BYTES) != hipSuccess) { fprintf(stderr, "hipFuncSetAttribute failed\n"); grid = -1; return; }
        int per_cu = 0;
        if (hipOccupancyMaxActiveBlocksPerMultiprocessor(&per_cu, (const void*)mk_fwd, 512, LDS_BYTES) != hipSuccess || per_cu < 1) fprintf(stderr, "kernel_launch: occupancy query says %d\n", per_cu);
        (void)hipGetLastError();
        grid = cus;
    }
    if (grid < 0) return;
    unsigned char* w = (unsigned char*)d_ws;
    if (hipMemsetAsync(w + wsm::CTL, 0, wsm::CTL_ZERO_BYTES, stream) != hipSuccess) return;
    Args a{};
    for (int i = 0; i < 32; ++i) a.in[i] = (const float*)d_in[i];
    a.out = (float*)d_out; a.ws = w; a.flags = 7; a.ph_lo = 0; a.ph_hi = 17;
    hipLaunchKernelGGL(mk_fwd, dim3(grid), dim3(512), LDS_BYTES, stream, a);
}
```

```cpp
#define DUP_PHASE -1
#include <hip/hip_runtime.h>
#include <cstdint>
#include <cstdio>
#include <cmath>

typedef unsigned short bf16;
__host__ __device__ __forceinline__ unsigned f2bf(float f) { unsigned u = __builtin_bit_cast(unsigned, f); return (u + 0x7fffu + ((u >> 16) & 1u)) >> 16; }
__host__ __device__ __forceinline__ float bf2f(bf16 b) { return __builtin_bit_cast(float, ((unsigned)b) << 16); }

namespace cfg {
constexpr int D = 2048, BATCH = 8, SEQ = 4096, M = BATCH * SEQ, NL = 2;
constexpr int INC = 6400;
constexpr int OFF_BQ = 1792, OFF_BK = 2304, OFF_BV = 2816, OFF_CQ = 3328, OFF_CK = 3840, OFF_CV = 4352, OFF_D = 4864;
constexpr int NEXP = 32, EH = 256;
}
#define GAS __attribute__((address_space(1)))
#define LAS __attribute__((address_space(3)))
typedef float f32x4 __attribute__((ext_vector_type(4)));
typedef float f32x2 __attribute__((ext_vector_type(2)));
typedef short bf16x8 __attribute__((ext_vector_type(8)));
typedef unsigned u32x4 __attribute__((ext_vector_type(4)));
typedef unsigned u32x2 __attribute__((ext_vector_type(2)));
#define RLX_AGENT __ATOMIC_RELAXED, __HIP_MEMORY_SCOPE_AGENT
#define LDS_WAIT() asm volatile("s_waitcnt lgkmcnt(0)" ::: "memory")
#define VM_WAIT() asm volatile("s_waitcnt vmcnt(0)" ::: "memory")

namespace wsm {
constexpr size_t MiB = 1u << 20;
constexpr size_t CTL = 0, CTL_ZERO_BYTES = 1 * MiB;
constexpr size_t LISTS = 2 * MiB;
constexpr size_t WLIST = 6 * MiB;
constexpr size_t TOKINFO = 10 * MiB;
constexpr size_t ROUTE = 11 * MiB;
constexpr size_t WRT = 12 * MiB;
constexpr size_t TABS = WRT + 1 * MiB;
constexpr size_t W_IN = 16 * MiB;
constexpr size_t W_OUT = 41 * MiB;
constexpr size_t W_GU = 49 * MiB;
constexpr size_t W_D = 113 * MiB;
constexpr size_t XN = 146 * MiB;
constexpr size_t LORA = XN + 64 * MiB;
constexpr size_t P = 274 * MiB;
constexpr size_t HB = P;
constexpr size_t OB = P + 40 * MiB;
constexpr size_t XB2 = P + 200 * MiB;
constexpr size_t Y = 674 * MiB;
constexpr size_t RW = 802 * MiB;
constexpr size_t END = 1010 * MiB;
constexpr int CW_BAR = 4096;
constexpr int CW_CNT = 16384;
constexpr int CW_Q = 32768;
}
constexpr int LCAP = 32768;
constexpr int RING_BYTES = 139264;
constexpr int MISC_OFF = RING_BYTES + 320;
constexpr int TAB_OFF = RING_BYTES + 1024;
constexpr int LDS_BYTES = 147456;
constexpr float C2F = 0.125f * 1.4426950408889634f;
constexpr float LOG2E = 1.4426950408889634f;

typedef __bf16 bf16x2_hw __attribute__((ext_vector_type(2)));
__device__ __forceinline__ unsigned pk2(float lo, float hi) { const f32x2 v = {lo, hi}; const bf16x2_hw b = __builtin_convertvector(v, bf16x2_hw); return __builtin_bit_cast(unsigned, b); }
__device__ __forceinline__ bf16 cvt1(float x) { return (bf16)(pk2(x, x) & 0xffffu); }
__device__ __forceinline__ float f8clamp(float x) { return __builtin_amdgcn_fmed3f(x, -448.f, 448.f); }
__device__ __forceinline__ unsigned pk2_fp8(float a, float b) { int w = 0; w = __builtin_amdgcn_cvt_pk_fp8_f32(f8clamp(a), f8clamp(b), w, false); return (unsigned)w & 0xffffu; }
__device__ __forceinline__ unsigned pk4_fp8(float a, float b, float c, float d) { int w = 0; w = __builtin_amdgcn_cvt_pk_fp8_f32(f8clamp(a), f8clamp(b), w, false); w = __builtin_amdgcn_cvt_pk_fp8_f32(f8clamp(c), f8clamp(d), w, true); return (unsigned)w; }
constexpr int F8_IN_MASK = 2, F8_OUT_MASK = 2;
#define F8IN(l) (((F8_IN_MASK >> (l)) & 1) != 0)
#define F8OUT(l) (((F8_OUT_MASK >> (l)) & 1) != 0)
constexpr float F8_Y = 16.f, F8_OB = 8.f, F8_H = 8.f;
constexpr bool F8_DOWN = true;
constexpr int F8_MOE_MASK = 3;
__device__ __forceinline__ float wave_sum(float v) {
#pragma unroll
    for (int o = 1; o < 64; o <<= 1) v += __shfl_xor(v, o);
    return v;
}

struct Args {
    const float* in[32]; float* out; unsigned char* ws;
    int ph_lo, ph_hi, flags, pad;
};
#define XB_TMO      128
#define XB_XCNT(j)  (256  + 64 * (j))
#define XB_XSUB(j)  (1280 + 64 * (j))
#define XB_XGEN(j)  (2304 + 64 * (j))
#define XB_TOP      3328
#define XB_TOPGEN   3392
#define XCD_BAR_WORDS 3456
#define XB_SPIN_CAP (1u << 22)

__device__ __forceinline__ unsigned xb_ld(unsigned* p)              { return __hip_atomic_load(p, __ATOMIC_RELAXED, __HIP_MEMORY_SCOPE_AGENT); }
__device__ __forceinline__ unsigned xb_add(unsigned* p, unsigned v) { return __hip_atomic_fetch_add(p, v, __ATOMIC_RELAXED, __HIP_MEMORY_SCOPE_AGENT); }
__device__ __forceinline__ unsigned xb_xcc_id() { return (unsigned)__builtin_amdgcn_s_getreg((3 << 11) | 20) & 0xFu; }
#define XB_SPIN(cond, bar) do { unsigned _sp = 0; while (cond) { __builtin_amdgcn_s_sleep(1); \
    if ((++_sp & 255u) == 0u) { if (xb_ld(&(bar)[XB_TMO])) break; if (_sp > XB_SPIN_CAP) { atomicAdd(&(bar)[XB_TMO], 1u); break; } } } } while (0)

struct XcdBarrier {
    unsigned* bar; unsigned x;
    volatile LAS unsigned* st;
};

__device__ __forceinline__ XcdBarrier xcd_barrier_post(unsigned* bar, volatile LAS unsigned* st) {
    XcdBarrier b; b.bar = bar; b.x = xb_xcc_id(); b.st = st;
    if (threadIdx.x == 0) (void)xb_add(&bar[XB_XCNT(b.x)], 1u);
    return b;
}
__device__ __forceinline__ void xcd_barrier_complete(unsigned* bar, unsigned x, unsigned& nloc, unsigned& nx) {
    const unsigned G = gridDim.x * gridDim.y * gridDim.z;
    unsigned sum, cnt, mine, sp = 0u;
    for (;;) {
        sum = 0u; cnt = 0u; mine = 0u;
#pragma unroll
        for (unsigned j = 0; j < 16; ++j) { const unsigned c = xb_ld(&bar[XB_XCNT(j)]); sum += c; cnt += (c > 0u) ? 1u : 0u; mine = (j == x) ? c : mine; }
        if (sum == G) break;
        __builtin_amdgcn_s_sleep(1);
        if ((++sp & 255u) == 0u) { if (xb_ld(&bar[XB_TMO])) break; if (sp > XB_SPIN_CAP) { atomicAdd(&bar[XB_TMO], 1u); break; } }
    }
    nloc = mine > 0u ? mine : 1u; nx = cnt > 0u ? cnt : 1u;
}

__device__ __forceinline__ void xcd_barrier(const XcdBarrier& b) {
    asm volatile("s_waitcnt vmcnt(0)" ::: "memory");
    __syncthreads();
    if (threadIdx.x == 0) {
        unsigned* bar = b.bar;
        __builtin_amdgcn_s_waitcnt(0);
        unsigned nloc = b.st[0], nx = b.st[1];
        if (nloc == 0u) { xcd_barrier_complete(bar, b.x, nloc, nx); b.st[0] = nloc; b.st[1] = nx; }
        const unsigned old = xb_add(&bar[XB_XSUB(b.x)], 1u);
        const unsigned gen = old / nloc;
        if (old + 1u == (gen + 1u) * nloc) {
            __builtin_amdgcn_fence(__ATOMIC_RELEASE, "agent");
            asm volatile("s_waitcnt vmcnt(0)" ::: "memory");
            const unsigned og = xb_add(&bar[XB_TOP], 1u);
            const unsigned tg = og / nx;
            if (og + 1u == (tg + 1u) * nx) xb_add(&bar[XB_TOPGEN], 1u);
            else XB_SPIN(xb_ld(&bar[XB_TOPGEN]) == tg, bar);
            __builtin_amdgcn_fence(__ATOMIC_ACQUIRE, "agent");
            xb_add(&bar[XB_XGEN(b.x)], 1u);
            asm volatile("s_waitcnt vmcnt(0)" ::: "memory");
        } else {
            XB_SPIN(xb_ld(&bar[XB_XGEN(b.x)]) == gen, bar);
            __builtin_amdgcn_fence(__ATOMIC_ACQUIRE, "agent");
            asm volatile("s_waitcnt vmcnt(0)" ::: "memory");
        }
    }
    __syncthreads();
}
namespace pg8 {
#define PG8_LAS __attribute__((address_space(3)))
typedef unsigned short bf16_t;
typedef short bf16x8 __attribute__((ext_vector_type(8)));
typedef float f32x4 __attribute__((ext_vector_type(4)));
typedef unsigned u32x4 __attribute__((ext_vector_type(4)));
typedef unsigned u32x2 __attribute__((ext_vector_type(2)));
typedef int i32x4_t __attribute__((ext_vector_type(4)));
typedef int i32x8_t __attribute__((ext_vector_type(8)));
constexpr float F8_ACT = 16.f, F8_WGT = 512.f, F8_INV = 1.f / (16.f * 512.f);
constexpr int BM = 256, BK = 64, HALF = 128, HTB = HALF * BK * 2, STAGE_BYTES = 8 * HTB, NXCD = 8, WGM = 8;

__host__ __device__ __forceinline__ int lds_byte(int r, int c) { const int st = (r >> 4) * 2 + (c >> 5), rr = r & 15, cc = c & 31, ob = rr * 64 + cc * 2; return st * 1024 + (ob ^ (((ob >> 9) & 1) << 5)); }
__host__ __device__ __forceinline__ void stage_rc(int b, int& R, int& C) { const int st = b / 1024, sb = b % 1024, swz = sb ^ (((sb >> 9) & 1) << 5); R = (st >> 1) * 16 + swz / 64; C = (st & 1) * 32 + (swz % 64) / 2; }
__host__ __device__ __forceinline__ int perm32(int rho) { const int n = rho >> 4, i = rho & 15; return 8 * (i >> 2) + 4 * n + (i & 3); }

struct Unit { int pm, pn; const char* a; const char* b; const int* rows; const float* wrow; int nvalid; int pad_; };

struct StaticOrder {
    int nM, nN, nwg, G, c; const char* A; const char* Bt; size_t tstep;
    __device__ void init(const void* A_, const void* Bt_, int M, int N, int K, int G_, int c_, int esz = 2) { nM = M / BM; nN = N / BM; nwg = nM * nN; G = G_; c = c_; A = (const char*)A_; Bt = (const char*)Bt_; tstep = (size_t)BM * K * esz; }
    __device__ bool next(int i, Unit& u) const {
        const long L = (long)i * G + c; if (L >= nwg) return false;
        int wgid = (int)L; { const int q = nwg / NXCD, r = nwg % NXCD, xcd = wgid % NXCD, off = wgid / NXCD; wgid = (xcd < r ? xcd * (q + 1) : r * (q + 1) + (xcd - r) * q) + off; }
        const int nig = WGM * nN, gid = wgid / nig, fm = gid * WGM, gsz = (nM - fm) < WGM ? (nM - fm) : WGM;
        u.pm = fm + ((wgid % nig) % gsz); u.pn = (wgid % nig) / gsz; u.a = A + (size_t)u.pm * tstep; u.b = Bt + (size_t)u.pn * tstep; u.rows = nullptr; u.wrow = nullptr; u.nvalid = 256; return true;
    }
};

__device__ __forceinline__ unsigned cvt_pk_bf16(float lo, float hi) { unsigned r; asm volatile("v_cvt_pk_bf16_f32 %0, %1, %2" : "=v"(r) : "v"(lo), "v"(hi)); return r; }

struct EpiBf16 {
    static constexpr bool PERM = true;
    bf16_t* O; int ldc; float mul;
    __device__ __forceinline__ void operator()(const f32x4 (&acc)[2][2][4][2], const Unit& u, int wr, int wc, int fr, int fq) const {
        const int row0 = u.pm * BM + wr * 64 + fr; const int col0 = u.pn * BM + wc * 32 + 8 * fq;
#pragma unroll
        for (int ai = 0; ai < 2; ++ai)
#pragma unroll
            for (int m = 0; m < 4; ++m) { bf16_t* rowp = O + (size_t)(row0 + ai * HALF + m * 16) * ldc + col0;
#pragma unroll
                for (int bj = 0; bj < 2; ++bj) { const f32x4 v0 = acc[ai][bj][m][0] * mul, v1 = acc[ai][bj][m][1] * mul;
                    u32x4 w; w.x = cvt_pk_bf16(v0[0], v0[1]); w.y = cvt_pk_bf16(v0[2], v0[3]); w.z = cvt_pk_bf16(v1[0], v1[1]); w.w = cvt_pk_bf16(v1[2], v1[3]);
                    *(u32x4*)(rowp + bj * HALF) = w; } }
    }
};
struct EpiF8 {
    static constexpr bool PERM = true;
    unsigned char* O; int ldc; float mul;
    __device__ __forceinline__ void operator()(const f32x4 (&acc)[2][2][4][2], const Unit& u, int wr, int wc, int fr, int fq) const {
        const int row0 = u.pm * BM + wr * 64 + fr; const int col0 = u.pn * BM + wc * 32 + 8 * fq;
#pragma unroll
        for (int ai = 0; ai < 2; ++ai)
#pragma unroll
            for (int m = 0; m < 4; ++m) { unsigned char* rowp = O + (size_t)(row0 + ai * HALF + m * 16) * ldc + col0;
#pragma unroll
                for (int bj = 0; bj < 2; ++bj) { const f32x4 v0 = acc[ai][bj][m][0] * mul, v1 = acc[ai][bj][m][1] * mul;
                    u32x2 w; w.x = ::pk4_fp8(v0[0], v0[1], v0[2], v0[3]); w.y = ::pk4_fp8(v1[0], v1[1], v1[2], v1[3]);
                    *(u32x2*)(rowp + bj * HALF) = w; } }
    }
};
template <bool BASE_BF16>
struct EpiRes {
    static constexpr bool PERM = true;
    const void* base; bf16_t* C; int ldc; float mul;
    __device__ __forceinline__ void operator()(const f32x4 (&acc)[2][2][4][2], const Unit& u, int wr, int wc, int fr, int fq) const {
        const int row0 = u.pm * BM + wr * 64 + fr, col0 = u.pn * BM + wc * 32 + 8 * fq;
#pragma unroll
        for (int ai = 0; ai < 2; ++ai)
#pragma unroll
            for (int m = 0; m < 4; ++m) { const size_t off = (size_t)(row0 + ai * HALF + m * 16) * ldc + col0;
#pragma unroll
                for (int bj = 0; bj < 2; ++bj) { const size_t o2 = off + bj * HALF; f32x4 b0, b1;
                    if constexpr (BASE_BF16) { const u32x4 w = *(const u32x4*)((const bf16_t*)base + o2);
                        b0 = (f32x4){__uint_as_float(w.x << 16), __uint_as_float(w.x & 0xffff0000u), __uint_as_float(w.y << 16), __uint_as_float(w.y & 0xffff0000u)};
                        b1 = (f32x4){__uint_as_float(w.z << 16), __uint_as_float(w.z & 0xffff0000u), __uint_as_float(w.w << 16), __uint_as_float(w.w & 0xffff0000u)}; }
                    else { b0 = *(const f32x4*)((const float*)base + o2); b1 = *(const f32x4*)((const float*)base + o2 + 4); }
                    const f32x4 r0 = b0 + acc[ai][bj][m][0] * mul, r1 = b1 + acc[ai][bj][m][1] * mul;
                    u32x4 ow; ow.x = ::pk2(r0[0], r0[1]); ow.y = ::pk2(r0[2], r0[3]); ow.z = ::pk2(r1[0], r1[1]); ow.w = ::pk2(r1[2], r1[3]);
                    *(u32x4*)(C + o2) = ow; }
                asm volatile("" ::: "memory"); }
    }
};
struct EpiSilu {
    static constexpr bool PERM = true;
    bf16_t* H; float mul; float h8;
    __device__ __forceinline__ void operator()(const f32x4 (&acc)[2][2][4][2], const Unit& u, int wr, int wc, int fr, int fq) const {
        const int row0 = u.pm * BM + wr * 64 + fr; const int col0 = u.pn * HALF + wc * 32 + 8 * fq;
#pragma unroll
        for (int ai = 0; ai < 2; ++ai)
#pragma unroll
            for (int m = 0; m < 4; ++m) { const int row = row0 + ai * HALF + m * 16; const float w = u.wrow[wr * 64 + fr + ai * HALF + m * 16];
                float o[8];
#pragma unroll
                for (int n = 0; n < 2; ++n)
#pragma unroll
                    for (int j = 0; j < 4; ++j) { const float g = acc[ai][0][m][n][j] * mul, up = acc[ai][1][m][n][j] * mul; o[n * 4 + j] = g * __builtin_amdgcn_rcpf(1.f + __expf(-g)) * up * w; }
                if (h8 > 0.f) { u32x2 w8; w8.x = ::pk4_fp8(o[0] * h8, o[1] * h8, o[2] * h8, o[3] * h8); w8.y = ::pk4_fp8(o[4] * h8, o[5] * h8, o[6] * h8, o[7] * h8); *(u32x2*)((unsigned char*)H + (size_t)row * 256 + col0) = w8; }
                else { u32x4 wv; wv.x = cvt_pk_bf16(o[0], o[1]); wv.y = cvt_pk_bf16(o[2], o[3]); wv.z = cvt_pk_bf16(o[4], o[5]); wv.w = cvt_pk_bf16(o[6], o[7]);
                    *(u32x4*)(H + (size_t)row * 256 + col0) = wv; } }
    }
};

template <class Epi, class Sched, bool GATHER, int ESZ = 2>
__device__ __forceinline__ void gemm_phase(PG8_LAS unsigned char* lds, const int K, const Sched& S, const Epi& E) {
    const int tid = threadIdx.x, wid = __builtin_amdgcn_readfirstlane(tid >> 6), lane = tid & 63, wr = wid >> 2, wc = wid & 3, fr = lane & 15, fq = lane >> 4;
    const int KB = K * ESZ;
    const int nt = KB / (BK * 2);
    const size_t kstep = (size_t)(BK * 2);
    const unsigned hstep = (unsigned)HALF * KB;
    int sR[2], sC[2];
    unsigned voffB[2], vc[2][2], vn[2][2];
#pragma unroll
    for (int i = 0; i < 2; ++i) { int R, C; stage_rc(tid * 16 + i * 8192, R, C); sR[i] = R; sC[i] = C; const int Rb = Epi::PERM ? ((R & ~31) + perm32(R & 31)) : R;
        voffB[i] = (unsigned)(Rb * KB + C * 2); vc[0][i] = (unsigned)(R * KB + C * 2); vc[1][i] = vc[0][i] + hstep; vn[0][i] = vc[0][i]; vn[1][i] = vc[1][i]; }
    const unsigned ldsw = (unsigned)wid * 1024u;
    const int aoff = lds_byte(wr * 64 + fr, fq * 8), boff = lds_byte(wc * 32 + fr, fq * 8);
#define PG8_SA(b, h) (((b) * 2 + (h)) * HTB)
#define PG8_SB(b, h) ((4 + (b) * 2 + (h)) * HTB)
#define PG8_STAGE(bufoff, gbase, voff) do { _Pragma("unroll") for (int _i = 0; _i < 2; ++_i) \
        __builtin_amdgcn_global_load_lds((const unsigned*)((const char*)(gbase) + (voff)[_i]), (PG8_LAS unsigned*)(lds + (bufoff) + ldsw + _i * 8192), 16, 0, 0); } while (0)
#define PG8_LD32(addr) __builtin_shufflevector(*(const PG8_LAS i32x4_t*)(addr), *(const PG8_LAS i32x4_t*)((addr) + 1024), 0, 1, 2, 3, 4, 5, 6, 7)
#define PG8_LDA(dst, b, h) do { if constexpr (ESZ == 2) { _Pragma("unroll") for (int m = 0; m < 4; ++m) _Pragma("unroll") for (int k = 0; k < 2; ++k) dst[m][k] = *(const PG8_LAS bf16x8*)(lds + PG8_SA(b, h) + aoff + m * 2048 + k * 1024); } \
        else { _Pragma("unroll") for (int m = 0; m < 4; ++m) dst##8[m] = PG8_LD32(lds + PG8_SA(b, h) + aoff + m * 2048); } } while (0)
#define PG8_LDB(dst, b, h) do { if constexpr (ESZ == 2) { _Pragma("unroll") for (int n = 0; n < 2; ++n) _Pragma("unroll") for (int k = 0; k < 2; ++k) dst[n][k] = *(const PG8_LAS bf16x8*)(lds + PG8_SB(b, h) + boff + n * 2048 + k * 1024); } \
        else { _Pragma("unroll") for (int n = 0; n < 2; ++n) dst##8[n] = PG8_LD32(lds + PG8_SB(b, h) + boff + n * 2048); } } while (0)
#define PG8_F8(x) __builtin_shufflevector(__builtin_bit_cast(i32x4_t, x[0]), __builtin_bit_cast(i32x4_t, x[1]), 0, 1, 2, 3, 4, 5, 6, 7)
#define PG8_MMA(ai, bj, At, Bt) do { __builtin_amdgcn_s_setprio(1); _Pragma("unroll") for (int m = 0; m < 4; ++m) _Pragma("unroll") for (int n = 0; n < 2; ++n) { \
        if constexpr (ESZ == 2) { _Pragma("unroll") for (int k = 0; k < 2; ++k) acc[ai][bj][m][n] = __builtin_amdgcn_mfma_f32_16x16x32_bf16(Bt[n][k], At[m][k], acc[ai][bj][m][n], 0, 0, 0); } \
        else asm volatile("s_nop 1\n\tv_mfma_f32_16x16x128_f8f6f4 %0, %1, %2, %0" : "+v"(acc[ai][bj][m][n]) : "v"(Bt##8[n]), "v"(At##8[m])); } __builtin_amdgcn_s_setprio(0); } while (0)
#define PG8_WAIT_V(n) asm volatile("s_waitcnt vmcnt(" #n ")" ::: "memory")
#define PG8_WAIT_L(n) asm volatile("s_waitcnt lgkmcnt(" #n ")" ::: "memory")
#define PG8_BAR __builtin_amdgcn_s_barrier()
#define PG8_SCHED __builtin_amdgcn_sched_barrier(0)
#define PG8_GV(dst, u) do { if constexpr (GATHER) { _Pragma("unroll") for (int _h = 0; _h < 2; ++_h) _Pragma("unroll") for (int _i = 0; _i < 2; ++_i) { const int _idx = _h * HALF + sR[_i]; \
        const int _tok = (u).rows[_idx < (u).nvalid ? _idx : 0]; dst[_h][_i] = (unsigned)_tok * (unsigned)KB + (unsigned)sC[_i] * 2u; } } } while (0)
    Unit cur, nxt; int ui = 0;
    if (!S.next(0, cur)) return;
    f32x4 acc[2][2][4][2];
#pragma unroll
    for (int a = 0; a < 2; ++a)
#pragma unroll
        for (int b = 0; b < 2; ++b)
#pragma unroll
            for (int m = 0; m < 4; ++m)
#pragma unroll
                for (int n = 0; n < 2; ++n) acc[a][b][m][n] = (f32x4){0.f, 0.f, 0.f, 0.f};
    bf16x8 At[4][2], B0[2][2], B1[2][2];
    i32x8_t At8[4], B08[2], B18[2];
    const char* cA = cur.a; const char* cB = cur.b;
    PG8_GV(vc, cur);
    PG8_STAGE(PG8_SB(0, 0), cB, voffB); PG8_STAGE(PG8_SB(0, 1), cB + hstep, voffB); PG8_STAGE(PG8_SA(0, 0), cA, vc[0]); PG8_STAGE(PG8_SA(0, 1), cA, vc[1]);
    if (wr == 1) PG8_BAR;
    PG8_WAIT_V(2); PG8_BAR;
    PG8_STAGE(PG8_SB(1, 0), cB + kstep, voffB); PG8_STAGE(PG8_SA(1, 0), cA + kstep, vc[0]); PG8_STAGE(PG8_SB(1, 1), cB + hstep + kstep, voffB);
    PG8_WAIT_V(6); PG8_BAR;
    for (;;) {
        const bool has_next = S.next(ui + 1, nxt);
        const char* nA = has_next ? nxt.a : cA; const char* nB = has_next ? nxt.b : cB;
        if constexpr (GATHER) { if (has_next) { PG8_GV(vn, nxt); } else {
#pragma unroll
            for (int h = 0; h < 2; ++h)
#pragma unroll
                for (int i = 0; i < 2; ++i) vn[h][i] = vc[h][i]; } }
#pragma unroll 1
        for (int t = 0; t < nt; t += 2) {
            const bool last = (t == nt - 2);
            const char* a1 = cA + (size_t)(t + 1) * kstep;
            const char* a2 = last ? nA : cA + (size_t)(t + 2) * kstep; const char* b2 = last ? nB : cB + (size_t)(t + 2) * kstep;
            const char* a3 = a2 + kstep; const char* b3 = b2 + kstep;
            unsigned v2[2][2];
#pragma unroll
            for (int h = 0; h < 2; ++h)
#pragma unroll
                for (int i = 0; i < 2; ++i) v2[h][i] = (GATHER && last) ? vn[h][i] : vc[h][i];
            PG8_LDB(B0, 0, 0); PG8_LDB(B1, 0, 1); PG8_SCHED; PG8_LDA(At, 0, 0); PG8_STAGE(PG8_SA(1, 1), a1, vc[1]);
            PG8_WAIT_V(8); PG8_WAIT_L(0); PG8_BAR; PG8_MMA(0, 0, At, B0); PG8_MMA(0, 1, At, B1); PG8_BAR; PG8_SCHED;
            PG8_LDA(At, 0, 1); PG8_STAGE(PG8_SB(0, 0), b2, voffB); PG8_STAGE(PG8_SB(0, 1), b2 + hstep, voffB); PG8_STAGE(PG8_SA(0, 0), a2, v2[0]);
            PG8_WAIT_V(8); PG8_WAIT_L(0); PG8_BAR; PG8_MMA(1, 0, At, B0); PG8_MMA(1, 1, At, B1); PG8_BAR; PG8_SCHED;
            PG8_LDB(B0, 1, 0); PG8_LDB(B1, 1, 1); PG8_SCHED; PG8_LDA(At, 1, 0); PG8_STAGE(PG8_SA(0, 1), a2, v2[1]);
            PG8_WAIT_V(8); PG8_WAIT_L(0); PG8_BAR; PG8_MMA(0, 0, At, B0); PG8_MMA(0, 1, At, B1); PG8_BAR; PG8_SCHED;
            PG8_LDA(At, 1, 1); PG8_STAGE(PG8_SB(1, 0), b3, voffB); PG8_STAGE(PG8_SB(1, 1), b3 + hstep, voffB); PG8_STAGE(PG8_SA(1, 0), a3, v2[0]);
            PG8_WAIT_V(8); PG8_WAIT_L(0); PG8_BAR; PG8_MMA(1, 0, At, B0); PG8_MMA(1, 1, At, B1); PG8_BAR; PG8_SCHED;
        }
        if (wr == 0) PG8_BAR;
        if constexpr (ESZ == 1) asm volatile("s_nop 15\n\ts_nop 7" ::: "memory");
        E(acc, cur, wr, wc, fr, fq);
        if (!has_next) break;
#pragma unroll
        for (int a = 0; a < 2; ++a)
#pragma unroll
            for (int b = 0; b < 2; ++b)
#pragma unroll
                for (int m = 0; m < 4; ++m)
#pragma unroll
                    for (int n = 0; n < 2; ++n) acc[a][b][m][n] = (f32x4){0.f, 0.f, 0.f, 0.f};
        cur = nxt; cA = nA; cB = nB; ++ui;
        if constexpr (GATHER) {
#pragma unroll
            for (int h = 0; h < 2; ++h)
#pragma unroll
                for (int i = 0; i < 2; ++i) vc[h][i] = vn[h][i]; }
        if (wr == 1) PG8_BAR;
    }
    PG8_WAIT_V(0);
    PG8_BAR;
#undef PG8_SA
#undef PG8_SB
#undef PG8_STAGE
#undef PG8_LDA
#undef PG8_LD32
#undef PG8_LDB
#undef PG8_MMA
#undef PG8_F8
#undef PG8_WAIT_V
#undef PG8_WAIT_L
#undef PG8_BAR
#undef PG8_SCHED
#undef PG8_GV
}
}
struct Frame {
    LAS unsigned char* lds; unsigned char* ws; unsigned* ctl;
    int tid, lane, wave, G, vcu;
    unsigned long long pacc;
};

__device__ __forceinline__ void cvt_tile(const float* W, int N, int K, int k0, int n0, bf16* dst, int drow0, float scale, LAS float* scr, int lane) {
#pragma unroll 8
    for (int i = 0; i < 32; ++i) { const int kk = 2 * i + (lane >> 5); scr[kk * 33 + (lane & 31)] = W[(size_t)(k0 + kk) * N + n0 + (lane & 31)]; }
    LDS_WAIT(); asm volatile("" ::: "memory");
    const int c = lane & 7;
#pragma unroll
    for (int j = 0; j < 4; ++j) { const int n = (lane >> 3) + 8 * j; const LAS float* s = scr + (8 * c) * 33 + n;
        u32x4 o; o.x = pk2(s[0 * 33] * scale, s[1 * 33] * scale); o.y = pk2(s[2 * 33] * scale, s[3 * 33] * scale); o.z = pk2(s[4 * 33] * scale, s[5 * 33] * scale); o.w = pk2(s[6 * 33] * scale, s[7 * 33] * scale);
        *(u32x4*)(dst + (size_t)(drow0 + n) * K + k0 + 8 * c) = o; }
    LDS_WAIT(); asm volatile("" ::: "memory");
}
__device__ __forceinline__ void cvt_tile8(const float* W, int N, int K, int k0, int n0, unsigned char* dst, int drow0, float scale, LAS float* scr, int lane) {
#pragma unroll 8
    for (int i = 0; i < 32; ++i) { const int kk = 2 * i + (lane >> 5); scr[kk * 33 + (lane & 31)] = W[(size_t)(k0 + kk) * N + n0 + (lane & 31)]; }
    LDS_WAIT(); asm volatile("" ::: "memory");
    const int c = lane & 7;
#pragma unroll
    for (int j = 0; j < 4; ++j) { const int n = (lane >> 3) + 8 * j; const LAS float* s = scr + (8 * c) * 33 + n;
        u32x2 o; o.x = pk4_fp8(s[0 * 33] * scale, s[1 * 33] * scale, s[2 * 33] * scale, s[3 * 33] * scale); o.y = pk4_fp8(s[4 * 33] * scale, s[5 * 33] * scale, s[6 * 33] * scale, s[7 * 33] * scale);
        *(u32x2*)(dst + (size_t)(drow0 + n) * K + k0 + 8 * c) = o; }
    LDS_WAIT(); asm volatile("" ::: "memory");
}
__device__ __forceinline__ void help_convert(Frame& F, const Args& a, int dq, bool q2);
__device__ __forceinline__ void convert_phase(Frame& F, const Args& a, int l) {
    using namespace cfg;
    LAS float* scr = (LAS float*)(F.lds + F.wave * 16384);
    const int gw = F.vcu * 8 + F.wave, NGW = F.G * 8;
    const float* w_in = a.in[1] + (size_t)l * D * INC; const float* w_out = a.in[2] + (size_t)l * D * D;
    const size_t es = (size_t)NEXP * D * EH;
    const float* wg = a.in[29] + l * es; const float* wu = a.in[30] + l * es; const float* wd = a.in[31] + l * es;
    bf16* Wi = (bf16*)(F.ws + wsm::W_IN); bf16* Wo = (bf16*)(F.ws + wsm::W_OUT); bf16* Wgu = (bf16*)(F.ws + wsm::W_GU); bf16* Wd = (bf16*)(F.ws + wsm::W_D);
    constexpr int I_IN = 32 * 200, I_OUT = 32 * 64, I_G = 32 * 256, I_D = 32 * 256;
    constexpr int NITEMS = I_IN + I_OUT + 2 * I_G + I_D;
    const int nit = (l == 1) ? 0 : NITEMS;
    for (int it = gw; it < nit; it += NGW) {
        int r = it;
        if (r < I_IN) { const int kb = r / 200, nb = r % 200, n0 = nb * 32; const bool isq = (n0 >= OFF_BQ && n0 < OFF_BK) || (n0 >= OFF_CQ && n0 < OFF_CK);
            if (F8IN(l)) cvt_tile8(w_in, INC, D, kb * 64, n0, (unsigned char*)Wi, n0, (isq ? C2F : 1.f) * pg8::F8_WGT, scr, F.lane); else cvt_tile(w_in, INC, D, kb * 64, n0, Wi, n0, isq ? C2F : 1.f, scr, F.lane); continue; } r -= I_IN;
        if (r < I_OUT) { const int kb = r / 64, nb = r % 64; if (F8OUT(l)) cvt_tile8(w_out, D, D, kb * 64, nb * 32, (unsigned char*)Wo, nb * 32, pg8::F8_WGT, scr, F.lane); else cvt_tile(w_out, D, D, kb * 64, nb * 32, Wo, nb * 32, 1.f, scr, F.lane); continue; } r -= I_OUT;
        if (r < 2 * I_G) { const int up = r >= I_G; if (up) r -= I_G; const int e = r >> 8, q = r & 255, kb = q >> 3, nb = q & 7, n0 = nb * 32;
            if ((F8_MOE_MASK >> l) & 1) cvt_tile8((up ? wu : wg) + (size_t)e * D * EH, EH, D, kb * 64, n0, (unsigned char*)Wgu, e * 512 + 256 * (n0 >> 7) + (n0 & 127) + (up ? 128 : 0), pg8::F8_WGT, scr, F.lane);
            else cvt_tile((up ? wu : wg) + (size_t)e * D * EH, EH, D, kb * 64, n0, Wgu, e * 512 + 256 * (n0 >> 7) + (n0 & 127) + (up ? 128 : 0), 1.f, scr, F.lane); continue; } r -= 2 * I_G;
        { const int e = r >> 8, q = r & 255, kb = q >> 6, nb = q & 63;
          if (F8_DOWN) cvt_tile8(wd + (size_t)e * EH * D, D, EH, kb * 64, nb * 32, (unsigned char*)Wd + (size_t)e * D * EH, nb * 32, pg8::F8_WGT, scr, F.lane);
          else cvt_tile(wd + (size_t)e * EH * D, D, EH, kb * 64, nb * 32, Wd + (size_t)e * D * EH, nb * 32, 1.f, scr, F.lane); }
    }
    if (l == 1) help_convert(F, a, -1, true);
    bf16* Wr = (bf16*)(F.ws + wsm::WRT); const float* rg = a.in[25] + (size_t)l * D * 4; const float* re = a.in[27] + (size_t)l * D * 32;
    for (int idx = (F.vcu * 512 + F.tid); idx < 48 * 2048; idx += F.G * 512) { const int n = idx >> 11, k = idx & 2047;
        const float v = n < 4 ? rg[k * 4 + n] : (n < 36 ? re[k * 32 + n - 4] : 0.f); Wr[idx] = cvt1(v); }
    bf16* w2t = (bf16*)(F.ws + wsm::WRT + 262144); bf16* a2t = w2t + 512 * 64; bf16* g2t = a2t + 512 * 64;
    const float* w2 = a.in[8] + (size_t)l * 64 * 512; const float* a2 = a.in[10] + (size_t)l * 64 * 512; const float* g2 = a.in[11] + (size_t)l * 128 * 512;
    for (int idx = (F.vcu * 512 + F.tid); idx < 512 * 256; idx += F.G * 512) { const int ch = idx & 511, j = idx >> 9;
        if (j < 64) w2t[ch * 64 + j] = cvt1(w2[j * 512 + ch]); else if (j < 128) a2t[ch * 64 + (j - 64)] = cvt1(a2[(j - 64) * 512 + ch]); else g2t[ch * 128 + (j - 128)] = cvt1(g2[(j - 128) * 512 + ch]); }
}

__device__ __forceinline__ int grab(Frame& F, int q) {
    volatile LAS int* slot = (volatile LAS int*)(F.lds + MISC_OFF + 64);
    if (F.tid == 0) *slot = (int)__hip_atomic_fetch_add(F.ctl + wsm::CW_Q + q * 64, 1u, RLX_AGENT);
    __syncthreads();
    const int v = *slot;
    __syncthreads();
    return __builtin_amdgcn_readfirstlane(v);
}
static_assert(F8_MOE_MASK == 3 && F8_DOWN, "per-layer halves of W_GU / W_D assume fp8 expert weights in both layers");
constexpr int CVQ_ITEMS = 2 * 32 * 256 + 32 * 256, CVQ_Q = 8;
constexpr size_t WGU_LSTRIDE = (size_t)32 << 20, WD_LSTRIDE = (size_t)16 << 20;
struct CvtDesc { const float* W; int N, K, k0, n0, drow0; unsigned char* dst; float scale; };
static_assert((F8_IN_MASK & 2) && (F8_OUT_MASK & 2), "queue 2 converts layer 1's w_in / w_out to fp8");
constexpr int CVQ2_ITEMS = 32 * 200 + 32 * 64, CVQ2_Q = 13;
__device__ __forceinline__ CvtDesc moe_item_desc(Frame& F, const Args& a, int l, int r) {
    using namespace cfg;
    if (r >= CVQ_ITEMS) { r -= CVQ_ITEMS; CvtDesc c; c.K = D;
        if (r < 32 * 200) { const int kb = r / 200, nb = r % 200, n0 = nb * 32; const bool isq = (n0 >= OFF_BQ && n0 < OFF_BK) || (n0 >= OFF_CQ && n0 < OFF_CK);
            c.W = a.in[1] + (size_t)l * D * INC; c.N = INC; c.k0 = kb * 64; c.n0 = n0; c.drow0 = n0; c.dst = F.ws + wsm::W_IN; c.scale = (isq ? C2F : 1.f) * pg8::F8_WGT; }
        else { r -= 32 * 200; const int kb = r / 64, nb = r % 64;
            c.W = a.in[2] + (size_t)l * D * D; c.N = D; c.k0 = kb * 64; c.n0 = nb * 32; c.drow0 = nb * 32; c.dst = F.ws + wsm::W_OUT; c.scale = pg8::F8_WGT; }
        return c; }
    const size_t es = (size_t)NEXP * D * EH;
    const float* wg = a.in[29] + l * es; const float* wu = a.in[30] + l * es; const float* wd = a.in[31] + l * es;
    unsigned char* Wgu = F.ws + wsm::W_GU + (size_t)l * WGU_LSTRIDE; unsigned char* Wd = F.ws + wsm::W_D + (size_t)l * WD_LSTRIDE;
    constexpr int I_G = 32 * 256;
    CvtDesc c; c.scale = pg8::F8_WGT;
    if (r < 2 * I_G) { const int up = r >= I_G; if (up) r -= I_G; const int e = r >> 8, q = r & 255, kb = q >> 3, nb = q & 7, n0 = nb * 32;
        c.W = (up ? wu : wg) + (size_t)e * D * EH; c.N = EH; c.K = D; c.k0 = kb * 64; c.n0 = n0; c.dst = Wgu; c.drow0 = e * 512 + 256 * (n0 >> 7) + (n0 & 127) + (up ? 128 : 0); }
    else { r -= 2 * I_G; const int e = r >> 8, q = r & 255, kb = q >> 6, nb = q & 63;
        c.W = wd + (size_t)e * EH * D; c.N = D; c.K = EH; c.k0 = kb * 64; c.n0 = nb * 32; c.dst = Wd + (size_t)e * D * EH; c.drow0 = nb * 32; }
    return c;
}
__device__ __forceinline__ void cvt_pair8(const CvtDesc& A, const CvtDesc& B, LAS float* scr, int lane) {
    float va[32], vb[32];
    { const float* pa = A.W + (size_t)(A.k0 + (lane >> 5)) * A.N + A.n0 + (lane & 31); const float* pb = B.W + (size_t)(B.k0 + (lane >> 5)) * B.N + B.n0 + (lane & 31);
#pragma unroll
      for (int i = 0; i < 32; ++i) va[i] = pa[(size_t)(2 * i) * A.N];
#pragma unroll
      for (int i = 0; i < 32; ++i) vb[i] = pb[(size_t)(2 * i) * B.N]; }
#pragma unroll
    for (int h = 0; h < 2; ++h) { const CvtDesc& C = h ? B : A; const float scale = C.scale;
#pragma unroll
        for (int i = 0; i < 32; ++i) scr[(2 * i + (lane >> 5)) * 33 + (lane & 31)] = h ? vb[i] : va[i];
        LDS_WAIT(); asm volatile("" ::: "memory");
        const int c = lane & 7;
#pragma unroll
        for (int j = 0; j < 4; ++j) { const int n = (lane >> 3) + 8 * j; const LAS float* sp = scr + (8 * c) * 33 + n;
            u32x2 o; o.x = pk4_fp8(sp[0 * 33] * scale, sp[1 * 33] * scale, sp[2 * 33] * scale, sp[3 * 33] * scale); o.y = pk4_fp8(sp[4 * 33] * scale, sp[5 * 33] * scale, sp[6 * 33] * scale, sp[7 * 33] * scale);
            *(u32x2*)(C.dst + (size_t)(C.drow0 + n) * C.K + C.k0 + 8 * c) = o; }
        LDS_WAIT(); asm volatile("" ::: "memory"); }
}
__device__ __forceinline__ void help_convert(Frame& F, const Args& a, int dq, bool q2) {
    volatile LAS int* slot = (volatile LAS int*)(F.lds + MISC_OFF + 64);
    LAS float* scr = (LAS float*)(F.lds + F.wave * 16384);
    __syncthreads();
    if (dq >= 0 && F.tid == 0) (void)__hip_atomic_fetch_add(F.ctl + wsm::CW_Q + dq * 64, 1u, RLX_AGENT);
    for (;;) {
        if (F.tid == 0) { const bool over = dq >= 0 && __hip_atomic_load(F.ctl + wsm::CW_Q + dq * 64, RLX_AGENT) >= (unsigned)F.G;
            int v = 0x7fffffff;
            if (!over) { v = (int)__hip_atomic_fetch_add(F.ctl + wsm::CW_Q + CVQ_Q * 64, 16u, RLX_AGENT);
                if (v >= CVQ_ITEMS) { v = 0x7fffffff;
                    if (q2) { const int v2 = (int)__hip_atomic_fetch_add(F.ctl + wsm::CW_Q + CVQ2_Q * 64, 16u, RLX_AGENT); if (v2 < CVQ2_ITEMS) v = CVQ_ITEMS + v2; } } }
            *slot = v; }
        __syncthreads(); const int q = __builtin_amdgcn_readfirstlane(*slot); __syncthreads();
        if (q == 0x7fffffff) break;
        const CvtDesc A = moe_item_desc(F, a, 1, q + 2 * F.wave), B = moe_item_desc(F, a, 1, q + 2 * F.wave + 1);
        cvt_pair8(A, B, scr, F.lane);
    }
}
__device__ __forceinline__ void build_pref(Frame& F, int l) {
    LAS int* pref = (LAS int*)(F.lds + TAB_OFF);
    if (F.tid < 64) { const int e = F.tid & 31;
        const unsigned c = __hip_atomic_load(F.ctl + wsm::CW_CNT + (l * 32 + e) * 64, RLX_AGENT);
        const int np = (int)((c + 255u) >> 8); int inc = np;
#pragma unroll
        for (int o = 1; o < 32; o <<= 1) { const int nb = __shfl_up(inc, o); if (e >= o) inc += nb; }
        if (F.tid < 32) { pref[e] = inc - np; pref[40 + e] = (int)c; if (e == 31) pref[32] = inc; } }
    __syncthreads();
}

template <bool COMBINE, bool ROUTER, bool FINAL, bool F8 = false, bool XBF = false>
__device__ __forceinline__ void norm_phase(Frame& F, const Args& a, const float* xsrc, float* xout, const float* gain, int l, int lc) {
    using namespace cfg;
    constexpr int PITCHB = 4112;
    LAS unsigned char* tile = F.lds;
    LAS float* part = (LAS float*)(F.lds + 67584);
    LAS int* pref = (LAS int*)(F.lds + TAB_OFF);
    bf16* xn = (bf16*)(F.ws + wsm::XN);
    const bf16* OB = (const bf16*)(F.ws + wsm::OB);
    const int4* tokinfo = (const int4*)(F.ws + wsm::TOKINFO);
    const int lane = F.lane, w = F.wave;
    f32x4 g4[8];
#pragma unroll
    for (int j = 0; j < 8; ++j) g4[j] = *(const f32x4*)(gain + 4 * lane + 256 * j);
    LAS float* rb = (LAS float*)(F.lds + TAB_OFF + 1024);
    if constexpr (ROUTER) { if (F.tid < 36) rb[F.tid] = F.tid < 4 ? a.in[26][l * 4 + F.tid] : a.in[28][l * 32 + F.tid - 4]; __syncthreads(); }
    bf16x8 wrf[ROUTER ? 8 : 1][3];
    if constexpr (ROUTER) { const bf16* Wr = (const bf16*)(F.ws + wsm::WRT);
#pragma unroll
        for (int s8 = 0; s8 < 8; ++s8)
#pragma unroll
            for (int nt = 0; nt < 3; ++nt) wrf[s8][nt] = *(const bf16x8*)(Wr + (size_t)(16 * nt + (lane & 15)) * D + 256 * w + 32 * s8 + 8 * (lane >> 4)); }
    for (int pass = F.vcu; pass < M / 16; pass += F.G) {
#pragma unroll
        for (int rr = 0; rr < 2; ++rr) {
            const int rt = 2 * w + rr, row = pass * 16 + rt;
            f32x4 v[8];
            if constexpr (XBF) { const bf16* xr = (const bf16*)xsrc + (size_t)row * D + 4 * lane;
#pragma unroll
                for (int j = 0; j < 8; ++j) { const u32x2 w = *(const u32x2*)(xr + 256 * j); v[j] = (f32x4){__uint_as_float(w.x << 16), __uint_as_float(w.x & 0xffff0000u), __uint_as_float(w.y << 16), __uint_as_float(w.y & 0xffff0000u)}; }
            } else { const float* xr = xsrc + (size_t)row * D + 4 * lane;
#pragma unroll
                for (int j = 0; j < 8; ++j) v[j] = *(const f32x4*)(xr + 256 * j); }
            if constexpr (COMBINE) {
                const int4 ti = tokinfo[row];
                const unsigned char* o0 = (const unsigned char*)OB + ((size_t)pref[ti.x] * 256 + ti.y) * D + 4 * lane; const unsigned char* o1 = (const unsigned char*)OB + ((size_t)pref[ti.z] * 256 + ti.w) * D + 4 * lane;
#pragma unroll
                for (int j = 0; j < 8; ++j) { const int p0 = *(const int*)(o0 + 256 * j), p1 = *(const int*)(o1 + 256 * j);
                    const f32x2 a0 = __builtin_amdgcn_cvt_pk_f32_fp8(p0, false), a1 = __builtin_amdgcn_cvt_pk_f32_fp8(p0, true), b0 = __builtin_amdgcn_cvt_pk_f32_fp8(p1, false), b1 = __builtin_amdgcn_cvt_pk_f32_fp8(p1, true);
                    v[j].x += (a0.x + b0.x) * (1.f / F8_OB); v[j].y += (a0.y + b0.y) * (1.f / F8_OB); v[j].z += (a1.x + b1.x) * (1.f / F8_OB); v[j].w += (a1.y + b1.y) * (1.f / F8_OB); }
                if constexpr (!FINAL) {
#pragma unroll
                    for (int j = 0; j < 8; ++j) { if constexpr (XBF) { u32x2 w; w.x = pk2(v[j].x, v[j].y); w.y = pk2(v[j].z, v[j].w); *(u32x2*)((bf16*)xout + (size_t)row * D + 4 * lane + 256 * j) = w; }
                        else *(f32x4*)(xout + (size_t)row * D + 4 * lane + 256 * j) = v[j]; }
                }
            }
            float s = 0.f;
#pragma unroll
            for (int j = 0; j < 8; ++j) s += (v[j].x * v[j].x + v[j].y * v[j].y) + (v[j].z * v[j].z + v[j].w * v[j].w);
            const float rstd = rsqrtf(wave_sum(s) * (1.f / D) + 1e-6f);
#pragma unroll
            for (int j = 0; j < 8; ++j) { const f32x4 o = v[j] * rstd * g4[j];
                if constexpr (FINAL) *(f32x4*)(xout + (size_t)row * D + 4 * lane + 256 * j) = o;
                else if constexpr (F8) { *(unsigned*)((unsigned char*)xn + (size_t)row * D + 4 * lane + 256 * j) = pk4_fp8(o.x * pg8::F8_ACT, o.y * pg8::F8_ACT, o.z * pg8::F8_ACT, o.w * pg8::F8_ACT);
                    if constexpr (ROUTER) { u32x2 pk; pk.x = pk2(o.x, o.y); pk.y = pk2(o.z, o.w); *(LAS u32x2*)(tile + rt * PITCHB + (4 * lane + 256 * j) * 2) = pk; } }
                else { u32x2 pk; pk.x = pk2(o.x, o.y); pk.y = pk2(o.z, o.w);
                    *(u32x2*)(xn + (size_t)row * D + 4 * lane + 256 * j) = pk;
                    if constexpr (ROUTER) *(LAS u32x2*)(tile + rt * PITCHB + (4 * lane + 256 * j) * 2) = pk; } }
        }
        if constexpr (ROUTER) {
            __syncthreads();
            f32x4 acc[3] = {(f32x4){0.f, 0.f, 0.f, 0.f}, (f32x4){0.f, 0.f, 0.f, 0.f}, (f32x4){0.f, 0.f, 0.f, 0.f}};
#pragma unroll
            for (int s8 = 0; s8 < 8; ++s8) { const int k = 256 * w + 32 * s8 + 8 * (lane >> 4);
                const bf16x8 af = *(const LAS bf16x8*)(tile + (lane & 15) * PITCHB + k * 2);
#pragma unroll
                for (int nt = 0; nt < 3; ++nt) acc[nt] = __builtin_amdgcn_mfma_f32_16x16x32_bf16(af, wrf[s8][nt], acc[nt], 0, 0, 0); }
#pragma unroll
            for (int nt = 0; nt < 3; ++nt)
#pragma unroll
                for (int i = 0; i < 4; ++i) part[(w * 16 + (lane >> 4) * 4 + i) * 48 + 16 * nt + (lane & 15)] = acc[nt][i];
            __syncthreads();
            if (F.tid < 16) {
                const int m = F.tid, tok = pass * 16 + m;
                const LAS float* bg = rb; const LAS float* be = rb + 4;
                float lg[4];
#pragma unroll
                for (int o = 0; o < 4; ++o) { float sacc = bg[o];
#pragma unroll
                    for (int ww = 0; ww < 8; ++ww) sacc += part[(ww * 16 + m) * 48 + o]; lg[o] = sacc; }
                int gi = 0; float gm = lg[0];
#pragma unroll
                for (int o = 1; o < 4; ++o) if (lg[o] > gm) { gm = lg[o]; gi = o; }
                float gs = 0.f;
#pragma unroll
                for (int o = 0; o < 4; ++o) gs += __expf(lg[o] - gm);
                const float gw = 1.f / gs;
                float el[8];
#pragma unroll
                for (int o = 0; o < 8; ++o) { float sacc = be[gi * 8 + o];
#pragma unroll
                    for (int ww = 0; ww < 8; ++ww) sacc += part[(ww * 16 + m) * 48 + 4 + gi * 8 + o]; el[o] = sacc; }
                int i1 = 0; float m1 = el[0];
#pragma unroll
                for (int o = 1; o < 8; ++o) if (el[o] > m1) { m1 = el[o]; i1 = o; }
                int i2 = 0; float m2 = -3e38f;
#pragma unroll
                for (int o = 0; o < 8; ++o) if (o != i1 && el[o] > m2) { m2 = el[o]; i2 = o; }
                const float e2x = __expf(m2 - m1); const float w1 = gw / (1.f + e2x), w2 = gw * e2x / (1.f + e2x);
                const int e1 = gi * 8 + i1, e2 = gi * 8 + i2;
                const int p1 = (int)__hip_atomic_fetch_add(F.ctl + wsm::CW_CNT + (lc * 32 + e1) * 64, 1u, RLX_AGENT);
                const int p2 = (int)__hip_atomic_fetch_add(F.ctl + wsm::CW_CNT + (lc * 32 + e2) * 64, 1u, RLX_AGENT);
                int* lists = (int*)(F.ws + wsm::LISTS); float* wl = (float*)(F.ws + wsm::WLIST);
                lists[e1 * LCAP + p1] = tok; lists[e2 * LCAP + p2] = tok; wl[e1 * LCAP + p1] = w1; wl[e2 * LCAP + p2] = w2;
                ((int4*)(F.ws + wsm::TOKINFO))[tok] = make_int4(e1, p1, e2, p2);
                ((int4*)(F.ws + wsm::ROUTE))[tok] = make_int4(e1, e2, __float_as_int(w1), __float_as_int(w2));
            }
            __syncthreads();
        }
    }
}
namespace att {
typedef float f32x16 __attribute__((ext_vector_type(16)));
typedef short s16x4 __attribute__((ext_vector_type(4)));
constexpr int L_K = 0, L_V = 16384, L_WSF = 135168, L_TAB = 137216;
__device__ __forceinline__ int crow(int r, int hi) { return (r & 3) + 8 * (r >> 2) + 4 * hi; }
__device__ __forceinline__ int t5_bucket(int rel) {
    const int ret = rel > 0 ? 16 : 0; const int n = rel < 0 ? -rel : rel; int bk;
    if (n < 8) bk = n; else if (n < 12) bk = 8; else if (n < 16) bk = 9; else if (n < 23) bk = 10; else if (n < 32) bk = 11;
    else if (n < 46) bk = 12; else if (n < 64) bk = 13; else if (n < 91) bk = 14; else bk = 15;
    return ret + bk;
}
__device__ __forceinline__ unsigned cvtpk(float lo, float hi) { return pk2(lo, hi); }
__device__ __forceinline__ void qkt(f32x16& p0, f32x16& p1, const LAS unsigned char* Kslot, const bf16x8* qr, const f32x16& c0, const f32x16& c1, int r32, int hi) {
    const LAS unsigned char* kb = Kslot + hi * 1024 + r32 * 16;
#pragma unroll
    for (int d0 = 0; d0 < 4; ++d0) {
        const bf16x8 b0 = *(const LAS bf16x8*)(kb + d0 * 2048);
        const bf16x8 b1 = *(const LAS bf16x8*)(kb + d0 * 2048 + 512);
        if (d0 == 0) { p0 = __builtin_amdgcn_mfma_f32_32x32x16_bf16(b0, qr[0], c0, 0, 0, 0); p1 = __builtin_amdgcn_mfma_f32_32x32x16_bf16(b1, qr[0], c1, 0, 0, 0); }
        else { p0 = __builtin_amdgcn_mfma_f32_32x32x16_bf16(b0, qr[d0], p0, 0, 0, 0); p1 = __builtin_amdgcn_mfma_f32_32x32x16_bf16(b1, qr[d0], p1, 0, 0, 0); } }
}
__device__ __forceinline__ float rowmax(const f32x16& p0, const f32x16& p1) {
    float a = fmaxf(fmaxf(p0[0], p0[1]), p1[0]), b = fmaxf(fmaxf(p0[2], p0[3]), p1[1]); a = fmaxf(fmaxf(a, p1[2]), p1[3]);
#pragma unroll
    for (int r = 4; r < 16; r += 4) { a = fmaxf(fmaxf(a, p0[r]), p0[r + 1]); b = fmaxf(fmaxf(b, p0[r + 2]), p0[r + 3]); a = fmaxf(fmaxf(a, p1[r]), p1[r + 1]); b = fmaxf(fmaxf(b, p1[r + 2]), p1[r + 3]); }
    const float m = fmaxf(a, b);
    auto rr = __builtin_amdgcn_permlane32_swap(__float_as_uint(m), __float_as_uint(m), false, false);
    return fmaxf(__uint_as_float(rr[0]), __uint_as_float(rr[1]));
}
template <int ND>
__device__ __forceinline__ void pv(f32x16* o, int vb, bf16x8 pa0, bf16x8 pa1, bf16x8 pa2, bf16x8 pa3) {
#pragma unroll
    for (int d0 = 0; d0 < ND; ++d0) { s16x4 lo[4], hi[4];
#pragma unroll
        for (int ks = 0; ks < 4; ++ks) {
            asm volatile("ds_read_b64_tr_b16 %0,%1 offset:%c2" : "=&v"(lo[ks]) : "v"(vb), "i"(d0 * 4096 + ks * 1024) : "memory");
            asm volatile("ds_read_b64_tr_b16 %0,%1 offset:%c2" : "=&v"(hi[ks]) : "v"(vb), "i"(d0 * 4096 + ks * 1024 + 512) : "memory"); }
        asm volatile("s_waitcnt lgkmcnt(0)" ::: "memory"); __builtin_amdgcn_sched_barrier(0);
#define ATT_PK(k) (bf16x8){lo[k][0], lo[k][1], lo[k][2], lo[k][3], hi[k][0], hi[k][1], hi[k][2], hi[k][3]}
        o[d0] = __builtin_amdgcn_mfma_f32_32x32x16_bf16(pa0, ATT_PK(0), o[d0], 0, 0, 0);
        o[d0] = __builtin_amdgcn_mfma_f32_32x32x16_bf16(pa1, ATT_PK(1), o[d0], 0, 0, 0);
        o[d0] = __builtin_amdgcn_mfma_f32_32x32x16_bf16(pa2, ATT_PK(2), o[d0], 0, 0, 0);
        o[d0] = __builtin_amdgcn_mfma_f32_32x32x16_bf16(pa3, ATT_PK(3), o[d0], 0, 0, 0);
#undef ATT_PK
    }
}
#define ATT_WAIT_BAR(N) asm volatile("s_waitcnt vmcnt(" #N ") lgkmcnt(0)\n\ts_barrier" ::: "memory")
#ifndef PROBE_ATT
#define PROBE_ATT -1
#endif
#define ATT_NOW() __builtin_amdgcn_s_memrealtime()
#define ATT_SBAR() __builtin_amdgcn_sched_barrier(0)
#define ATT_PIN(x) asm volatile("" : "+v"(x))
#define ATT_MFMA(a, b, c) __builtin_amdgcn_mfma_f32_32x32x16_bf16(a, b, c, 0, 0, 0)
typedef const LAS char* lds_cptr;
typedef short v4i16_t __attribute__((ext_vector_type(4)));
__device__ __forceinline__ void glds16(const void* g, unsigned lds_base) {
    unsigned sv; asm volatile("s_mov_b32 %0, m0\n\ts_mov_b32 m0, %2\n\ts_nop 0\n\tglobal_load_lds_dwordx4 %1, off\n\ts_mov_b32 m0, %0" : "=&s"(sv) : "v"(g), "s"(lds_base) : "memory"); }
__device__ __forceinline__ void kload2(bf16x8* kf, lds_cptr kp, int d0) { kf[2 * d0] = *(const LAS bf16x8*)(kp + d0 * 2048); kf[2 * d0 + 1] = *(const LAS bf16x8*)(kp + d0 * 2048 + 512); }
__device__ __forceinline__ s16x4 vtr(lds_cptr q) { return __builtin_bit_cast(s16x4, __builtin_amdgcn_ds_read_tr16_b64_v4i16((LAS v4i16_t*)q)); }

template <int MODE>
__device__ __forceinline__ void attn_unit(Frame& F, const Args& a, const int l, const int b, const int hh, const int qb) {
    using namespace cfg;
    constexpr int ND = MODE ? 4 : 2, VSLOT = ND * 4096, NV = MODE ? 2 : 1, EPG = 8 / ND, KRD0 = MODE ? 8 : 2, VLEAD = 5;
    constexpr int NS = 4, LK = 0, LV = NS * 8192, LQ = 98304;
    constexpr float THR = 8.f;
    unsigned long long pu0_ = 0; if (PROBE_ATT == 3) pu0_ = ATT_NOW();
    const int lane = F.lane, r32 = lane & 31, hi = lane >> 5, wid = F.wave;
    const bf16* p = (const bf16*)(F.ws + wsm::P);
    bf16* y = (bf16*)(F.ws + wsm::Y);
    float* O1s = (float*)(F.ws + wsm::XN);
    LAS unsigned char* lds = F.lds;
    LAS float* wsf = (LAS float*)(lds + L_WSF) + wid * 64;
    LAS float* tab = (LAS float*)(lds + L_TAB);
    const size_t rowbase = (size_t)b * SEQ;
    const float* tg = (const float*)(F.ws + wsm::TABS) + (size_t)(F.vcu & 7) * 4096;
    if (F.tid < 320) tab[319 - F.tid] = tg[(MODE ? 2560 : 0) + hh * 320 + F.tid];
    const int t0 = MODE == 0 ? (4 * qb - 8 > 0 ? 4 * qb - 8 : 0) : 0, t1 = 4 * qb + 3;
    const int cw = 4 * qb + (wid >> 1);
    const int va = MODE == 0 ? (cw - 8 > 0 ? cw - 8 : 0) : 0, vb = cw;
    const int q0w = qb * 256 + 32 * wid, myq = q0w + r32;
    const unsigned lds0 = (unsigned)(uintptr_t)lds;
    const lds_cptr kp0 = (lds_cptr)lds + LK + hi * 1024 + r32 * 16;
    const lds_cptr vp0 = (lds_cptr)lds + LV + ((lane >> 4) & 1) * 32 + (lane & 3) * 8 + (4 * hi + ((lane & 15) >> 2)) * 64;
#pragma unroll 1
    for (int sub = 0; sub < (MODE ? 2 : 1); ++sub) {
        const int qcol = MODE ? OFF_CQ + (hh * 2 + sub) * 64 : OFF_BQ + hh * 64;
        const int kcol = MODE ? OFF_CK + (hh * 2 + sub) * 64 : OFF_BK + hh * 64;
        const int vcol = MODE ? OFF_CV + hh * 128 : OFF_BV + hh * 64;
        const bf16* Kh = p + rowbase * INC + kcol; const bf16* Vh = p + rowbase * INC + vcol;
        const bf16* ksrc = Kh + (size_t)lane * INC + wid * 8;
        const bf16* vsrc0 = Vh + (size_t)(16 * (wid & 3) + (lane >> 2)) * INC + (wid >> 2) * 32 + (lane & 3) * 8;
        const unsigned kdst = lds0 + LK + wid * 1024, vdst = lds0 + LV + wid * 1024;
#define ATT_DMA_K(t, s) glds16(ksrc + (size_t)(t) * 64 * INC, (unsigned)__builtin_amdgcn_readfirstlane(kdst + (s) * 8192))
#define ATT_DMA_V(t, s) do { glds16(vsrc0 + (size_t)(t) * 64 * INC, (unsigned)__builtin_amdgcn_readfirstlane(vdst + (s) * VSLOT)); \
        if (MODE) glds16(vsrc0 + (size_t)(t) * 64 * INC + 64, (unsigned)__builtin_amdgcn_readfirstlane(vdst + (s) * VSLOT + 8192)); } while (0)
        { const bf16* Qw = p + (rowbase + q0w) * INC + qcol + (size_t)r32 * INC + hi * 8;
#pragma unroll
          for (int d0 = 0; d0 < 4; ++d0) glds16(Qw + d0 * 16, (unsigned)__builtin_amdgcn_readfirstlane(lds0 + LQ + wid * 4096 + d0 * 1024)); }
        ATT_DMA_K(t0, 0); ATT_DMA_V(t0, 0); ATT_DMA_K(t0 + 1, 1); ATT_DMA_K(t0 + 2, 2); ATT_DMA_K(t0 + 3, 3); ATT_DMA_V(t0 + 1, 1);
        float mhat = 0.f, l_reg = 0.f;
        f32x16 o[ND];
#pragma unroll
        for (int d0 = 0; d0 < ND; ++d0)
#pragma unroll
            for (int r = 0; r < 16; ++r) o[d0][r] = 0.f;
        { LAS unsigned char* z = lds + LV + 3 * VSLOT + F.tid * (VSLOT / 512);
#pragma unroll
          for (int i = 0; i < VSLOT / 512 / 16; ++i) *(LAS u32x4*)(z + 16 * i) = (u32x4){0u, 0u, 0u, 0u}; }
        if (MODE) { ATT_WAIT_BAR(4); } else { ATT_WAIT_BAR(3); }
        const float cf = tab[319 - 300];
        bf16x8 qr[4];
#pragma unroll
        for (int d0 = 0; d0 < 4; ++d0) qr[d0] = *(const LAS bf16x8*)(lds + LQ + wid * 4096 + d0 * 1024 + lane * 16);
        bf16x8 kf[8];
#pragma unroll
        for (int d0 = 0; d0 < 4; ++d0) kload2(kf, kp0, d0);
        asm volatile("s_waitcnt lgkmcnt(0)\n\ts_barrier" ::: "memory");
        f32x16 C0, C1; u32x4 pw[4];
#pragma unroll
        for (int r = 0; r < 16; ++r) { C0[r] = 0.f; C1[r] = 0.f; }
#pragma unroll
        for (int g = 0; g < 4; ++g) pw[g] = (u32x4){0u, 0u, 0u, 0u};
#define ATT_CE(e) (((e) < 16) ? C0[(e) & 15] : C1[(e) & 15])
#define ATT_CEXP(e) do { if ((e) < 16) C0[(e) & 15] = __builtin_amdgcn_exp2f(C0[(e) & 15]); else C1[(e) & 15] = __builtin_amdgcn_exp2f(C1[(e) & 15]); } while (0)
#define ATT_VRD(ks, d0) do { vlo[(ks) * ND + (d0)] = vtr(vpp + (d0) * 4096 + (ks) * 1024); vhi[(ks) * ND + (d0)] = vtr(vpp + (d0) * 4096 + (ks) * 1024 + 512); } while (0)
#define ATT_VRDF(f) ATT_VRD((f) / ND, (f) % ND)
#define ATT_VFR(i) (bf16x8){vlo[i][0], vlo[i][1], vlo[i][2], vlo[i][3], vhi[i][0], vhi[i][1], vhi[i][2], vhi[i][3]}
#define ATT_PAF(g) __builtin_bit_cast(bf16x8, pw[g])
        unsigned long long pl0_ = 0; if (PROBE_ATT == 2) pl0_ = ATT_NOW(); if (PROBE_ATT == 4) pl0_ = __builtin_amdgcn_s_memtime();
#pragma unroll 1
        for (int t = t0; t <= t1; ++t) {
            const bool gk = (t + 4 <= t1), gv = (t + 2 <= t1);
            const int s_cur = (t - t0) & 3, s_prev = (t - t0 - 1) & 3, s_next = (t - t0 + 1) & 3, s_nn = (t - t0 + 2) & 3;
            const lds_cptr vpp = vp0 + s_prev * VSLOT;
            const lds_cptr kpn = kp0 + s_next * 8192;
            bool resc = false;
            ATT_SBAR();
            {
                s16x4 vlo[4 * ND], vhi[4 * ND];
                const bool msk = (t > vb) || (t < va);
                const bool nearb = !msk && (q0w - (t * 64 + 63)) < 128;
                if (nearb) {
                    const LAS float* tb = tab + (260 - (myq - t * 64 - 4 * hi + 64 - 27 - 32));
                    const f32x2 nm = {-mhat, -mhat};
#pragma unroll
                    for (int r = 0; r < 16; r += 2) { const int x = (r & 3) + 8 * (r >> 2);
                        f32x2 p0 = {tb[x], tb[x + 1]}, p1 = {tb[32 + x], tb[33 + x]};
                        asm("v_pk_add_f32 %0, %1, %2" : "=v"(p0) : "v"(p0), "v"(nm)); asm("v_pk_add_f32 %0, %1, %2" : "=v"(p1) : "v"(p1), "v"(nm));
                        C0[r] = p0[0]; C0[r + 1] = p0[1]; C1[r] = p1[0]; C1[r + 1] = p1[1]; }
                    ATT_SBAR();
                    C0 = ATT_MFMA(kf[0], qr[0], C0); ATT_SBAR(); C1 = ATT_MFMA(kf[1], qr[0], C1); ATT_SBAR();
                } else {
                    f32x16 cfm; const float cfv = msk ? -1e30f : cf - mhat;
                    { f32x2 c2; c2[0] = cfv; c2[1] = cfv; cfm[0] = c2[0]; cfm[1] = c2[1];
#pragma unroll
                      for (int r = 2; r < 16; r += 2) { f32x2 q2; asm volatile("v_pk_mov_b32 %0, %1, %1" : "=v"(q2) : "v"(c2)); cfm[r] = q2[0]; cfm[r + 1] = q2[1]; } }
                    ATT_SBAR();
                    C0 = ATT_MFMA(kf[0], qr[0], cfm); ATT_SBAR(); C1 = ATT_MFMA(kf[1], qr[0], cfm); ATT_SBAR();
                }
#pragma unroll
                for (int i = 2; i < 8; ++i) {
                    if (i >= 8 - VLEAD) { ATT_VRDF(i - (8 - VLEAD)); ATT_SBAR(); }
                    if (i & 1) C1 = ATT_MFMA(kf[i], qr[i >> 1], C1); else C0 = ATT_MFMA(kf[i], qr[i >> 1], C0);
                    ATT_SBAR();
                }
                if (gk) ATT_DMA_K(t + 4, s_cur);
                if (gv) ATT_DMA_V(t + 2, s_nn);
                const float rm = rowmax(C0, C1);
                const bool firstv = (t == va);
                if (__builtin_expect(firstv || __any(rm > THR), 0)) {
                    const float dl = firstv ? rm : fmaxf(rm, 0.f); mhat += dl;
#pragma unroll
                    for (int r = 0; r < 16; ++r) { C0[r] -= dl; C1[r] -= dl; }
                    const float f = firstv ? 1.f : __builtin_amdgcn_exp2f(-dl); l_reg *= f; if (hi == 0) wsf[r32] = f; resc = !firstv;
                }
                ATT_SBAR();
                f32x2 sab = {0.f, 0.f};
#pragma unroll
                for (int m = 0; m < 4 * ND; ++m) {
                    const int g = m / ND, d0 = m % ND;
                    if (m + VLEAD < 4 * ND) { ATT_VRDF(m + VLEAD); ATT_SBAR(); }
                    if (m >= KRD0 && m < KRD0 + 4) { kload2(kf, kpn, m - KRD0); ATT_SBAR(); }
                    o[d0] = ATT_MFMA(ATT_PAF(g), ATT_VFR(g * ND + d0), o[d0]);
#pragma unroll
                    for (int jj = 0; jj < EPG; ++jj) ATT_CEXP(8 * g + EPG * d0 + jj);
                    if (g >= 1) {
#pragma unroll
                        for (int jj = 0; jj < EPG; jj += 2) { const int e = 8 * (g - 1) + EPG * d0 + jj; sab += (f32x2){ATT_CE(e), ATT_CE(e + 1)}; pw[g - 1][(EPG * d0 + jj) >> 1] = pk2(ATT_CE(e), ATT_CE(e + 1)); }
                        ATT_PIN(pw[g - 1]); ATT_PIN(sab);
                    }
                    if (g < 2) ATT_PIN(C0); else ATT_PIN(C1);
                    ATT_SBAR();
                }
#pragma unroll
                for (int jj = 0; jj < 8; jj += 2) { const int e = 24 + jj; sab += (f32x2){ATT_CE(e), ATT_CE(e + 1)}; pw[3][jj >> 1] = pk2(ATT_CE(e), ATT_CE(e + 1)); }
                l_reg += sab[0] + sab[1];
            }
            ATT_SBAR();
            unsigned long long pw0_ = 0; if (PROBE_ATT == 0) pw0_ = ATT_NOW();
            { const int dleft = t1 - t;
              if (dleft >= 4) { if (MODE) { ATT_WAIT_BAR(6); } else { ATT_WAIT_BAR(4); } }
              else if (dleft == 3) { if (MODE) { ATT_WAIT_BAR(5); } else { ATT_WAIT_BAR(3); } }
              else if (dleft == 2) { if (MODE) { ATT_WAIT_BAR(4); } else { ATT_WAIT_BAR(2); } }
              else if (dleft == 1) { if (MODE) { ATT_WAIT_BAR(2); } else { ATT_WAIT_BAR(1); } }
              else { ATT_WAIT_BAR(0); } }
            if (PROBE_ATT == 0) F.pacc += ATT_NOW() - pw0_;
            if (resc) {
#pragma unroll
                for (int r = 0; r < 16; ++r) { const float fr = wsf[crow(r, hi)];
#pragma unroll
                    for (int d0 = 0; d0 < ND; ++d0) o[d0][r] *= fr; }
            }
        }
        if (PROBE_ATT == 2) F.pacc += ATT_NOW() - pl0_; if (PROBE_ATT == 4) F.pacc += (__builtin_amdgcn_s_memtime() - pl0_) / 100;
        {
            const lds_cptr vpp = vp0 + ((t1 - t0) & 3) * VSLOT;
            s16x4 vlo[4 * ND], vhi[4 * ND];
#pragma unroll
            for (int ks = 0; ks < 4; ++ks) {
#pragma unroll
                for (int d0 = 0; d0 < ND; ++d0) ATT_VRD(ks, d0);
#pragma unroll
                for (int d0 = 0; d0 < ND; ++d0) o[d0] = ATT_MFMA(ATT_PAF(ks), ATT_VFR(ks * ND + d0), o[d0]);
            }
            asm volatile("s_waitcnt lgkmcnt(0)\n\ts_barrier" ::: "memory");
        }
#undef ATT_DMA_K
#undef ATT_DMA_V
#undef ATT_CE
#undef ATT_CEXP
#undef ATT_VRD
#undef ATT_VFR
#undef ATT_VRDF
#undef ATT_PAF
        float lh = l_reg;
        int ln = lane; asm volatile("" : "+v"(ln));
        const int e32 = ln & 31, ehi = ln >> 5;
        { auto rr = __builtin_amdgcn_permlane32_swap(__float_as_uint(lh), __float_as_uint(lh), false, false); lh = __uint_as_float(rr[0]) + __uint_as_float(rr[1]); }
        if (ehi == 0) wsf[32 + e32] = lh;
        LDS_WAIT();
        constexpr int SP = ND * 128 + 16;
        LAS unsigned char* stg = lds + wid * (32 * SP);
#pragma unroll
        for (int r = 0; r < 16; ++r) { const float rl = __builtin_amdgcn_rcpf(wsf[32 + crow(r, ehi)]);
#pragma unroll
            for (int d0 = 0; d0 < ND; ++d0) *(LAS float*)(stg + crow(r, ehi) * SP + (d0 * 32 + e32) * 4) = o[d0][r] * rl; }
        LDS_WAIT();
        const size_t tok0 = rowbase + (size_t)(qb * 256 + 32 * wid);
        if (MODE == 0) {
#pragma unroll 4
            for (int row = 0; row < 32; ++row) { const float v = *(const LAS float*)(stg + row * SP + ln * 4);
                if (F8OUT(l)) ((unsigned char*)y)[(tok0 + row) * D + 512 + hh * 64 + ln] = (unsigned char)(pk2_fp8(v * F8_Y, 0.f) & 0xffu); else y[(tok0 + row) * D + 512 + hh * 64 + ln] = cvt1(v); }
        } else if (sub == 0) {
#pragma unroll 4
            for (int row = 0; row < 32; ++row) { const f32x2 v = *(const LAS f32x2*)(stg + row * SP + ln * 8); *(f32x2*)(O1s + ((tok0 + row) * 4 + hh) * 128 + 2 * ln) = v; }
        } else {
            const float lam = tg[3840];
            const float sw0 = tg[3848 + 2 * ln], sw1 = tg[3848 + 2 * ln + 1];
#pragma unroll 2
            for (int row = 0; row < 32; ++row) { const f32x2 v2 = *(const LAS f32x2*)(stg + row * SP + ln * 8); const f32x2 o1 = *(const f32x2*)(O1s + ((tok0 + row) * 4 + hh) * 128 + 2 * ln);
                const float v0 = o1.x - lam * v2.x, v1 = o1.y - lam * v2.y;
                const float ms = wave_sum(v0 * v0 + v1 * v1);
                const float rs = rsqrtf(ms * (1.f / 128.f) + 1e-5f);
                if (F8OUT(l)) *(unsigned short*)((unsigned char*)y + (tok0 + row) * D + 1024 + hh * 128 + 2 * ln) = (unsigned short)pk2_fp8(v0 * rs * sw0 * F8_Y, v1 * rs * sw1 * F8_Y);
                else *(unsigned*)(y + (tok0 + row) * D + 1024 + hh * 128 + 2 * ln) = pk2(v0 * rs * sw0, v1 * rs * sw1); }
        }
        asm volatile("s_waitcnt vmcnt(0) lgkmcnt(0)\n\ts_barrier" ::: "memory");
    }
    if (PROBE_ATT == 3) F.pacc += ATT_NOW() - pu0_;
}

__device__ __forceinline__ void conv_items(Frame& F, const Args& a, const int l, const int start, const int stride) {
    using namespace cfg;
    const bf16* p = (const bf16*)(F.ws + wsm::P); bf16* y = (bf16*)(F.ws + wsm::Y);
    const float* cwp = a.in[24] + l * 3 * 512;
    float cw[3][8];
    { const int cg0 = (start & 63) * 8;
#pragma unroll
      for (int q = 0; q < 3; ++q) { const f32x4 w0 = *(const f32x4*)(cwp + q * 512 + cg0), w1 = *(const f32x4*)(cwp + q * 512 + cg0 + 4);
#pragma unroll
          for (int j = 0; j < 4; ++j) { cw[q][j] = w0[j]; cw[q][4 + j] = w1[j]; } } }
    for (int it = start; it < M * 64; it += stride) {
        const int tok = it >> 6, cg = (it & 63) * 8, t = tok & (SEQ - 1);
        const bf16* r0 = p + (size_t)tok * INC + OFF_D + cg;
        const u32x4 bg = *(const u32x4*)r0;
        u32x4 c0 = *(const u32x4*)(r0 + 512), h0 = *(const u32x4*)(r0 + 1024);
        u32x4 c1 = (u32x4){0, 0, 0, 0}, h1 = c1, c2 = c1, h2 = c1;
        if (t >= 1) { c1 = *(const u32x4*)(r0 - INC + 512); h1 = *(const u32x4*)(r0 - INC + 1024); }
        if (t >= 2) { c2 = *(const u32x4*)(r0 - 2 * INC + 512); h2 = *(const u32x4*)(r0 - 2 * INC + 1024); }
        unsigned ow[4];
#pragma unroll
        for (int j = 0; j < 4; ++j) {
            float res[2];
#pragma unroll
            for (int e = 0; e < 2; ++e) {
#define ATT_UP(w) (e ? __uint_as_float((w) & 0xffff0000u) : __uint_as_float((w) << 16))
                const float u0 = ATT_UP(c0[j]) * ATT_UP(h0[j]), u1 = ATT_UP(c1[j]) * ATT_UP(h1[j]), u2 = ATT_UP(c2[j]) * ATT_UP(h2[j]);
                res[e] = ATT_UP(bg[j]) * (cw[0][2 * j + e] * u2 + cw[1][2 * j + e] * u1 + cw[2][2 * j + e] * u0);
#undef ATT_UP
            }
            ow[j] = (F8OUT(l)) ? pk2_fp8(res[0] * F8_Y, res[1] * F8_Y) : pk2(res[0], res[1]);
        }
        if (F8OUT(l)) *(u32x2*)((unsigned char*)y + (size_t)tok * D + 1536 + cg) = (u32x2){ow[0] | (ow[1] << 16), ow[2] | (ow[3] << 16)};
        else *(u32x4*)(y + (size_t)tok * D + 1536 + cg) = (u32x4){ow[0], ow[1], ow[2], ow[3]};
    }
}
}
__device__ __forceinline__ void build_attn_tables(Frame& F, const Args& a, const int l) {
    float* tabs = (float*)(F.ws + wsm::TABS);
    const float lam_init = l == 0 ? 0.2f : (float)(0.8 - 0.6 * 0.7408182206817179);
    for (int idx = F.vcu * 512 + F.tid; idx < 8 * 4096; idx += F.G * 512) {
        const int e = idx & 4095; float v = 0.f;
        if (e < 2560) { const int hh = e / 320, i = e - hh * 320; int d = i - 64; d = d < -128 ? -128 : (d > 128 ? 128 : d); v = a.in[17][(size_t)(l * 8 + hh) * 257 + d + 128] * LOG2E; }
        else if (e < 3840) { const int e2 = e - 2560, hh = e2 / 320, i = e2 - hh * 320; v = a.in[18][att::t5_bucket(-(i - 64)) * 4 + hh] * LOG2E; }
        else if (e == 3840) { float s1 = 0.f, s2 = 0.f;
            for (int j = 0; j < 64; ++j) { s1 += a.in[19][l * 64 + j] * a.in[20][l * 64 + j]; s2 += a.in[21][l * 64 + j] * a.in[22][l * 64 + j]; }
            v = __expf(s1) - __expf(s2) + lam_init; }
        else if (e >= 3848 && e < 3976) v = a.in[23][l * 128 + e - 3848] * (1.f - lam_init);
        tabs[idx] = v;
    }
}
namespace rw {
constexpr int PB = 144, PB2 = 272;
constexpr int SLOT = 9216;
constexpr int R0 = 0, R1B = 49152;
constexpr int O_P0 = 0, O_P0T = 9216, O_AAK = 18432, O_ARB = 27648, O_ARK = 36864;
constexpr int O_SEG = R1B + 9 * SLOT, O_BON = O_SEG + 2048;
constexpr size_t UNIT_BYTES = 49152;
constexpr size_t WL_OFF = (size_t)4096 * UNIT_BYTES;
#define RW_S(i) (R1B + (i) * SLOT)

__device__ __forceinline__ bf16x8 ldfrag(const LAS unsigned char* base, int pitch, int row0, int lane, int s) {
    return *(const LAS bf16x8*)(base + (row0 + (lane & 15)) * pitch + (32 * s + 8 * (lane >> 4)) * 2);
}
template <int KS>
__device__ __forceinline__ f32x4 tile_mm(f32x4 acc, const LAS unsigned char* X, int px, int m0, const LAS unsigned char* Y, int py, int n0, int lane) {
#pragma unroll
    for (int s = 0; s < KS; ++s) acc = __builtin_amdgcn_mfma_f32_16x16x32_bf16(ldfrag(Y, py, n0, lane, s), ldfrag(X, px, m0, lane, s), acc, 0, 0, 0);
    return acc;
}
template <int KS>
__device__ __forceinline__ void tile_row(f32x4 (&acc)[4], const LAS unsigned char* X, int px, int m0, const LAS unsigned char* Y, int py, int lane) {
    bf16x8 xf[KS], yf[4][KS];
#pragma unroll
    for (int s = 0; s < KS; ++s) xf[s] = ldfrag(X, px, m0, lane, s);
#pragma unroll
    for (int nt = 0; nt < 4; ++nt)
#pragma unroll
        for (int s = 0; s < KS; ++s) yf[nt][s] = ldfrag(Y, py, 16 * nt, lane, s);
#pragma unroll
    for (int nt = 0; nt < 4; ++nt)
#pragma unroll
        for (int s = 0; s < KS; ++s) acc[nt] = __builtin_amdgcn_mfma_f32_16x16x32_bf16(yf[nt][s], xf[s], acc[nt], 0, 0, 0);
}
__device__ __forceinline__ void st_rm(LAS unsigned char* base, int pitch, int m, int n0, f32x4 v) {
    u32x2 w; w.x = pk2(v[0], v[1]); w.y = pk2(v[2], v[3]); *(LAS u32x2*)(base + m * pitch + n0 * 2) = w;
}
__device__ __forceinline__ void st_tr(LAS unsigned char* base, int pitch, int m, int n0, f32x4 v) {
    const unsigned p01 = pk2(v[0], v[1]), p23 = pk2(v[2], v[3]);
    *(LAS bf16*)(base + (n0 + 0) * pitch + m * 2) = (bf16)(p01 & 0xffffu); *(LAS bf16*)(base + (n0 + 1) * pitch + m * 2) = (bf16)(p01 >> 16);
    *(LAS bf16*)(base + (n0 + 2) * pitch + m * 2) = (bf16)(p23 & 0xffffu); *(LAS bf16*)(base + (n0 + 3) * pitch + m * 2) = (bf16)(p23 >> 16);
}
__device__ __forceinline__ f32x4 ld_rm(const LAS unsigned char* base, int pitch, int m, int n0) {
    const u32x2 w = *(const LAS u32x2*)(base + m * pitch + n0 * 2);
    return (f32x4){__uint_as_float(w.x << 16), __uint_as_float(w.x & 0xffff0000u), __uint_as_float(w.y << 16), __uint_as_float(w.y & 0xffff0000u)};
}
__device__ __forceinline__ void unpack8(const u32x4 w, float* f) {
#pragma unroll
    for (int j = 0; j < 4; ++j) { f[2 * j] = __uint_as_float(w[j] << 16); f[2 * j + 1] = __uint_as_float(w[j] & 0xffff0000u); }
}
__device__ __forceinline__ u32x4 pack8(const float* f) { return (u32x4){pk2(f[0], f[1]), pk2(f[2], f[3]), pk2(f[4], f[5]), pk2(f[6], f[7])}; }
__device__ __forceinline__ float sigm(float x) { return __builtin_amdgcn_rcpf(1.f + __expf(-x)); }
#define RW_BAR() do { asm volatile("s_waitcnt lgkmcnt(0)" ::: "memory"); __builtin_amdgcn_s_barrier(); asm volatile("" ::: "memory"); } while (0)

#ifndef PROBE_R1
#define PROBE_R1 -1
#endif
#define R1_STAMP(k) do { if (PROBE_R1 >= 0) { const unsigned long long now_ = __builtin_amdgcn_s_memrealtime(); if (PROBE_R1 == (k)) racc += now_ - rlast; rlast = now_; } } while (0)
__device__ __forceinline__ int fsw(int row, int col) { return row * 64 + ((((col >> 2) ^ (row & 15)) << 2) | (col & 3)); }
__device__ __forceinline__ int xo_frag(int rt, int s, int lane) { return ((rt * 2 + s) * 64 + lane) * 16; }
__device__ __forceinline__ int xo_acc(int rt, int nt, int lane) { return ((rt * 4 + nt) * 64 + lane) * 8; }
__device__ __forceinline__ int xo_frag_from_acc(int rt, int nt, int lane) { const int q = lane >> 4, kc = 2 * nt + (q >> 1); return ((rt * 2 + (kc >> 2)) * 64 + (kc & 3) * 16 + (lane & 15)) * 16 + (q & 1) * 8; }
struct R1Raw { u32x4 c[3], p[3]; bf16x8 fl[8]; };
template <int PART = -1>
__device__ __forceinline__ void r1_load(Frame& F, const int u, R1Raw& raw, const int tid) {
    using namespace cfg;
    const int c = u & 63, h = (u >> 6) & 7, b = u >> 9, t = tid >> 3, j0 = (tid & 7) * 8, lane = tid & 63;
    const size_t tok0 = (size_t)b * SEQ + c * 64;
    if (PART < 0 || PART == 0) {
        const bf16* cur = (const bf16*)(F.ws + wsm::P) + (tok0 + t) * INC + j0; const bf16* prv = cur - INC;
#pragma unroll
        for (int i = 0; i < 3; ++i) { const int col = i * 512 + h * 64; raw.c[i] = *(const u32x4*)(cur + col); raw.p[i] = *(const u32x4*)(prv + col); }
    }
    const bf16* lr = (const bf16*)(F.ws + wsm::LORA) + (tok0 + 16 * (F.wave >> 1) + (lane & 15)) * 256 + 8 * (lane >> 4);
    if (PART < 0 || PART == 1) {
#pragma unroll
        for (int s2 = 0; s2 < 2; ++s2) { raw.fl[s2] = *(const bf16x8*)(lr + 32 * s2); raw.fl[2 + s2] = *(const bf16x8*)(lr + 64 + 32 * s2); }
    }
    if (PART < 0 || PART == 2) {
#pragma unroll
        for (int s2 = 0; s2 < 4; ++s2) raw.fl[4 + s2] = *(const bf16x8*)(lr + 128 + 32 * s2);
    }
}
struct R1W { bf16x8 fw[2][2], fa[2][2], fg[2][4]; };
__device__ __forceinline__ void lora_prepass(Frame& F, const Args& a, const int l) {
    using namespace cfg;
    const bf16* p = (const bf16*)(F.ws + wsm::P); bf16* lora = (bf16*)(F.ws + wsm::LORA);
    const float* mu = a.in[6] + l * 1792 + 1536;
    const int cg = (F.tid & 31) * 8;
    const f32x4 m0 = *(const f32x4*)(mu + cg), m1 = *(const f32x4*)(mu + cg + 4);
    for (int it = F.vcu * 512 + F.tid; it < M * 32; it += F.G * 512) {
        const int tok = it >> 5;
        const bf16* cur = p + (size_t)tok * INC + 1536 + cg;
        float cv[8], pv[8], x[8];
        unpack8(*(const u32x4*)cur, cv);
        if ((tok & (SEQ - 1)) != 0) unpack8(*(const u32x4*)(cur - INC), pv); else {
#pragma unroll
            for (int j = 0; j < 8; ++j) pv[j] = 0.f; }
#pragma unroll
        for (int j = 0; j < 8; ++j) { const float mj = j < 4 ? m0[j] : m1[j - 4]; x[j] = cv[j] + (pv[j] - cv[j]) * mj; }
        if (cg < 64) {
#pragma unroll
            for (int j = 0; j < 8; ++j) { const float e2 = __expf(2.f * x[j]); x[j] = 1.f - 2.f * __builtin_amdgcn_rcpf(e2 + 1.f); }
        } else if (cg >= 128) {
#pragma unroll
            for (int j = 0; j < 8; ++j) x[j] = sigm(x[j]);
        }
        *(u32x4*)(lora + (size_t)tok * 256 + cg) = pack8(x);
    }
}
__device__ __forceinline__ void r1_unit(Frame& F, const Args& a, const int l, const int u, const int unext, R1Raw& raw, R1W& W, unsigned long long& racc, int& hcur) {
    using namespace cfg;
    unsigned long long rlast = PROBE_R1 >= 0 ? __builtin_amdgcn_s_memrealtime() : 0ull;
    int tid_ = F.tid; asm volatile("" : "+v"(tid_));
    const int tid = tid_, lane = tid & 63, w = F.wave;
    const int c = u & 63, h = (u >> 6) & 7, b = u >> 9;
    unsigned lbase_ = (unsigned)(uintptr_t)F.lds; asm volatile("" : "+s"(lbase_));
    LAS unsigned char* lds = (LAS unsigned char*)(uintptr_t)lbase_;
    const bf16* p = (const bf16*)(F.ws + wsm::P);
    const bf16* w2t = (const bf16*)(F.ws + wsm::WRT + 262144);
    const bf16* a2t = w2t + 512 * 64; const bf16* g2t = a2t + 512 * 64;
    unsigned char* gout = F.ws + wsm::RW + (size_t)u * UNIT_BYTES;
    float* wl_out = (float*)(F.ws + wsm::RW + WL_OFF) + (size_t)u * 64;
    const float* mu = a.in[6] + l * 1792;
    const size_t tok0 = (size_t)b * SEQ + c * 64;
    const int t = tid >> 3, j0 = (tid & 7) * 8;
    const bool hasprev = (c > 0) || (t > 0);
    const bf16* cur = p + (tok0 + t) * INC; const bf16* prv = cur - INC;
    LAS float* WPRE = (LAS float*)(lds + 0); LAS float* APRE = (LAS float*)(lds + 16384); LAS float* GG = (LAS float*)(lds + 32768);
    LAS float* PAR = (LAS float*)(lds + 134400);
    const int mtA = w >> 1;
    if (h != hcur) {
        RW_BAR();
        if (w < 7) { const int pidx = w == 0 ? 7 : (w == 1 ? 9 : 10 + w); PAR[w * 64 + lane] = a.in[pidx][l * 512 + h * 64 + lane]; }
        if (tid < 448) { const int col = tid < 192 ? (tid >> 6) * 512 + h * 64 + (tid & 63) : 1536 + (tid - 192); PAR[448 + tid] = mu[col]; }
        hcur = h;
#pragma unroll
        for (int q = 0; q < 2; ++q) { const int ch = h * 64 + 16 * (2 * (w & 1) + q) + (lane & 15);
#pragma unroll
            for (int s2 = 0; s2 < 2; ++s2) { const int kq = 32 * s2 + 8 * (lane >> 4); W.fw[q][s2] = *(const bf16x8*)(w2t + ch * 64 + kq); W.fa[q][s2] = *(const bf16x8*)(a2t + ch * 64 + kq); }
#pragma unroll
            for (int s2 = 0; s2 < 4; ++s2) W.fg[q][s2] = *(const bf16x8*)(g2t + ch * 128 + 32 * s2 + 8 * (lane >> 4)); }
        RW_BAR();
    }
    float r[8], k[8], v[8];
    {
        auto mix8 = [&](int i, int mo, float* o) { float cv[8], pv[8], m8[8]; unpack8(raw.c[i], cv);
            if (hasprev) unpack8(raw.p[i], pv); else {
#pragma unroll
                for (int j = 0; j < 8; ++j) pv[j] = 0.f; }
            *(f32x4*)m8 = *(const LAS f32x4*)(PAR + 448 + mo); *(f32x4*)(m8 + 4) = *(const LAS f32x4*)(PAR + 448 + mo + 4);
#pragma unroll
            for (int j = 0; j < 8; j += 2) { const f32x2 c2 = {cv[j], cv[j + 1]}, p2 = {pv[j], pv[j + 1]}, m2 = {m8[j], m8[j + 1]}; const f32x2 o2 = c2 + (p2 - c2) * m2; o[j] = o2[0]; o[j + 1] = o2[1]; } };
        mix8(0, j0, r); mix8(1, 64 + j0, k); mix8(2, 128 + j0, v);
    }
    r1_load<0>(F, unext, raw, tid);
    R1_STAMP(0);
    {
#pragma unroll
        for (int q = 0; q < 2; ++q) { const int nt = 2 * (w & 1) + q;
            f32x4 aw = {0.f, 0.f, 0.f, 0.f}, aa = aw, ag = aw;
#pragma unroll
            for (int s2 = 0; s2 < 2; ++s2) {
                aw = __builtin_amdgcn_mfma_f32_16x16x32_bf16(W.fw[q][s2], raw.fl[s2], aw, 0, 0, 0);
                aa = __builtin_amdgcn_mfma_f32_16x16x32_bf16(W.fa[q][s2], raw.fl[2 + s2], aa, 0, 0, 0); }
#pragma unroll
            for (int s2 = 0; s2 < 4; ++s2) ag = __builtin_amdgcn_mfma_f32_16x16x32_bf16(W.fg[q][s2], raw.fl[4 + s2], ag, 0, 0, 0);
            const int m = 16 * mtA + (lane & 15), n0 = 16 * nt + 4 * (lane >> 4);
            const f32x4 w04 = *(const LAS f32x4*)(PAR + n0), a04 = *(const LAS f32x4*)(PAR + 64 + n0);
#pragma unroll
            for (int i = 0; i < 4; ++i) { aw[i] = -0.8750387749145276f * sigm(w04[i] + aw[i]); aa[i] = sigm(a04[i] + aa[i]); }
            *(LAS f32x4*)(WPRE + fsw(m, n0)) = aw; *(LAS f32x4*)(APRE + fsw(m, n0)) = aa; *(LAS f32x4*)(GG + fsw(m, n0)) = ag; }
    }
    r1_load<1>(F, unext, raw, tid);
    RW_BAR(); R1_STAMP(1); R1_STAMP(2);
    {
        LAS float* SEG = (LAS float*)(lds + O_SEG);
        const int ch = tid & 63, seg = tid >> 6;
        float pf[8]; float run = 0.f;
#pragma unroll
        for (int i = 0; i < 8; ++i) { run += WPRE[fsw(8 * seg + i, ch)]; pf[i] = run; }
        SEG[seg * 64 + ch] = run;
        RW_BAR();
        float off = 0.f;
        for (int s2 = 0; s2 < seg; ++s2) off += SEG[s2 * 64 + ch];
#pragma unroll
        for (int i = 0; i < 8; ++i) WPRE[fsw(8 * seg + i, ch)] = off + pf[i];
    }
    RW_BAR(); R1_STAMP(3);
    r1_load<2>(F, unext, raw, tid);
    {
        float kk[8], k2[8], aic[8]; float ss = 0.f, bon = 0.f;
        { float pkk[8], pka[8], prk[8];
#define R1_LD8(dst, src) do { *(f32x4*)(dst) = *(const LAS f32x4*)(src); *(f32x4*)((dst) + 4) = *(const LAS f32x4*)((src) + 4); } while (0)
          *(f32x4*)aic = *(const LAS f32x4*)(APRE + fsw(t, j0)); *(f32x4*)(aic + 4) = *(const LAS f32x4*)(APRE + fsw(t, j0 + 4)); R1_LD8(pkk, PAR + 128 + j0); R1_LD8(pka, PAR + 192 + j0); R1_LD8(prk, PAR + 256 + j0);
#undef R1_LD8
#pragma unroll
          for (int j = 0; j < 8; ++j) { kk[j] = k[j] * pkk[j]; ss += kk[j] * kk[j]; k2[j] = k[j] * (1.f + (aic[j] - 1.f) * pka[j]); bon += r[j] * k2[j] * prk[j]; } }
        ss += __shfl_xor(ss, 1); ss += __shfl_xor(ss, 2); ss += __shfl_xor(ss, 4);
        bon += __shfl_xor(bon, 1); bon += __shfl_xor(bon, 2); bon += __shfl_xor(bon, 4);
        const float inv = 1.f / fmaxf(sqrtf(ss), 1e-12f);
        unsigned g1w[4], g0w[4];
#pragma unroll
        for (int jp = 0; jp < 8; jp += 2) {
            const f32x2 cum = *(const LAS f32x2*)(WPRE + fsw(t, j0 + jp)), tot = *(const LAS f32x2*)(WPRE + fsw(63, j0 + jp)), gg = *(const LAS f32x2*)(GG + fsw(t, j0 + jp));
            f32x2 cpv = {0.f, 0.f}; if (t > 0) cpv = *(const LAS f32x2*)(WPRE + fsw(t - 1, j0 + jp));
            const f32x2 pgw = *(const LAS f32x2*)(PAR + 320 + j0 + jp), pgb = *(const LAS f32x2*)(PAR + 384 + j0 + jp);
            const f32x2 kk2 = {kk[jp], kk[jp + 1]}, ai2 = {aic[jp], aic[jp + 1]}, k22 = {k2[jp], k2[jp + 1]}, r2 = {r[jp], r[jp + 1]}, v2 = {v[jp], v[jp + 1]};
            const f32x2 kn = kk2 * inv, bv = kn * ai2;
            const f32x2 e_ex = {__builtin_amdgcn_exp2f(cpv[0]), __builtin_amdgcn_exp2f(cpv[1])}, e_in = {__builtin_amdgcn_exp2f(cum[0]), __builtin_amdgcn_exp2f(cum[1])};
            const f32x2 e_ng = {__builtin_amdgcn_exp2f(-cum[0]), __builtin_amdgcn_exp2f(-cum[1])}, e_tt = {__builtin_amdgcn_exp2f(tot[0] - cum[0]), __builtin_amdgcn_exp2f(tot[1] - cum[1])};
            const f32x2 xa = -kn * e_ex, xr = r2 * e_in, xb = bv * e_ng, xk = k22 * e_ng, xbh = bv * e_tt, xkh = k22 * e_tt;
            const f32x2 g1 = pgw * gg, g0 = (pgb + bon * v2) * gg;
            const unsigned pa = pk2(xa[0], xa[1]), pr = pk2(xr[0], xr[1]), pb = pk2(xb[0], xb[1]), pkn = pk2(xk[0], xk[1]), pv2 = pk2(v[jp], v[jp + 1]), pbh = pk2(xbh[0], xbh[1]), pkh = pk2(xkh[0], xkh[1]);
            *(LAS unsigned*)(lds + RW_S(0) + t * PB + (j0 + jp) * 2) = pa; *(LAS unsigned*)(lds + RW_S(1) + t * PB + (j0 + jp) * 2) = pr;
            *(LAS unsigned*)(lds + RW_S(2) + t * PB + (j0 + jp) * 2) = pb; *(LAS unsigned*)(lds + RW_S(3) + t * PB + (j0 + jp) * 2) = pkn;
            *(LAS bf16*)(lds + RW_S(4) + (j0 + jp) * PB + t * 2) = (bf16)(pa & 0xffffu); *(LAS bf16*)(lds + RW_S(4) + (j0 + jp + 1) * PB + t * 2) = (bf16)(pa >> 16);
            *(LAS bf16*)(lds + RW_S(5) + (j0 + jp) * PB + t * 2) = (bf16)(pv2 & 0xffffu); *(LAS bf16*)(lds + RW_S(5) + (j0 + jp + 1) * PB + t * 2) = (bf16)(pv2 >> 16);
            *(LAS bf16*)(lds + RW_S(6) + (j0 + jp) * PB + t * 2) = (bf16)(pbh & 0xffffu); *(LAS bf16*)(lds + RW_S(6) + (j0 + jp + 1) * PB + t * 2) = (bf16)(pbh >> 16);
            *(LAS bf16*)(lds + RW_S(7) + (j0 + jp) * PB + t * 2) = (bf16)(pkh & 0xffffu); *(LAS bf16*)(lds + RW_S(7) + (j0 + jp + 1) * PB + t * 2) = (bf16)(pkh >> 16);
            g1w[jp >> 1] = pk2(g1[0], g1[1]); g0w[jp >> 1] = pk2(g0[0], g0[1]);
        }
        if (t == 63) {
            const f32x4 t0 = *(const LAS f32x4*)(WPRE + fsw(63, j0)), t1 = *(const LAS f32x4*)(WPRE + fsw(63, j0 + 4));
            *(f32x4*)(wl_out + j0) = (f32x4){__builtin_amdgcn_exp2f(t0[0]), __builtin_amdgcn_exp2f(t0[1]), __builtin_amdgcn_exp2f(t0[2]), __builtin_amdgcn_exp2f(t0[3])}; *(f32x4*)(wl_out + j0 + 4) = (f32x4){__builtin_amdgcn_exp2f(t1[0]), __builtin_amdgcn_exp2f(t1[1]), __builtin_amdgcn_exp2f(t1[2]), __builtin_amdgcn_exp2f(t1[3])}; }
        { const int rt = t >> 4, nt_ = j0 >> 4, ql = (((j0 & 15) >> 2) << 4) + (t & 15);
          *(u32x2*)(gout + 32768 + xo_acc(rt, nt_, ql)) = (u32x2){g1w[0], g1w[1]}; *(u32x2*)(gout + 32768 + xo_acc(rt, nt_, ql + 16)) = (u32x2){g1w[2], g1w[3]};
          *(u32x2*)(gout + 40960 + xo_acc(rt, nt_, ql)) = (u32x2){g0w[0], g0w[1]}; *(u32x2*)(gout + 40960 + xo_acc(rt, nt_, ql + 16)) = (u32x2){g0w[2], g0w[3]}; }
    }
    RW_BAR(); R1_STAMP(4);
    {
        const int mi = w >> 1;
        const LAS unsigned char* X = lds + RW_S(mi < 2 ? 0 : 1); const LAS unsigned char* Y = lds + RW_S((mi & 1) ? 3 : 2);
        LAS unsigned char* dst = lds + (mi == 0 ? O_P0 : mi == 1 ? O_AAK : mi == 2 ? O_ARB : O_ARK);
        const bool incl = mi >= 2;
        const int lim_off = incl ? 0 : 1;
#pragma unroll
        for (int q = 0; q < 2; ++q) { const int mt = 2 * (w & 1) + q; const int m = 16 * mt + (lane & 15), lim = m - lim_off;
            f32x4 ac4[4];
#pragma unroll
            for (int nt = 0; nt < 4; ++nt) ac4[nt] = (f32x4){0.f, 0.f, 0.f, 0.f};
            tile_row<2>(ac4, X, PB, 16 * mt, Y, PB, lane);
#pragma unroll
            for (int nt = 0; nt < 4; ++nt) { f32x4 acc = ac4[nt];
                const int n0 = 16 * nt + 4 * (lane >> 4);
#pragma unroll
                for (int i = 0; i < 4; ++i) acc[i] = (n0 + i <= lim) ? acc[i] : 0.f;
                st_rm(dst, PB, m, n0, acc);
                if (mi == 0) st_tr(lds + O_P0T, PB, m, n0, acc); } }
    }
    RW_BAR(); R1_STAMP(5);
    {
        f32x4 T[4];
        const int wr = w & 3, m = 16 * wr + (lane & 15);
        LAS unsigned char* Trm = lds + RW_S(8);
        if (w < 4) {
#pragma unroll
            for (int nt = 0; nt < 4; ++nt) { const int n0 = 16 * nt + 4 * (lane >> 4); T[nt] = ld_rm(lds + O_P0, PB, m, n0);
#pragma unroll
                for (int i = 0; i < 4; ++i) if (n0 + i == m) T[nt][i] += 1.f;
                st_rm(Trm, PB, m, n0, T[nt]); }
            { f32x4 ac4[4];
#pragma unroll
              for (int nt = 0; nt < 4; ++nt) ac4[nt] = (f32x4){0.f, 0.f, 0.f, 0.f};
              tile_row<2>(ac4, lds + RW_S(5), PB, 16 * wr, lds + O_AAK, PB, lane);
#pragma unroll
              for (int nt = 0; nt < 4; ++nt) st_rm(lds + RW_S(0), PB, m, 16 * nt + 4 * (lane >> 4), ac4[nt]); }
        } else {
            { f32x4 ac4[4];
#pragma unroll
              for (int nt = 0; nt < 4; ++nt) ac4[nt] = (f32x4){0.f, 0.f, 0.f, 0.f};
              tile_row<2>(ac4, lds + O_P0, PB, 16 * wr, lds + O_P0T, PB, lane);
#pragma unroll
              for (int nt = 0; nt < 4; ++nt) { const int n0 = 16 * nt + 4 * (lane >> 4); st_rm(lds + RW_S(2), PB, m, n0, ac4[nt]); st_tr(lds + RW_S(3), PB, m, n0, ac4[nt]); } }
        }
        RW_BAR();
#pragma unroll 1
        for (int s = 1; s <= 5; ++s) {
            const int cb = s & 1;
            const LAS unsigned char* Pc = lds + (cb ? RW_S(2) : O_P0); const LAS unsigned char* PcT = lds + (cb ? RW_S(3) : O_P0T);
            LAS unsigned char* Pn = lds + (cb ? O_P0 : RW_S(2)); LAS unsigned char* PnT = lds + (cb ? O_P0T : RW_S(3));
            if (w < 4) {
                f32x4 d[4];
#pragma unroll
                for (int nt = 0; nt < 4; ++nt) d[nt] = (f32x4){0.f, 0.f, 0.f, 0.f};
                tile_row<2>(d, Trm, PB, 16 * wr, PcT, PB, lane);
                LDS_WAIT();
#pragma unroll
                for (int nt = 0; nt < 4; ++nt) { T[nt] += d[nt]; st_rm(Trm, PB, m, 16 * nt + 4 * (lane >> 4), T[nt]); }
            } else if (s < 5) {
                f32x4 d4[4];
#pragma unroll
                for (int nt = 0; nt < 4; ++nt) d4[nt] = (f32x4){0.f, 0.f, 0.f, 0.f};
                tile_row<2>(d4, Pc, PB, 16 * wr, PcT, PB, lane);
#pragma unroll
                for (int nt = 0; nt < 4; ++nt) { const int n0 = 16 * nt + 4 * (lane >> 4); st_rm(Pn, PB, m, n0, d4[nt]); st_tr(PnT, PB, m, n0, d4[nt]); }
            }
            RW_BAR();
        }
    }
    R1_STAMP(6);
    {
        const LAS unsigned char* Z = lds + (w < 4 ? RW_S(4) : RW_S(0)); const int zr0 = 16 * (w & 3);
        f32x4 acc[4];
#pragma unroll
        for (int nt = 0; nt < 4; ++nt) acc[nt] = (f32x4){0.f, 0.f, 0.f, 0.f};
        tile_row<2>(acc, Z, PB, zr0, lds + RW_S(8), PB, lane);
#pragma unroll
        for (int nt = 0; nt < 4; ++nt) st_rm(lds + RW_S(2), PB, 16 * w + (lane & 15), 16 * nt + 4 * (lane >> 4), acc[nt]);
    }
    RW_BAR(); R1_STAMP(7);
    {
        const int job = w >> 1;
        const LAS unsigned char* XTt = lds + RW_S(2); const LAS unsigned char* XTb = lds + RW_S(2) + 64 * PB;
#pragma unroll
        for (int q = 0; q < 2; ++q) { const int mt = 2 * (w & 1) + q; const int m = 16 * mt + (lane & 15);
            f32x4 ac4[4];
#pragma unroll
            for (int nt = 0; nt < 4; ++nt) ac4[nt] = (job == 0) ? ld_rm(lds + RW_S(1), PB, m, 16 * nt + 4 * (lane >> 4)) : (f32x4){0.f, 0.f, 0.f, 0.f};
            if (job == 0) tile_row<2>(ac4, lds + O_ARB, PB, 16 * mt, XTt, PB, lane);
            else if (job == 1) { tile_row<2>(ac4, lds + O_ARB, PB, 16 * mt, XTb, PB, lane); tile_row<2>(ac4, lds + O_ARK, PB, 16 * mt, lds + RW_S(5), PB, lane); }
            else if (job == 2) tile_row<2>(ac4, lds + RW_S(6), PB, 16 * mt, XTt, PB, lane);
            else { tile_row<2>(ac4, XTb, PB, 16 * mt, lds + RW_S(6), PB, lane); tile_row<2>(ac4, lds + RW_S(5), PB, 16 * mt, lds + RW_S(7), PB, lane); }
#pragma unroll
            for (int nt = 0; nt < 4; ++nt) { const f32x4 acc = ac4[nt];
                u32x2 o; o.x = pk2(acc[0], acc[1]); o.y = pk2(acc[2], acc[3]);
                *(u32x2*)(gout + job * 8192 + (((job & 1) == 0) ? xo_frag_from_acc(mt, nt, lane) : xo_acc(mt, nt, lane))) = o; } }
    }
    RW_BAR(); R1_STAMP(8);
}

__device__ __forceinline__ void r2_unit(Frame& F, const Args& a, const int l, const int bh) {
    using namespace cfg;
    const int lane = F.lane, w = F.wave, wr = w & 3;
    LAS unsigned char* lds = F.lds;
    bf16* y = (bf16*)(F.ws + wsm::Y);
    const unsigned char* gin = F.ws + wsm::RW + (size_t)bh * 64 * UNIT_BYTES;
    const float* wlp = (const float*)(F.ws + wsm::RW + WL_OFF) + (size_t)bh * 64 * 64;
    const int b = bh >> 3, h = bh & 7;
    const int m = 16 * wr + (lane & 15), q4 = 4 * (lane >> 4);
    if (w < 4) {
        f32x4 S[4];
#pragma unroll
        for (int nt = 0; nt < 4; ++nt) { S[nt] = (f32x4){0.f, 0.f, 0.f, 0.f}; st_rm(lds, PB, m, 16 * nt + q4, S[nt]); }
        bf16x8 mtf[4][2], mtn[4][2]; u32x2 cf[4], cfn[4]; f32x4 wl[4], wln[4];
#define R2_LDS(c_, M_, C_, W_) do { const unsigned char* g_ = gin + (size_t)(c_) * UNIT_BYTES; _Pragma("unroll") for (int nt = 0; nt < 4; ++nt) { \
            _Pragma("unroll") for (int s_ = 0; s_ < 2; ++s_) M_[nt][s_] = *(const bf16x8*)(g_ + 16384 + xo_frag(nt, s_, lane)); \
            C_[nt] = *(const u32x2*)(g_ + 24576 + xo_acc(wr, nt, lane)); W_[nt] = *(const f32x4*)(wlp + (c_) * 64 + 16 * nt + q4); } } while (0)
        R2_LDS(0, mtf, cf, wl);
#define R2_STEP(c_, M_, C_, W_) do { LAS unsigned char* Scur = lds + ((c_) & 1) * SLOT; LAS unsigned char* Snxt = lds + (((c_) + 1) & 1) * SLOT; \
            RW_BAR(); \
            bf16x8 sf[2]; _Pragma("unroll") for (int s = 0; s < 2; ++s) sf[s] = ldfrag(Scur, PB, 16 * wr, lane, s); \
            _Pragma("unroll") for (int nt = 0; nt < 4; ++nt) { f32x4 acc = S[nt] * W_[nt]; \
                acc[0] += __uint_as_float(C_[nt].x << 16); acc[1] += __uint_as_float(C_[nt].x & 0xffff0000u); acc[2] += __uint_as_float(C_[nt].y << 16); acc[3] += __uint_as_float(C_[nt].y & 0xffff0000u); \
                _Pragma("unroll") for (int s = 0; s < 2; ++s) acc = __builtin_amdgcn_mfma_f32_16x16x32_bf16(M_[nt][s], sf[s], acc, 0, 0, 0); \
                S[nt] = acc; st_rm(Snxt, PB, m, 16 * nt + q4, acc); } } while (0)
#pragma unroll 1
        for (int c = 0; c < 64; c += 2) {
            R2_LDS(c + 1, mtn, cfn, wln); __builtin_amdgcn_sched_barrier(0);
            R2_STEP(c, mtf, cf, wl); __builtin_amdgcn_sched_barrier(0);
            R2_LDS(c + 2 < 63 ? c + 2 : 63, mtf, cf, wl); __builtin_amdgcn_sched_barrier(0);
            R2_STEP(c + 1, mtn, cfn, wln); __builtin_amdgcn_sched_barrier(0);
        }
#undef R2_STEP
#undef R2_LDS
    } else {
        bf16x8 rf[2], rfn[2]; u32x2 y0[4], g1[4], g0[4], y0n[4], g1n[4], g0n[4];
#define R2_LDY(c_, R_, Y_, G1_, G0_) do { const unsigned char* g_ = gin + (size_t)(c_) * UNIT_BYTES; \
            _Pragma("unroll") for (int s_ = 0; s_ < 2; ++s_) R_[s_] = *(const bf16x8*)(g_ + xo_frag(wr, s_, lane)); \
            _Pragma("unroll") for (int nt = 0; nt < 4; ++nt) { const int o_ = xo_acc(wr, nt, lane); Y_[nt] = *(const u32x2*)(g_ + 8192 + o_); G1_[nt] = *(const u32x2*)(g_ + 32768 + o_); G0_[nt] = *(const u32x2*)(g_ + 40960 + o_); } } while (0)
        R2_LDY(0, rf, y0, g1, g0);
#define R2_OUT(c_, R_, Y0_, G1_, G0_) do { LAS unsigned char* Scur = lds + ((c_) & 1) * SLOT; \
            RW_BAR(); \
            f32x4 Y[4]; float sum = 0.f; \
            _Pragma("unroll") for (int nt = 0; nt < 4; ++nt) { \
                f32x4 acc = {__uint_as_float(Y0_[nt].x << 16), __uint_as_float(Y0_[nt].x & 0xffff0000u), __uint_as_float(Y0_[nt].y << 16), __uint_as_float(Y0_[nt].y & 0xffff0000u)}; \
                _Pragma("unroll") for (int s = 0; s < 2; ++s) acc = __builtin_amdgcn_mfma_f32_16x16x32_bf16(ldfrag(Scur, PB, 16 * nt, lane, s), R_[s], acc, 0, 0, 0); \
                Y[nt] = acc; sum += (acc[0] + acc[1]) + (acc[2] + acc[3]); } \
            sum += __shfl_xor(sum, 16); sum += __shfl_xor(sum, 32); \
            const float mean = sum * (1.f / 64.f); float var = 0.f; \
            _Pragma("unroll") for (int nt = 0; nt < 4; ++nt) _Pragma("unroll") for (int i = 0; i < 4; ++i) { const float d = Y[nt][i] - mean; var += d * d; } \
            var += __shfl_xor(var, 16); var += __shfl_xor(var, 32); \
            const float rs = rsqrtf(var * (1.f / 64.f) + 64e-5f); \
            const size_t yrow = ((size_t)b * SEQ + (c_) * 64 + m) * D + h * 64; \
            _Pragma("unroll") for (int nt = 0; nt < 4; ++nt) { \
                const f32x4 a1 = {__uint_as_float(G1_[nt].x << 16), __uint_as_float(G1_[nt].x & 0xffff0000u), __uint_as_float(G1_[nt].y << 16), __uint_as_float(G1_[nt].y & 0xffff0000u)}; \
                const f32x4 a0 = {__uint_as_float(G0_[nt].x << 16), __uint_as_float(G0_[nt].x & 0xffff0000u), __uint_as_float(G0_[nt].y << 16), __uint_as_float(G0_[nt].y & 0xffff0000u)}; \
                const f32x4 o = (Y[nt] - mean) * rs * a1 + a0; \
                if (F8OUT(l)) *(unsigned*)((unsigned char*)y + yrow + 16 * nt + q4) = pk4_fp8(o[0] * F8_Y, o[1] * F8_Y, o[2] * F8_Y, o[3] * F8_Y); \
                else { u32x2 ow; ow.x = pk2(o[0], o[1]); ow.y = pk2(o[2], o[3]); *(u32x2*)(y + yrow + 16 * nt + q4) = ow; } } } while (0)
#pragma unroll 1
        for (int c = 0; c < 64; c += 2) {
            R2_LDY(c + 1, rfn, y0n, g1n, g0n); __builtin_amdgcn_sched_barrier(0);
            R2_OUT(c, rf, y0, g1, g0); __builtin_amdgcn_sched_barrier(0);
            R2_LDY(c + 2 < 63 ? c + 2 : 63, rf, y0, g1, g0); __builtin_amdgcn_sched_barrier(0);
            R2_OUT(c + 1, rfn, y0n, g1n, g0n); __builtin_amdgcn_sched_barrier(0);
        }
#undef R2_OUT
#undef R2_LDY
    }
    RW_BAR();
}
}
struct MoeOrder {
    const LAS int* pref; int G, c, npn, mode;
    const char* A; const char* B; const int* lists; const float* wl; int esz;
    __device__ __forceinline__ bool next(int i, pg8::Unit& u) const {
        const int total = __builtin_amdgcn_readfirstlane(pref[32]) * npn;
        const long L = (long)i * G + c; if (L >= total) return false;
        int wgid = (int)L; { const int q = total / 8, r = total % 8, xcd = wgid % 8, off = wgid / 8; wgid = (xcd < r ? xcd * (q + 1) : r * (q + 1) + (xcd - r) * q) + off; }
        const int panel = wgid / npn, pn = wgid % npn;
        int e = 0;
        for (int k = 1; k < 32; ++k) { const int pk = __builtin_amdgcn_readfirstlane(pref[k]); if (pk <= panel) e = k; }
        const int tl = panel - __builtin_amdgcn_readfirstlane(pref[e]);
        u.pm = panel; u.pn = pn;
        if (mode == 0) { u.a = A; u.b = B + ((size_t)e * 512 + (size_t)pn * 256) * 2048 * esz; u.rows = lists + e * LCAP + tl * 256; const int rem = __builtin_amdgcn_readfirstlane(pref[40 + e]) - tl * 256; u.nvalid = rem < 256 ? rem : 256; u.wrow = wl + e * LCAP + tl * 256; }
        else { u.a = A + (size_t)panel * 256 * 256 * esz; u.b = B + ((size_t)e * 2048 + (size_t)pn * 256) * 256 * esz; u.rows = nullptr; u.nvalid = 256; u.wrow = nullptr; }
        return true;
    }
};

#define IN(k) (lo <= (k) && (k) < hi)
#define SEAM(k) do { if (IN(k) && IN((k) + 1)) xcd_barrier(bar); } while (0)
#ifndef DUP_PHASE
#define DUP_PHASE -1
#endif
template <int l> __device__ __forceinline__ void ph_n1(Frame& F, const Args& args) {
    using namespace cfg; float* xo = args.out; const float* xin = (l == 0) ? args.in[0] : xo;
    convert_phase(F, args, l);
    build_attn_tables(F, args, l);
    if (l == 0) norm_phase<false, false, false, F8IN(l)>(F, args, xin, nullptr, args.in[3] + l * D, l, l);
    else { build_pref(F, l - 1); norm_phase<true, false, false, F8IN(l), true>(F, args, xin, xo, args.in[3] + l * D, l, l); }
}
template <int l> __device__ __forceinline__ void ph_g1(Frame& F, const Args& args) {
    using namespace cfg;
    constexpr int ESZ = F8IN(l) ? 1 : 2;
    pg8::StaticOrder S; S.init(F.ws + wsm::XN, F.ws + wsm::W_IN, M, INC, D, F.G, (int)blockIdx.x, ESZ);
    pg8::EpiBf16 E{(bf16*)(F.ws + wsm::P), INC, ESZ == 1 ? pg8::F8_INV : 1.f};
    pg8::gemm_phase<pg8::EpiBf16, pg8::StaticOrder, false, ESZ>(F.lds, D, S, E);
}
template <int l> __device__ __forceinline__ void ph_m1(Frame& F, const Args& args, const XcdBarrier& bar, unsigned long long& racc) {
    rw::lora_prepass(F, args, l);
    xcd_barrier(bar);
    { int hcur = -1; rw::R1Raw raw; rw::R1W W;
      auto unit_of = [&](int i) { return (F.G == 256) ? ((F.vcu >> 2) << 6) + ((F.vcu & 3) << 4) + i : F.vcu + i * F.G; };
      if (unit_of(0) < 4096) rw::r1_load(F, unit_of(0), raw, F.tid);
      for (int i = 0; unit_of(i) < 4096 && i * F.G < 4096; ++i) { const int u = unit_of(i); const int un = ((i + 1) * F.G < 4096 && unit_of(i + 1) < 4096) ? unit_of(i + 1) : u; rw::r1_unit(F, args, l, u, un, raw, W, racc, hcur); } }

    for (int u = F.vcu; u < 1024; u += F.G) { const int b = u >> 7, hh = (u >> 4) & 7, qb = ((u & 15) + (u >> 8) * 4) & 15; att::attn_unit<0>(F, args, l, b, hh, qb); }
    if (DUP_PHASE == 21 + 100 * l) { for (int u = F.vcu; u < 1024; u += F.G) { const int b = u >> 7, hh = (u >> 4) & 7, qb = ((u & 15) + (u >> 8) * 4) & 15; att::attn_unit<0>(F, args, l, b, hh, qb); } }
    att::conv_items(F, args, l, F.vcu * 512 + F.tid, F.G * 512);
    if (DUP_PHASE == 22 + 100 * l) att::conv_items(F, args, l, F.vcu * 512 + F.tid, F.G * 512);
}
template <int l> __device__ __forceinline__ void ph_m2(Frame& F, const Args& args) {
    for (;;) { const int it = grab(F, l); if (it >= 64 + 512) break;
        int t_ = F.tid; asm volatile("" : "+v"(t_)); F.tid = t_; F.lane = t_ & 63;
        if (it < 64) rw::r2_unit(F, args, l, it);
        else { const int j = it - 64, qb = 15 - (j >> 5), b = (j & 31) >> 2, hh = j & 3; att::attn_unit<1>(F, args, l, b, hh, qb); } }
    if (DUP_PHASE == 8 * l + 3) { __syncthreads();
    for (;;) { const int it = grab(F, l + 2); if (it >= 64 + 512) break;
        if (it < 64) rw::r2_unit(F, args, l, it);
        else { const int j = it - 64, qb = 15 - (j >> 5), b = (j & 31) >> 2, hh = j & 3; att::attn_unit<1>(F, args, l, b, hh, qb); } } }
    if (DUP_PHASE == 30 + 100 * l) { if (F.vcu < 64) rw::r2_unit(F, args, l, F.vcu); }
    if (DUP_PHASE == 31 + 100 * l) { for (int u = F.vcu; u < 512; u += F.G) { const int b = u >> 6, hh = (u >> 4) & 3, qb = (u < 256) ? (u & 15) : 15 - (u & 15); att::attn_unit<1>(F, args, l, b, hh, qb); } }
}
template <int l> __device__ __forceinline__ void ph_g2(Frame& F, const Args& args) {
    using namespace cfg;
    constexpr int ESZ = F8OUT(l) ? 1 : 2;
    pg8::StaticOrder S; S.init(F.ws + wsm::Y, F.ws + wsm::W_OUT, M, D, D, F.G, (int)blockIdx.x, ESZ);
    const void* xin = (l == 0) ? (const void*)args.in[0] : (const void*)args.out;
    bf16* xo = (l == 0) ? (bf16*)args.out : (bf16*)(F.ws + wsm::XB2);
    pg8::EpiRes<l != 0> E{xin, xo, D, ESZ == 1 ? 1.f / (F8_Y * pg8::F8_WGT) : 1.f};
    pg8::gemm_phase<pg8::EpiRes<l != 0>, pg8::StaticOrder, false, ESZ>(F.lds, D, S, E);
}
template <int l> __device__ __forceinline__ void ph_n2(Frame& F, const Args& args) { using namespace cfg;
    const float* xs = (l == 0) ? (const float*)args.out : (const float*)(F.ws + wsm::XB2);
    norm_phase<false, true, false, ((F8_MOE_MASK >> l) & 1) != 0, true>(F, args, xs, nullptr, args.in[4] + l * D, l, l); }
template <int l> __device__ __forceinline__ void ph_e1(Frame& F, const Args& args) {
    using namespace cfg;
    build_pref(F, l);
    constexpr int ESZ = ((F8_MOE_MASK >> l) & 1) ? 1 : 2;
    MoeOrder S{(const LAS int*)(F.lds + TAB_OFF), F.G, (int)blockIdx.x, 2, 0, (const char*)(F.ws + wsm::XN), (const char*)(F.ws + wsm::W_GU + (size_t)l * WGU_LSTRIDE), (const int*)(F.ws + wsm::LISTS), (const float*)(F.ws + wsm::WLIST), ESZ};
    pg8::EpiSilu E{(bf16*)(F.ws + wsm::HB), ESZ == 1 ? pg8::F8_INV : 1.f, F8_DOWN ? F8_H : 0.f};
    pg8::gemm_phase<pg8::EpiSilu, MoeOrder, true, ESZ>(F.lds, D, S, E);
}
template <int l> __device__ __forceinline__ void ph_e2(Frame& F, const Args& args) {
    using namespace cfg;
    build_pref(F, l);
    constexpr int ESZ = F8_DOWN ? 1 : 2;
    MoeOrder S{(const LAS int*)(F.lds + TAB_OFF), F.G, (int)blockIdx.x, 8, 1, (const char*)(F.ws + wsm::HB), (const char*)(F.ws + wsm::W_D + (size_t)l * WD_LSTRIDE), nullptr, nullptr, ESZ};
    pg8::EpiF8 E{F.ws + wsm::OB, D, F8_DOWN ? F8_OB / (F8_H * pg8::F8_WGT) : F8_OB};
    pg8::gemm_phase<pg8::EpiF8, MoeOrder, false, ESZ>(F.lds, EH, S, E);
}
#ifndef PROBE_T
#define PROBE_T -1
#endif
#define RUNPH(k, call) do { if (PROBE_T == (k)) pt0 = __builtin_amdgcn_s_memrealtime(); RUNPH_(k, call); if (PROBE_T == (k)) pt1 = __builtin_amdgcn_s_memrealtime(); } while (0)
#define RUNPH_(k, call) do { if (IN(k)) { call; if (DUP_PHASE == (k) && ((k) & 7) != 3 && ((k) & 7) != 5) { __syncthreads(); call; } } SEAM(k); } while (0)
template <int l>
__device__ __forceinline__ void layer_phases(Frame& F, const Args& args, const XcdBarrier& bar, const int lo, const int hi, unsigned long long& pt0, unsigned long long& pt1) {
    constexpr int pb = 8 * l;
    RUNPH(pb + 0, ph_n1<l>(F, args));
    RUNPH(pb + 1, { ph_g1<l>(F, args); if (l == 0) help_convert(F, args, 9, false); });
    { unsigned long long racc = 0; RUNPH(pb + 2, ph_m1<l>(F, args, bar, racc)); if (PROBE_R1 >= 0 && l == 0) { pt0 = 0; pt1 = racc; } }
    RUNPH(pb + 3, ph_m2<l>(F, args));
    RUNPH(pb + 4, ph_g2<l>(F, args));
    RUNPH(pb + 5, ph_n2<l>(F, args));
    RUNPH(pb + 6, { ph_e1<l>(F, args); if (l == 0) help_convert(F, args, 10, true); });
    RUNPH(pb + 7, { ph_e2<l>(F, args); if (l == 0) help_convert(F, args, 11, true); });
}
__global__ void __launch_bounds__(512, 2) mk_fwd(Args args) {
    extern __shared__ __attribute__((aligned(16))) unsigned char lds_raw[];
    using namespace cfg;
    Frame F;
    F.lds = (LAS unsigned char*)lds_raw; F.ws = args.ws; F.ctl = (unsigned*)(args.ws + wsm::CTL);
    F.tid = threadIdx.x; F.lane = F.tid & 63; F.wave = __builtin_amdgcn_readfirstlane(F.tid >> 6);
    F.pacc = 0ull;
    F.G = gridDim.x; { const int bx = blockIdx.x; F.vcu = (F.G % 8 == 0) ? (bx % 8) * (F.G / 8) + bx / 8 : bx; }
    volatile LAS unsigned* MISC = (volatile LAS unsigned*)(F.lds + MISC_OFF);
    for (int u = F.tid; u < (LDS_BYTES - RING_BYTES) / 4; u += 512) ((LAS unsigned*)(F.lds + RING_BYTES))[u] = 0u;
    __syncthreads();
    const int lo = args.ph_lo, hi = args.ph_hi;
    XcdBarrier bar; bar.bar = F.ctl + wsm::CW_BAR; bar.x = 0; bar.st = nullptr;
    if (hi - lo > 1) bar = xcd_barrier_post(F.ctl + wsm::CW_BAR, MISC + 8);
    float* xo = args.out;
    unsigned long long pt0 = 0, pt1 = 0;
    layer_phases<0>(F, args, bar, lo, hi, pt0, pt1);
    layer_phases<1>(F, args, bar, lo, hi, pt0, pt1);
    if (PROBE_T == 16) pt0 = __builtin_amdgcn_s_memrealtime();
    if (IN(16)) {
        build_pref(F, NL - 1); norm_phase<true, false, true, false, true>(F, args, (const float*)(F.ws + wsm::XB2), xo, args.in[5], 0, 0);
    }
    if (PROBE_T == 16) pt1 = __builtin_amdgcn_s_memrealtime();
    if (PROBE_ATT >= 0 && blockIdx.x == 0 && F.tid == 448) { const unsigned long long te = __builtin_amdgcn_s_memrealtime(); while (__builtin_amdgcn_s_memrealtime() - te < 4ull * F.pacc) __builtin_amdgcn_s_sleep(8); }
    if ((PROBE_T >= 0 || PROBE_R1 >= 0) && blockIdx.x == 0 && F.tid == 0) { const unsigned long long te = __builtin_amdgcn_s_memrealtime(); while (__builtin_amdgcn_s_memrealtime() - te < 4ull * (pt1 - pt0)) __builtin_amdgcn_s_sleep(8); }
#undef IN
#undef SEAM
}
extern "C" void kernel_launch(void* const* d_in, const int* in_sizes, int n_in, void* d_out, int out_size, void* d_ws, size_t ws_size, hipStream_t stream) {
    using namespace cfg;
    static int grid = 0;
    if (grid == 0) {
        if (n_in != 32 || ws_size < wsm::END || out_size != M * D) { fprintf(stderr, "kernel_launch: bad args n_in=%d ws=%zu out=%d\n", n_in, ws_size, out_size); grid = -1; return; }
        int dev = 0, cus = 0;
        if (hipGetDevice(&dev) != hipSuccess || hipDeviceGetAttribute(&cus, hipDeviceAttributeMultiprocessorCount, dev) != hipSuccess) { grid = -1; return; }
        if (hipFuncSetAttribute((const void*)mk_fwd, hipFuncAttributeMaxDynamicSharedMemorySize, LDS_BYTES) != hipSuccess) { fprintf(stderr, "hipFuncSetAttribute failed\n"); grid = -1; return; }
        int per_cu = 0;
        if (hipOccupancyMaxActiveBlocksPerMultiprocessor(&per_cu, (const void*)mk_fwd, 512, LDS_BYTES) != hipSuccess || per_cu < 1) fprintf(stderr, "kernel_launch: occupancy query says %d\n", per_cu);
        (void)hipGetLastError();
        grid = cus;
    }
    if (grid < 0) return;
    unsigned char* w = (unsigned char*)d_ws;
    if (hipMemsetAsync(w + wsm::CTL, 0, wsm::CTL_ZERO_BYTES, stream) != hipSuccess) return;
    Args a{};
    for (int i = 0; i < 32; ++i) a.in[i] = (const float*)d_in[i];
    a.out = (float*)d_out; a.ws = w; a.flags = 7; a.ph_lo = 0; a.ph_hi = 17;
    hipLaunchKernelGGL(mk_fwd, dim3(grid), dim3(512), LDS_BYTES, stream, a);
}
```
